# Optimizing an MI355X kernel written in HIP

```python
import jax
import jax.numpy as jnp
from jax import lax
import numpy as np

D_MODEL = 2048
BATCH = 2
SEQ = 4096
DEPTH = 4

GRID_W = 64
CTX_LEN = 256
MIX_W = 512
N_BRANCH = 4
CONV_K = 31
ML_HEADS = 4
ML_DH = 128
GD_HEADS = 4
GD_DH = 128
GD_CONV_K = 5
RW_HEADS = 8
RW_DH = 64
RW_DECAY_LORA = 96
RW_ICLR_LORA = 96
RW_GATE_LORA = 256
RW_MIX = 3 * MIX_W + RW_DECAY_LORA + RW_ICLR_LORA + RW_GATE_LORA
CHUNK = 64
D_FF = 5632
FFN_K = 3
NORM_EPS = 1e-6
GN_EPS = 64e-5
IN_SIZES = (2 * MIX_W, 3 * MIX_W, MIX_W, 4 * ML_HEADS, 3 * MIX_W, MIX_W, 4 * GD_HEADS, RW_MIX, N_BRANCH * D_MODEL)
N_IN = 2 * MIX_W + 3 * MIX_W + MIX_W + 4 * ML_HEADS + 3 * MIX_W + MIX_W + 4 * GD_HEADS + RW_MIX + N_BRANCH * D_MODEL

kernel_name = "hybrid_parallel_gated_mixer_dit"

F32 = jnp.float32


def rms_norm(x, g):
    xf = x.astype(F32)
    y = xf * lax.rsqrt(jnp.mean(xf * xf, axis=-1, keepdims=True) + NORM_EPS)
    return (y * g.astype(F32)).astype(x.dtype)


def layer_norm(x, g, b, eps):
    xf = x.astype(F32)
    mu = jnp.mean(xf, axis=-1, keepdims=True)
    var = jnp.mean(jnp.square(xf - mu), axis=-1, keepdims=True)
    y = (xf - mu) * lax.rsqrt(var + eps)
    return (y * g.astype(F32) + b.astype(F32)).astype(x.dtype)


def l2_normalize(x):
    return x * lax.rsqrt(jnp.sum(x * x, axis=-1, keepdims=True) + 1e-6)


def modulate(h, shift, scale):
    return h * (1 + scale) + shift


def dwconv1d(x, w):
    k = w.shape[0]
    return lax.conv_general_dilated(x, w.astype(x.dtype)[:, None, :], (1,), [(k // 2, k // 2)],
                                    dimension_numbers=('NWC', 'WIO', 'NWC'), feature_group_count=x.shape[-1])


def dwconv2d_grid(x, w):
    b, t, ch = x.shape
    k = w.shape[0]
    xg = x.reshape(b, t // GRID_W, GRID_W, ch)
    y = lax.conv_general_dilated(xg, w.astype(x.dtype)[:, :, None, :], (1, 1), [(k // 2, k // 2)] * 2,
                                 dimension_numbers=('NHWC', 'HWIO', 'NHWC'), feature_group_count=ch)
    return y.reshape(b, t, ch)


def token_shift_mix(x, mu):
    prev = jnp.pad(x[:, :-1], ((0, 0), (1, 0), (0, 0)))
    nxt = jnp.pad(x[:, 1:], ((0, 0), (0, 1), (0, 0)))
    return x + mu[0] * (prev - x) + mu[1] * (nxt - x)


def dir_stack(fwd, bwd):
    return jnp.concatenate([fwd, jnp.flip(bwd, 1)], axis=0)


def dir_merge(y):
    n = y.shape[0] // 2
    return y[:n] + jnp.flip(y[n:], 1)


def to_chunks(a):
    g, t = a.shape[:2]
    a = a.reshape(g, t // CHUNK, CHUNK, *a.shape[2:])
    return jnp.moveaxis(jnp.moveaxis(a, 1, 0), 3, 2)


def from_chunks(a):
    a = jnp.moveaxis(jnp.moveaxis(a, 0, 1), 3, 2)
    return a.reshape(a.shape[0], a.shape[1] * a.shape[2], *a.shape[3:])


def split_cols(z):
    idx = [int(i) for i in np.cumsum(IN_SIZES)[:-1]]
    return jnp.split(z, idx, axis=-1)


def conv_module(u, p):
    a, gte = jnp.split(u, 2, axis=-1)
    y = a * jax.nn.sigmoid(gte)
    y = dwconv1d(y, p['conv_dw']) + p['conv_b']
    y = layer_norm(y, p['conv_ln_g'], p['conv_ln_b'], NORM_EPS)
    return jax.nn.silu(y)


def mlstm_inputs(qkv, gates, gate_b):
    b, t, _ = qkv.shape
    q, k, v = jnp.split(qkv.astype(F32), 3, axis=-1)
    heads = lambda a: a.reshape(b, t, ML_HEADS, ML_DH)
    q, k, v = heads(q) * (ML_DH ** -0.5), heads(k), heads(v)
    g = gates.astype(F32).reshape(b, t, 2, 2, ML_HEADS) + gate_b.astype(F32)
    li = g[:, :, :, 0]
    lf = jax.nn.log_sigmoid(g[:, :, :, 1])
    return (dir_stack(q, q), dir_stack(k, k), dir_stack(v, v),
            dir_stack(li[:, :, 0], li[:, :, 1]), dir_stack(lf[:, :, 0], lf[:, :, 1]))


def mlstm_scan(q, k, v, li, lf, state):
    qc, kc, vc = to_chunks(q), to_chunks(k), to_chunks(v)
    lic = to_chunks(li)
    bc = jnp.cumsum(to_chunks(lf), axis=-1)
    tri = jnp.tril(jnp.ones((CHUNK, CHUNK), dtype=bool))

    def step(carry, inp):
        C, n, m = carry
        qt, kt, vt, it, bt = inp
        dlog = jnp.where(tri, bt[..., :, None] - bt[..., None, :] + it[..., None, :], -jnp.inf)
        inter = bt + m[..., None]
        mt = jnp.maximum(inter, jnp.max(dlog, axis=-1))
        dw = jnp.exp(dlog - mt[..., None])
        iw = jnp.exp(inter - mt)
        s = jnp.einsum('ghtd,ghsd->ghts', qt, kt) * dw
        num = iw[..., None] * jnp.einsum('ghtd,ghde->ghte', qt, C) + jnp.einsum('ghts,ghse->ghte', s, vt)
        den = iw * jnp.einsum('ghtd,ghd->ght', qt, n) + jnp.sum(s, axis=-1)
        h = num / jnp.maximum(jnp.abs(den), jnp.exp(-mt))[..., None]
        bl = bt[..., -1]
        wlog = bl[..., None] - bt + it
        m_new = jnp.maximum(bl + m, jnp.max(wlog, axis=-1))
        sw = jnp.exp(wlog - m_new[..., None])
        dec = jnp.exp(bl + m - m_new)
        C_new = dec[..., None, None] * C + jnp.einsum('ghs,ghsd,ghse->ghde', sw, kt, vt)
        n_new = dec[..., None] * n + jnp.einsum('ghs,ghsd->ghd', sw, kt)
        return (C_new, n_new, m_new), h

    state, h = lax.scan(step, state, (qc, kc, vc, lic, bc))
    return from_chunks(h), state


def mlstm_out(h, o_cols, norm_g):
    h = dir_merge(h)
    h = rms_norm(h, norm_g.reshape(ML_HEADS, ML_DH))
    return h.reshape(*h.shape[:2], -1) * jax.nn.sigmoid(o_cols.astype(F32))


def gdn_inputs(qkv, ab, conv_w, a_log, dt_bias):
    b, t, _ = qkv.shape
    y = jax.nn.silu(dwconv1d(qkv, conv_w)).astype(F32)
    q, k, v = jnp.split(y, 3, axis=-1)
    heads = lambda a: a.reshape(b, t, GD_HEADS, GD_DH)
    q = l2_normalize(heads(q)) * (GD_DH ** -0.5)
    k = l2_normalize(heads(k))
    v = heads(v)
    ab = ab.astype(F32).reshape(b, t, 2, 2, GD_HEADS)
    lg = -jnp.exp(a_log.astype(F32)) * jax.nn.softplus(ab[:, :, :, 0] + dt_bias.astype(F32))
    beta = jax.nn.sigmoid(ab[:, :, :, 1])
    return (dir_stack(q, q), dir_stack(k, k), dir_stack(v, v),
            dir_stack(lg[:, :, 0], lg[:, :, 1]), dir_stack(beta[:, :, 0], beta[:, :, 1]))


def gdn_scan(q, k, v, lg, beta, S):
    qc, kc, vc = to_chunks(q), to_chunks(k), to_chunks(v)
    gc = jnp.cumsum(to_chunks(lg), axis=-1)
    bc = to_chunks(beta)
    tri = jnp.tril(jnp.ones((CHUNK, CHUNK), dtype=bool))
    strict = jnp.tril(jnp.ones((CHUNK, CHUNK), dtype=bool), k=-1)
    dec = jnp.exp(jnp.where(tri, gc[..., :, None] - gc[..., None, :], -jnp.inf))
    kb = kc * bc[..., None]
    kkt = jnp.where(strict, jnp.einsum('nghtd,nghsd->nghts', kb, kc) * dec, 0.0)
    amat = kkt + jnp.eye(CHUNK, dtype=kkt.dtype)
    dv = vc.shape[-1]
    rhs = jnp.concatenate([vc * bc[..., None], kb * jnp.exp(gc)[..., None]], axis=-1)
    sol = lax.linalg.triangular_solve(amat, rhs, left_side=True, lower=True, unit_diagonal=True)
    u, w = sol[..., :dv], sol[..., dv:]
    attn = jnp.einsum('nghtd,nghsd->nghts', qc, kc) * dec
    qd = qc * jnp.exp(gc)[..., None]
    gl = gc[..., -1]
    kd = kc * jnp.exp(gl[..., None] - gc)[..., None]

    def step(S, inp):
        ut, wt, at, qt, kt, glt = inp
        vnew = ut - jnp.einsum('ghld,ghde->ghle', wt, S)
        o = jnp.einsum('ghld,ghde->ghle', qt, S) + jnp.einsum('ghts,ghse->ghte', at, vnew)
        S = S * jnp.exp(glt)[..., None, None] + jnp.einsum('ghld,ghle->ghde', kt, vnew)
        return S, o

    S, o = lax.scan(step, S, (u, w, attn, qd, kd, gl))
    return from_chunks(o), S


def gdn_out(o, z, norm_g):
    o = dir_merge(o)
    o = rms_norm(o, norm_g.reshape(GD_HEADS, GD_DH))
    return o.reshape(*o.shape[:2], -1) * jax.nn.silu(z.astype(F32))


def rwkv_inputs(feat, p):
    f = token_shift_mix(feat, p['rw_mu']).astype(F32)
    idx = [int(i) for i in np.cumsum([MIX_W, MIX_W, MIX_W, RW_DECAY_LORA, RW_ICLR_LORA])]
    r, k, v, xw, xa, xg = jnp.split(f, idx, axis=-1)
    heads = lambda a: a.reshape(*a.shape[:-1], RW_HEADS, RW_DH)
    wl = p['rw_w0'] + jnp.einsum('btr,nrw->btnw', jnp.tanh(xw), p['rw_w2'])
    decay = jnp.exp(-jnp.exp(-jax.nn.softplus(-wl) - 0.5))
    iclr = jax.nn.sigmoid(p['rw_a0'] + jnp.einsum('btr,nrw->btnw', xa, p['rw_a2']))
    g = jax.nn.sigmoid(xg) @ p['rw_g2']
    kk = l2_normalize(heads(k * p['rw_kk']))
    kmod = heads(k[:, :, None] * (1 + (iclr - 1) * p['rw_ka']))
    r_h, v_h = heads(r), heads(v)
    b_vec = kk[:, :, None] * heads(iclr)
    dec_h = heads(decay)
    bonus = jnp.sum(r_h[:, :, None] * kmod * p['rw_rk'], axis=(2, 4))
    scan_in = (dir_stack(r_h, r_h), dir_stack(dec_h[:, :, 0], dec_h[:, :, 1]),
               dir_stack(kmod[:, :, 0], kmod[:, :, 1]), dir_stack(v_h, v_h),
               dir_stack(-kk, -kk), dir_stack(b_vec[:, :, 0], b_vec[:, :, 1]))
    return scan_in, (bonus[..., None] * v_h, g)


def rwkv_scan(r, w, k, v, a, b, S):
    def step(S, inp):
        rt, wt, kt, vt, at, bt = inp
        sa = jnp.einsum('ghij,ghj->ghi', S, at)
        S = S * wt[:, :, None, :] + sa[..., None] * bt[:, :, None, :] + vt[..., None] * kt[:, :, None, :]
        return S, jnp.einsum('ghij,ghj->ghi', S, rt)

    xs = tuple(jnp.moveaxis(t, 1, 0) for t in (r, w, k, v, a, b))
    S, y = lax.scan(step, S, xs)
    return jnp.moveaxis(y, 0, 1), S


def rwkv_out(wkv, aux, p):
    y = dir_merge(wkv)
    y = layer_norm(y, p['rw_ln_g'].reshape(RW_HEADS, RW_DH), p['rw_ln_b'].reshape(RW_HEADS, RW_DH), GN_EPS) + aux[0]
    return y.reshape(*y.shape[:2], -1) * aux[1]


def merge_branches(ys, gate_cols, w_br, w_out):
    dt = gate_cols.dtype
    ys = jnp.stack([y.astype(dt) for y in ys], axis=2)
    br = jnp.einsum('btnw,nwd->btnd', ys, w_br)
    gates = jax.nn.sigmoid(gate_cols.reshape(*gate_cols.shape[:2], N_BRANCH, -1))
    return jnp.sum(gates * br, axis=2) @ w_out


def token_mixers(hc, hx, p, need_ctx):
    sc = split_cols(hc @ p['w_in'])
    sx = split_cols(hx @ p['w_in'])
    g = 2 * hx.shape[0]
    st0 = (jnp.zeros((g, ML_HEADS, ML_DH, ML_DH), F32), jnp.zeros((g, ML_HEADS, ML_DH), F32),
           jnp.zeros((g, ML_HEADS), F32))
    ml_c, st = mlstm_scan(*mlstm_inputs(sc[1], sc[3], p['ml_gate_b']), st0)
    ml_x, _ = mlstm_scan(*mlstm_inputs(sx[1], sx[3], p['ml_gate_b']), st)
    gdn_args = (p['gd_conv'], p['gd_a_log'], p['gd_dt_bias'])
    s0 = jnp.zeros((g, GD_HEADS, GD_DH, GD_DH), F32)
    gd_c, s = gdn_scan(*gdn_inputs(sc[4], sc[6], *gdn_args), s0)
    gd_x, _ = gdn_scan(*gdn_inputs(sx[4], sx[6], *gdn_args), s)
    rin_c, raux_c = rwkv_inputs(sc[7], p)
    rin_x, raux_x = rwkv_inputs(sx[7], p)
    S0 = jnp.zeros((g, RW_HEADS, RW_DH, RW_DH), F32)
    wkv_c, S = rwkv_scan(*rin_c, S0)
    wkv_x, _ = rwkv_scan(*rin_x, S)

    def finish(s_cols, ml, gd, wkv, raux):
        ya = conv_module(s_cols[0], p)
        yb = mlstm_out(ml, s_cols[2], p['ml_norm_g'])
        yc = gdn_out(gd, s_cols[5], p['gd_norm_g'])
        yd = rwkv_out(wkv, raux, p)
        return merge_branches([ya, yb, yc, yd], s_cols[8], p['w_br'], p['w_out'])

    out_x = finish(sx, ml_x, gd_x, wkv_x, raux_x)
    out_c = finish(sc, ml_c, gd_c, wkv_c, raux_c) if need_ctx else None
    return out_c, out_x


def conv_ffn(h, up, dw, down, grid):
    u, v = jnp.split(h @ up, 2, axis=-1)
    u = dwconv2d_grid(u, dw) if grid else dwconv1d(u, dw[FFN_K // 2])
    return (jax.nn.gelu(u, approximate=True) * v) @ down


def setup_inputs(seed: int = 0) -> dict:
    key = jax.random.key(seed)
    ks = iter(jax.random.split(key, 48))
    nrm = lambda shape, scale: jax.random.normal(next(ks), shape, F32) * scale
    uni = lambda shape, lo, hi: jax.random.uniform(next(ks), shape, F32, lo, hi)
    D = D_MODEL
    dt = jnp.exp(uni((DEPTH, 2, GD_HEADS), float(np.log(1e-3)), float(np.log(1e-1))))
    return {
        "x": nrm((BATCH, SEQ, D), 1.0),
        "c": nrm((BATCH, D), 1.0),
        "ctx": nrm((BATCH, CTX_LEN, D), 1.0),
        "c_ctx": nrm((D,), 1.0),
        "w_mod": nrm((DEPTH, D, 6 * D), 0.5 * D ** -0.5),
        "b_mod": nrm((DEPTH, 6 * D), 0.02),
        "norm_g": 1.0 + nrm((DEPTH, 4, D), 0.05),
        "w_in": nrm((DEPTH, D, N_IN), D ** -0.5),
        "conv_dw": nrm((DEPTH, CONV_K, MIX_W), CONV_K ** -0.5),
        "conv_b": nrm((DEPTH, MIX_W), 0.02),
        "conv_ln_g": 1.0 + nrm((DEPTH, MIX_W), 0.05),
        "conv_ln_b": nrm((DEPTH, MIX_W), 0.02),
        "ml_gate_b": jnp.stack([nrm((DEPTH, 2, ML_HEADS), 0.1), 3.0 + nrm((DEPTH, 2, ML_HEADS), 0.5)], axis=2),
        "ml_norm_g": 1.0 + nrm((DEPTH, MIX_W), 0.05),
        "gd_conv": nrm((DEPTH, GD_CONV_K, 3 * MIX_W), GD_CONV_K ** -0.5),
        "gd_a_log": jnp.log(uni((DEPTH, 2, GD_HEADS), 1.0, 16.0)),
        "gd_dt_bias": dt + jnp.log(-jnp.expm1(-dt)),
        "gd_norm_g": 1.0 + nrm((DEPTH, MIX_W), 0.05),
        "rw_mu": uni((DEPTH, 2, RW_MIX), 0.0, 0.5),
        "rw_w0": uni((DEPTH, 2, MIX_W), -6.0, 1.0),
        "rw_w2": nrm((DEPTH, 2, RW_DECAY_LORA, MIX_W), 0.5 * RW_DECAY_LORA ** -0.5),
        "rw_a0": nrm((DEPTH, 2, MIX_W), 0.1),
        "rw_a2": nrm((DEPTH, 2, RW_ICLR_LORA, MIX_W), 0.5 * RW_ICLR_LORA ** -0.5),
        "rw_g2": nrm((DEPTH, RW_GATE_LORA, MIX_W), RW_GATE_LORA ** -0.5),
        "rw_kk": 0.85 + nrm((DEPTH, MIX_W), 0.05),
        "rw_ka": 1.0 + nrm((DEPTH, MIX_W), 0.05),
        "rw_rk": nrm((DEPTH, RW_HEADS, RW_DH), 0.1),
        "rw_ln_g": 1.0 + nrm((DEPTH, MIX_W), 0.05),
        "rw_ln_b": nrm((DEPTH, MIX_W), 0.02),
        "w_br": nrm((DEPTH, N_BRANCH, MIX_W, D), MIX_W ** -0.5),
        "w_out": nrm((DEPTH, D, D), D ** -0.5),
        "ffn_up": nrm((DEPTH, D, 2 * D_FF), D ** -0.5),
        "ffn_dw": nrm((DEPTH, FFN_K, FFN_K, D_FF), 1.0 / FFN_K),
        "ffn_down": nrm((DEPTH, D_FF, D), D_FF ** -0.5),
    }


def reference(x, c, ctx, c_ctx, w_mod, b_mod, norm_g, w_in, conv_dw, conv_b, conv_ln_g, conv_ln_b,
              ml_gate_b, ml_norm_g, gd_conv, gd_a_log, gd_dt_bias, gd_norm_g,
              rw_mu, rw_w0, rw_w2, rw_a0, rw_a2, rw_g2, rw_kk, rw_ka, rw_rk, rw_ln_g, rw_ln_b,
              w_br, w_out, ffn_up, ffn_dw, ffn_down):
    cx = ctx
    for l in range(DEPTH):
        last = l == DEPTH - 1
        p = dict(w_in=w_in[l], conv_dw=conv_dw[l], conv_b=conv_b[l], conv_ln_g=conv_ln_g[l],
                 conv_ln_b=conv_ln_b[l], ml_gate_b=ml_gate_b[l], ml_norm_g=ml_norm_g[l],
                 gd_conv=gd_conv[l], gd_a_log=gd_a_log[l], gd_dt_bias=gd_dt_bias[l], gd_norm_g=gd_norm_g[l],
                 rw_mu=rw_mu[l], rw_w0=rw_w0[l], rw_w2=rw_w2[l], rw_a0=rw_a0[l], rw_a2=rw_a2[l],
                 rw_g2=rw_g2[l], rw_kk=rw_kk[l], rw_ka=rw_ka[l], rw_rk=rw_rk[l], rw_ln_g=rw_ln_g[l],
                 rw_ln_b=rw_ln_b[l], w_br=w_br[l], w_out=w_out[l])
        mod_x = (jax.nn.silu(c) @ w_mod[l] + b_mod[l])[:, None, :]
        mod_c = jax.nn.silu(c_ctx) @ w_mod[l] + b_mod[l]
        sh1x, sc1x, gt1x, sh2x, sc2x, gt2x = jnp.split(mod_x, 6, axis=-1)
        sh1c, sc1c, gt1c, sh2c, sc2c, gt2c = jnp.split(mod_c, 6, axis=-1)
        ux = modulate(rms_norm(x, norm_g[l, 0]), sh1x, sc1x)
        uc = modulate(rms_norm(cx, norm_g[l, 0]), sh1c, sc1c)
        mc, mx = token_mixers(uc, ux, p, not last)
        x = x + gt1x * rms_norm(mx, norm_g[l, 1])
        fx = conv_ffn(modulate(rms_norm(x, norm_g[l, 2]), sh2x, sc2x), ffn_up[l], ffn_dw[l], ffn_down[l], True)
        x = x + gt2x * rms_norm(fx, norm_g[l, 3])
        if not last:
            cx = cx + gt1c * rms_norm(mc, norm_g[l, 1])
            fc = conv_ffn(modulate(rms_norm(cx, norm_g[l, 2]), sh2c, sc2c), ffn_up[l], ffn_dw[l], ffn_down[l], False)
            cx = cx + gt2c * rms_norm(fc, norm_g[l, 3])
    return x
```

```cpp
#include <hip/hip_runtime.h>
#include <cstdio>
#include <cstdint>

#define GAS __attribute__((address_space(1)))
#define LAS __attribute__((address_space(3)))
#define DI __device__ __forceinline__
typedef unsigned short bf16;
typedef float f32x4 __attribute__((ext_vector_type(4)));
typedef float f32x2 __attribute__((ext_vector_type(2)));
typedef unsigned u32x4 __attribute__((ext_vector_type(4)));
typedef unsigned u32x2 __attribute__((ext_vector_type(2)));
typedef short bf16x8 __attribute__((ext_vector_type(8)));

constexpr int D = 2048, NB = 2, T = 4096, TC = 256, NL = 4;
constexpr int LAT = NB * T;
constexpr int MROWS = LAT + NB * TC;
constexpr int MIXW = 512, DFF = 5632;
constexpr int NIN = 15328, NZ = 15360;
constexpr int ZA = 0, ZAG = 512, MLQ = 1024, MLK = 1536, MLV = 2048, MLO = 2560, GDQ = 3072, GDK = 3584, GDV = 4096, GDZ = 4608;
constexpr int RWR = 5120, RWK = 5632, RWV = 6144, RWXW = 6656, RWXA = 6752, RWXG = 6848, ZG = 7104, ZSM = 15296;
constexpr int RWMIX = 1984;

namespace pg8 {
typedef unsigned short bf16_t;
constexpr int BM = 256, BK = 64, HALF = 128, HTB = HALF * BK * 2, STAGE_BYTES = 8 * HTB, NXCD = 8, WGM = 8;
__host__ __device__ __forceinline__ int lds_byte(int r, int c) { const int st = (r >> 4) * 2 + (c >> 5), rr = r & 15, cc = c & 31, ob = rr * 64 + cc * 2; return st * 1024 + (ob ^ (((ob >> 9) & 1) << 5)); }
__host__ __device__ __forceinline__ void stage_rc(int b, int& R, int& C) { const int st = b / 1024, sb = b % 1024, swz = sb ^ (((sb >> 9) & 1) << 5); R = (st >> 1) * 16 + swz / 64; C = (st & 1) * 32 + (swz % 64) / 2; }
__host__ __device__ __forceinline__ int perm32(int rho) { const int n = rho >> 4, i = rho & 15; return 8 * (i >> 2) + 4 * n + (i & 3); }

struct Unit { int pm, pn, sub; };
struct Gemm { const bf16_t* A; const bf16_t* Bt; int lda, ldb, K; };

struct StdOrder {
    int nM, nN, nwg, G, c;
    DI void init(int nM_, int nN_, int G_, int c_) { nM = nM_; nN = nN_; nwg = nM * nN; G = G_; c = c_; }
    DI bool map(int i, Unit& u) const {
        const long L = (long)i * G + c; if (L >= nwg) return false;
        int wgid = (int)L; { const int q = nwg / NXCD, r = nwg % NXCD, xcd = wgid % NXCD, off = wgid / NXCD; wgid = (xcd < r ? xcd * (q + 1) : r * (q + 1) + (xcd - r) * q) + off; }
        const int nig = WGM * nN, gid = wgid / nig, fm = gid * WGM, gsz = (nM - fm) < WGM ? (nM - fm) : WGM;
        u.pm = fm + ((wgid % nig) % gsz); u.pn = (wgid % nig) / gsz; return true;
    }
    DI bool next(int i, Unit& u) const { u.sub = 0; return map(i, u); }
    DI const char* a_ptr(const Gemm& g, const Unit& u) const { return (const char*)g.A + (size_t)u.pm * BM * g.lda * 2; }
    DI const char* b_ptr(const Gemm& g, const Unit& u) const { return (const char*)g.Bt + (size_t)u.pn * BM * g.ldb * 2; }
};
struct MergeOrder : StdOrder {
    DI bool next(int i4, Unit& u) const { u.sub = i4 & 3; return map(i4 >> 2, u); }
    DI const char* a_ptr(const Gemm& g, const Unit& u) const { return (const char*)g.A + (size_t)u.pm * BM * g.lda * 2 + (size_t)u.sub * 512 * 2; }
    DI const char* b_ptr(const Gemm& g, const Unit& u) const { return (const char*)g.Bt + ((size_t)u.sub * 2048 + (size_t)u.pn * BM) * g.ldb * 2; }
};

DI unsigned cvt_pk_bf16(float lo, float hi) { unsigned r; asm volatile("v_cvt_pk_bf16_f32 %0, %1, %2" : "=v"(r) : "v"(lo), "v"(hi)); return r; }

struct EpiF32 {
    static constexpr bool PERM = false;
    float* C; int ldc;
    DI void operator()(const f32x4 (&acc)[2][2][4][2], const Unit& u, int wr, int wc, int fr, int fq) const {
        const int row0 = u.pm * BM + wr * 64 + fr, col0 = u.pn * BM + wc * 32 + 4 * fq;
#pragma unroll
        for (int ai = 0; ai < 2; ++ai)
#pragma unroll
            for (int m = 0; m < 4; ++m) { float* rowp = C + (size_t)(row0 + ai * HALF + m * 16) * ldc + col0;
#pragma unroll
                for (int bj = 0; bj < 2; ++bj)
#pragma unroll
                    for (int n = 0; n < 2; ++n) *(f32x4*)(rowp + bj * HALF + n * 16) = acc[ai][bj][m][n]; }
    }
};
struct EpiBf16 {
    static constexpr bool PERM = true;
    bf16_t* O; int ldc; float* G32; int gtile;
    DI void operator()(const f32x4 (&acc)[2][2][4][2], const Unit& u, int wr, int wc, int fr, int fq) const {
        const int row0 = u.pm * BM + wr * 64 + fr; const int col0 = u.pn * BM + wc * 32 + 8 * fq;
#pragma unroll
        for (int ai = 0; ai < 2; ++ai)
#pragma unroll
            for (int m = 0; m < 4; ++m) { const int row = row0 + ai * HALF + m * 16; bf16_t* rowp = O + (size_t)row * ldc + col0;
#pragma unroll
                for (int bj = 0; bj < 2; ++bj) { const f32x4 v0 = acc[ai][bj][m][0], v1 = acc[ai][bj][m][1];
                    u32x4 w; w.x = cvt_pk_bf16(v0[0], v0[1]); w.y = cvt_pk_bf16(v0[2], v0[3]); w.z = cvt_pk_bf16(v1[0], v1[1]); w.w = cvt_pk_bf16(v1[2], v1[3]);
                    *(u32x4*)(rowp + bj * HALF) = w;
                    if (bj == 1 && G32 != nullptr && u.pn == gtile && wc == 2) { float* gp = G32 + (size_t)row * 32 + 8 * fq; *(f32x4*)gp = v0; *(f32x4*)(gp + 4) = v1; } } }
    }
};
struct EpiMerge {
    static constexpr bool PERM = true;
    const bf16_t* Z; int ldz; int zg; float* P; bf16_t* Mb; int ldc;
    DI void operator()(const f32x4 (&acc)[2][2][4][2], const Unit& u, int wr, int wc, int fr, int fq) const {
        const int row0 = u.pm * BM + wr * 64 + fr; const int col0 = u.pn * BM + wc * 32 + 8 * fq;
#pragma unroll
        for (int ai = 0; ai < 2; ++ai)
#pragma unroll
            for (int m = 0; m < 4; ++m) { const int row = row0 + ai * HALF + m * 16;
#pragma unroll
                for (int bj = 0; bj < 2; ++bj) { const int col = col0 + bj * HALF;
                    const u32x4 gw = *(const u32x4*)(Z + (size_t)row * ldz + zg + u.sub * 2048 + col);
                    float gt[8];
#pragma unroll
                    for (int j = 0; j < 4; ++j) { gt[2 * j] = __uint_as_float(gw[j] << 16); gt[2 * j + 1] = __uint_as_float(gw[j] & 0xffff0000u); }
                    f32x4 v0 = acc[ai][bj][m][0], v1 = acc[ai][bj][m][1];
#pragma unroll
                    for (int j = 0; j < 4; ++j) { v0[j] *= 1.f / (1.f + __expf(-gt[j])); v1[j] *= 1.f / (1.f + __expf(-gt[4 + j])); }
                    float* pp = P + (size_t)row * ldc + col;
                    if (u.sub > 0) { v0 += *(const f32x4*)pp; v1 += *(const f32x4*)(pp + 4); }
                    if (u.sub < 3) { *(f32x4*)pp = v0; *(f32x4*)(pp + 4) = v1; }
                    else { u32x4 w; w.x = cvt_pk_bf16(v0[0], v0[1]); w.y = cvt_pk_bf16(v0[2], v0[3]); w.z = cvt_pk_bf16(v1[0], v1[1]); w.w = cvt_pk_bf16(v1[2], v1[3]);
                        *(u32x4*)(Mb + (size_t)row * ldc + col) = w; } } }
    }
};

template <class Epi, class Sched>
DI void gemm_phase(LAS unsigned char* lds, const Gemm g, const Sched& S, const Epi& E) {
    int tid_ = threadIdx.x; asm volatile("" : "+v"(tid_));
    const int tid = tid_, wid = __builtin_amdgcn_readfirstlane(tid >> 6), lane = tid & 63, wr = wid >> 2, wc = wid & 3, fr = lane & 15, fq = lane >> 4;
    const int K = g.K, nt = K / BK;
    unsigned voffA[2], voffB[2];
#pragma unroll
    for (int i = 0; i < 2; ++i) { int R, C; stage_rc(tid * 16 + i * 8192, R, C); const int Rb = Epi::PERM ? ((R & ~31) + perm32(R & 31)) : R;
        voffA[i] = (unsigned)(R * g.lda + C) * 2u; voffB[i] = (unsigned)(Rb * g.ldb + C) * 2u; }
    const size_t kstep = (size_t)(BK * 2);
    const size_t hstepA = (size_t)HALF * g.lda * 2, hstepB = (size_t)HALF * g.ldb * 2;
    const unsigned ldsw = (unsigned)wid * 1024u;
    const int aoff = lds_byte(wr * 64 + fr, fq * 8), boff = lds_byte(wc * 32 + fr, fq * 8);
#define PG8_SA(b, h) (((b) * 2 + (h)) * HTB)
#define PG8_SB(b, h) ((4 + (b) * 2 + (h)) * HTB)
#define PG8_STAGE(bufoff, gbase, voff) do { _Pragma("unroll") for (int _i = 0; _i < 2; ++_i) \
        __builtin_amdgcn_global_load_lds((const unsigned*)((const char*)(gbase) + (voff)[_i]), (LAS unsigned*)(lds + (bufoff) + ldsw + _i * 8192), 16, 0, 0); } while (0)
#define PG8_LDA(dst, b, h) do { _Pragma("unroll") for (int m = 0; m < 4; ++m) _Pragma("unroll") for (int k = 0; k < 2; ++k) dst[m][k] = *(const LAS bf16x8*)(lds + PG8_SA(b, h) + aoff + m * 2048 + k * 1024); } while (0)
#define PG8_LDB(dst, b, h) do { _Pragma("unroll") for (int n = 0; n < 2; ++n) _Pragma("unroll") for (int k = 0; k < 2; ++k) dst[n][k] = *(const LAS bf16x8*)(lds + PG8_SB(b, h) + boff + n * 2048 + k * 1024); } while (0)
#define PG8_MMA(ai, bj, At, Bt) do { __builtin_amdgcn_s_setprio(1); _Pragma("unroll") for (int m = 0; m < 4; ++m) _Pragma("unroll") for (int n = 0; n < 2; ++n) _Pragma("unroll") for (int k = 0; k < 2; ++k) \
        acc[ai][bj][m][n] = __builtin_amdgcn_mfma_f32_16x16x32_bf16(Bt[n][k], At[m][k], acc[ai][bj][m][n], 0, 0, 0); __builtin_amdgcn_s_setprio(0); } while (0)
#define PG8_WAIT_V(n) asm volatile("s_waitcnt vmcnt(" #n ")" ::: "memory")
#define PG8_WAIT_L(n) asm volatile("s_waitcnt lgkmcnt(" #n ")" ::: "memory")
#define PG8_BAR __builtin_amdgcn_s_barrier()
#define PG8_SCHED __builtin_amdgcn_sched_barrier(0)
    Unit cur, nxt; int ui = 0;
    if (!S.next(0, cur)) return;
    f32x4 acc[2][2][4][2];
#pragma unroll
    for (int a = 0; a < 2; ++a)
#pragma unroll
        for (int b = 0; b < 2; ++b)
#pragma unroll
            for (int m = 0; m < 4; ++m)
#pragma unroll
                for (int n = 0; n < 2; ++n) acc[a][b][m][n] = (f32x4){0.f, 0.f, 0.f, 0.f};
    bf16x8 At[4][2], B0[2][2], B1[2][2];
    const char* cA = S.a_ptr(g, cur); const char* cB = S.b_ptr(g, cur);
    PG8_STAGE(PG8_SB(0, 0), cB, voffB); PG8_STAGE(PG8_SB(0, 1), cB + hstepB, voffB); PG8_STAGE(PG8_SA(0, 0), cA, voffA); PG8_STAGE(PG8_SA(0, 1), cA + hstepA, voffA);
    if (wr == 1) PG8_BAR;
    PG8_WAIT_V(2); PG8_BAR;
    PG8_STAGE(PG8_SB(1, 0), cB + kstep, voffB); PG8_STAGE(PG8_SA(1, 0), cA + kstep, voffA); PG8_STAGE(PG8_SB(1, 1), cB + hstepB + kstep, voffB);
    PG8_WAIT_V(6); PG8_BAR;
    for (;;) {
        const bool has_next = S.next(ui + 1, nxt);
        const char* nA = has_next ? S.a_ptr(g, nxt) : cA; const char* nB = has_next ? S.b_ptr(g, nxt) : cB;
        for (int t = 0; t < nt; t += 2) {
            const bool last = (t == nt - 2);
            const char* a1 = cA + (size_t)(t + 1) * kstep;
            const char* a2 = last ? nA : cA + (size_t)(t + 2) * kstep; const char* b2 = last ? nB : cB + (size_t)(t + 2) * kstep;
            const char* a3 = a2 + kstep; const char* b3 = b2 + kstep;
            PG8_LDB(B0, 0, 0); PG8_LDB(B1, 0, 1); PG8_SCHED; PG8_LDA(At, 0, 0); PG8_STAGE(PG8_SA(1, 1), a1 + hstepA, voffA);
            PG8_WAIT_V(8); PG8_WAIT_L(0); PG8_BAR; PG8_MMA(0, 0, At, B0); PG8_MMA(0, 1, At, B1); PG8_BAR; PG8_SCHED;
            PG8_LDA(At, 0, 1); PG8_STAGE(PG8_SB(0, 0), b2, voffB); PG8_STAGE(PG8_SB(0, 1), b2 + hstepB, voffB); PG8_STAGE(PG8_SA(0, 0), a2, voffA);
            PG8_WAIT_V(8); PG8_WAIT_L(0); PG8_BAR; PG8_MMA(1, 0, At, B0); PG8_MMA(1, 1, At, B1); PG8_BAR; PG8_SCHED;
            PG8_LDB(B0, 1, 0); PG8_LDB(B1, 1, 1); PG8_SCHED; PG8_LDA(At, 1, 0); PG8_STAGE(PG8_SA(0, 1), a2 + hstepA, voffA);
            PG8_WAIT_V(8); PG8_WAIT_L(0); PG8_BAR; PG8_MMA(0, 0, At, B0); PG8_MMA(0, 1, At, B1); PG8_BAR; PG8_SCHED;
            PG8_LDA(At, 1, 1); PG8_STAGE(PG8_SB(1, 0), b3, voffB); PG8_STAGE(PG8_SB(1, 1), b3 + hstepB, voffB); PG8_STAGE(PG8_SA(1, 0), a3, voffA);
            PG8_WAIT_V(8); PG8_WAIT_L(0); PG8_BAR; PG8_MMA(1, 0, At, B0); PG8_MMA(1, 1, At, B1); PG8_BAR; PG8_SCHED;
        }
        if (wr == 0) PG8_BAR;
        E(acc, cur, wr, wc, fr, fq);
        if (!has_next) break;
#pragma unroll
        for (int a = 0; a < 2; ++a)
#pragma unroll
            for (int b = 0; b < 2; ++b)
#pragma unroll
                for (int m = 0; m < 4; ++m)
#pragma unroll
                    for (int n = 0; n < 2; ++n) acc[a][b][m][n] = (f32x4){0.f, 0.f, 0.f, 0.f};
        cur = nxt; cA = nA; cB = nB; ++ui;
        if (wr == 1) PG8_BAR;
    }
    PG8_WAIT_V(0);
    PG8_BAR;
#undef PG8_SA
#undef PG8_SB
#undef PG8_STAGE
#undef PG8_LDA
#undef PG8_LDB
#undef PG8_MMA
#undef PG8_WAIT_V
#undef PG8_WAIT_L
#undef PG8_BAR
#undef PG8_SCHED
}
}

constexpr size_t al256(size_t x) { return (x + 255) & ~(size_t)255; }
constexpr size_t WS_CTL = 0, CTL_BYTES = 1u << 20;
constexpr size_t WS_MODP = WS_CTL + CTL_BYTES;
constexpr size_t WS_MOD = WS_MODP + al256((size_t)NL * 8 * 3 * 12288 * 4);
constexpr size_t WS_W = WS_MOD + al256((size_t)NL * 3 * 12288 * 4);
constexpr size_t WL_IN = 0, WL_BR = WL_IN + (size_t)NZ * D * 2, WL_OUT = WL_BR + (size_t)4 * D * MIXW * 2, WL_UP = WL_OUT + (size_t)D * D * 2,
                 WL_DN = WL_UP + (size_t)2 * DFF * D * 2, WL_SIZE = WL_DN + (size_t)D * DFF * 2;
constexpr size_t WS_U = WS_W + NL * WL_SIZE;
constexpr size_t WS_Y = WS_U + (size_t)MROWS * D * 2;
constexpr size_t WS_MB = WS_Y + (size_t)MROWS * D * 2;
constexpr size_t WS_G32 = WS_MB + (size_t)MROWS * D * 2;
constexpr size_t WS_X = WS_G32 + (size_t)MROWS * 32 * 4;
constexpr size_t WS_F = WS_X + (size_t)MROWS * D * 4;
constexpr size_t WS_Z = WS_F + (size_t)MROWS * D * 4;
constexpr size_t WS_S = WS_Z + (size_t)MROWS * NZ * 2;
constexpr size_t SARR = (size_t)MROWS * MIXW * 4;
constexpr int N_SARR = 20;
constexpr size_t WS_SG = WS_S + N_SARR * SARR;
constexpr size_t WS_END = WS_SG + (size_t)MROWS * 16 * 4;
static_assert((size_t)MROWS * DFF * 2 <= N_SARR * SARR && (size_t)MROWS * 2 * DFF * 2 <= (size_t)MROWS * NZ * 2, "aliases");
static_assert(WS_END < 1590000000ull, "workspace budget");
enum { SA_GQ = 0, SA_GK, SA_GV, SA_RR, SA_RV, SA_RA, SA_RW0, SA_RW1, SA_RK0, SA_RK1, SA_RB0, SA_RB1, SA_RAUX, SA_RG, SA_HM0, SA_HM1, SA_HG0, SA_HG1, SA_HR0, SA_HR1 };

constexpr int LDS_RING = 131072, LDS_MISC = LDS_RING + 320, LDS_BYTES = 147456;

#define XB_TMO      128
#define XB_XCNT(j)  (256  + 64 * (j))
#define XB_XSUB(j)  (1280 + 64 * (j))
#define XB_XGEN(j)  (2304 + 64 * (j))
#define XB_TOP      3328
#define XB_TOPGEN   3392
#define XCD_BAR_WORDS 3456
#define XB_SPIN_CAP (1u << 18)
__device__ __forceinline__ unsigned xb_ld(unsigned* p)              { return __hip_atomic_load(p, __ATOMIC_RELAXED, __HIP_MEMORY_SCOPE_AGENT); }
__device__ __forceinline__ unsigned xb_add(unsigned* p, unsigned v) { return __hip_atomic_fetch_add(p, v, __ATOMIC_RELAXED, __HIP_MEMORY_SCOPE_AGENT); }
__device__ __forceinline__ unsigned xb_xcc_id() { return (unsigned)__builtin_amdgcn_s_getreg((3 << 11) | 20) & 0xFu; }
#define XB_SPIN(cond, bar) do { unsigned _sp = 0; while (cond) { __builtin_amdgcn_s_sleep(1); \
    if ((++_sp & 255u) == 0u) { if (xb_ld(&(bar)[XB_TMO])) break; if (_sp > XB_SPIN_CAP) { atomicAdd(&(bar)[XB_TMO], 1u); break; } } } } while (0)
struct XcdBarrier { unsigned* bar; unsigned x; volatile LAS unsigned* st; };
__device__ __forceinline__ XcdBarrier xcd_barrier_post(unsigned* bar, volatile LAS unsigned* st) {
    XcdBarrier b; b.bar = bar; b.x = xb_xcc_id(); b.st = st;
    if (threadIdx.x == 0) (void)xb_add(&bar[XB_XCNT(b.x)], 1u);
    return b;
}
__device__ __forceinline__ void xcd_barrier_complete(unsigned* bar, unsigned x, unsigned& nloc, unsigned& nx) {
    const unsigned G = gridDim.x * gridDim.y * gridDim.z;
    unsigned sum, cnt, mine, sp = 0u;
    for (;;) {
        sum = 0u; cnt = 0u; mine = 0u;
#pragma unroll
        for (unsigned j = 0; j < 16; ++j) { const unsigned c = xb_ld(&bar[XB_XCNT(j)]); sum += c; cnt += (c > 0u) ? 1u : 0u; mine = (j == x) ? c : mine; }
        if (sum == G) break;
        __builtin_amdgcn_s_sleep(1);
        if ((++sp & 255u) == 0u) { if (xb_ld(&bar[XB_TMO])) break; if (sp > XB_SPIN_CAP) { atomicAdd(&bar[XB_TMO], 1u); break; } }
    }
    nloc = mine > 0u ? mine : 1u; nx = cnt > 0u ? cnt : 1u;
}
__device__ __forceinline__ void xcd_barrier(const XcdBarrier& b) {
    asm volatile("s_waitcnt vmcnt(0)" ::: "memory");
    __syncthreads();
    if (threadIdx.x == 0) {
        unsigned* bar = b.bar;
        __builtin_amdgcn_s_waitcnt(0);
        unsigned nloc = b.st[0], nx = b.st[1];
        if (nloc == 0u) { xcd_barrier_complete(bar, b.x, nloc, nx); b.st[0] = nloc; b.st[1] = nx; }
        const unsigned old = xb_add(&bar[XB_XSUB(b.x)], 1u);
        const unsigned gen = old / nloc;
        if (old + 1u == (gen + 1u) * nloc) {
            __builtin_amdgcn_fence(__ATOMIC_RELEASE, "agent");
            asm volatile("s_waitcnt vmcnt(0)" ::: "memory");
            const unsigned og = xb_add(&bar[XB_TOP], 1u);
            const unsigned tg = og / nx;
            if (og + 1u == (tg + 1u) * nx) xb_add(&bar[XB_TOPGEN], 1u);
            else XB_SPIN(xb_ld(&bar[XB_TOPGEN]) == tg, bar);
            __builtin_amdgcn_fence(__ATOMIC_ACQUIRE, "agent");
            xb_add(&bar[XB_XGEN(b.x)], 1u);
            asm volatile("s_waitcnt vmcnt(0)" ::: "memory");
        } else {
            XB_SPIN(xb_ld(&bar[XB_XGEN(b.x)]) == gen, bar);
            __builtin_amdgcn_fence(__ATOMIC_ACQUIRE, "agent");
            asm volatile("s_waitcnt vmcnt(0)" ::: "memory");
        }
    }
    __syncthreads();
}

struct Params {
    const float *x, *c, *ctx, *c_ctx, *w_mod, *b_mod, *norm_g, *w_in, *conv_dw, *conv_b, *conv_ln_g, *conv_ln_b, *ml_gate_b, *ml_norm_g,
        *gd_conv, *gd_a_log, *gd_dt_bias, *gd_norm_g, *rw_mu, *rw_w0, *rw_w2, *rw_a0, *rw_a2, *rw_g2, *rw_kk, *rw_ka, *rw_rk, *rw_ln_g, *rw_ln_b,
        *w_br, *w_out, *ffn_up, *ffn_dw, *ffn_down;
    float* out; unsigned char* ws; int ph_lo, ph_hi;
};

DI float bf2f(unsigned short u) { return __uint_as_float(((unsigned)u) << 16); }
DI unsigned f2bf(float f) { unsigned u = __float_as_uint(f); return (u + 0x7fffu + ((u >> 16) & 1u)) >> 16; }
DI unsigned pk2(float lo, float hi) { return f2bf(lo) | (f2bf(hi) << 16); }
DI void ld8(const bf16* p, float (&o)[8]) { const u32x4 w = *(const u32x4*)p;
#pragma unroll
    for (int j = 0; j < 4; ++j) { o[2 * j] = __uint_as_float(w[j] << 16); o[2 * j + 1] = __uint_as_float(w[j] & 0xffff0000u); } }
DI void st8(bf16* p, const float (&v)[8]) { u32x4 w; w.x = pk2(v[0], v[1]); w.y = pk2(v[2], v[3]); w.z = pk2(v[4], v[5]); w.w = pk2(v[6], v[7]); *(u32x4*)p = w; }
DI void ldf8(const float* p, float (&o)[8]) { const f32x4 a = *(const f32x4*)p, b = *(const f32x4*)(p + 4);
    o[0] = a[0]; o[1] = a[1]; o[2] = a[2]; o[3] = a[3]; o[4] = b[0]; o[5] = b[1]; o[6] = b[2]; o[7] = b[3]; }
DI void stf8(float* p, const float (&v)[8]) { *(f32x4*)p = (f32x4){v[0], v[1], v[2], v[3]}; *(f32x4*)(p + 4) = (f32x4){v[4], v[5], v[6], v[7]}; }
DI float wave_sum(float v) {
#pragma unroll
    for (int o = 1; o < 64; o <<= 1) v += __shfl_xor(v, o);
    return v; }
template <int W> DI float grp_sum(float v) {
#pragma unroll
    for (int o = 1; o < W; o <<= 1) v += __shfl_xor(v, o);
    return v; }
DI float sigmoidf_(float x) { return 1.f / (1.f + __expf(-x)); }
DI float siluf_(float x) { return x / (1.f + __expf(-x)); }
DI float softplusf_(float x) { return fmaxf(x, 0.f) + log1pf(__expf(-fabsf(x))); }
DI float logsigmoidf_(float x) { return fminf(x, 0.f) - log1pf(__expf(-fabsf(x))); }
DI float gelu_tanh(float x) { const float u = 0.7978845608028654f * (x + 0.044715f * x * x * x); return 0.5f * x * (1.f + tanhf(u)); }

DI void seq_of(int row, int& base, int& len, int& t) { if (row < LAT) { base = row & ~(T - 1); len = T; t = row & (T - 1); } else { const int r = row - LAT; base = LAT + (r & ~(TC - 1)); len = TC; t = r & (TC - 1); } }
DI int scan_row(int dir, int b, int j) { if (j < TC) { const int tok = dir ? (TC - 1 - j) : j; return LAT + b * TC + tok; } const int jj = j - TC; const int tok = dir ? (T - 1 - jj) : jj; return b * T + tok; }

struct Ctx {
    LAS unsigned char* lds; int tid, lane, wave, G, bid;
    const Params* p; unsigned char* ws;
};

DI int zcol_src(int j) { if (j < 3072) return j; if (j < 5120) return j + 16; if (j < ZSM) return j + 32; if (j < ZSM + 16) return 3072 + (j - ZSM); if (j < ZSM + 32) return 5136 + (j - ZSM - 16); return -1; }
template <bool ZMAP> DI void transpose_item(const float* W, int K, int N, bf16* WT, LAS float* scr, int kb, int nb, int lane) {
    const int k0 = 64 * kb, n0 = 32 * nb; const int nn = n0 + (lane & 31); const int src = ZMAP ? zcol_src(nn) : nn;
#pragma unroll 8
    for (int i = 0; i < 32; ++i) { const int kk = 2 * i + (lane >> 5); scr[kk * 33 + (lane & 31)] = (src >= 0) ? W[(size_t)(k0 + kk) * N + src] : 0.f; }
    asm volatile("s_waitcnt lgkmcnt(0)" ::: "memory");
    const int c = lane & 7;
#pragma unroll
    for (int j = 0; j < 4; ++j) { const int n = (lane >> 3) + 8 * j; const LAS float* s = scr + (8 * c) * 33 + n;
        u32x4 o; o.x = pk2(s[0 * 33], s[1 * 33]); o.y = pk2(s[2 * 33], s[3 * 33]); o.z = pk2(s[4 * 33], s[5 * 33]); o.w = pk2(s[6 * 33], s[7 * 33]);
        *(u32x4*)(WT + (size_t)(n0 + n) * K + k0 + 8 * c) = o; }
    asm volatile("s_waitcnt lgkmcnt(0)" ::: "memory");
}
DI void phase_pro0(Ctx& c) {
    const Params& p = *c.p;
    {
        LAS float* red = (LAS float*)c.lds;
        float* MODP = (float*)(c.ws + WS_MODP);
        for (int u = c.bid; u < NL * 48 * 8; u += c.G) {
            const int l = u / 384, cb = (u >> 3) % 48, ks = u & 7; const int col = cb * 256 + c.lane * 4;
            f32x4 a0 = {0.f, 0.f, 0.f, 0.f}, a1 = a0, a2 = a0;
            const float* wp = p.w_mod + ((size_t)l * D + ks * 256 + c.wave * 32) * 12288 + col;
            const int kb = ks * 256 + c.wave * 32;
#pragma unroll 8
            for (int i = 0; i < 32; ++i) { const f32x4 w = *(const f32x4*)(wp + (size_t)i * 12288);
                const float s0 = siluf_(p.c[kb + i]), s1 = siluf_(p.c[D + kb + i]), s2 = siluf_(p.c_ctx[kb + i]);
                a0 += w * s0; a1 += w * s1; a2 += w * s2; }
            __syncthreads();
            *(LAS f32x4*)(red + (c.wave * 3 + 0) * 256 + c.lane * 4) = a0; *(LAS f32x4*)(red + (c.wave * 3 + 1) * 256 + c.lane * 4) = a1; *(LAS f32x4*)(red + (c.wave * 3 + 2) * 256 + c.lane * 4) = a2;
            __syncthreads();
            for (int o = c.tid; o < 768; o += 512) { float s = 0.f;
#pragma unroll
                for (int w = 0; w < 8; ++w) s += red[w * 768 + o];
                MODP[((size_t)(l * 8 + ks) * 3 + o / 256) * 12288 + cb * 256 + (o & 255)] = s; }
        }
        __syncthreads();
    }
    {
        LAS float* scr = (LAS float*)(c.lds + c.wave * 16384);
        const int gw = c.bid * 8 + c.wave, NGW = c.G * 8;
        constexpr int I_IN = 32 * 480, I_BR = 8 * 64, I_OUT = 32 * 64, I_UP = 32 * 352, I_DN = 88 * 64, I_L = I_IN + 4 * I_BR + I_OUT + I_UP + I_DN;
        for (int it = gw; it < NL * I_L; it += NGW) {
            const int l = it / I_L; int r = it % I_L; unsigned char* wl = c.ws + WS_W + (size_t)l * WL_SIZE;
            if (r < I_IN) { transpose_item<true>(p.w_in + (size_t)l * D * NIN, D, NIN, (bf16*)(wl + WL_IN), scr, r / 480, r % 480, c.lane); continue; } r -= I_IN;
            if (r < 4 * I_BR) { const int nb = r / I_BR; r %= I_BR; transpose_item<false>(p.w_br + ((size_t)l * 4 + nb) * MIXW * D, MIXW, D, (bf16*)(wl + WL_BR) + (size_t)nb * D * MIXW, scr, r / 64, r % 64, c.lane); continue; } r -= 4 * I_BR;
            if (r < I_OUT) { transpose_item<false>(p.w_out + (size_t)l * D * D, D, D, (bf16*)(wl + WL_OUT), scr, r / 64, r % 64, c.lane); continue; } r -= I_OUT;
            if (r < I_UP) { transpose_item<false>(p.ffn_up + (size_t)l * D * 2 * DFF, D, 2 * DFF, (bf16*)(wl + WL_UP), scr, r / 352, r % 352, c.lane); continue; } r -= I_UP;
            transpose_item<false>(p.ffn_down + (size_t)l * DFF * D, DFF, D, (bf16*)(wl + WL_DN), scr, r / 64, r % 64, c.lane);
        }
    }
}
DI void phase_pro1(Ctx& c) {
    const Params& p = *c.p; const float* MODP = (const float*)(c.ws + WS_MODP); float* MOD = (float*)(c.ws + WS_MOD);
    for (int i = c.bid * 512 + c.tid; i < NL * 3 * 12288; i += c.G * 512) { const int l = i / 36864, v = (i / 12288) % 3, n = i % 12288;
        float s = p.b_mod[l * 12288 + n];
#pragma unroll
        for (int ks = 0; ks < 8; ++ks) s += MODP[((size_t)(l * 8 + ks) * 3 + v) * 12288 + n];
        MOD[i] = s; }
}
DI void row_load(const float* r, int lane, f32x4 (&v)[8]) {
#pragma unroll
    for (int j = 0; j < 8; ++j) v[j] = *(const f32x4*)(r + 4 * lane + 256 * j); }
DI float row_rstd(const f32x4 (&v)[8]) { float s = 0.f;
#pragma unroll
    for (int j = 0; j < 8; ++j) s += (v[j][0] * v[j][0] + v[j][1] * v[j][1]) + (v[j][2] * v[j][2] + v[j][3] * v[j][3]);
    return rsqrtf(wave_sum(s) * (1.f / D) + 1e-6f); }
DI void norm_mod_store(const f32x4 (&v)[8], float rstd, const float* g, const float* sh, const float* sc, bf16* o, int lane) {
#pragma unroll
    for (int j = 0; j < 8; ++j) { const int cc = 4 * lane + 256 * j; const f32x4 g4 = *(const f32x4*)(g + cc), s4 = *(const f32x4*)(sh + cc), c4 = *(const f32x4*)(sc + cc);
        const f32x4 r = v[j] * rstd * g4 * (c4 + 1.f) + s4; u32x2 w; w.x = pk2(r[0], r[1]); w.y = pk2(r[2], r[3]); *(u32x2*)(o + cc) = w; } }
DI int mod_vec(int row) { return row < LAT ? (row >> 12) : 2; }
DI void phase_pro2(Ctx& c) {
    const Params& p = *c.p; const float* MOD = (const float*)(c.ws + WS_MOD); bf16* U = (bf16*)(c.ws + WS_U);
    const int gw = c.bid * 8 + c.wave, NGW = c.G * 8;
    for (int row = gw; row < MROWS; row += NGW) { const float* xr = row < LAT ? p.x + (size_t)row * D : p.ctx + (size_t)(row - LAT) * D;
        f32x4 v[8]; row_load(xr, c.lane, v); const float rs = row_rstd(v); const float* mv = MOD + (size_t)(0 * 3 + mod_vec(row)) * 12288;
        norm_mod_store(v, rs, p.norm_g, mv, mv + 2048, U + (size_t)row * D, c.lane); }
}
DI void phase_resid(Ctx& c, int l, int which) {
    const Params& p = *c.p; const float* MOD = (const float*)(c.ws + WS_MOD); bf16* U = (bf16*)(c.ws + WS_U); float* X = (float*)(c.ws + WS_X); const float* F = (const float*)(c.ws + WS_F);
    const int gw = c.bid * 8 + c.wave, NGW = c.G * 8;
    for (int row = gw; row < MROWS; row += NGW) {
        const float* xr = (l == 0 && which == 0) ? (row < LAT ? p.x + (size_t)row * D : p.ctx + (size_t)(row - LAT) * D) : X + (size_t)row * D;
        f32x4 fv[8], xv[8]; row_load(F + (size_t)row * D, c.lane, fv); row_load(xr, c.lane, xv);
        const float rs = row_rstd(fv); const float* mv = MOD + (size_t)(l * 3 + mod_vec(row)) * 12288;
        const float* g = p.norm_g + (size_t)(l * 4 + (which ? 3 : 1)) * D; const float* gt = mv + (which ? 10240 : 4096);
#pragma unroll
        for (int j = 0; j < 8; ++j) { const int cc = 4 * c.lane + 256 * j; xv[j] += *(const f32x4*)(gt + cc) * (fv[j] * rs * *(const f32x4*)(g + cc)); }
        const bool fin = (which == 1 && l == NL - 1);
        if (fin) { if (row < LAT) {
#pragma unroll
            for (int j = 0; j < 8; ++j) *(f32x4*)(p.out + (size_t)row * D + 4 * c.lane + 256 * j) = xv[j]; } continue; }
#pragma unroll
        for (int j = 0; j < 8; ++j) *(f32x4*)(X + (size_t)row * D + 4 * c.lane + 256 * j) = xv[j];
        const float rs2 = row_rstd(xv);
        if (which == 0) norm_mod_store(xv, rs2, p.norm_g + (size_t)(l * 4 + 2) * D, mv + 6144, mv + 8192, U + (size_t)row * D, c.lane);
        else { const float* mv2 = MOD + (size_t)((l + 1) * 3 + mod_vec(row)) * 12288; norm_mod_store(xv, rs2, p.norm_g + (size_t)((l + 1) * 4) * D, mv2, mv2 + 2048, U + (size_t)row * D, c.lane); }
    }
}

DI float rw_feat(const bf16* Z, const float* mu, int row, int cz) {
    int base, len, t; seq_of(row, base, len, t); const bf16* zp = Z + (size_t)row * NZ + RWR + cz;
    const float x = bf2f(zp[0]); const float pv = t > 0 ? bf2f(zp[-NZ]) : 0.f; const float nx = t < len - 1 ? bf2f(zp[NZ]) : 0.f;
    return x + mu[cz] * (pv - x) + mu[RWMIX + cz] * (nx - x);
}
template <int K, int NT> DI void lora_nt(const float* Wm, const LAS float* in, int c, float (&acc)[NT]) {
#pragma unroll
    for (int t = 0; t < NT; ++t) acc[t] = 0.f;
    for (int k = 0; k < K; k += 4) { const float w0 = Wm[(k + 0) * 512 + c], w1 = Wm[(k + 1) * 512 + c], w2 = Wm[(k + 2) * 512 + c], w3 = Wm[(k + 3) * 512 + c];
#pragma unroll
        for (int t = 0; t < NT; ++t) { const f32x4 x = *(const LAS f32x4*)(in + t * 448 + k); acc[t] = fmaf(x[0], w0, acc[t]); acc[t] = fmaf(x[1], w1, acc[t]); acc[t] = fmaf(x[2], w2, acc[t]); acc[t] = fmaf(x[3], w3, acc[t]); } }
}
constexpr int RWT = 17;
DI void rwkv_prep_rows(Ctx& c, int l, int row0, const LAS float* in, LAS float* bufA, LAS float* bufB) {
    const Params& p = *c.p; const bf16* Z = (const bf16*)(c.ws + WS_Z); float* SA = (float*)(c.ws + WS_S);
    const float* mu = p.rw_mu + (size_t)l * 2 * RWMIX; const int cc = c.tid; const size_t AS = (size_t)MROWS * 512;
    float acc[RWT];
#pragma unroll
    for (int dir = 0; dir < 2; ++dir) {
        lora_nt<96, RWT>(p.rw_w2 + (size_t)(l * 2 + dir) * 96 * 512, in, cc, acc);
        const float w0 = p.rw_w0[(l * 2 + dir) * 512 + cc];
#pragma unroll
        for (int t = 0; t < RWT; ++t) { const float wl = w0 + acc[t]; SA[(SA_RW0 + dir) * AS + (size_t)(row0 + t) * 512 + cc] = expf(-expf(-softplusf_(-wl) - 0.5f)); }
        lora_nt<96, RWT>(p.rw_a2 + (size_t)(l * 2 + dir) * 96 * 512, in + 96, cc, acc);
        const float a0 = p.rw_a0[(l * 2 + dir) * 512 + cc]; LAS float* bb = dir ? bufB : bufA;
#pragma unroll
        for (int t = 0; t < RWT; ++t) bb[t * 512 + cc] = sigmoidf_(a0 + acc[t]);
    }
    lora_nt<256, RWT>(p.rw_g2 + (size_t)l * 256 * 512, in + 192, cc, acc);
#pragma unroll
    for (int t = 0; t < RWT; ++t) SA[SA_RG * AS + (size_t)(row0 + t) * 512 + cc] = acc[t];
    const float kks = p.rw_kk[l * 512 + cc], kas = p.rw_ka[l * 512 + cc], rks = p.rw_rk[l * 512 + cc];
#pragma unroll 1
    for (int t = 0; t < RWT; ++t) { const int row = row0 + t; const size_t o = (size_t)row * 512 + cc;
        const float rf = rw_feat(Z, mu, row, cc), kf = rw_feat(Z, mu, row, 512 + cc), vf = rw_feat(Z, mu, row, 1024 + cc);
        const float kx = kf * kks; const float kkv = kx * rsqrtf(wave_sum(kx * kx) + 1e-6f);
        const float ic0 = bufA[t * 512 + cc], ic1 = bufB[t * 512 + cc];
        const float km0 = kf * (1.f + (ic0 - 1.f) * kas), km1 = kf * (1.f + (ic1 - 1.f) * kas);
        const float bonus = wave_sum(rf * rks * (km0 + km1));
        SA[SA_RK0 * AS + o] = km0; SA[SA_RK1 * AS + o] = km1; SA[SA_RB0 * AS + o] = kkv * ic0; SA[SA_RB1 * AS + o] = kkv * ic1;
        SA[SA_RAUX * AS + o] = bonus * vf; SA[SA_RR * AS + o] = rf; SA[SA_RV * AS + o] = vf; SA[SA_RA * AS + o] = -kkv; }
}
DI void phase_prep(Ctx& c, int l) {
    const Params& p = *c.p; const bf16* Z = (const bf16*)(c.ws + WS_Z); bf16* Y = (bf16*)(c.ws + WS_Y); const float* G32 = (const float*)(c.ws + WS_G32);
    float* SA = (float*)(c.ws + WS_S); float* SG = (float*)(c.ws + WS_SG);
    const int gw = c.bid * 8 + c.wave, NGW = c.G * 8; const int ch = c.lane * 8;
    for (int row = gw; row < MROWS; row += NGW) {
        int base, len, t; seq_of(row, base, len, t);
        float acc[8];
#pragma unroll
        for (int i = 0; i < 8; ++i) acc[i] = 0.f;
        const float* w = p.conv_dw + (size_t)l * 31 * 512;
        for (int j = 0; j < 31; ++j) { const int tt = t + j - 15; if (tt < 0 || tt >= len) continue;
            const bf16* zr = Z + (size_t)(base + tt) * NZ; float a[8], g[8], wv[8]; ld8(zr + ZA + ch, a); ld8(zr + ZAG + ch, g); ldf8(w + j * 512 + ch, wv);
#pragma unroll
            for (int i = 0; i < 8; ++i) acc[i] = fmaf(a[i] * sigmoidf_(g[i]), wv[i], acc[i]); }
        float bv[8]; ldf8(p.conv_b + l * 512 + ch, bv); float s = 0.f;
#pragma unroll
        for (int i = 0; i < 8; ++i) { acc[i] += bv[i]; s += acc[i]; }
        const float mean = wave_sum(s) * (1.f / 512.f); float q = 0.f;
#pragma unroll
        for (int i = 0; i < 8; ++i) { acc[i] -= mean; q += acc[i] * acc[i]; }
        const float rstd = rsqrtf(wave_sum(q) * (1.f / 512.f) + 1e-6f);
        float lg[8], lb[8], o[8]; ldf8(p.conv_ln_g + l * 512 + ch, lg); ldf8(p.conv_ln_b + l * 512 + ch, lb);
#pragma unroll
        for (int i = 0; i < 8; ++i) o[i] = siluf_(acc[i] * rstd * lg[i] + lb[i]);
        st8(Y + (size_t)row * D + ch, o);
    }
    for (int row = gw; row < MROWS; row += NGW) {
        int base, len, t; seq_of(row, base, len, t);
        const float* w = p.gd_conv + (size_t)l * 5 * 1536;
#pragma unroll
        for (int part = 0; part < 3; ++part) {
            float acc[8];
#pragma unroll
            for (int i = 0; i < 8; ++i) acc[i] = 0.f;
#pragma unroll
            for (int j = 0; j < 5; ++j) { const int tt = t + j - 2; if (tt < 0 || tt >= len) continue;
                float a[8], wv[8]; ld8(Z + (size_t)(base + tt) * NZ + GDQ + part * 512 + ch, a); ldf8(w + j * 1536 + part * 512 + ch, wv);
#pragma unroll
                for (int i = 0; i < 8; ++i) acc[i] = fmaf(a[i], wv[i], acc[i]); }
            float ss = 0.f;
#pragma unroll
            for (int i = 0; i < 8; ++i) { acc[i] = siluf_(acc[i]); ss += acc[i] * acc[i]; }
            if (part < 2) { ss = grp_sum<16>(ss); const float sc = rsqrtf(ss + 1e-6f) * (part == 0 ? 0.08838834764831845f : 1.f);
#pragma unroll
                for (int i = 0; i < 8; ++i) acc[i] *= sc; }
            stf8(SA + (size_t)(SA_GQ + part) * (MROWS * 512) + (size_t)row * 512 + ch, acc);
        }
        if (c.lane < 8) { const int dir = c.lane >> 2, h = c.lane & 3; const float a = G32[(size_t)row * 32 + 16 + dir * 8 + h], bb = G32[(size_t)row * 32 + 16 + dir * 8 + 4 + h];
            SG[(size_t)row * 16 + dir * 4 + h] = -expf(p.gd_a_log[l * 8 + dir * 4 + h]) * softplusf_(a + p.gd_dt_bias[l * 8 + dir * 4 + h]);
            SG[(size_t)row * 16 + 8 + dir * 4 + h] = sigmoidf_(bb); }
    }
    {
        LAS float* in = (LAS float*)c.lds;
        const float* mu = p.rw_mu + (size_t)l * 2 * RWMIX;
        for (int u = c.bid; u < MROWS / 34; u += c.G) {
            const int row0 = u * 34;
            __syncthreads();
            for (int i = c.tid; i < 34 * 448; i += 512) { const int t = i / 448, k = i % 448; float f = rw_feat(Z, mu, row0 + t, 1536 + k);
                if (k < 96) f = tanhf(f); else if (k >= 192) f = sigmoidf_(f); in[i] = f; }
            __syncthreads();
            for (int hf = 0; hf < 34 / RWT; ++hf) rwkv_prep_rows(c, l, row0 + hf * RWT, in + hf * RWT * 448, in + 34 * 448, in + 34 * 448 + RWT * 512);
        }
        __syncthreads();
    }
}

DI void scan_mlstm(Ctx& c, int l, int chain) {
    const Params& p = *c.p; const bf16* Z = (const bf16*)(c.ws + WS_Z); const float* G32 = (const float*)(c.ws + WS_G32); float* SA = (float*)(c.ws + WS_S);
    const int g = chain >> 2, h = chain & 3, dir = g >> 1, b = g & 1; const int e = c.tid >> 2, dq = c.tid & 3;
    LAS float* sq = (LAS float*)c.lds; LAS float* sk = sq + 64 * 144; LAS float* sv = sk + 64 * 144; LAS float* sg = sv + 64 * 128;
    float* HM = SA + (size_t)(SA_HM0 + dir) * ((size_t)MROWS * 512);
    float C[32], nn[32], m = 0.f;
#pragma unroll
    for (int i = 0; i < 32; ++i) { C[i] = 0.f; nn[i] = 0.f; }
    const float gbi = p.ml_gate_b[((l * 2 + dir) * 2 + 0) * 4 + h], gbf = p.ml_gate_b[((l * 2 + dir) * 2 + 1) * 4 + h];
    for (int blk = 0; blk < (TC + T) / 64; ++blk) {
        __syncthreads();
        for (int it = c.tid; it < 64 * 48; it += 512) { const int tt = it / 48, r = it % 48, part = r >> 4, c8 = (r & 15) * 8; const int row = scan_row(dir, b, blk * 64 + tt);
            float v[8]; ld8(Z + (size_t)row * NZ + MLQ + part * 512 + h * 128 + c8, v);
            if (part == 2) {
#pragma unroll
                for (int i = 0; i < 8; ++i) sv[tt * 128 + c8 + i] = v[i]; }
            else { LAS float* d = (part == 0 ? sq : sk) + tt * 144 + (c8 >> 5) * 36 + (c8 & 31); const float sc = part == 0 ? 0.08838834764831845f : 1.f;
#pragma unroll
                for (int i = 0; i < 8; ++i) d[i] = v[i] * sc; } }
        if (c.tid < 64) { const int row = scan_row(dir, b, blk * 64 + c.tid); sg[c.tid * 2] = G32[(size_t)row * 32 + dir * 8 + h] + gbi; sg[c.tid * 2 + 1] = logsigmoidf_(G32[(size_t)row * 32 + dir * 8 + 4 + h] + gbf); }
        __syncthreads();
        for (int tt = 0; tt < 64; ++tt) {
            const float li = sg[2 * tt], lf = sg[2 * tt + 1]; const float mn = fmaxf(lf + m, li); const float fs = expf(lf + m - mn), is = expf(li - mn); m = mn;
            const float iv = is * sv[tt * 128 + e]; float hp = 0.f, dp = 0.f;
#pragma unroll
            for (int i4 = 0; i4 < 8; ++i4) { const f32x4 k4 = *(const LAS f32x4*)(sk + tt * 144 + dq * 36 + i4 * 4), q4 = *(const LAS f32x4*)(sq + tt * 144 + dq * 36 + i4 * 4);
#pragma unroll
                for (int j = 0; j < 4; ++j) { const int i = i4 * 4 + j; C[i] = fmaf(C[i], fs, iv * k4[j]); hp = fmaf(C[i], q4[j], hp); nn[i] = fmaf(nn[i], fs, is * k4[j]); dp = fmaf(nn[i], q4[j], dp); } }
            hp += __shfl_xor(hp, 1); hp += __shfl_xor(hp, 2); dp += __shfl_xor(dp, 1); dp += __shfl_xor(dp, 2);
            if (dq == 0) HM[(size_t)scan_row(dir, b, blk * 64 + tt) * 512 + h * 128 + e] = hp / fmaxf(fabsf(dp), expf(-m));
        }
    }
}
DI void scan_gdn(Ctx& c, int l, int chain) {
    float* SA = (float*)(c.ws + WS_S); const float* SG = (const float*)(c.ws + WS_SG); const size_t AS = (size_t)MROWS * 512;
    const int g = chain >> 2, h = chain & 3, dir = g >> 1, b = g & 1; const int e = c.tid >> 2, dq = c.tid & 3;
    LAS float* sq = (LAS float*)c.lds; LAS float* sk = sq + 64 * 144; LAS float* sv = sk + 64 * 144; LAS float* sg = sv + 64 * 128;
    float* HG = SA + (size_t)(SA_HG0 + dir) * AS;
    float S[32];
#pragma unroll
    for (int i = 0; i < 32; ++i) S[i] = 0.f;
    for (int blk = 0; blk < (TC + T) / 64; ++blk) {
        __syncthreads();
        for (int it = c.tid; it < 64 * 48; it += 512) { const int tt = it / 48, r = it % 48, part = r >> 4, c8 = (r & 15) * 8; const int row = scan_row(dir, b, blk * 64 + tt);
            float v[8]; ldf8(SA + (size_t)(SA_GQ + part) * AS + (size_t)row * 512 + h * 128 + c8, v);
            LAS float* d = part == 2 ? sv + tt * 128 + c8 : (part == 0 ? sq : sk) + tt * 144 + (c8 >> 5) * 36 + (c8 & 31);
#pragma unroll
            for (int i = 0; i < 8; ++i) d[i] = v[i]; }
        if (c.tid < 64) { const int row = scan_row(dir, b, blk * 64 + c.tid); sg[c.tid * 2] = expf(SG[(size_t)row * 16 + dir * 4 + h]); sg[c.tid * 2 + 1] = SG[(size_t)row * 16 + 8 + dir * 4 + h]; }
        __syncthreads();
        for (int tt = 0; tt < 64; ++tt) {
            const float a = sg[2 * tt], be = sg[2 * tt + 1]; float pp = 0.f; f32x4 k4[8];
#pragma unroll
            for (int i4 = 0; i4 < 8; ++i4) { k4[i4] = *(const LAS f32x4*)(sk + tt * 144 + dq * 36 + i4 * 4);
#pragma unroll
                for (int j = 0; j < 4; ++j) { const int i = i4 * 4 + j; S[i] *= a; pp = fmaf(k4[i4][j], S[i], pp); } }
            pp += __shfl_xor(pp, 1); pp += __shfl_xor(pp, 2);
            const float vn = be * (sv[tt * 128 + e] - pp); float o = 0.f;
#pragma unroll
            for (int i4 = 0; i4 < 8; ++i4) { const f32x4 q4 = *(const LAS f32x4*)(sq + tt * 144 + dq * 36 + i4 * 4);
#pragma unroll
                for (int j = 0; j < 4; ++j) { const int i = i4 * 4 + j; S[i] = fmaf(k4[i4][j], vn, S[i]); o = fmaf(q4[j], S[i], o); } }
            o += __shfl_xor(o, 1); o += __shfl_xor(o, 2);
            if (dq == 0) HG[(size_t)scan_row(dir, b, blk * 64 + tt) * 512 + h * 128 + e] = o;
        }
    }
}
DI void scan_rwkv(Ctx& c, int l, int chain) {
    float* SA = (float*)(c.ws + WS_S); const size_t AS = (size_t)MROWS * 512;
    const int g = chain >> 3, h = chain & 7, dir = g >> 1, b = g & 1; const int i = c.tid >> 3, part = c.tid & 7;
    LAS float* sr = (LAS float*)c.lds;
    float* HR = SA + (size_t)(SA_HR0 + dir) * AS;
    float S[8];
#pragma unroll
    for (int j = 0; j < 8; ++j) S[j] = 0.f;
    for (int blk = 0; blk < (TC + T) / 64; ++blk) {
        __syncthreads();
        for (int it = c.tid; it < 6 * 64 * 8; it += 512) { const int arr = it / 512, r = it % 512, tt = r >> 3, c8 = (r & 7) * 8; const int row = scan_row(dir, b, blk * 64 + tt);
            const int sa = arr == 0 ? SA_RR : arr == 1 ? SA_RW0 + dir : arr == 2 ? SA_RK0 + dir : arr == 3 ? SA_RV : arr == 4 ? SA_RA : SA_RB0 + dir;
            float v[8]; ldf8(SA + (size_t)sa * AS + (size_t)row * 512 + h * 64 + c8, v); LAS float* d = sr + arr * 4096 + tt * 64 + c8;
#pragma unroll
            for (int j = 0; j < 8; ++j) d[j] = v[j]; }
        __syncthreads();
        for (int tt = 0; tt < 64; ++tt) {
            const LAS float* bp = sr + tt * 64 + part * 8;
            float r8[8], w8[8], k8[8], a8[8], b8[8];
#pragma unroll
            for (int j = 0; j < 8; j += 4) { const f32x4 x0 = *(const LAS f32x4*)(bp + j), x1 = *(const LAS f32x4*)(bp + 4096 + j), x2 = *(const LAS f32x4*)(bp + 8192 + j), x4 = *(const LAS f32x4*)(bp + 16384 + j), x5 = *(const LAS f32x4*)(bp + 20480 + j);
#pragma unroll
                for (int q = 0; q < 4; ++q) { r8[j + q] = x0[q]; w8[j + q] = x1[q]; k8[j + q] = x2[q]; a8[j + q] = x4[q]; b8[j + q] = x5[q]; } }
            const float vi = sr[3 * 4096 + tt * 64 + i];
            float sa = 0.f;
#pragma unroll
            for (int j = 0; j < 8; ++j) sa = fmaf(S[j], a8[j], sa);
            sa += __shfl_xor(sa, 1); sa += __shfl_xor(sa, 2); sa += __shfl_xor(sa, 4);
            float y = 0.f;
#pragma unroll
            for (int j = 0; j < 8; ++j) { S[j] = fmaf(S[j], w8[j], fmaf(sa, b8[j], vi * k8[j])); y = fmaf(S[j], r8[j], y); }
            y += __shfl_xor(y, 1); y += __shfl_xor(y, 2); y += __shfl_xor(y, 4);
            if (part == 0) HR[(size_t)scan_row(dir, b, blk * 64 + tt) * 512 + h * 64 + i] = y;
        }
    }
}
DI void phase_scan(Ctx& c, int l) {
    for (int u = c.bid; u < 64; u += c.G) {
        if (u < 16) scan_mlstm(c, l, u); else if (u < 32) scan_gdn(c, l, u - 16); else scan_rwkv(c, l, u - 32);
    }
    __syncthreads();
}
DI void phase_finish(Ctx& c, int l) {
    const Params& p = *c.p; const bf16* Z = (const bf16*)(c.ws + WS_Z); bf16* Y = (bf16*)(c.ws + WS_Y); const float* SA = (const float*)(c.ws + WS_S); const size_t AS = (size_t)MROWS * 512;
    const int gw = c.bid * 8 + c.wave, NGW = c.G * 8; const int ch = c.lane * 8;
    for (int row = gw; row < MROWS; row += NGW) {
        const size_t ro = (size_t)row * 512 + ch;
        { float a[8], b[8], g[8], o[8], y[8]; ldf8(SA + SA_HM0 * AS + ro, a); ldf8(SA + SA_HM1 * AS + ro, b); float ss = 0.f;
#pragma unroll
          for (int i = 0; i < 8; ++i) { a[i] += b[i]; ss += a[i] * a[i]; }
          const float rs = rsqrtf(grp_sum<16>(ss) * (1.f / 128.f) + 1e-6f); ldf8(p.ml_norm_g + l * 512 + ch, g); ld8(Z + (size_t)row * NZ + MLO + ch, o);
#pragma unroll
          for (int i = 0; i < 8; ++i) y[i] = a[i] * rs * g[i] * sigmoidf_(o[i]);
          st8(Y + (size_t)row * D + 512 + ch, y); }
        { float a[8], b[8], g[8], o[8], y[8]; ldf8(SA + SA_HG0 * AS + ro, a); ldf8(SA + SA_HG1 * AS + ro, b); float ss = 0.f;
#pragma unroll
          for (int i = 0; i < 8; ++i) { a[i] += b[i]; ss += a[i] * a[i]; }
          const float rs = rsqrtf(grp_sum<16>(ss) * (1.f / 128.f) + 1e-6f); ldf8(p.gd_norm_g + l * 512 + ch, g); ld8(Z + (size_t)row * NZ + GDZ + ch, o);
#pragma unroll
          for (int i = 0; i < 8; ++i) y[i] = a[i] * rs * g[i] * siluf_(o[i]);
          st8(Y + (size_t)row * D + 1024 + ch, y); }
        { float a[8], b[8], g[8], bb[8], ax[8], gg[8], y[8]; ldf8(SA + SA_HR0 * AS + ro, a); ldf8(SA + SA_HR1 * AS + ro, b); float s = 0.f;
#pragma unroll
          for (int i = 0; i < 8; ++i) { a[i] += b[i]; s += a[i]; }
          const float mean = grp_sum<8>(s) * (1.f / 64.f); float q = 0.f;
#pragma unroll
          for (int i = 0; i < 8; ++i) { a[i] -= mean; q += a[i] * a[i]; }
          const float rs = rsqrtf(grp_sum<8>(q) * (1.f / 64.f) + 64e-5f);
          ldf8(p.rw_ln_g + l * 512 + ch, g); ldf8(p.rw_ln_b + l * 512 + ch, bb); ldf8(SA + SA_RAUX * AS + ro, ax); ldf8(SA + SA_RG * AS + ro, gg);
#pragma unroll
          for (int i = 0; i < 8; ++i) y[i] = (a[i] * rs * g[i] + bb[i] + ax[i]) * gg[i];
          st8(Y + (size_t)row * D + 1536 + ch, y); }
    }
}
DI void phase_ffnconv(Ctx& c, int l) {
    const Params& p = *c.p; const bf16* UP = (const bf16*)(c.ws + WS_Z); bf16* H = (bf16*)(c.ws + WS_S); const float* w = p.ffn_dw + (size_t)l * 9 * DFF;
    constexpr int CPR = DFF / 8;
    for (int it = c.bid * 512 + c.tid; it < MROWS * CPR; it += c.G * 512) {
        const int row = it / CPR, ch = (it % CPR) * 8; float acc[8];
#pragma unroll
        for (int i = 0; i < 8; ++i) acc[i] = 0.f;
        if (row < LAT) { const int bb = row >> 12, t = row & 4095, gy = t >> 6, gx = t & 63;
#pragma unroll
            for (int dy = 0; dy < 3; ++dy)
#pragma unroll
                for (int dx = 0; dx < 3; ++dx) { const int yy = gy + dy - 1, xx = gx + dx - 1; if (yy < 0 || yy >= 64 || xx < 0 || xx >= 64) continue;
                    float a[8], wv[8]; ld8(UP + (size_t)(bb * T + yy * 64 + xx) * (2 * DFF) + ch, a); ldf8(w + (dy * 3 + dx) * DFF + ch, wv);
#pragma unroll
                    for (int i = 0; i < 8; ++i) acc[i] = fmaf(a[i], wv[i], acc[i]); } }
        else { const int r = row - LAT, t = r & (TC - 1);
#pragma unroll
            for (int dx = 0; dx < 3; ++dx) { const int tt = t + dx - 1; if (tt < 0 || tt >= TC) continue;
                float a[8], wv[8]; ld8(UP + (size_t)(row + dx - 1) * (2 * DFF) + ch, a); ldf8(w + (3 + dx) * DFF + ch, wv);
#pragma unroll
                for (int i = 0; i < 8; ++i) acc[i] = fmaf(a[i], wv[i], acc[i]); } }
        float v[8], o[8]; ld8(UP + (size_t)row * (2 * DFF) + DFF + ch, v);
#pragma unroll
        for (int i = 0; i < 8; ++i) o[i] = gelu_tanh(acc[i]) * v[i];
        st8(H + (size_t)row * DFF + ch, o);
    }
}

constexpr int PH_PRO = 3, PH_PER_LAYER = 11, NPHASE = PH_PRO + NL * PH_PER_LAYER;
#ifndef MK_PER_PHASE
#define MK_PER_PHASE 1
#endif
constexpr int CW_BAR = 4096;

__global__ void __launch_bounds__(512, 2) fwd_kernel(Params p) {
    extern __shared__ __attribute__((aligned(16))) unsigned char lds_raw[];
    Ctx c; c.lds = (LAS unsigned char*)lds_raw; c.tid = threadIdx.x; c.lane = c.tid & 63; c.wave = __builtin_amdgcn_readfirstlane(c.tid >> 6); c.G = gridDim.x; c.bid = blockIdx.x; c.p = &p; c.ws = p.ws;
    volatile LAS unsigned* MISC = (volatile LAS unsigned*)(c.lds + LDS_MISC);
    if (c.tid < 32) MISC[c.tid] = 0u;
    __syncthreads();
    const int lo = p.ph_lo, hi = p.ph_hi;
    XcdBarrier bar; bar.bar = (unsigned*)(p.ws + WS_CTL) + CW_BAR; bar.x = 0; bar.st = MISC + 8;
    if (hi - lo > 1) bar = xcd_barrier_post((unsigned*)(p.ws + WS_CTL) + CW_BAR, MISC + 8);
#ifndef PH_MASK
#define PH_MASK 0xFFFFFFFFu
#endif
#define IN(k) (lo <= (k) && (k) < hi)
#define EN(b) ((PH_MASK >> (b)) & 1u)
#define RF() do { int t_ = threadIdx.x; asm volatile("" : "+v"(t_)); c.tid = t_; c.lane = t_ & 63; } while (0)
#define SEAM(k) do { if (IN((k) + 1)) xcd_barrier(bar); } while (0)
    if (EN(0) && IN(0)) { RF(); phase_pro0(c); SEAM(0); }
    if (EN(1) && IN(1)) { RF(); phase_pro1(c); SEAM(1); }
    if (EN(2) && IN(2)) { RF(); phase_pro2(c); SEAM(2); }
    bf16* U = (bf16*)(p.ws + WS_U); bf16* Y = (bf16*)(p.ws + WS_Y); bf16* MB = (bf16*)(p.ws + WS_MB); float* G32 = (float*)(p.ws + WS_G32); float* F = (float*)(p.ws + WS_F);
    bf16* Z = (bf16*)(p.ws + WS_Z); bf16* H = (bf16*)(p.ws + WS_S);
    for (int l = 0; l < NL; ++l) {
        const int pb = PH_PRO + l * PH_PER_LAYER; unsigned char* wl = p.ws + WS_W + (size_t)l * WL_SIZE;
        if (EN(3) && IN(pb + 0)) { pg8::Gemm g{U, (const bf16*)(wl + WL_IN), D, D, D}; pg8::StdOrder S; S.init(MROWS / 256, NZ / 256, c.G, c.bid); pg8::EpiBf16 E{Z, NZ, G32, (ZSM - 192) / 256};
            pg8::gemm_phase(c.lds, g, S, E); SEAM(pb + 0); }
        if (EN(4) && IN(pb + 1)) { RF(); phase_prep(c, l); SEAM(pb + 1); }
        if (EN(5) && IN(pb + 2)) { RF(); phase_scan(c, l); SEAM(pb + 2); }
        if (EN(6) && IN(pb + 3)) { RF(); phase_finish(c, l); SEAM(pb + 3); }
        if (EN(7) && IN(pb + 4)) { pg8::Gemm g{Y, (const bf16*)(wl + WL_BR), D, MIXW, MIXW}; pg8::MergeOrder S; S.init(MROWS / 256, D / 256, c.G, c.bid); pg8::EpiMerge E{Z, NZ, ZG, F, MB, D};
            pg8::gemm_phase(c.lds, g, S, E); SEAM(pb + 4); }
        if (EN(8) && IN(pb + 5)) { pg8::Gemm g{MB, (const bf16*)(wl + WL_OUT), D, D, D}; pg8::StdOrder S; S.init(MROWS / 256, D / 256, c.G, c.bid); pg8::EpiF32 E{F, D};
            pg8::gemm_phase(c.lds, g, S, E); SEAM(pb + 5); }
        if (EN(9) && IN(pb + 6)) { RF(); phase_resid(c, l, 0); SEAM(pb + 6); }
        if (EN(10) && IN(pb + 7)) { pg8::Gemm g{U, (const bf16*)(wl + WL_UP), D, D, D}; pg8::StdOrder S; S.init(MROWS / 256, 2 * DFF / 256, c.G, c.bid); pg8::EpiBf16 E{Z, 2 * DFF, nullptr, -1};
            pg8::gemm_phase(c.lds, g, S, E); SEAM(pb + 7); }
        if (EN(11) && IN(pb + 8)) { RF(); phase_ffnconv(c, l); SEAM(pb + 8); }
        if (EN(12) && IN(pb + 9)) { pg8::Gemm g{H, (const bf16*)(wl + WL_DN), DFF, DFF, DFF}; pg8::StdOrder S; S.init(MROWS / 256, D / 256, c.G, c.bid); pg8::EpiF32 E{F, D};
            pg8::gemm_phase(c.lds, g, S, E); SEAM(pb + 9); }
        if (EN(13) && IN(pb + 10)) { RF(); phase_resid(c, l, 1); SEAM(pb + 10); }
    }
#undef IN
#undef SEAM
}

extern "C" void kernel_launch(void* const* d_in, const int* in_sizes, int n_in, void* d_out, int out_size, void* d_ws, size_t ws_size, hipStream_t stream) {
    static int grid = 0;
    if (grid == 0) {
        if (n_in != 34 || ws_size < WS_END) { fprintf(stderr, "kernel_launch: unexpected n_in %d / ws %zu (need %zu)\n", n_in, ws_size, (size_t)WS_END); grid = -1; return; }
        int dev = 0, cus = 0;
        if (hipGetDevice(&dev) != hipSuccess || hipDeviceGetAttribute(&cus, hipDeviceAttributeMultiprocessorCount, dev) != hipSuccess) { grid = -1; return; }
        if (hipFuncSetAttribute((const void*)fwd_kernel, hipFuncAttributeMaxDynamicSharedMemorySize, LDS_BYTES) != hipSuccess) { fprintf(stderr, "kernel_launch: hipFuncSetAttribute failed\n"); grid = -1; return; }
        int per_cu = 0;
        if (hipOccupancyMaxActiveBlocksPerMultiprocessor(&per_cu, (const void*)fwd_kernel, 512, LDS_BYTES) != hipSuccess || per_cu < 1) { fprintf(stderr, "kernel_launch: occupancy query says %d\n", per_cu); }
        (void)hipGetLastError();
        grid = cus;
    }
    if (grid < 0) return;
    (void)hipMemsetAsync((char*)d_ws + WS_CTL, 0, CTL_BYTES, stream);
    Params p{};
    const float** pp = (const float**)&p;
    for (int i = 0; i < 34; ++i) pp[i] = (const float*)d_in[i];
    p.out = (float*)d_out; p.ws = (unsigned char*)d_ws;
#if MK_PER_PHASE
    for (int k = 0; k < NPHASE; ++k) { p.ph_lo = k; p.ph_hi = k + 1; hipLaunchKernelGGL(fwd_kernel, dim3(grid), dim3(512), LDS_BYTES, stream, p); }
#else
    p.ph_lo = 0; p.ph_hi = NPHASE; hipLaunchKernelGGL(fwd_kernel, dim3(grid), dim3(512), LDS_BYTES, stream, p);
#endif
}
```

```cpp
#include <hip/hip_runtime.h>
#include <cstdio>
#include <cstdint>

#define GAS __attribute__((address_space(1)))
#define LAS __attribute__((address_space(3)))
#define DI __device__ __forceinline__
typedef unsigned short bf16;
typedef float f32x4 __attribute__((ext_vector_type(4)));
typedef float f32x2 __attribute__((ext_vector_type(2)));
typedef unsigned u32x4 __attribute__((ext_vector_type(4)));
typedef unsigned u32x2 __attribute__((ext_vector_type(2)));
typedef short bf16x8 __attribute__((ext_vector_type(8)));

constexpr int D = 2048, NB = 2, T = 4096, TC = 256, NL = 4;
constexpr int LAT = NB * T;
constexpr int MROWS = LAT + NB * TC;
constexpr int MIXW = 512, DFF = 5632;
constexpr int NIN = 15328, NZ = 15360;
constexpr int ZA = 0, ZAG = 512, MLQ = 1024, MLK = 1536, MLV = 2048, MLO = 2560, GDQ = 3072, GDK = 3584, GDV = 4096, GDZ = 4608;
constexpr int RWR = 5120, RWK = 5632, RWV = 6144, RWXW = 6656, RWXA = 6752, RWXG = 6848, ZG = 7104, ZSM = 15296;
constexpr int RWMIX = 1984;

namespace pg8 {
typedef unsigned short bf16_t;
constexpr int BM = 256, BK = 64, HALF = 128, HTB = HALF * BK * 2, STAGE_BYTES = 8 * HTB, NXCD = 8, WGM = 8;
__host__ __device__ __forceinline__ int lds_byte(int r, int c) { const int st = (r >> 4) * 2 + (c >> 5), rr = r & 15, cc = c & 31, ob = rr * 64 + cc * 2; return st * 1024 + (ob ^ (((ob >> 9) & 1) << 5)); }
__host__ __device__ __forceinline__ void stage_rc(int b, int& R, int& C) { const int st = b / 1024, sb = b % 1024, swz = sb ^ (((sb >> 9) & 1) << 5); R = (st >> 1) * 16 + swz / 64; C = (st & 1) * 32 + (swz % 64) / 2; }
__host__ __device__ __forceinline__ int perm32(int rho) { const int n = rho >> 4, i = rho & 15; return 8 * (i >> 2) + 4 * n + (i & 3); }

struct Unit { int pm, pn, sub; };
struct Gemm { const bf16_t* A; const bf16_t* Bt; int lda, ldb, K; };

struct StdOrder {
    int nM, nN, nwg, G, c;
    DI void init(int nM_, int nN_, int G_, int c_) { nM = nM_; nN = nN_; nwg = nM * nN; G = G_; c = c_; }
    DI bool map(int i, Unit& u) const {
        const long L = (long)i * G + c; if (L >= nwg) return false;
        int wgid = (int)L; { const int q = nwg / NXCD, r = nwg % NXCD, xcd = wgid % NXCD, off = wgid / NXCD; wgid = (xcd < r ? xcd * (q + 1) : r * (q + 1) + (xcd - r) * q) + off; }
        const int nig = WGM * nN, gid = wgid / nig, fm = gid * WGM, gsz = (nM - fm) < WGM ? (nM - fm) : WGM;
        u.pm = fm + ((wgid % nig) % gsz); u.pn = (wgid % nig) / gsz; return true;
    }
    DI bool next(int i, Unit& u) const { u.sub = 0; return map(i, u); }
    DI const char* a_ptr(const Gemm& g, const Unit& u) const { return (const char*)g.A + (size_t)u.pm * BM * g.lda * 2; }
    DI const char* b_ptr(const Gemm& g, const Unit& u) const { return (const char*)g.Bt + (size_t)u.pn * BM * g.ldb * 2; }
};
struct MergeOrder : StdOrder {
    DI bool next(int i4, Unit& u) const { u.sub = i4 & 3; return map(i4 >> 2, u); }
    DI const char* a_ptr(const Gemm& g, const Unit& u) const { return (const char*)g.A + (size_t)u.pm * BM * g.lda * 2 + (size_t)u.sub * 512 * 2; }
    DI const char* b_ptr(const Gemm& g, const Unit& u) const { return (const char*)g.Bt + ((size_t)u.sub * 2048 + (size_t)u.pn * BM) * g.ldb * 2; }
};

DI unsigned cvt_pk_bf16(float lo, float hi) { unsigned r; asm volatile("v_cvt_pk_bf16_f32 %0, %1, %2" : "=v"(r) : "v"(lo), "v"(hi)); return r; }

struct EpiF32 {
    static constexpr bool PERM = false;
    float* C; int ldc;
    DI void operator()(const f32x4 (&acc)[2][2][4][2], const Unit& u, int wr, int wc, int fr, int fq) const {
        const int row0 = u.pm * BM + wr * 64 + fr, col0 = u.pn * BM + wc * 32 + 4 * fq;
#pragma unroll
        for (int ai = 0; ai < 2; ++ai)
#pragma unroll
            for (int m = 0; m < 4; ++m) { float* rowp = C + (size_t)(row0 + ai * HALF + m * 16) * ldc + col0;
#pragma unroll
                for (int bj = 0; bj < 2; ++bj)
#pragma unroll
                    for (int n = 0; n < 2; ++n) *(f32x4*)(rowp + bj * HALF + n * 16) = acc[ai][bj][m][n]; }
    }
};
struct EpiBf16 {
    static constexpr bool PERM = true;
    bf16_t* O; int ldc; float* G32; int gtile;
    DI void operator()(const f32x4 (&acc)[2][2][4][2], const Unit& u, int wr, int wc, int fr, int fq) const {
        const int row0 = u.pm * BM + wr * 64 + fr; const int col0 = u.pn * BM + wc * 32 + 8 * fq;
#pragma unroll
        for (int ai = 0; ai < 2; ++ai)
#pragma unroll
            for (int m = 0; m < 4; ++m) { const int row = row0 + ai * HALF + m * 16; bf16_t* rowp = O + (size_t)row * ldc + col0;
#pragma unroll
                for (int bj = 0; bj < 2; ++bj) { const f32x4 v0 = acc[ai][bj][m][0], v1 = acc[ai][bj][m][1];
                    u32x4 w; w.x = cvt_pk_bf16(v0[0], v0[1]); w.y = cvt_pk_bf16(v0[2], v0[3]); w.z = cvt_pk_bf16(v1[0], v1[1]); w.w = cvt_pk_bf16(v1[2], v1[3]);
                    *(u32x4*)(rowp + bj * HALF) = w;
                    if (bj == 1 && G32 != nullptr && u.pn == gtile && wc == 2) { float* gp = G32 + (size_t)row * 32 + 8 * fq; *(f32x4*)gp = v0; *(f32x4*)(gp + 4) = v1; } } }
    }
};
struct EpiMerge {
    static constexpr bool PERM = true;
    const bf16_t* Z; int ldz; int zg; float* P; bf16_t* Mb; int ldc;
    DI void operator()(const f32x4 (&acc)[2][2][4][2], const Unit& u, int wr, int wc, int fr, int fq) const {
        const int row0 = u.pm * BM + wr * 64 + fr; const int col0 = u.pn * BM + wc * 32 + 8 * fq;
#pragma unroll
        for (int ai = 0; ai < 2; ++ai)
#pragma unroll
            for (int m = 0; m < 4; ++m) { const int row = row0 + ai * HALF + m * 16;
#pragma unroll
                for (int bj = 0; bj < 2; ++bj) { const int col = col0 + bj * HALF;
                    const u32x4 gw = *(const u32x4*)(Z + (size_t)row * ldz + zg + u.sub * 2048 + col);
                    float gt[8];
#pragma unroll
                    for (int j = 0; j < 4; ++j) { gt[2 * j] = __uint_as_float(gw[j] << 16); gt[2 * j + 1] = __uint_as_float(gw[j] & 0xffff0000u); }
                    f32x4 v0 = acc[ai][bj][m][0], v1 = acc[ai][bj][m][1];
#pragma unroll
                    for (int j = 0; j < 4; ++j) { v0[j] *= 1.f / (1.f + __expf(-gt[j])); v1[j] *= 1.f / (1.f + __expf(-gt[4 + j])); }
                    float* pp = P + (size_t)row * ldc + col;
                    if (u.sub > 0) { v0 += *(const f32x4*)pp; v1 += *(const f32x4*)(pp + 4); }
                    if (u.sub < 3) { *(f32x4*)pp = v0; *(f32x4*)(pp + 4) = v1; }
                    else { u32x4 w; w.x = cvt_pk_bf16(v0[0], v0[1]); w.y = cvt_pk_bf16(v0[2], v0[3]); w.z = cvt_pk_bf16(v1[0], v1[1]); w.w = cvt_pk_bf16(v1[2], v1[3]);
                        *(u32x4*)(Mb + (size_t)row * ldc + col) = w; } } }
    }
};

template <class Epi, class Sched>
DI void gemm_phase(LAS unsigned char* lds, const Gemm g, const Sched& S, const Epi& E) {
    int tid_ = threadIdx.x; asm volatile("" : "+v"(tid_));
    const int tid = tid_, wid = __builtin_amdgcn_readfirstlane(tid >> 6), lane = tid & 63, wr = wid >> 2, wc = wid & 3, fr = lane & 15, fq = lane >> 4;
    const int K = g.K, nt = K / BK;
    unsigned voffA[2], voffB[2];
#pragma unroll
    for (int i = 0; i < 2; ++i) { int R, C; stage_rc(tid * 16 + i * 8192, R, C); const int Rb = Epi::PERM ? ((R & ~31) + perm32(R & 31)) : R;
        voffA[i] = (unsigned)(R * g.lda + C) * 2u; voffB[i] = (unsigned)(Rb * g.ldb + C) * 2u; }
    const size_t kstep = (size_t)(BK * 2);
    const size_t hstepA = (size_t)HALF * g.lda * 2, hstepB = (size_t)HALF * g.ldb * 2;
    const unsigned ldsw = (unsigned)wid * 1024u;
    const int aoff = lds_byte(wr * 64 + fr, fq * 8), boff = lds_byte(wc * 32 + fr, fq * 8);
#define PG8_SA(b, h) (((b) * 2 + (h)) * HTB)
#define PG8_SB(b, h) ((4 + (b) * 2 + (h)) * HTB)
#define PG8_STAGE(bufoff, gbase, voff) do { _Pragma("unroll") for (int _i = 0; _i < 2; ++_i) \
        __builtin_amdgcn_global_load_lds((const unsigned*)((const char*)(gbase) + (voff)[_i]), (LAS unsigned*)(lds + (bufoff) + ldsw + _i * 8192), 16, 0, 0); } while (0)
#define PG8_LDA(dst, b, h) do { _Pragma("unroll") for (int m = 0; m < 4; ++m) _Pragma("unroll") for (int k = 0; k < 2; ++k) dst[m][k] = *(const LAS bf16x8*)(lds + PG8_SA(b, h) + aoff + m * 2048 + k * 1024); } while (0)
#define PG8_LDB(dst, b, h) do { _Pragma("unroll") for (int n = 0; n < 2; ++n) _Pragma("unroll") for (int k = 0; k < 2; ++k) dst[n][k] = *(const LAS bf16x8*)(lds + PG8_SB(b, h) + boff + n * 2048 + k * 1024); } while (0)
#define PG8_MMA(ai, bj, At, Bt) do { __builtin_amdgcn_s_setprio(1); _Pragma("unroll") for (int m = 0; m < 4; ++m) _Pragma("unroll") for (int n = 0; n < 2; ++n) _Pragma("unroll") for (int k = 0; k < 2; ++k) \
        acc[ai][bj][m][n] = __builtin_amdgcn_mfma_f32_16x16x32_bf16(Bt[n][k], At[m][k], acc[ai][bj][m][n], 0, 0, 0); __builtin_amdgcn_s_setprio(0); } while (0)
#define PG8_WAIT_V(n) asm volatile("s_waitcnt vmcnt(" #n ")" ::: "memory")
#define PG8_WAIT_L(n) asm volatile("s_waitcnt lgkmcnt(" #n ")" ::: "memory")
#define PG8_BAR __builtin_amdgcn_s_barrier()
#define PG8_SCHED __builtin_amdgcn_sched_barrier(0)
    Unit cur, nxt; int ui = 0;
    if (!S.next(0, cur)) return;
    f32x4 acc[2][2][4][2];
#pragma unroll
    for (int a = 0; a < 2; ++a)
#pragma unroll
        for (int b = 0; b < 2; ++b)
#pragma unroll
            for (int m = 0; m < 4; ++m)
#pragma unroll
                for (int n = 0; n < 2; ++n) acc[a][b][m][n] = (f32x4){0.f, 0.f, 0.f, 0.f};
    bf16x8 At[4][2], B0[2][2], B1[2][2];
    const char* cA = S.a_ptr(g, cur); const char* cB = S.b_ptr(g, cur);
    PG8_STAGE(PG8_SB(0, 0), cB, voffB); PG8_STAGE(PG8_SB(0, 1), cB + hstepB, voffB); PG8_STAGE(PG8_SA(0, 0), cA, voffA); PG8_STAGE(PG8_SA(0, 1), cA + hstepA, voffA);
    if (wr == 1) PG8_BAR;
    PG8_WAIT_V(2); PG8_BAR;
    PG8_STAGE(PG8_SB(1, 0), cB + kstep, voffB); PG8_STAGE(PG8_SA(1, 0), cA + kstep, voffA); PG8_STAGE(PG8_SB(1, 1), cB + hstepB + kstep, voffB);
    PG8_WAIT_V(6); PG8_BAR;
    for (;;) {
        const bool has_next = S.next(ui + 1, nxt);
        const char* nA = has_next ? S.a_ptr(g, nxt) : cA; const char* nB = has_next ? S.b_ptr(g, nxt) : cB;
        for (int t = 0; t < nt; t += 2) {
            const bool last = (t == nt - 2);
            const char* a1 = cA + (size_t)(t + 1) * kstep;
            const char* a2 = last ? nA : cA + (size_t)(t + 2) * kstep; const char* b2 = last ? nB : cB + (size_t)(t + 2) * kstep;
            const char* a3 = a2 + kstep; const char* b3 = b2 + kstep;
            PG8_LDB(B0, 0, 0); PG8_LDB(B1, 0, 1); PG8_SCHED; PG8_LDA(At, 0, 0); PG8_STAGE(PG8_SA(1, 1), a1 + hstepA, voffA);
            PG8_WAIT_V(8); PG8_WAIT_L(0); PG8_BAR; PG8_MMA(0, 0, At, B0); PG8_MMA(0, 1, At, B1); PG8_BAR; PG8_SCHED;
            PG8_LDA(At, 0, 1); PG8_STAGE(PG8_SB(0, 0), b2, voffB); PG8_STAGE(PG8_SB(0, 1), b2 + hstepB, voffB); PG8_STAGE(PG8_SA(0, 0), a2, voffA);
            PG8_WAIT_V(8); PG8_WAIT_L(0); PG8_BAR; PG8_MMA(1, 0, At, B0); PG8_MMA(1, 1, At, B1); PG8_BAR; PG8_SCHED;
            PG8_LDB(B0, 1, 0); PG8_LDB(B1, 1, 1); PG8_SCHED; PG8_LDA(At, 1, 0); PG8_STAGE(PG8_SA(0, 1), a2 + hstepA, voffA);
            PG8_WAIT_V(8); PG8_WAIT_L(0); PG8_BAR; PG8_MMA(0, 0, At, B0); PG8_MMA(0, 1, At, B1); PG8_BAR; PG8_SCHED;
            PG8_LDA(At, 1, 1); PG8_STAGE(PG8_SB(1, 0), b3, voffB); PG8_STAGE(PG8_SB(1, 1), b3 + hstepB, voffB); PG8_STAGE(PG8_SA(1, 0), a3, voffA);
            PG8_WAIT_V(8); PG8_WAIT_L(0); PG8_BAR; PG8_MMA(1, 0, At, B0); PG8_MMA(1, 1, At, B1); PG8_BAR; PG8_SCHED;
        }
        if (wr == 0) PG8_BAR;
        E(acc, cur, wr, wc, fr, fq);
        if (!has_next) break;
#pragma unroll
        for (int a = 0; a < 2; ++a)
#pragma unroll
            for (int b = 0; b < 2; ++b)
#pragma unroll
                for (int m = 0; m < 4; ++m)
#pragma unroll
                    for (int n = 0; n < 2; ++n) acc[a][b][m][n] = (f32x4){0.f, 0.f, 0.f, 0.f};
        cur = nxt; cA = nA; cB = nB; ++ui;
        if (wr == 1) PG8_BAR;
    }
    PG8_WAIT_V(0);
    PG8_BAR;
#undef PG8_SA
#undef PG8_SB
#undef PG8_STAGE
#undef PG8_LDA
#undef PG8_LDB
#undef PG8_MMA
#undef PG8_WAIT_V
#undef PG8_WAIT_L
#undef PG8_BAR
#undef PG8_SCHED
}
}

constexpr size_t al256(size_t x) { return (x + 255) & ~(size_t)255; }
constexpr size_t WS_CTL = 0, CTL_BYTES = 1u << 20;
constexpr size_t WS_MODP = WS_CTL + CTL_BYTES;
constexpr size_t WS_MOD = WS_MODP + al256((size_t)NL * 8 * 3 * 12288 * 4);
constexpr size_t WS_W = WS_MOD + al256((size_t)NL * 3 * 12288 * 4);
constexpr size_t WL_IN = 0, WL_BR = WL_IN + (size_t)NZ * D * 2, WL_OUT = WL_BR + (size_t)4 * D * MIXW * 2, WL_UP = WL_OUT + (size_t)D * D * 2,
                 WL_DN = WL_UP + (size_t)2 * DFF * D * 2, WL_SIZE = WL_DN + (size_t)D * DFF * 2;
constexpr size_t WS_U = WS_W + NL * WL_SIZE;
constexpr size_t WS_Y = WS_U + (size_t)MROWS * D * 2;
constexpr size_t WS_MB = WS_Y + (size_t)MROWS * D * 2;
constexpr size_t WS_G32 = WS_MB + (size_t)MROWS * D * 2;
constexpr size_t WS_X = WS_G32 + (size_t)MROWS * 32 * 4;
constexpr size_t WS_F = WS_X + (size_t)MROWS * D * 4;
constexpr size_t WS_Z = WS_F + (size_t)MROWS * D * 4;
constexpr size_t WS_S = WS_Z + (size_t)MROWS * NZ * 2;
constexpr size_t SARR = (size_t)MROWS * MIXW * 4;
constexpr int N_SARR = 20;
constexpr size_t WS_SG = WS_S + N_SARR * SARR;
constexpr size_t WS_END = WS_SG + (size_t)MROWS * 16 * 4;
static_assert((size_t)MROWS * DFF * 2 <= N_SARR * SARR && (size_t)MROWS * 2 * DFF * 2 <= (size_t)MROWS * NZ * 2, "aliases");
static_assert(WS_END < 1590000000ull, "workspace budget");
enum { SA_GQ = 0, SA_GK, SA_GV, SA_RR, SA_RV, SA_RA, SA_RW0, SA_RW1, SA_RK0, SA_RK1, SA_RB0, SA_RB1, SA_RAUX, SA_RG, SA_HM0, SA_HM1, SA_HG0, SA_HG1, SA_HR0, SA_HR1 };

constexpr int LDS_RING = 131072, LDS_MISC = LDS_RING + 320, LDS_BYTES = 147456;

#define XB_TMO      128
#define XB_XCNT(j)  (256  + 64 * (j))
#define XB_XSUB(j)  (1280 + 64 * (j))
#define XB_XGEN(j)  (2304 + 64 * (j))
#define XB_TOP      3328
#define XB_TOPGEN   3392
#define XCD_BAR_WORDS 3456
#define XB_SPIN_CAP (1u << 18)
__device__ __forceinline__ unsigned xb_ld(unsigned* p)              { return __hip_atomic_load(p, __ATOMIC_RELAXED, __HIP_MEMORY_SCOPE_AGENT); }
__device__ __forceinline__ unsigned xb_add(unsigned* p, unsigned v) { return __hip_atomic_fetch_add(p, v, __ATOMIC_RELAXED, __HIP_MEMORY_SCOPE_AGENT); }
__device__ __forceinline__ unsigned xb_xcc_id() { return (unsigned)__builtin_amdgcn_s_getreg((3 << 11) | 20) & 0xFu; }
#define XB_SPIN(cond, bar) do { unsigned _sp = 0; while (cond) { __builtin_amdgcn_s_sleep(1); \
    if ((++_sp & 255u) == 0u) { if (xb_ld(&(bar)[XB_TMO])) break; if (_sp > XB_SPIN_CAP) { atomicAdd(&(bar)[XB_TMO], 1u); break; } } } } while (0)
struct XcdBarrier { unsigned* bar; unsigned x; volatile LAS unsigned* st; };
__device__ __forceinline__ XcdBarrier xcd_barrier_post(unsigned* bar, volatile LAS unsigned* st) {
    XcdBarrier b; b.bar = bar; b.x = xb_xcc_id(); b.st = st;
    if (threadIdx.x == 0) (void)xb_add(&bar[XB_XCNT(b.x)], 1u);
    return b;
}
__device__ __forceinline__ void xcd_barrier_complete(unsigned* bar, unsigned x, unsigned& nloc, unsigned& nx) {
    const unsigned G = gridDim.x * gridDim.y * gridDim.z;
    unsigned sum, cnt, mine, sp = 0u;
    for (;;) {
        sum = 0u; cnt = 0u; mine = 0u;
#pragma unroll
        for (unsigned j = 0; j < 16; ++j) { const unsigned c = xb_ld(&bar[XB_XCNT(j)]); sum += c; cnt += (c > 0u) ? 1u : 0u; mine = (j == x) ? c : mine; }
        if (sum == G) break;
        __builtin_amdgcn_s_sleep(1);
        if ((++sp & 255u) == 0u) { if (xb_ld(&bar[XB_TMO])) break; if (sp > XB_SPIN_CAP) { atomicAdd(&bar[XB_TMO], 1u); break; } }
    }
    nloc = mine > 0u ? mine : 1u; nx = cnt > 0u ? cnt : 1u;
}
__device__ __forceinline__ void xcd_barrier(const XcdBarrier& b) {
    asm volatile("s_waitcnt vmcnt(0)" ::: "memory");
    __syncthreads();
    if (threadIdx.x == 0) {
        unsigned* bar = b.bar;
        __builtin_amdgcn_s_waitcnt(0);
        unsigned nloc = b.st[0], nx = b.st[1];
        if (nloc == 0u) { xcd_barrier_complete(bar, b.x, nloc, nx); b.st[0] = nloc; b.st[1] = nx; }
        const unsigned old = xb_add(&bar[XB_XSUB(b.x)], 1u);
        const unsigned gen = old / nloc;
        if (old + 1u == (gen + 1u) * nloc) {
            __builtin_amdgcn_fence(__ATOMIC_RELEASE, "agent");
            asm volatile("s_waitcnt vmcnt(0)" ::: "memory");
            const unsigned og = xb_add(&bar[XB_TOP], 1u);
            const unsigned tg = og / nx;
            if (og + 1u == (tg + 1u) * nx) xb_add(&bar[XB_TOPGEN], 1u);
            else XB_SPIN(xb_ld(&bar[XB_TOPGEN]) == tg, bar);
            __builtin_amdgcn_fence(__ATOMIC_ACQUIRE, "agent");
            xb_add(&bar[XB_XGEN(b.x)], 1u);
            asm volatile("s_waitcnt vmcnt(0)" ::: "memory");
        } else {
            XB_SPIN(xb_ld(&bar[XB_XGEN(b.x)]) == gen, bar);
            __builtin_amdgcn_fence(__ATOMIC_ACQUIRE, "agent");
            asm volatile("s_waitcnt vmcnt(0)" ::: "memory");
        }
    }
    __syncthreads();
}

struct Params {
    const float *x, *c, *ctx, *c_ctx, *w_mod, *b_mod, *norm_g, *w_in, *conv_dw, *conv_b, *conv_ln_g, *conv_ln_b, *ml_gate_b, *ml_norm_g,
        *gd_conv, *gd_a_log, *gd_dt_bias, *gd_norm_g, *rw_mu, *rw_w0, *rw_w2, *rw_a0, *rw_a2, *rw_g2, *rw_kk, *rw_ka, *rw_rk, *rw_ln_g, *rw_ln_b,
        *w_br, *w_out, *ffn_up, *ffn_dw, *ffn_down;
    float* out; unsigned char* ws; int ph_lo, ph_hi;
};

DI float bf2f(unsigned short u) { return __uint_as_float(((unsigned)u) << 16); }
DI unsigned f2bf(float f) { unsigned u = __float_as_uint(f); return (u + 0x7fffu + ((u >> 16) & 1u)) >> 16; }
DI unsigned pk2(float lo, float hi) { return f2bf(lo) | (f2bf(hi) << 16); }
DI void ld8(const bf16* p, float (&o)[8]) { const u32x4 w = *(const u32x4*)p;
#pragma unroll
    for (int j = 0; j < 4; ++j) { o[2 * j] = __uint_as_float(w[j] << 16); o[2 * j + 1] = __uint_as_float(w[j] & 0xffff0000u); } }
DI void st8(bf16* p, const float (&v)[8]) { u32x4 w; w.x = pk2(v[0], v[1]); w.y = pk2(v[2], v[3]); w.z = pk2(v[4], v[5]); w.w = pk2(v[6], v[7]); *(u32x4*)p = w; }
DI void ldf8(const float* p, float (&o)[8]) { const f32x4 a = *(const f32x4*)p, b = *(const f32x4*)(p + 4);
    o[0] = a[0]; o[1] = a[1]; o[2] = a[2]; o[3] = a[3]; o[4] = b[0]; o[5] = b[1]; o[6] = b[2]; o[7] = b[3]; }
DI void stf8(float* p, const float (&v)[8]) { *(f32x4*)p = (f32x4){v[0], v[1], v[2], v[3]}; *(f32x4*)(p + 4) = (f32x4){v[4], v[5], v[6], v[7]}; }
DI float wave_sum(float v) {
#pragma unroll
    for (int o = 1; o < 64; o <<= 1) v += __shfl_xor(v, o);
    return v; }
template <int W> DI float grp_sum(float v) {
#pragma unroll
    for (int o = 1; o < W; o <<= 1) v += __shfl_xor(v, o);
    return v; }
DI float sigmoidf_(float x) { return 1.f / (1.f + __expf(-x)); }
DI float siluf_(float x) { return x / (1.f + __expf(-x)); }
DI float softplusf_(float x) { return fmaxf(x, 0.f) + log1pf(__expf(-fabsf(x))); }
DI float logsigmoidf_(float x) { return fminf(x, 0.f) - log1pf(__expf(-fabsf(x))); }
DI float gelu_tanh(float x) { const float u = 0.7978845608028654f * (x + 0.044715f * x * x * x); return 0.5f * x * (1.f + tanhf(u)); }

DI void seq_of(int row, int& base, int& len, int& t) { if (row < LAT) { base = row & ~(T - 1); len = T; t = row & (T - 1); } else { const int r = row - LAT; base = LAT + (r & ~(TC - 1)); len = TC; t = r & (TC - 1); } }
DI int scan_row(int dir, int b, int j) { if (j < TC) { const int tok = dir ? (TC - 1 - j) : j; return LAT + b * TC + tok; } const int jj = j - TC; const int tok = dir ? (T - 1 - jj) : jj; return b * T + tok; }

struct Ctx {
    LAS unsigned char* lds; int tid, lane, wave, G, bid;
    const Params* p; unsigned char* ws;
};

DI int zcol_src(int j) { if (j < 3072) return j; if (j < 5120) return j + 16; if (j < ZSM) return j + 32; if (j < ZSM + 16) return 3072 + (j - ZSM); if (j < ZSM + 32) return 5136 + (j - ZSM - 16); return -1; }
template <bool ZMAP> DI void transpose_item(const float* W, int K, int N, bf16* WT, LAS float* scr, int kb, int nb, int lane) {
    const int k0 = 64 * kb, n0 = 32 * nb; const int nn = n0 + (lane & 31); const int src = ZMAP ? zcol_src(nn) : nn;
#pragma unroll 8
    for (int i = 0; i < 32; ++i) { const int kk = 2 * i + (lane >> 5); scr[kk * 33 + (lane & 31)] = (src >= 0) ? W[(size_t)(k0 + kk) * N + src] : 0.f; }
    asm volatile("s_waitcnt lgkmcnt(0)" ::: "memory");
    const int c = lane & 7;
#pragma unroll
    for (int j = 0; j < 4; ++j) { const int n = (lane >> 3) + 8 * j; const LAS float* s = scr + (8 * c) * 33 + n;
        u32x4 o; o.x = pk2(s[0 * 33], s[1 * 33]); o.y = pk2(s[2 * 33], s[3 * 33]); o.z = pk2(s[4 * 33], s[5 * 33]); o.w = pk2(s[6 * 33], s[7 * 33]);
        *(u32x4*)(WT + (size_t)(n0 + n) * K + k0 + 8 * c) = o; }
    asm volatile("s_waitcnt lgkmcnt(0)" ::: "memory");
}
DI void phase_pro0(Ctx& c) {
    const Params& p = *c.p;
    {
        LAS float* red = (LAS float*)c.lds;
        float* MODP = (float*)(c.ws + WS_MODP);
        for (int u = c.bid; u < NL * 48 * 8; u += c.G) {
            const int l = u / 384, cb = (u >> 3) % 48, ks = u & 7; const int col = cb * 256 + c.lane * 4;
            f32x4 a0 = {0.f, 0.f, 0.f, 0.f}, a1 = a0, a2 = a0;
            const float* wp = p.w_mod + ((size_t)l * D + ks * 256 + c.wave * 32) * 12288 + col;
            const int kb = ks * 256 + c.wave * 32;
#pragma unroll 8
            for (int i = 0; i < 32; ++i) { const f32x4 w = *(const f32x4*)(wp + (size_t)i * 12288);
                const float s0 = siluf_(p.c[kb + i]), s1 = siluf_(p.c[D + kb + i]), s2 = siluf_(p.c_ctx[kb + i]);
                a0 += w * s0; a1 += w * s1; a2 += w * s2; }
            __syncthreads();
            *(LAS f32x4*)(red + (c.wave * 3 + 0) * 256 + c.lane * 4) = a0; *(LAS f32x4*)(red + (c.wave * 3 + 1) * 256 + c.lane * 4) = a1; *(LAS f32x4*)(red + (c.wave * 3 + 2) * 256 + c.lane * 4) = a2;
            __syncthreads();
            for (int o = c.tid; o < 768; o += 512) { float s = 0.f;
#pragma unroll
                for (int w = 0; w < 8; ++w) s += red[w * 768 + o];
                MODP[((size_t)(l * 8 + ks) * 3 + o / 256) * 12288 + cb * 256 + (o & 255)] = s; }
        }
        __syncthreads();
    }
    {
        LAS float* scr = (LAS float*)(c.lds + c.wave * 16384);
        const int gw = c.bid * 8 + c.wave, NGW = c.G * 8;
        constexpr int I_IN = 32 * 480, I_BR = 8 * 64, I_OUT = 32 * 64, I_UP = 32 * 352, I_DN = 88 * 64, I_L = I_IN + 4 * I_BR + I_OUT + I_UP + I_DN;
        for (int it = gw; it < NL * I_L; it += NGW) {
            const int l = it / I_L; int r = it % I_L; unsigned char* wl = c.ws + WS_W + (size_t)l * WL_SIZE;
            if (r < I_IN) { transpose_item<true>(p.w_in + (size_t)l * D * NIN, D, NIN, (bf16*)(wl + WL_IN), scr, r / 480, r % 480, c.lane); continue; } r -= I_IN;
            if (r < 4 * I_BR) { const int nb = r / I_BR; r %= I_BR; transpose_item<false>(p.w_br + ((size_t)l * 4 + nb) * MIXW * D, MIXW, D, (bf16*)(wl + WL_BR) + (size_t)nb * D * MIXW, scr, r / 64, r % 64, c.lane); continue; } r -= 4 * I_BR;
            if (r < I_OUT) { transpose_item<false>(p.w_out + (size_t)l * D * D, D, D, (bf16*)(wl + WL_OUT), scr, r / 64, r % 64, c.lane); continue; } r -= I_OUT;
            if (r < I_UP) { transpose_item<false>(p.ffn_up + (size_t)l * D * 2 * DFF, D, 2 * DFF, (bf16*)(wl + WL_UP), scr, r / 352, r % 352, c.lane); continue; } r -= I_UP;
            transpose_item<false>(p.ffn_down + (size_t)l * DFF * D, DFF, D, (bf16*)(wl + WL_DN), scr, r / 64, r % 64, c.lane);
        }
    }
}
DI void phase_pro1(Ctx& c) {
    const Params& p = *c.p; const float* MODP = (const float*)(c.ws + WS_MODP); float* MOD = (float*)(c.ws + WS_MOD);
    for (int i = c.bid * 512 + c.tid; i < NL * 3 * 12288; i += c.G * 512) { const int l = i / 36864, v = (i / 12288) % 3, n = i % 12288;
        float s = p.b_mod[l * 12288 + n];
#pragma unroll
        for (int ks = 0; ks < 8; ++ks) s += MODP[((size_t)(l * 8 + ks) * 3 + v) * 12288 + n];
        MOD[i] = s; }
}
DI void row_load(const float* r, int lane, f32x4 (&v)[8]) {
#pragma unroll
    for (int j = 0; j < 8; ++j) v[j] = *(const f32x4*)(r + 4 * lane + 256 * j); }
DI float row_rstd(const f32x4 (&v)[8]) { float s = 0.f;
#pragma unroll
    for (int j = 0; j < 8; ++j) s += (v[j][0] * v[j][0] + v[j][1] * v[j][1]) + (v[j][2] * v[j][2] + v[j][3] * v[j][3]);
    return rsqrtf(wave_sum(s) * (1.f / D) + 1e-6f); }
DI void norm_mod_store(const f32x4 (&v)[8], float rstd, const float* g, const float* sh, const float* sc, bf16* o, int lane) {
#pragma unroll
    for (int j = 0; j < 8; ++j) { const int cc = 4 * lane + 256 * j; const f32x4 g4 = *(const f32x4*)(g + cc), s4 = *(const f32x4*)(sh + cc), c4 = *(const f32x4*)(sc + cc);
        const f32x4 r = v[j] * rstd * g4 * (c4 + 1.f) + s4; u32x2 w; w.x = pk2(r[0], r[1]); w.y = pk2(r[2], r[3]); *(u32x2*)(o + cc) = w; } }
DI int mod_vec(int row) { return row < LAT ? (row >> 12) : 2; }
DI void phase_pro2(Ctx& c) {
    const Params& p = *c.p; const float* MOD = (const float*)(c.ws + WS_MOD); bf16* U = (bf16*)(c.ws + WS_U);
    const int gw = c.bid * 8 + c.wave, NGW = c.G * 8;
    for (int row = gw; row < MROWS; row += NGW) { const float* xr = row < LAT ? p.x + (size_t)row * D : p.ctx + (size_t)(row - LAT) * D;
        f32x4 v[8]; row_load(xr, c.lane, v); const float rs = row_rstd(v); const float* mv = MOD + (size_t)(0 * 3 + mod_vec(row)) * 12288;
        norm_mod_store(v, rs, p.norm_g, mv, mv + 2048, U + (size_t)row * D, c.lane); }
}
DI void phase_resid(Ctx& c, int l, int which) {
    const Params& p = *c.p; const float* MOD = (const float*)(c.ws + WS_MOD); bf16* U = (bf16*)(c.ws + WS_U); float* X = (float*)(c.ws + WS_X); const float* F = (const float*)(c.ws + WS_F);
    const int gw = c.bid * 8 + c.wave, NGW = c.G * 8;
    for (int row = gw; row < MROWS; row += NGW) {
        const float* xr = (l == 0 && which == 0) ? (row < LAT ? p.x + (size_t)row * D : p.ctx + (size_t)(row - LAT) * D) : X + (size_t)row * D;
        f32x4 fv[8], xv[8]; row_load(F + (size_t)row * D, c.lane, fv); row_load(xr, c.lane, xv);
        const float rs = row_rstd(fv); const float* mv = MOD + (size_t)(l * 3 + mod_vec(row)) * 12288;
        const float* g = p.norm_g + (size_t)(l * 4 + (which ? 3 : 1)) * D; const float* gt = mv + (which ? 10240 : 4096);
#pragma unroll
        for (int j = 0; j < 8; ++j) { const int cc = 4 * c.lane + 256 * j; xv[j] += *(const f32x4*)(gt + cc) * (fv[j] * rs * *(const f32x4*)(g + cc)); }
        const bool fin = (which == 1 && l == NL - 1);
        if (fin) { if (row < LAT) {
#pragma unroll
            for (int j = 0; j < 8; ++j) *(f32x4*)(p.out + (size_t)row * D + 4 * c.lane + 256 * j) = xv[j]; } continue; }
#pragma unroll
        for (int j = 0; j < 8; ++j) *(f32x4*)(X + (size_t)row * D + 4 * c.lane + 256 * j) = xv[j];
        const float rs2 = row_rstd(xv);
        if (which == 0) norm_mod_store(xv, rs2, p.norm_g + (size_t)(l * 4 + 2) * D, mv + 6144, mv + 8192, U + (size_t)row * D, c.lane);
        else { const float* mv2 = MOD + (size_t)((l + 1) * 3 + mod_vec(row)) * 12288; norm_mod_store(xv, rs2, p.norm_g + (size_t)((l + 1) * 4) * D, mv2, mv2 + 2048, U + (size_t)row * D, c.lane); }
    }
}

DI float rw_feat(const bf16* Z, const float* mu, int row, int cz) {
    int base, len, t; seq_of(row, base, len, t); const bf16* zp = Z + (size_t)row * NZ + RWR + cz;
    const float x = bf2f(zp[0]); const float pv = t > 0 ? bf2f(zp[-NZ]) : 0.f; const float nx = t < len - 1 ? bf2f(zp[NZ]) : 0.f;
    return x + mu[cz] * (pv - x) + mu[RWMIX + cz] * (nx - x);
}
template <int K, int NT> DI void lora_nt(const float* Wm, const LAS float* in, int c, float (&acc)[NT]) {
#pragma unroll
    for (int t = 0; t < NT; ++t) acc[t] = 0.f;
    for (int k = 0; k < K; k += 4) { const float w0 = Wm[(k + 0) * 512 + c], w1 = Wm[(k + 1) * 512 + c], w2 = Wm[(k + 2) * 512 + c], w3 = Wm[(k + 3) * 512 + c];
#pragma unroll
        for (int t = 0; t < NT; ++t) { const f32x4 x = *(const LAS f32x4*)(in + t * 448 + k); acc[t] = fmaf(x[0], w0, acc[t]); acc[t] = fmaf(x[1], w1, acc[t]); acc[t] = fmaf(x[2], w2, acc[t]); acc[t] = fmaf(x[3], w3, acc[t]); } }
}
constexpr int RWT = 17;
DI void rwkv_prep_rows(Ctx& c, int l, int row0, const LAS float* in, LAS float* bufA, LAS float* bufB) {
    const Params& p = *c.p; const bf16* Z = (const bf16*)(c.ws + WS_Z); float* SA = (float*)(c.ws + WS_S);
    const float* mu = p.rw_mu + (size_t)l * 2 * RWMIX; const int cc = c.tid; const size_t AS = (size_t)MROWS * 512;
    float acc[RWT];
#pragma unroll
    for (int dir = 0; dir < 2; ++dir) {
        lora_nt<96, RWT>(p.rw_w2 + (size_t)(l * 2 + dir) * 96 * 512, in, cc, acc);
        const float w0 = p.rw_w0[(l * 2 + dir) * 512 + cc];
#pragma unroll
        for (int t = 0; t < RWT; ++t) { const float wl = w0 + acc[t]; SA[(SA_RW0 + dir) * AS + (size_t)(row0 + t) * 512 + cc] = expf(-expf(-softplusf_(-wl) - 0.5f)); }
        lora_nt<96, RWT>(p.rw_a2 + (size_t)(l * 2 + dir) * 96 * 512, in + 96, cc, acc);
        const float a0 = p.rw_a0[(l * 2 + dir) * 512 + cc]; LAS float* bb = dir ? bufB : bufA;
#pragma unroll
        for (int t = 0; t < RWT; ++t) bb[t * 512 + cc] = sigmoidf_(a0 + acc[t]);
    }
    lora_nt<256, RWT>(p.rw_g2 + (size_t)l * 256 * 512, in + 192, cc, acc);
#pragma unroll
    for (int t = 0; t < RWT; ++t) SA[SA_RG * AS + (size_t)(row0 + t) * 512 + cc] = acc[t];
    const float kks = p.rw_kk[l * 512 + cc], kas = p.rw_ka[l * 512 + cc], rks = p.rw_rk[l * 512 + cc];
#pragma unroll 1
    for (int t = 0; t < RWT; ++t) { const int row = row0 + t; const size_t o = (size_t)row * 512 + cc;
        const float rf = rw_feat(Z, mu, row, cc), kf = rw_feat(Z, mu, row, 512 + cc), vf = rw_feat(Z, mu, row, 1024 + cc);
        const float kx = kf * kks; const float kkv = kx * rsqrtf(wave_sum(kx * kx) + 1e-6f);
        const float ic0 = bufA[t * 512 + cc], ic1 = bufB[t * 512 + cc];
        const float km0 = kf * (1.f + (ic0 - 1.f) * kas), km1 = kf * (1.f + (ic1 - 1.f) * kas);
        const float bonus = wave_sum(rf * rks * (km0 + km1));
        SA[SA_RK0 * AS + o] = km0; SA[SA_RK1 * AS + o] = km1; SA[SA_RB0 * AS + o] = kkv * ic0; SA[SA_RB1 * AS + o] = kkv * ic1;
        SA[SA_RAUX * AS + o] = bonus * vf; SA[SA_RR * AS + o] = rf; SA[SA_RV * AS + o] = vf; SA[SA_RA * AS + o] = -kkv; }
}
DI void phase_prep(Ctx& c, int l) {
    const Params& p = *c.p; const bf16* Z = (const bf16*)(c.ws + WS_Z); bf16* Y = (bf16*)(c.ws + WS_Y); const float* G32 = (const float*)(c.ws + WS_G32);
    float* SA = (float*)(c.ws + WS_S); float* SG = (float*)(c.ws + WS_SG);
    const int gw = c.bid * 8 + c.wave, NGW = c.G * 8; const int ch = c.lane * 8;
    for (int row = gw; row < MROWS; row += NGW) {
        int base, len, t; seq_of(row, base, len, t);
        float acc[8];
#pragma unroll
        for (int i = 0; i < 8; ++i) acc[i] = 0.f;
        const float* w = p.conv_dw + (size_t)l * 31 * 512;
        for (int j = 0; j < 31; ++j) { const int tt = t + j - 15; if (tt < 0 || tt >= len) continue;
            const bf16* zr = Z + (size_t)(base + tt) * NZ; float a[8], g[8], wv[8]; ld8(zr + ZA + ch, a); ld8(zr + ZAG + ch, g); ldf8(w + j * 512 + ch, wv);
#pragma unroll
            for (int i = 0; i < 8; ++i) acc[i] = fmaf(a[i] * sigmoidf_(g[i]), wv[i], acc[i]); }
        float bv[8]; ldf8(p.conv_b + l * 512 + ch, bv); float s = 0.f;
#pragma unroll
        for (int i = 0; i < 8; ++i) { acc[i] += bv[i]; s += acc[i]; }
        const float mean = wave_sum(s) * (1.f / 512.f); float q = 0.f;
#pragma unroll
        for (int i = 0; i < 8; ++i) { acc[i] -= mean; q += acc[i] * acc[i]; }
        const float rstd = rsqrtf(wave_sum(q) * (1.f / 512.f) + 1e-6f);
        float lg[8], lb[8], o[8]; ldf8(p.conv_ln_g + l * 512 + ch, lg); ldf8(p.conv_ln_b + l * 512 + ch, lb);
#pragma unroll
        for (int i = 0; i < 8; ++i) o[i] = siluf_(acc[i] * rstd * lg[i] + lb[i]);
        st8(Y + (size_t)row * D + ch, o);
    }
    for (int row = gw; row < MROWS; row += NGW) {
        int base, len, t; seq_of(row, base, len, t);
        const float* w = p.gd_conv + (size_t)l * 5 * 1536;
#pragma unroll
        for (int part = 0; part < 3; ++part) {
            float acc[8];
#pragma unroll
            for (int i = 0; i < 8; ++i) acc[i] = 0.f;
#pragma unroll
            for (int j = 0; j < 5; ++j) { const int tt = t + j - 2; if (tt < 0 || tt >= len) continue;
                float a[8], wv[8]; ld8(Z + (size_t)(base + tt) * NZ + GDQ + part * 512 + ch, a); ldf8(w + j * 1536 + part * 512 + ch, wv);
#pragma unroll
                for (int i = 0; i < 8; ++i) acc[i] = fmaf(a[i], wv[i], acc[i]); }
            float ss = 0.f;
#pragma unroll
            for (int i = 0; i < 8; ++i) { acc[i] = siluf_(acc[i]); ss += acc[i] * acc[i]; }
            if (part < 2) { ss = grp_sum<16>(ss); const float sc = rsqrtf(ss + 1e-6f) * (part == 0 ? 0.08838834764831845f : 1.f);
#pragma unroll
                for (int i = 0; i < 8; ++i) acc[i] *= sc; }
            stf8(SA + (size_t)(SA_GQ + part) * (MROWS * 512) + (size_t)row * 512 + ch, acc);
        }
        if (c.lane < 8) { const int dir = c.lane >> 2, h = c.lane & 3; const float a = G32[(size_t)row * 32 + 16 + dir * 8 + h], bb = G32[(size_t)row * 32 + 16 + dir * 8 + 4 + h];
            SG[(size_t)row * 16 + dir * 4 + h] = -expf(p.gd_a_log[l * 8 + dir * 4 + h]) * softplusf_(a + p.gd_dt_bias[l * 8 + dir * 4 + h]);
            SG[(size_t)row * 16 + 8 + dir * 4 + h] = sigmoidf_(bb); }
    }
    {
        LAS float* in = (LAS float*)c.lds;
        const float* mu = p.rw_mu + (size_t)l * 2 * RWMIX;
        for (int u = c.bid; u < MROWS / 34; u += c.G) {
            const int row0 = u * 34;
            __syncthreads();
            for (int i = c.tid; i < 34 * 448; i += 512) { const int t = i / 448, k = i % 448; float f = rw_feat(Z, mu, row0 + t, 1536 + k);
                if (k < 96) f = tanhf(f); else if (k >= 192) f = sigmoidf_(f); in[i] = f; }
            __syncthreads();
            for (int hf = 0; hf < 34 / RWT; ++hf) rwkv_prep_rows(c, l, row0 + hf * RWT, in + hf * RWT * 448, in + 34 * 448, in + 34 * 448 + RWT * 512);
        }
        __syncthreads();
    }
}

DI void scan_mlstm(Ctx& c, int l, int chain) {
    const Params& p = *c.p; const bf16* Z = (const bf16*)(c.ws + WS_Z); const float* G32 = (const float*)(c.ws + WS_G32); float* SA = (float*)(c.ws + WS_S);
    const int g = chain >> 2, h = chain & 3, dir = g >> 1, b = g & 1; const int e = c.tid >> 2, dq = c.tid & 3;
    LAS float* sq = (LAS float*)c.lds; LAS float* sk = sq + 64 * 144; LAS float* sv = sk + 64 * 144; LAS float* sg = sv + 64 * 128;
    float* HM = SA + (size_t)(SA_HM0 + dir) * ((size_t)MROWS * 512);
    float C[32], nn[32], m = 0.f;
#pragma unroll
    for (int i = 0; i < 32; ++i) { C[i] = 0.f; nn[i] = 0.f; }
    const float gbi = p.ml_gate_b[((l * 2 + dir) * 2 + 0) * 4 + h], gbf = p.ml_gate_b[((l * 2 + dir) * 2 + 1) * 4 + h];
    for (int blk = 0; blk < (TC + T) / 64; ++blk) {
        __syncthreads();
        for (int it = c.tid; it < 64 * 48; it += 512) { const int tt = it / 48, r = it % 48, part = r >> 4, c8 = (r & 15) * 8; const int row = scan_row(dir, b, blk * 64 + tt);
            float v[8]; ld8(Z + (size_t)row * NZ + MLQ + part * 512 + h * 128 + c8, v);
            if (part == 2) {
#pragma unroll
                for (int i = 0; i < 8; ++i) sv[tt * 128 + c8 + i] = v[i]; }
            else { LAS float* d = (part == 0 ? sq : sk) + tt * 144 + (c8 >> 5) * 36 + (c8 & 31); const float sc = part == 0 ? 0.08838834764831845f : 1.f;
#pragma unroll
                for (int i = 0; i < 8; ++i) d[i] = v[i] * sc; } }
        if (c.tid < 64) { const int row = scan_row(dir, b, blk * 64 + c.tid); sg[c.tid * 2] = G32[(size_t)row * 32 + dir * 8 + h] + gbi; sg[c.tid * 2 + 1] = logsigmoidf_(G32[(size_t)row * 32 + dir * 8 + 4 + h] + gbf); }
        __syncthreads();
        for (int tt = 0; tt < 64; ++tt) {
            const float li = sg[2 * tt], lf = sg[2 * tt + 1]; const float mn = fmaxf(lf + m, li); const float fs = expf(lf + m - mn), is = expf(li - mn); m = mn;
            const float iv = is * sv[tt * 128 + e]; float hp = 0.f, dp = 0.f;
#pragma unroll
            for (int i4 = 0; i4 < 8; ++i4) { const f32x4 k4 = *(const LAS f32x4*)(sk + tt * 144 + dq * 36 + i4 * 4), q4 = *(const LAS f32x4*)(sq + tt * 144 + dq * 36 + i4 * 4);
#pragma unroll
                for (int j = 0; j < 4; ++j) { const int i = i4 * 4 + j; C[i] = fmaf(C[i], fs, iv * k4[j]); hp = fmaf(C[i], q4[j], hp); nn[i] = fmaf(nn[i], fs, is * k4[j]); dp = fmaf(nn[i], q4[j], dp); } }
            hp += __shfl_xor(hp, 1); hp += __shfl_xor(hp, 2); dp += __shfl_xor(dp, 1); dp += __shfl_xor(dp, 2);
            if (dq == 0) HM[(size_t)scan_row(dir, b, blk * 64 + tt) * 512 + h * 128 + e] = hp / fmaxf(fabsf(dp), expf(-m));
        }
    }
}
DI void scan_gdn(Ctx& c, int l, int chain) {
    float* SA = (float*)(c.ws + WS_S); const float* SG = (const float*)(c.ws + WS_SG); const size_t AS = (size_t)MROWS * 512;
    const int g = chain >> 2, h = chain & 3, dir = g >> 1, b = g & 1; const int e = c.tid >> 2, dq = c.tid & 3;
    LAS float* sq = (LAS float*)c.lds; LAS float* sk = sq + 64 * 144; LAS float* sv = sk + 64 * 144; LAS float* sg = sv + 64 * 128;
    float* HG = SA + (size_t)(SA_HG0 + dir) * AS;
    float S[32];
#pragma unroll
    for (int i = 0; i < 32; ++i) S[i] = 0.f;
    for (int blk = 0; blk < (TC + T) / 64; ++blk) {
        __syncthreads();
        for (int it = c.tid; it < 64 * 48; it += 512) { const int tt = it / 48, r = it % 48, part = r >> 4, c8 = (r & 15) * 8; const int row = scan_row(dir, b, blk * 64 + tt);
            float v[8]; ldf8(SA + (size_t)(SA_GQ + part) * AS + (size_t)row * 512 + h * 128 + c8, v);
            LAS float* d = part == 2 ? sv + tt * 128 + c8 : (part == 0 ? sq : sk) + tt * 144 + (c8 >> 5) * 36 + (c8 & 31);
#pragma unroll
            for (int i = 0; i < 8; ++i) d[i] = v[i]; }
        if (c.tid < 64) { const int row = scan_row(dir, b, blk * 64 + c.tid); sg[c.tid * 2] = expf(SG[(size_t)row * 16 + dir * 4 + h]); sg[c.tid * 2 + 1] = SG[(size_t)row * 16 + 8 + dir * 4 + h]; }
        __syncthreads();
        for (int tt = 0; tt < 64; ++tt) {
            const float a = sg[2 * tt], be = sg[2 * tt + 1]; float pp = 0.f; f32x4 k4[8];
#pragma unroll
            for (int i4 = 0; i4 < 8; ++i4) { k4[i4] = *(const LAS f32x4*)(sk + tt * 144 + dq * 36 + i4 * 4);
#pragma unroll
                for (int j = 0; j < 4; ++j) { const int i = i4 * 4 + j; S[i] *= a; pp = fmaf(k4[i4][j], S[i], pp); } }
            pp += __shfl_xor(pp, 1); pp += __shfl_xor(pp, 2);
            const float vn = be * (sv[tt * 128 + e] - pp); float o = 0.f;
#pragma unroll
            for (int i4 = 0; i4 < 8; ++i4) { const f32x4 q4 = *(const LAS f32x4*)(sq + tt * 144 + dq * 36 + i4 * 4);
#pragma unroll
                for (int j = 0; j < 4; ++j) { const int i = i4 * 4 + j; S[i] = fmaf(k4[i4][j], vn, S[i]); o = fmaf(q4[j], S[i], o); } }
            o += __shfl_xor(o, 1); o += __shfl_xor(o, 2);
            if (dq == 0) HG[(size_t)scan_row(dir, b, blk * 64 + tt) * 512 + h * 128 + e] = o;
        }
    }
}
DI void scan_rwkv(Ctx& c, int l, int chain) {
    float* SA = (float*)(c.ws + WS_S); const size_t AS = (size_t)MROWS * 512;
    const int g = chain >> 3, h = chain & 7, dir = g >> 1, b = g & 1; const int i = c.tid >> 3, part = c.tid & 7;
    LAS float* sr = (LAS float*)c.lds;
    float* HR = SA + (size_t)(SA_HR0 + dir) * AS;
    float S[8];
#pragma unroll
    for (int j = 0; j < 8; ++j) S[j] = 0.f;
    for (int blk = 0; blk < (TC + T) / 64; ++blk) {
        __syncthreads();
        for (int it = c.tid; it < 6 * 64 * 8; it += 512) { const int arr = it / 512, r = it % 512, tt = r >> 3, c8 = (r & 7) * 8; const int row = scan_row(dir, b, blk * 64 + tt);
            const int sa = arr == 0 ? SA_RR : arr == 1 ? SA_RW0 + dir : arr == 2 ? SA_RK0 + dir : arr == 3 ? SA_RV : arr == 4 ? SA_RA : SA_RB0 + dir;
            float v[8]; ldf8(SA + (size_t)sa * AS + (size_t)row * 512 + h * 64 + c8, v); LAS float* d = sr + arr * 4096 + tt * 64 + c8;
#pragma unroll
            for (int j = 0; j < 8; ++j) d[j] = v[j]; }
        __syncthreads();
        for (int tt = 0; tt < 64; ++tt) {
            const LAS float* bp = sr + tt * 64 + part * 8;
            float r8[8], w8[8], k8[8], a8[8], b8[8];
#pragma unroll
            for (int j = 0; j < 8; j += 4) { const f32x4 x0 = *(const LAS f32x4*)(bp + j), x1 = *(const LAS f32x4*)(bp + 4096 + j), x2 = *(const LAS f32x4*)(bp + 8192 + j), x4 = *(const LAS f32x4*)(bp + 16384 + j), x5 = *(const LAS f32x4*)(bp + 20480 + j);
#pragma unroll
                for (int q = 0; q < 4; ++q) { r8[j + q] = x0[q]; w8[j + q] = x1[q]; k8[j + q] = x2[q]; a8[j + q] = x4[q]; b8[j + q] = x5[q]; } }
            const float vi = sr[3 * 4096 + tt * 64 + i];
            float sa = 0.f;
#pragma unroll
            for (int j = 0; j < 8; ++j) sa = fmaf(S[j], a8[j], sa);
            sa += __shfl_xor(sa, 1); sa += __shfl_xor(sa, 2); sa += __shfl_xor(sa, 4);
            float y = 0.f;
#pragma unroll
            for (int j = 0; j < 8; ++j) { S[j] = fmaf(S[j], w8[j], fmaf(sa, b8[j], vi * k8[j])); y = fmaf(S[j], r8[j], y); }
            y += __shfl_xor(y, 1); y += __shfl_xor(y, 2); y += __shfl_xor(y, 4);
            if (part == 0) HR[(size_t)scan_row(dir, b, blk * 64 + tt) * 512 + h * 64 + i] = y;
        }
    }
}
DI void phase_scan(Ctx& c, int l) {
    for (int u = c.bid; u < 64; u += c.G) {
        if (u < 16) scan_mlstm(c, l, u); else if (u < 32) scan_gdn(c, l, u - 16); else scan_rwkv(c, l, u - 32);
    }
    __syncthreads();
}
DI void phase_finish(Ctx& c, int l) {
    const Params& p = *c.p; const bf16* Z = (const bf16*)(c.ws + WS_Z); bf16* Y = (bf16*)(c.ws + WS_Y); const float* SA = (const float*)(c.ws + WS_S); const size_t AS = (size_t)MROWS * 512;
    const int gw = c.bid * 8 + c.wave, NGW = c.G * 8; const int ch = c.lane * 8;
    for (int row = gw; row < MROWS; row += NGW) {
        const size_t ro = (size_t)row * 512 + ch;
        { float a[8], b[8], g[8], o[8], y[8]; ldf8(SA + SA_HM0 * AS + ro, a); ldf8(SA + SA_HM1 * AS + ro, b); float ss = 0.f;
#pragma unroll
          for (int i = 0; i < 8; ++i) { a[i] += b[i]; ss += a[i] * a[i]; }
          const float rs = rsqrtf(grp_sum<16>(ss) * (1.f / 128.f) + 1e-6f); ldf8(p.ml_norm_g + l * 512 + ch, g); ld8(Z + (size_t)row * NZ + MLO + ch, o);
#pragma unroll
          for (int i = 0; i < 8; ++i) y[i] = a[i] * rs * g[i] * sigmoidf_(o[i]);
          st8(Y + (size_t)row * D + 512 + ch, y); }
        { float a[8], b[8], g[8], o[8], y[8]; ldf8(SA + SA_HG0 * AS + ro, a); ldf8(SA + SA_HG1 * AS + ro, b); float ss = 0.f;
#pragma unroll
          for (int i = 0; i < 8; ++i) { a[i] += b[i]; ss += a[i] * a[i]; }
          const float rs = rsqrtf(grp_sum<16>(ss) * (1.f / 128.f) + 1e-6f); ldf8(p.gd_norm_g + l * 512 + ch, g); ld8(Z + (size_t)row * NZ + GDZ + ch, o);
#pragma unroll
          for (int i = 0; i < 8; ++i) y[i] = a[i] * rs * g[i] * siluf_(o[i]);
          st8(Y + (size_t)row * D + 1024 + ch, y); }
        { float a[8], b[8], g[8], bb[8], ax[8], gg[8], y[8]; ldf8(SA + SA_HR0 * AS + ro, a); ldf8(SA + SA_HR1 * AS + ro, b); float s = 0.f;
#pragma unroll
          for (int i = 0; i < 8; ++i) { a[i] += b[i]; s += a[i]; }
          const float mean = grp_sum<8>(s) * (1.f / 64.f); float q = 0.f;
#pragma unroll
          for (int i = 0; i < 8; ++i) { a[i] -= mean; q += a[i] * a[i]; }
          const float rs = rsqrtf(grp_sum<8>(q) * (1.f / 64.f) + 64e-5f);
          ldf8(p.rw_ln_g + l * 512 + ch, g); ldf8(p.rw_ln_b + l * 512 + ch, bb); ldf8(SA + SA_RAUX * AS + ro, ax); ldf8(SA + SA_RG * AS + ro, gg);
#pragma unroll
          for (int i = 0; i < 8; ++i) y[i] = (a[i] * rs * g[i] + bb[i] + ax[i]) * gg[i];
          st8(Y + (size_t)row * D + 1536 + ch, y); }
    }
}
DI void phase_ffnconv(Ctx& c, int l) {
    const Params& p = *c.p; const bf16* UP = (const bf16*)(c.ws + WS_Z); bf16* H = (bf16*)(c.ws + WS_S); const float* w = p.ffn_dw + (size_t)l * 9 * DFF;
    constexpr int CPR = DFF / 8;
    for (int it = c.bid * 512 + c.tid; it < MROWS * CPR; it += c.G * 512) {
        const int row = it / CPR, ch = (it % CPR) * 8; float acc[8];
#pragma unroll
        for (int i = 0; i < 8; ++i) acc[i] = 0.f;
        if (row < LAT) { const int bb = row >> 12, t = row & 4095, gy = t >> 6, gx = t & 63;
#pragma unroll
            for (int dy = 0; dy < 3; ++dy)
#pragma unroll
                for (int dx = 0; dx < 3; ++dx) { const int yy = gy + dy - 1, xx = gx + dx - 1; if (yy < 0 || yy >= 64 || xx < 0 || xx >= 64) continue;
                    float a[8], wv[8]; ld8(UP + (size_t)(bb * T + yy * 64 + xx) * (2 * DFF) + ch, a); ldf8(w + (dy * 3 + dx) * DFF + ch, wv);
#pragma unroll
                    for (int i = 0; i < 8; ++i) acc[i] = fmaf(a[i], wv[i], acc[i]); } }
        else { const int r = row - LAT, t = r & (TC - 1);
#pragma unroll
            for (int dx = 0; dx < 3; ++dx) { const int tt = t + dx - 1; if (tt < 0 || tt >= TC) continue;
                float a[8], wv[8]; ld8(UP + (size_t)(row + dx - 1) * (2 * DFF) + ch, a); ldf8(w + (3 + dx) * DFF + ch, wv);
#pragma unroll
                for (int i = 0; i < 8; ++i) acc[i] = fmaf(a[i], wv[i], acc[i]); } }
        float v[8], o[8]; ld8(UP + (size_t)row * (2 * DFF) + DFF + ch, v);
#pragma unroll
        for (int i = 0; i < 8; ++i) o[i] = gelu_tanh(acc[i]) * v[i];
        st8(H + (size_t)row * DFF + ch, o);
    }
}

constexpr int PH_PRO = 3, PH_PER_LAYER = 11, NPHASE = PH_PRO + NL * PH_PER_LAYER;
#ifndef MK_PER_PHASE
#define MK_PER_PHASE 0
#endif
constexpr int CW_BAR = 4096;

__global__ void __launch_bounds__(512, 2) fwd_kernel(Params p) {
    extern __shared__ __attribute__((aligned(16))) unsigned char lds_raw[];
    Ctx c; c.lds = (LAS unsigned char*)lds_raw; c.tid = threadIdx.x; c.lane = c.tid & 63; c.wave = __builtin_amdgcn_readfirstlane(c.tid >> 6); c.G = gridDim.x; c.bid = blockIdx.x; c.p = &p; c.ws = p.ws;
    volatile LAS unsigned* MISC = (volatile LAS unsigned*)(c.lds + LDS_MISC);
    if (c.tid < 32) MISC[c.tid] = 0u;
    __syncthreads();
    const int lo = p.ph_lo, hi = p.ph_hi;
    XcdBarrier bar; bar.bar = (unsigned*)(p.ws + WS_CTL) + CW_BAR; bar.x = 0; bar.st = MISC + 8;
    if (hi - lo > 1) bar = xcd_barrier_post((unsigned*)(p.ws + WS_CTL) + CW_BAR, MISC + 8);
#ifndef PH_MASK
#define PH_MASK 0xFFFFFFFFu
#endif
#define IN(k) (lo <= (k) && (k) < hi)
#define EN(b) ((PH_MASK >> (b)) & 1u)
#define RF() do { int t_ = threadIdx.x; asm volatile("" : "+v"(t_)); c.tid = t_; c.lane = t_ & 63; } while (0)
#define SEAM(k) do { if (IN((k) + 1)) xcd_barrier(bar); } while (0)
    if (EN(0) && IN(0)) { RF(); phase_pro0(c); SEAM(0); }
    if (EN(1) && IN(1)) { RF(); phase_pro1(c); SEAM(1); }
    if (EN(2) && IN(2)) { RF(); phase_pro2(c); SEAM(2); }
    bf16* U = (bf16*)(p.ws + WS_U); bf16* Y = (bf16*)(p.ws + WS_Y); bf16* MB = (bf16*)(p.ws + WS_MB); float* G32 = (float*)(p.ws + WS_G32); float* F = (float*)(p.ws + WS_F);
    bf16* Z = (bf16*)(p.ws + WS_Z); bf16* H = (bf16*)(p.ws + WS_S);
    for (int l = 0; l < NL; ++l) {
        const int pb = PH_PRO + l * PH_PER_LAYER; unsigned char* wl = p.ws + WS_W + (size_t)l * WL_SIZE;
        if (EN(3) && IN(pb + 0)) { pg8::Gemm g{U, (const bf16*)(wl + WL_IN), D, D, D}; pg8::StdOrder S; S.init(MROWS / 256, NZ / 256, c.G, c.bid); pg8::EpiBf16 E{Z, NZ, G32, (ZSM - 192) / 256};
            pg8::gemm_phase(c.lds, g, S, E); SEAM(pb + 0); }
        if (EN(4) && IN(pb + 1)) { RF(); phase_prep(c, l); SEAM(pb + 1); }
        if (EN(5) && IN(pb + 2)) { RF(); phase_scan(c, l); SEAM(pb + 2); }
        if (EN(6) && IN(pb + 3)) { RF(); phase_finish(c, l); SEAM(pb + 3); }
        if (EN(7) && IN(pb + 4)) { pg8::Gemm g{Y, (const bf16*)(wl + WL_BR), D, MIXW, MIXW}; pg8::MergeOrder S; S.init(MROWS / 256, D / 256, c.G, c.bid); pg8::EpiMerge E{Z, NZ, ZG, F, MB, D};
            pg8::gemm_phase(c.lds, g, S, E); SEAM(pb + 4); }
        if (EN(8) && IN(pb + 5)) { pg8::Gemm g{MB, (const bf16*)(wl + WL_OUT), D, D, D}; pg8::StdOrder S; S.init(MROWS / 256, D / 256, c.G, c.bid); pg8::EpiF32 E{F, D};
            pg8::gemm_phase(c.lds, g, S, E); SEAM(pb + 5); }
        if (EN(9) && IN(pb + 6)) { RF(); phase_resid(c, l, 0); SEAM(pb + 6); }
        if (EN(10) && IN(pb + 7)) { pg8::Gemm g{U, (const bf16*)(wl + WL_UP), D, D, D}; pg8::StdOrder S; S.init(MROWS / 256, 2 * DFF / 256, c.G, c.bid); pg8::EpiBf16 E{Z, 2 * DFF, nullptr, -1};
            pg8::gemm_phase(c.lds, g, S, E); SEAM(pb + 7); }
        if (EN(11) && IN(pb + 8)) { RF(); phase_ffnconv(c, l); SEAM(pb + 8); }
        if (EN(12) && IN(pb + 9)) { pg8::Gemm g{H, (const bf16*)(wl + WL_DN), DFF, DFF, DFF}; pg8::StdOrder S; S.init(MROWS / 256, D / 256, c.G, c.bid); pg8::EpiF32 E{F, D};
            pg8::gemm_phase(c.lds, g, S, E); SEAM(pb + 9); }
        if (EN(13) && IN(pb + 10)) { RF(); phase_resid(c, l, 1); SEAM(pb + 10); }
    }
#undef IN
#undef SEAM
}

extern "C" void kernel_launch(void* const* d_in, const int* in_sizes, int n_in, void* d_out, int out_size, void* d_ws, size_t ws_size, hipStream_t stream) {
    static int grid = 0;
    if (grid == 0) {
        if (n_in != 34 || ws_size < WS_END) { fprintf(stderr, "kernel_launch: unexpected n_in %d / ws %zu (need %zu)\n", n_in, ws_size, (size_t)WS_END); grid = -1; return; }
        int dev = 0, cus = 0;
        if (hipGetDevice(&dev) != hipSuccess || hipDeviceGetAttribute(&cus, hipDeviceAttributeMultiprocessorCount, dev) != hipSuccess) { grid = -1; return; }
        if (hipFuncSetAttribute((const void*)fwd_kernel, hipFuncAttributeMaxDynamicSharedMemorySize, LDS_BYTES) != hipSuccess) { fprintf(stderr, "kernel_launch: hipFuncSetAttribute failed\n"); grid = -1; return; }
        int per_cu = 0;
        if (hipOccupancyMaxActiveBlocksPerMultiprocessor(&per_cu, (const void*)fwd_kernel, 512, LDS_BYTES) != hipSuccess || per_cu < 1) { fprintf(stderr, "kernel_launch: occupancy query says %d\n", per_cu); }
        (void)hipGetLastError();
        grid = cus;
    }
    if (grid < 0) return;
    (void)hipMemsetAsync((char*)d_ws + WS_CTL, 0, CTL_BYTES, stream);
    Params p{};
    const float** pp = (const float**)&p;
    for (int i = 0; i < 34; ++i) pp[i] = (const float*)d_in[i];
    p.out = (float*)d_out; p.ws = (unsigned char*)d_ws;
#if MK_PER_PHASE
    for (int k = 0; k < NPHASE; ++k) { p.ph_lo = k; p.ph_hi = k + 1; hipLaunchKernelGGL(fwd_kernel, dim3(grid), dim3(512), LDS_BYTES, stream, p); }
#else
    p.ph_lo = 0; p.ph_hi = NPHASE; hipLaunchKernelGGL(fwd_kernel, dim3(grid), dim3(512), LDS_BYTES, stream, p);
#endif
}
```

```cpp
#include <hip/hip_runtime.h>
#include <cstdio>
#include <cstdint>

#define GAS __attribute__((address_space(1)))
#define LAS __attribute__((address_space(3)))
#define DI __device__ __forceinline__
typedef unsigned short bf16;
typedef float f32x4 __attribute__((ext_vector_type(4)));
typedef float f32x2 __attribute__((ext_vector_type(2)));
typedef unsigned u32x4 __attribute__((ext_vector_type(4)));
typedef unsigned u32x2 __attribute__((ext_vector_type(2)));
typedef short bf16x8 __attribute__((ext_vector_type(8)));

constexpr int D = 2048, NB = 2, T = 4096, TC = 256, NL = 4;
constexpr int LAT = NB * T;
constexpr int MROWS = LAT + NB * TC;
constexpr int MIXW = 512, DFF = 5632;
constexpr int NIN = 15328, NZ = 15360;
constexpr int ZA = 0, ZAG = 512, MLQ = 1024, MLK = 1536, MLV = 2048, MLO = 2560, GDQ = 3072, GDK = 3584, GDV = 4096, GDZ = 4608;
constexpr int RWR = 5120, RWK = 5632, RWV = 6144, RWXW = 6656, RWXA = 6752, RWXG = 6848, ZG = 7104, ZSM = 15296;
constexpr int RWMIX = 1984;

namespace pg8 {
typedef unsigned short bf16_t;
constexpr int BM = 256, BK = 64, HALF = 128, HTB = HALF * BK * 2, STAGE_BYTES = 8 * HTB, NXCD = 8, WGM = 8;
__host__ __device__ __forceinline__ int lds_byte(int r, int c) { const int st = (r >> 4) * 2 + (c >> 5), rr = r & 15, cc = c & 31, ob = rr * 64 + cc * 2; return st * 1024 + (ob ^ (((ob >> 9) & 1) << 5)); }
__host__ __device__ __forceinline__ void stage_rc(int b, int& R, int& C) { const int st = b / 1024, sb = b % 1024, swz = sb ^ (((sb >> 9) & 1) << 5); R = (st >> 1) * 16 + swz / 64; C = (st & 1) * 32 + (swz % 64) / 2; }
__host__ __device__ __forceinline__ int perm32(int rho) { const int n = rho >> 4, i = rho & 15; return 8 * (i >> 2) + 4 * n + (i & 3); }

struct Unit { int pm, pn, sub; };
struct Gemm { const bf16_t* A; const bf16_t* Bt; int lda, ldb, K; };

struct StdOrder {
    int nM, nN, nwg, G, c;
    DI void init(int nM_, int nN_, int G_, int c_) { nM = nM_; nN = nN_; nwg = nM * nN; G = G_; c = c_; }
    DI bool map(int i, Unit& u) const {
        const long L = (long)i * G + c; if (L >= nwg) return false;
        int wgid = (int)L; { const int q = nwg / NXCD, r = nwg % NXCD, xcd = wgid % NXCD, off = wgid / NXCD; wgid = (xcd < r ? xcd * (q + 1) : r * (q + 1) + (xcd - r) * q) + off; }
        const int nig = WGM * nN, gid = wgid / nig, fm = gid * WGM, gsz = (nM - fm) < WGM ? (nM - fm) : WGM;
        u.pm = fm + ((wgid % nig) % gsz); u.pn = (wgid % nig) / gsz; return true;
    }
    DI bool next(int i, Unit& u) const { u.sub = 0; return map(i, u); }
    DI const char* a_ptr(const Gemm& g, const Unit& u) const { return (const char*)g.A + (size_t)u.pm * BM * g.lda * 2; }
    DI const char* b_ptr(const Gemm& g, const Unit& u) const { return (const char*)g.Bt + (size_t)u.pn * BM * g.ldb * 2; }
};
struct MergeOrder : StdOrder {
    DI bool next(int i4, Unit& u) const { u.sub = i4 & 3; return map(i4 >> 2, u); }
    DI const char* a_ptr(const Gemm& g, const Unit& u) const { return (const char*)g.A + (size_t)u.pm * BM * g.lda * 2 + (size_t)u.sub * 512 * 2; }
    DI const char* b_ptr(const Gemm& g, const Unit& u) const { return (const char*)g.Bt + ((size_t)u.sub * 2048 + (size_t)u.pn * BM) * g.ldb * 2; }
};

DI unsigned cvt_pk_bf16(float lo, float hi) { unsigned r; asm volatile("v_cvt_pk_bf16_f32 %0, %1, %2" : "=v"(r) : "v"(lo), "v"(hi)); return r; }

struct EpiF32 {
    static constexpr bool PERM = false;
    float* C; int ldc;
    DI void operator()(const f32x4 (&acc)[2][2][4][2], const Unit& u, int wr, int wc, int fr, int fq) const {
        const int row0 = u.pm * BM + wr * 64 + fr, col0 = u.pn * BM + wc * 32 + 4 * fq;
#pragma unroll
        for (int ai = 0; ai < 2; ++ai)
#pragma unroll
            for (int m = 0; m < 4; ++m) { float* rowp = C + (size_t)(row0 + ai * HALF + m * 16) * ldc + col0;
#pragma unroll
                for (int bj = 0; bj < 2; ++bj)
#pragma unroll
                    for (int n = 0; n < 2; ++n) *(f32x4*)(rowp + bj * HALF + n * 16) = acc[ai][bj][m][n]; }
    }
};
struct EpiBf16 {
    static constexpr bool PERM = true;
    bf16_t* O; int ldc; float* G32; int gtile;
    DI void operator()(const f32x4 (&acc)[2][2][4][2], const Unit& u, int wr, int wc, int fr, int fq) const {
        const int row0 = u.pm * BM + wr * 64 + fr; const int col0 = u.pn * BM + wc * 32 + 8 * fq;
#pragma unroll
        for (int ai = 0; ai < 2; ++ai)
#pragma unroll
            for (int m = 0; m < 4; ++m) { const int row = row0 + ai * HALF + m * 16; bf16_t* rowp = O + (size_t)row * ldc + col0;
#pragma unroll
                for (int bj = 0; bj < 2; ++bj) { const f32x4 v0 = acc[ai][bj][m][0], v1 = acc[ai][bj][m][1];
                    u32x4 w; w.x = cvt_pk_bf16(v0[0], v0[1]); w.y = cvt_pk_bf16(v0[2], v0[3]); w.z = cvt_pk_bf16(v1[0], v1[1]); w.w = cvt_pk_bf16(v1[2], v1[3]);
                    *(u32x4*)(rowp + bj * HALF) = w;
                    if (bj == 1 && G32 != nullptr && u.pn == gtile && wc == 2) { float* gp = G32 + (size_t)row * 32 + 8 * fq; *(f32x4*)gp = v0; *(f32x4*)(gp + 4) = v1; } } }
    }
};
struct EpiMerge {
    static constexpr bool PERM = true;
    const bf16_t* Z; int ldz; int zg; float* P; bf16_t* Mb; int ldc;
    DI void operator()(const f32x4 (&acc)[2][2][4][2], const Unit& u, int wr, int wc, int fr, int fq) const {
        const int row0 = u.pm * BM + wr * 64 + fr; const int col0 = u.pn * BM + wc * 32 + 8 * fq;
#pragma unroll
        for (int ai = 0; ai < 2; ++ai)
#pragma unroll
            for (int m = 0; m < 4; ++m) { const int row = row0 + ai * HALF + m * 16;
#pragma unroll
                for (int bj = 0; bj < 2; ++bj) { const int col = col0 + bj * HALF;
                    const u32x4 gw = *(const u32x4*)(Z + (size_t)row * ldz + zg + u.sub * 2048 + col);
                    float gt[8];
#pragma unroll
                    for (int j = 0; j < 4; ++j) { gt[2 * j] = __uint_as_float(gw[j] << 16); gt[2 * j + 1] = __uint_as_float(gw[j] & 0xffff0000u); }
                    f32x4 v0 = acc[ai][bj][m][0], v1 = acc[ai][bj][m][1];
#pragma unroll
                    for (int j = 0; j < 4; ++j) { v0[j] *= 1.f / (1.f + __expf(-gt[j])); v1[j] *= 1.f / (1.f + __expf(-gt[4 + j])); }
                    float* pp = P + (size_t)row * ldc + col;
                    if (u.sub > 0) { v0 += *(const f32x4*)pp; v1 += *(const f32x4*)(pp + 4); }
                    if (u.sub < 3) { *(f32x4*)pp = v0; *(f32x4*)(pp + 4) = v1; }
                    else { u32x4 w; w.x = cvt_pk_bf16(v0[0], v0[1]); w.y = cvt_pk_bf16(v0[2], v0[3]); w.z = cvt_pk_bf16(v1[0], v1[1]); w.w = cvt_pk_bf16(v1[2], v1[3]);
                        *(u32x4*)(Mb + (size_t)row * ldc + col) = w; } } }
    }
};

template <class Epi, class Sched>
DI void gemm_phase(LAS unsigned char* lds, const Gemm g, const Sched& S, const Epi& E) {
    int tid_ = threadIdx.x; asm volatile("" : "+v"(tid_));
    const int tid = tid_, wid = __builtin_amdgcn_readfirstlane(tid >> 6), lane = tid & 63, wr = wid >> 2, wc = wid & 3, fr = lane & 15, fq = lane >> 4;
    const int K = g.K, nt = K / BK;
    unsigned voffA[2], voffB[2];
#pragma unroll
    for (int i = 0; i < 2; ++i) { int R, C; stage_rc(tid * 16 + i * 8192, R, C); const int Rb = Epi::PERM ? ((R & ~31) + perm32(R & 31)) : R;
        voffA[i] = (unsigned)(R * g.lda + C) * 2u; voffB[i] = (unsigned)(Rb * g.ldb + C) * 2u; }
    const size_t kstep = (size_t)(BK * 2);
    const size_t hstepA = (size_t)HALF * g.lda * 2, hstepB = (size_t)HALF * g.ldb * 2;
    const unsigned ldsw = (unsigned)wid * 1024u;
    const int aoff = lds_byte(wr * 64 + fr, fq * 8), boff = lds_byte(wc * 32 + fr, fq * 8);
#define PG8_SA(b, h) (((b) * 2 + (h)) * HTB)
#define PG8_SB(b, h) ((4 + (b) * 2 + (h)) * HTB)
#define PG8_STAGE(bufoff, gbase, voff) do { _Pragma("unroll") for (int _i = 0; _i < 2; ++_i) \
        __builtin_amdgcn_global_load_lds((const unsigned*)((const char*)(gbase) + (voff)[_i]), (LAS unsigned*)(lds + (bufoff) + ldsw + _i * 8192), 16, 0, 0); } while (0)
#define PG8_LDA(dst, b, h) do { _Pragma("unroll") for (int m = 0; m < 4; ++m) _Pragma("unroll") for (int k = 0; k < 2; ++k) dst[m][k] = *(const LAS bf16x8*)(lds + PG8_SA(b, h) + aoff + m * 2048 + k * 1024); } while (0)
#define PG8_LDB(dst, b, h) do { _Pragma("unroll") for (int n = 0; n < 2; ++n) _Pragma("unroll") for (int k = 0; k < 2; ++k) dst[n][k] = *(const LAS bf16x8*)(lds + PG8_SB(b, h) + boff + n * 2048 + k * 1024); } while (0)
#define PG8_MMA(ai, bj, At, Bt) do { __builtin_amdgcn_s_setprio(1); _Pragma("unroll") for (int m = 0; m < 4; ++m) _Pragma("unroll") for (int n = 0; n < 2; ++n) _Pragma("unroll") for (int k = 0; k < 2; ++k) \
        acc[ai][bj][m][n] = __builtin_amdgcn_mfma_f32_16x16x32_bf16(Bt[n][k], At[m][k], acc[ai][bj][m][n], 0, 0, 0); __builtin_amdgcn_s_setprio(0); } while (0)
#define PG8_WAIT_V(n) asm volatile("s_waitcnt vmcnt(" #n ")" ::: "memory")
#define PG8_WAIT_L(n) asm volatile("s_waitcnt lgkmcnt(" #n ")" ::: "memory")
#define PG8_BAR __builtin_amdgcn_s_barrier()
#define PG8_SCHED __builtin_amdgcn_sched_barrier(0)
    Unit cur, nxt; int ui = 0;
    if (!S.next(0, cur)) return;
    f32x4 acc[2][2][4][2];
#pragma unroll
    for (int a = 0; a < 2; ++a)
#pragma unroll
        for (int b = 0; b < 2; ++b)
#pragma unroll
            for (int m = 0; m < 4; ++m)
#pragma unroll
                for (int n = 0; n < 2; ++n) acc[a][b][m][n] = (f32x4){0.f, 0.f, 0.f, 0.f};
    bf16x8 At[4][2], B0[2][2], B1[2][2];
    const char* cA = S.a_ptr(g, cur); const char* cB = S.b_ptr(g, cur);
    PG8_STAGE(PG8_SB(0, 0), cB, voffB); PG8_STAGE(PG8_SB(0, 1), cB + hstepB, voffB); PG8_STAGE(PG8_SA(0, 0), cA, voffA); PG8_STAGE(PG8_SA(0, 1), cA + hstepA, voffA);
    if (wr == 1) PG8_BAR;
    PG8_WAIT_V(2); PG8_BAR;
    PG8_STAGE(PG8_SB(1, 0), cB + kstep, voffB); PG8_STAGE(PG8_SA(1, 0), cA + kstep, voffA); PG8_STAGE(PG8_SB(1, 1), cB + hstepB + kstep, voffB);
    PG8_WAIT_V(6); PG8_BAR;
    for (;;) {
        const bool has_next = S.next(ui + 1, nxt);
        const char* nA = has_next ? S.a_ptr(g, nxt) : cA; const char* nB = has_next ? S.b_ptr(g, nxt) : cB;
        for (int t = 0; t < nt; t += 2) {
            const bool last = (t == nt - 2);
            const char* a1 = cA + (size_t)(t + 1) * kstep;
            const char* a2 = last ? nA : cA + (size_t)(t + 2) * kstep; const char* b2 = last ? nB : cB + (size_t)(t + 2) * kstep;
            const char* a3 = a2 + kstep; const char* b3 = b2 + kstep;
            PG8_LDB(B0, 0, 0); PG8_LDB(B1, 0, 1); PG8_SCHED; PG8_LDA(At, 0, 0); PG8_STAGE(PG8_SA(1, 1), a1 + hstepA, voffA);
            PG8_WAIT_V(8); PG8_WAIT_L(0); PG8_BAR; PG8_MMA(0, 0, At, B0); PG8_MMA(0, 1, At, B1); PG8_BAR; PG8_SCHED;
            PG8_LDA(At, 0, 1); PG8_STAGE(PG8_SB(0, 0), b2, voffB); PG8_STAGE(PG8_SB(0, 1), b2 + hstepB, voffB); PG8_STAGE(PG8_SA(0, 0), a2, voffA);
            PG8_WAIT_V(8); PG8_WAIT_L(0); PG8_BAR; PG8_MMA(1, 0, At, B0); PG8_MMA(1, 1, At, B1); PG8_BAR; PG8_SCHED;
            PG8_LDB(B0, 1, 0); PG8_LDB(B1, 1, 1); PG8_SCHED; PG8_LDA(At, 1, 0); PG8_STAGE(PG8_SA(0, 1), a2 + hstepA, voffA);
            PG8_WAIT_V(8); PG8_WAIT_L(0); PG8_BAR; PG8_MMA(0, 0, At, B0); PG8_MMA(0, 1, At, B1); PG8_BAR; PG8_SCHED;
            PG8_LDA(At, 1, 1); PG8_STAGE(PG8_SB(1, 0), b3, voffB); PG8_STAGE(PG8_SB(1, 1), b3 + hstepB, voffB); PG8_STAGE(PG8_SA(1, 0), a3, voffA);
            PG8_WAIT_V(8); PG8_WAIT_L(0); PG8_BAR; PG8_MMA(1, 0, At, B0); PG8_MMA(1, 1, At, B1); PG8_BAR; PG8_SCHED;
        }
        if (wr == 0) PG8_BAR;
        E(acc, cur, wr, wc, fr, fq);
        if (!has_next) break;
#pragma unroll
        for (int a = 0; a < 2; ++a)
#pragma unroll
            for (int b = 0; b < 2; ++b)
#pragma unroll
                for (int m = 0; m < 4; ++m)
#pragma unroll
                    for (int n = 0; n < 2; ++n) acc[a][b][m][n] = (f32x4){0.f, 0.f, 0.f, 0.f};
        cur = nxt; cA = nA; cB = nB; ++ui;
        if (wr == 1) PG8_BAR;
    }
    PG8_WAIT_V(0);
    PG8_BAR;
#undef PG8_SA
#undef PG8_SB
#undef PG8_STAGE
#undef PG8_LDA
#undef PG8_LDB
#undef PG8_MMA
#undef PG8_WAIT_V
#undef PG8_WAIT_L
#undef PG8_BAR
#undef PG8_SCHED
}
}

constexpr size_t al256(size_t x) { return (x + 255) & ~(size_t)255; }
constexpr size_t WS_CTL = 0, CTL_BYTES = 1u << 20;
constexpr size_t WS_MODP = WS_CTL + CTL_BYTES;
constexpr size_t WS_MOD = WS_MODP + al256((size_t)NL * 8 * 3 * 12288 * 4);
constexpr size_t WS_W = WS_MOD + al256((size_t)NL * 3 * 12288 * 4);
constexpr size_t WL_IN = 0, WL_BR = WL_IN + (size_t)NZ * D * 2, WL_OUT = WL_BR + (size_t)4 * D * MIXW * 2, WL_UP = WL_OUT + (size_t)D * D * 2,
                 WL_DN = WL_UP + (size_t)2 * DFF * D * 2, WL_SIZE = WL_DN + (size_t)D * DFF * 2;
constexpr size_t WS_U = WS_W + NL * WL_SIZE;
constexpr size_t WS_Y = WS_U + (size_t)MROWS * D * 2;
constexpr size_t WS_MB = WS_Y + (size_t)MROWS * D * 2;
constexpr size_t WS_G32 = WS_MB + (size_t)MROWS * D * 2;
constexpr size_t WS_X = WS_G32 + (size_t)MROWS * 32 * 4;
constexpr size_t WS_F = WS_X + (size_t)MROWS * D * 4;
constexpr size_t WS_Z = WS_F + (size_t)MROWS * D * 4;
constexpr size_t WS_S = WS_Z + (size_t)MROWS * NZ * 2;
constexpr size_t SARR = (size_t)MROWS * MIXW * 4;
constexpr int N_SARR = 20;
constexpr size_t WS_SG = WS_S + N_SARR * SARR;
constexpr size_t WS_ML = WS_SG + (size_t)MROWS * 16 * 4;
constexpr int ML_US = 16640, ML_NL = 16384, ML_HDR = 16512, ML_NU = 16 * 68;
constexpr size_t WS_MLC = WS_ML + (size_t)ML_NU * ML_US * 4;
constexpr int MLC_US = 144 * 128;
constexpr size_t WS_MLM = WS_MLC + (size_t)ML_NU * MLC_US * 2;
constexpr size_t WS_END = WS_MLM + al256((size_t)ML_NU * 4);
static_assert((size_t)MROWS * DFF * 2 <= N_SARR * SARR && (size_t)MROWS * 2 * DFF * 2 <= (size_t)MROWS * NZ * 2, "aliases");
static_assert(WS_END < 1590000000ull, "workspace budget");
enum { SA_GQ = 0, SA_GK, SA_GV, SA_RR, SA_RV, SA_RA, SA_RW0, SA_RW1, SA_RK0, SA_RK1, SA_RB0, SA_RB1, SA_RAUX, SA_RG, SA_HM0, SA_HM1, SA_HG0, SA_HG1, SA_HR0, SA_HR1 };

constexpr int LDS_RING = 131072, LDS_BYTES = 147456, LDS_MISC = LDS_BYTES - 128;

#define XB_TMO      128
#define XB_XCNT(j)  (256  + 64 * (j))
#define XB_XSUB(j)  (1280 + 64 * (j))
#define XB_XGEN(j)  (2304 + 64 * (j))
#define XB_TOP      3328
#define XB_TOPGEN   3392
#define XCD_BAR_WORDS 3456
#define XB_SPIN_CAP (1u << 18)
__device__ __forceinline__ unsigned xb_ld(unsigned* p)              { return __hip_atomic_load(p, __ATOMIC_RELAXED, __HIP_MEMORY_SCOPE_AGENT); }
__device__ __forceinline__ unsigned xb_add(unsigned* p, unsigned v) { return __hip_atomic_fetch_add(p, v, __ATOMIC_RELAXED, __HIP_MEMORY_SCOPE_AGENT); }
__device__ __forceinline__ unsigned xb_xcc_id() { return (unsigned)__builtin_amdgcn_s_getreg((3 << 11) | 20) & 0xFu; }
#define XB_SPIN(cond, bar) do { unsigned _sp = 0; while (cond) { __builtin_amdgcn_s_sleep(1); \
    if ((++_sp & 255u) == 0u) { if (xb_ld(&(bar)[XB_TMO])) break; if (_sp > XB_SPIN_CAP) { atomicAdd(&(bar)[XB_TMO], 1u); break; } } } } while (0)
struct XcdBarrier { unsigned* bar; unsigned x; volatile LAS unsigned* st; };
__device__ __forceinline__ XcdBarrier xcd_barrier_post(unsigned* bar, volatile LAS unsigned* st) {
    XcdBarrier b; b.bar = bar; b.x = xb_xcc_id(); b.st = st;
    if (threadIdx.x == 0) (void)xb_add(&bar[XB_XCNT(b.x)], 1u);
    return b;
}
__device__ __forceinline__ void xcd_barrier_complete(unsigned* bar, unsigned x, unsigned& nloc, unsigned& nx) {
    const unsigned G = gridDim.x * gridDim.y * gridDim.z;
    unsigned sum, cnt, mine, sp = 0u;
    for (;;) {
        sum = 0u; cnt = 0u; mine = 0u;
#pragma unroll
        for (unsigned j = 0; j < 16; ++j) { const unsigned c = xb_ld(&bar[XB_XCNT(j)]); sum += c; cnt += (c > 0u) ? 1u : 0u; mine = (j == x) ? c : mine; }
        if (sum == G) break;
        __builtin_amdgcn_s_sleep(1);
        if ((++sp & 255u) == 0u) { if (xb_ld(&bar[XB_TMO])) break; if (sp > XB_SPIN_CAP) { atomicAdd(&bar[XB_TMO], 1u); break; } }
    }
    nloc = mine > 0u ? mine : 1u; nx = cnt > 0u ? cnt : 1u;
}
__device__ __forceinline__ void xcd_barrier(const XcdBarrier& b) {
    asm volatile("s_waitcnt vmcnt(0)" ::: "memory");
    __syncthreads();
    if (threadIdx.x == 0) {
        unsigned* bar = b.bar;
        __builtin_amdgcn_s_waitcnt(0);
        unsigned nloc = b.st[0], nx = b.st[1];
        if (nloc == 0u) { xcd_barrier_complete(bar, b.x, nloc, nx); b.st[0] = nloc; b.st[1] = nx; }
        const unsigned old = xb_add(&bar[XB_XSUB(b.x)], 1u);
        const unsigned gen = old / nloc;
        if (old + 1u == (gen + 1u) * nloc) {
            __builtin_amdgcn_fence(__ATOMIC_RELEASE, "agent");
            asm volatile("s_waitcnt vmcnt(0)" ::: "memory");
            const unsigned og = xb_add(&bar[XB_TOP], 1u);
            const unsigned tg = og / nx;
            if (og + 1u == (tg + 1u) * nx) xb_add(&bar[XB_TOPGEN], 1u);
            else XB_SPIN(xb_ld(&bar[XB_TOPGEN]) == tg, bar);
            __builtin_amdgcn_fence(__ATOMIC_ACQUIRE, "agent");
            xb_add(&bar[XB_XGEN(b.x)], 1u);
            asm volatile("s_waitcnt vmcnt(0)" ::: "memory");
        } else {
            XB_SPIN(xb_ld(&bar[XB_XGEN(b.x)]) == gen, bar);
            __builtin_amdgcn_fence(__ATOMIC_ACQUIRE, "agent");
            asm volatile("s_waitcnt vmcnt(0)" ::: "memory");
        }
    }
    __syncthreads();
}

struct Params {
    const float *x, *c, *ctx, *c_ctx, *w_mod, *b_mod, *norm_g, *w_in, *conv_dw, *conv_b, *conv_ln_g, *conv_ln_b, *ml_gate_b, *ml_norm_g,
        *gd_conv, *gd_a_log, *gd_dt_bias, *gd_norm_g, *rw_mu, *rw_w0, *rw_w2, *rw_a0, *rw_a2, *rw_g2, *rw_kk, *rw_ka, *rw_rk, *rw_ln_g, *rw_ln_b,
        *w_br, *w_out, *ffn_up, *ffn_dw, *ffn_down;
    float* out; unsigned char* ws; int ph_lo, ph_hi;
};

DI float bf2f(unsigned short u) { return __uint_as_float(((unsigned)u) << 16); }
DI unsigned f2bf(float f) { unsigned u = __float_as_uint(f); return (u + 0x7fffu + ((u >> 16) & 1u)) >> 16; }
DI unsigned pk2(float lo, float hi) { return f2bf(lo) | (f2bf(hi) << 16); }
DI void ld8(const bf16* p, float (&o)[8]) { const u32x4 w = *(const u32x4*)p;
#pragma unroll
    for (int j = 0; j < 4; ++j) { o[2 * j] = __uint_as_float(w[j] << 16); o[2 * j + 1] = __uint_as_float(w[j] & 0xffff0000u); } }
DI void st8(bf16* p, const float (&v)[8]) { u32x4 w; w.x = pk2(v[0], v[1]); w.y = pk2(v[2], v[3]); w.z = pk2(v[4], v[5]); w.w = pk2(v[6], v[7]); *(u32x4*)p = w; }
DI void ldf8(const float* p, float (&o)[8]) { const f32x4 a = *(const f32x4*)p, b = *(const f32x4*)(p + 4);
    o[0] = a[0]; o[1] = a[1]; o[2] = a[2]; o[3] = a[3]; o[4] = b[0]; o[5] = b[1]; o[6] = b[2]; o[7] = b[3]; }
DI void stf8(float* p, const float (&v)[8]) { *(f32x4*)p = (f32x4){v[0], v[1], v[2], v[3]}; *(f32x4*)(p + 4) = (f32x4){v[4], v[5], v[6], v[7]}; }
DI float wave_sum(float v) {
#pragma unroll
    for (int o = 1; o < 64; o <<= 1) v += __shfl_xor(v, o);
    return v; }
template <int W> DI float grp_sum(float v) {
#pragma unroll
    for (int o = 1; o < W; o <<= 1) v += __shfl_xor(v, o);
    return v; }
DI float sigmoidf_(float x) { return 1.f / (1.f + __expf(-x)); }
DI float siluf_(float x) { return x / (1.f + __expf(-x)); }
DI float softplusf_(float x) { return fmaxf(x, 0.f) + log1pf(__expf(-fabsf(x))); }
DI float logsigmoidf_(float x) { return fminf(x, 0.f) - log1pf(__expf(-fabsf(x))); }
DI float gelu_tanh(float x) { const float u = 0.7978845608028654f * (x + 0.044715f * x * x * x); return 0.5f * x * (1.f + tanhf(u)); }

DI void seq_of(int row, int& base, int& len, int& t) { if (row < LAT) { base = row & ~(T - 1); len = T; t = row & (T - 1); } else { const int r = row - LAT; base = LAT + (r & ~(TC - 1)); len = TC; t = r & (TC - 1); } }
DI int scan_row(int dir, int b, int j) { if (j < TC) { const int tok = dir ? (TC - 1 - j) : j; return LAT + b * TC + tok; } const int jj = j - TC; const int tok = dir ? (T - 1 - jj) : jj; return b * T + tok; }

struct Ctx {
    LAS unsigned char* lds; int tid, lane, wave, G, bid;
    const Params* p; unsigned char* ws;
};

DI int zcol_src(int j) { if (j < 3072) return j; if (j < 5120) return j + 16; if (j < ZSM) return j + 32; if (j < ZSM + 16) return 3072 + (j - ZSM); if (j < ZSM + 32) return 5136 + (j - ZSM - 16); return -1; }
template <bool ZMAP> DI void transpose_item(const float* W, int K, int N, bf16* WT, LAS float* scr, int kb, int nb, int lane) {
    const int k0 = 64 * kb, n0 = 32 * nb; const int nn = n0 + (lane & 31); const int src = ZMAP ? zcol_src(nn) : nn;
#pragma unroll 8
    for (int i = 0; i < 32; ++i) { const int kk = 2 * i + (lane >> 5); scr[kk * 33 + (lane & 31)] = (src >= 0) ? W[(size_t)(k0 + kk) * N + src] : 0.f; }
    asm volatile("s_waitcnt lgkmcnt(0)" ::: "memory");
    const int c = lane & 7;
#pragma unroll
    for (int j = 0; j < 4; ++j) { const int n = (lane >> 3) + 8 * j; const LAS float* s = scr + (8 * c) * 33 + n;
        u32x4 o; o.x = pk2(s[0 * 33], s[1 * 33]); o.y = pk2(s[2 * 33], s[3 * 33]); o.z = pk2(s[4 * 33], s[5 * 33]); o.w = pk2(s[6 * 33], s[7 * 33]);
        *(u32x4*)(WT + (size_t)(n0 + n) * K + k0 + 8 * c) = o; }
    asm volatile("s_waitcnt lgkmcnt(0)" ::: "memory");
}
DI void phase_pro0(Ctx& c) {
    const Params& p = *c.p;
    {
        LAS float* red = (LAS float*)c.lds;
        float* MODP = (float*)(c.ws + WS_MODP);
        for (int u = c.bid; u < NL * 48 * 8; u += c.G) {
            const int l = u / 384, cb = (u >> 3) % 48, ks = u & 7; const int col = cb * 256 + c.lane * 4;
            f32x4 a0 = {0.f, 0.f, 0.f, 0.f}, a1 = a0, a2 = a0;
            const float* wp = p.w_mod + ((size_t)l * D + ks * 256 + c.wave * 32) * 12288 + col;
            const int kb = ks * 256 + c.wave * 32;
#pragma unroll 8
            for (int i = 0; i < 32; ++i) { const f32x4 w = *(const f32x4*)(wp + (size_t)i * 12288);
                const float s0 = siluf_(p.c[kb + i]), s1 = siluf_(p.c[D + kb + i]), s2 = siluf_(p.c_ctx[kb + i]);
                a0 += w * s0; a1 += w * s1; a2 += w * s2; }
            __syncthreads();
            *(LAS f32x4*)(red + (c.wave * 3 + 0) * 256 + c.lane * 4) = a0; *(LAS f32x4*)(red + (c.wave * 3 + 1) * 256 + c.lane * 4) = a1; *(LAS f32x4*)(red + (c.wave * 3 + 2) * 256 + c.lane * 4) = a2;
            __syncthreads();
            for (int o = c.tid; o < 768; o += 512) { float s = 0.f;
#pragma unroll
                for (int w = 0; w < 8; ++w) s += red[w * 768 + o];
                MODP[((size_t)(l * 8 + ks) * 3 + o / 256) * 12288 + cb * 256 + (o & 255)] = s; }
        }
        __syncthreads();
    }
    {
        LAS float* scr = (LAS float*)(c.lds + c.wave * 16384);
        const int gw = c.bid * 8 + c.wave, NGW = c.G * 8;
        constexpr int I_IN = 32 * 480, I_BR = 8 * 64, I_OUT = 32 * 64, I_UP = 32 * 352, I_DN = 88 * 64, I_L = I_IN + 4 * I_BR + I_OUT + I_UP + I_DN;
        for (int it = gw; it < NL * I_L; it += NGW) {
            const int l = it / I_L; int r = it % I_L; unsigned char* wl = c.ws + WS_W + (size_t)l * WL_SIZE;
            if (r < I_IN) { transpose_item<true>(p.w_in + (size_t)l * D * NIN, D, NIN, (bf16*)(wl + WL_IN), scr, r / 480, r % 480, c.lane); continue; } r -= I_IN;
            if (r < 4 * I_BR) { const int nb = r / I_BR; r %= I_BR; transpose_item<false>(p.w_br + ((size_t)l * 4 + nb) * MIXW * D, MIXW, D, (bf16*)(wl + WL_BR) + (size_t)nb * D * MIXW, scr, r / 64, r % 64, c.lane); continue; } r -= 4 * I_BR;
            if (r < I_OUT) { transpose_item<false>(p.w_out + (size_t)l * D * D, D, D, (bf16*)(wl + WL_OUT), scr, r / 64, r % 64, c.lane); continue; } r -= I_OUT;
            if (r < I_UP) { transpose_item<false>(p.ffn_up + (size_t)l * D * 2 * DFF, D, 2 * DFF, (bf16*)(wl + WL_UP), scr, r / 352, r % 352, c.lane); continue; } r -= I_UP;
            transpose_item<false>(p.ffn_down + (size_t)l * DFF * D, DFF, D, (bf16*)(wl + WL_DN), scr, r / 64, r % 64, c.lane);
        }
    }
}
DI void phase_pro1(Ctx& c) {
    const Params& p = *c.p; const float* MODP = (const float*)(c.ws + WS_MODP); float* MOD = (float*)(c.ws + WS_MOD);
    for (int i = c.bid * 512 + c.tid; i < NL * 3 * 12288; i += c.G * 512) { const int l = i / 36864, v = (i / 12288) % 3, n = i % 12288;
        float s = p.b_mod[l * 12288 + n];
#pragma unroll
        for (int ks = 0; ks < 8; ++ks) s += MODP[((size_t)(l * 8 + ks) * 3 + v) * 12288 + n];
        MOD[i] = s; }
}
DI void row_load(const float* r, int lane, f32x4 (&v)[8]) {
#pragma unroll
    for (int j = 0; j < 8; ++j) v[j] = *(const f32x4*)(r + 4 * lane + 256 * j); }
DI float row_rstd(const f32x4 (&v)[8]) { float s = 0.f;
#pragma unroll
    for (int j = 0; j < 8; ++j) s += (v[j][0] * v[j][0] + v[j][1] * v[j][1]) + (v[j][2] * v[j][2] + v[j][3] * v[j][3]);
    return rsqrtf(wave_sum(s) * (1.f / D) + 1e-6f); }
DI void norm_mod_store(const f32x4 (&v)[8], float rstd, const float* g, const float* sh, const float* sc, bf16* o, int lane) {
#pragma unroll
    for (int j = 0; j < 8; ++j) { const int cc = 4 * lane + 256 * j; const f32x4 g4 = *(const f32x4*)(g + cc), s4 = *(const f32x4*)(sh + cc), c4 = *(const f32x4*)(sc + cc);
        const f32x4 r = v[j] * rstd * g4 * (c4 + 1.f) + s4; u32x2 w; w.x = pk2(r[0], r[1]); w.y = pk2(r[2], r[3]); *(u32x2*)(o + cc) = w; } }
DI int mod_vec(int row) { return row < LAT ? (row >> 12) : 2; }
DI void phase_pro2(Ctx& c) {
    const Params& p = *c.p; const float* MOD = (const float*)(c.ws + WS_MOD); bf16* U = (bf16*)(c.ws + WS_U);
    const int gw = c.bid * 8 + c.wave, NGW = c.G * 8;
    for (int row = gw; row < MROWS; row += NGW) { const float* xr = row < LAT ? p.x + (size_t)row * D : p.ctx + (size_t)(row - LAT) * D;
        f32x4 v[8]; row_load(xr, c.lane, v); const float rs = row_rstd(v); const float* mv = MOD + (size_t)(0 * 3 + mod_vec(row)) * 12288;
        norm_mod_store(v, rs, p.norm_g, mv, mv + 2048, U + (size_t)row * D, c.lane); }
}
DI void phase_resid(Ctx& c, int l, int which) {
    const Params& p = *c.p; const float* MOD = (const float*)(c.ws + WS_MOD); bf16* U = (bf16*)(c.ws + WS_U); float* X = (float*)(c.ws + WS_X); const float* F = (const float*)(c.ws + WS_F);
    const int gw = c.bid * 8 + c.wave, NGW = c.G * 8;
    for (int row = gw; row < MROWS; row += NGW) {
        const float* xr = (l == 0 && which == 0) ? (row < LAT ? p.x + (size_t)row * D : p.ctx + (size_t)(row - LAT) * D) : X + (size_t)row * D;
        f32x4 fv[8], xv[8]; row_load(F + (size_t)row * D, c.lane, fv); row_load(xr, c.lane, xv);
        const float rs = row_rstd(fv); const float* mv = MOD + (size_t)(l * 3 + mod_vec(row)) * 12288;
        const float* g = p.norm_g + (size_t)(l * 4 + (which ? 3 : 1)) * D; const float* gt = mv + (which ? 10240 : 4096);
#pragma unroll
        for (int j = 0; j < 8; ++j) { const int cc = 4 * c.lane + 256 * j; xv[j] += *(const f32x4*)(gt + cc) * (fv[j] * rs * *(const f32x4*)(g + cc)); }
        const bool fin = (which == 1 && l == NL - 1);
        if (fin) { if (row < LAT) {
#pragma unroll
            for (int j = 0; j < 8; ++j) *(f32x4*)(p.out + (size_t)row * D + 4 * c.lane + 256 * j) = xv[j]; } continue; }
#pragma unroll
        for (int j = 0; j < 8; ++j) *(f32x4*)(X + (size_t)row * D + 4 * c.lane + 256 * j) = xv[j];
        const float rs2 = row_rstd(xv);
        if (which == 0) norm_mod_store(xv, rs2, p.norm_g + (size_t)(l * 4 + 2) * D, mv + 6144, mv + 8192, U + (size_t)row * D, c.lane);
        else { const float* mv2 = MOD + (size_t)((l + 1) * 3 + mod_vec(row)) * 12288; norm_mod_store(xv, rs2, p.norm_g + (size_t)((l + 1) * 4) * D, mv2, mv2 + 2048, U + (size_t)row * D, c.lane); }
    }
}

DI f32x4 mfma16(bf16x8 a, bf16x8 b, f32x4 c) { return __builtin_amdgcn_mfma_f32_16x16x32_bf16(a, b, c, 0, 0, 0); }
DI bf16x8 ldfrag(const LAS bf16* base, int ld, int r0, int k0, int lane) { return *(const LAS bf16x8*)(base + (r0 + (lane & 15)) * ld + k0 + 8 * (lane >> 4)); }
template <int K> DI f32x4 mm_tile(const LAS bf16* X, int ldx, int xr0, const LAS bf16* Yt, int ldy, int yr0, int lane, f32x4 acc) {
#pragma unroll
    for (int k0 = 0; k0 < K; k0 += 32) acc = mfma16(ldfrag(X, ldx, xr0, k0, lane), ldfrag(Yt, ldy, yr0, k0, lane), acc);
    return acc; }
DI float wave_scan_add(float v, int lane) {
#pragma unroll
    for (int o = 1; o < 64; o <<= 1) { const float t = __shfl_up(v, o); if (lane >= o) v += t; }
    return v; }
DI float wave_scan_max(float v, int lane) {
#pragma unroll
    for (int o = 1; o < 64; o <<= 1) { const float t = __shfl_up(v, o); if (lane >= o) v = fmaxf(v, t); }
    return v; }
DI float wave_max(float v) {
#pragma unroll
    for (int o = 1; o < 64; o <<= 1) v = fmaxf(v, __shfl_xor(v, o));
    return v; }
constexpr float QSC = 0.08838834764831845f;

DI void mlstm_local(Ctx& c, int l, int u) {
    const Params& p = *c.p; const bf16* Z = (const bf16*)(c.ws + WS_Z); const float* G32 = (const float*)(c.ws + WS_G32); float* ML = (float*)(c.ws + WS_ML) + (size_t)u * ML_US;
    const int chain = u / 68, cc = u % 68, g = chain >> 2, h = chain & 3, dir = g >> 1, b = g & 1;
    LAS bf16* kT = (LAS bf16*)c.lds; LAS bf16* vT = kT + 128 * 72; LAS float* sw = (LAS float*)(vT + 128 * 72);
    __syncthreads();
    if (c.wave == 0) { const int row = scan_row(dir, b, cc * 64 + c.lane);
        const float li = G32[(size_t)row * 32 + dir * 8 + h] + p.ml_gate_b[((l * 2 + dir) * 2 + 0) * 4 + h];
        const float lf = logsigmoidf_(G32[(size_t)row * 32 + dir * 8 + 4 + h] + p.ml_gate_b[((l * 2 + dir) * 2 + 1) * 4 + h]);
        const float bt = wave_scan_add(lf, c.lane); const float bl = __shfl(bt, 63); const float wl = bl - bt + li; const float mloc = wave_max(wl);
        sw[c.lane] = expf(wl - mloc); if (c.lane == 0) { ML[ML_HDR] = mloc; ML[ML_HDR + 1] = bl; } }
    __syncthreads();
    for (int it = c.tid; it < 64 * 32; it += 512) { const int s = it & 63, r = it >> 6, mat = r >> 4, ch = (r & 15) * 8; const int row = scan_row(dir, b, cc * 64 + s);
        float v[8]; ld8(Z + (size_t)row * NZ + (mat ? MLV : MLK) + h * 128 + ch, v); const float sc = mat ? 1.f : sw[s]; LAS bf16* dst = (mat ? vT : kT) + ch * 72 + s;
#pragma unroll
        for (int i = 0; i < 8; ++i) dst[i * 72] = (bf16)f2bf(v[i] * sc); }
    __syncthreads();
    f32x4 acc[8];
#pragma unroll
    for (int nt = 0; nt < 8; ++nt) acc[nt] = mm_tile<64>(kT, 72, 16 * c.wave, vT, 72, 16 * nt, c.lane, (f32x4){0.f, 0.f, 0.f, 0.f});
    const int q = c.lane >> 4, r = c.lane & 15;
#pragma unroll
    for (int nt = 0; nt < 8; ++nt) *(f32x4*)(ML + (size_t)(16 * nt + r) * 128 + 16 * c.wave + 4 * q) = acc[nt];
    if (c.tid < 128) { float s = 0.f;
#pragma unroll
        for (int j = 0; j < 64; j += 8) { const u32x4 w = *(const LAS u32x4*)(kT + c.tid * 72 + j);
#pragma unroll
            for (int i = 0; i < 4; ++i) s += __uint_as_float(w[i] << 16) + __uint_as_float(w[i] & 0xffff0000u); }
        ML[ML_NL + c.tid] = s; }
}
DI void mlstm_prefix(Ctx& c) {
    const float* ML = (const float*)(c.ws + WS_ML); bf16* CT = (bf16*)(c.ws + WS_MLC); float* MS = (float*)(c.ws + WS_MLM);
    for (int item = c.bid * 512 + c.tid; item < 65536 + 512; item += c.G * 512) {
        int chain, e, dq; if (item < 65536) { chain = item >> 12; e = (item >> 5) & 127; dq = item & 31; } else { const int j = item - 65536; chain = j >> 5; e = 128; dq = j & 31; }
        const size_t so = (e < 128 ? (size_t)e * 128 : (size_t)ML_NL) + 4 * dq; const size_t dofs = (size_t)e * 128 + 4 * dq;
        f32x4 C = {0.f, 0.f, 0.f, 0.f}; float m = 0.f;
#pragma unroll 4
        for (int cc = 0; cc < 68; ++cc) { const size_t u = (size_t)chain * 68 + cc; const float* mu = ML + u * ML_US;
            const f32x4 L = *(const f32x4*)(mu + so); const float mloc = mu[ML_HDR], bl = mu[ML_HDR + 1];
            u32x2 w; w.x = pk2(C[0], C[1]); w.y = pk2(C[2], C[3]); *(u32x2*)(CT + u * MLC_US + dofs) = w;
            if (e == 0 && dq == 0) MS[u] = m;
            const float mn = fmaxf(bl + m, mloc); const float dec = expf(bl + m - mn), wl = expf(mloc - mn); m = mn;
            C = C * dec + L * wl; }
    }
}
DI void mlstm_out(Ctx& c, int l, int u) {
    const Params& p = *c.p; const bf16* Z = (const bf16*)(c.ws + WS_Z); const float* G32 = (const float*)(c.ws + WS_G32); bf16* Y = (bf16*)(c.ws + WS_Y);
    const bf16* CTg = (const bf16*)(c.ws + WS_MLC); const float* MS = (const float*)(c.ws + WS_MLM);
    const int b = u / (4 * 68), h = (u / 68) & 3, tb = u % 68;
    LAS bf16* sq = (LAS bf16*)c.lds; LAS bf16* sk = sq + 64 * 136; LAS bf16* vT = sk + 64 * 136; LAS bf16* CT = vT + 144 * 72; LAS bf16* sdw = CT + 144 * 136;
    LAS float* hbuf = (LAS float*)(sdw + 64 * 72); LAS float* sAt = hbuf + 64 * 128; LAS float* sBs = sAt + 64; LAS float* siw = sBs + 64; LAS float* semt = siw + 64; LAS float* sden = semt + 64;
    const int q = c.lane >> 4, r = c.lane & 15;
    for (int dir = 0; dir < 2; ++dir) {
        const int cc = dir == 0 ? tb : (tb < 4 ? 3 - tb : 71 - tb); const int chain = (dir * 2 + b) * 4 + h; const size_t un = (size_t)chain * 68 + cc;
        __syncthreads();
        if (c.wave == 0) { const int row = scan_row(dir, b, cc * 64 + c.lane); const float mc = MS[un];
            const float li = G32[(size_t)row * 32 + dir * 8 + h] + p.ml_gate_b[((l * 2 + dir) * 2 + 0) * 4 + h];
            const float lf = logsigmoidf_(G32[(size_t)row * 32 + dir * 8 + 4 + h] + p.ml_gate_b[((l * 2 + dir) * 2 + 1) * 4 + h]);
            const float bt = wave_scan_add(lf, c.lane); const float x = li - bt; const float cm = wave_scan_max(x, c.lane); const float mt = bt + fmaxf(mc, cm);
            sAt[c.lane] = bt - mt; sBs[c.lane] = x; siw[c.lane] = expf(bt + mc - mt) * QSC; semt[c.lane] = expf(-mt); }
        for (int it = c.tid; it < 64 * 32; it += 512) { const int s = it >> 5, r2 = it & 31, mat = r2 >> 4, ch = (r2 & 15) * 8; const int row = scan_row(dir, b, cc * 64 + s);
            *(LAS u32x4*)((mat ? sk : sq) + s * 136 + ch) = *(const u32x4*)(Z + (size_t)row * NZ + (mat ? MLK : MLQ) + h * 128 + ch); }
        for (int it = c.tid; it < 64 * 16; it += 512) { const int s = it & 63, ch = (it >> 6) * 8; const int row = scan_row(dir, b, cc * 64 + s);
            const u32x4 w = *(const u32x4*)(Z + (size_t)row * NZ + MLV + h * 128 + ch); LAS bf16* dst = vT + ch * 72 + s;
#pragma unroll
            for (int i = 0; i < 4; ++i) { dst[(2 * i) * 72] = (bf16)(w[i] & 0xffffu); dst[(2 * i + 1) * 72] = (bf16)(w[i] >> 16); } }
        if (c.tid < 64) vT[128 * 72 + c.tid] = (bf16)0x3F80u;
        for (int it = c.tid; it < 129 * 16; it += 512) { const int e = it >> 4, ch = (it & 15) * 8; *(LAS u32x4*)(CT + e * 136 + ch) = *(const u32x4*)(CTg + un * MLC_US + (size_t)e * 128 + ch); }
        __syncthreads();
#pragma unroll
        for (int j = 0; j < 2; ++j) { const int ti = 2 * c.wave + j, mt = ti >> 2, nt = ti & 3;
            const f32x4 a = mm_tile<128>(sk, 136, 16 * nt, sq, 136, 16 * mt, c.lane, (f32x4){0.f, 0.f, 0.f, 0.f});
            const int t = 16 * mt + r; const float At = sAt[t]; float d[4];
#pragma unroll
            for (int i = 0; i < 4; ++i) { const int s = 16 * nt + 4 * q + i; d[i] = (s <= t) ? a[i] * QSC * expf(At + sBs[s]) : 0.f; }
            u32x2 w; w.x = pk2(d[0], d[1]); w.y = pk2(d[2], d[3]); *(LAS u32x2*)(sdw + t * 72 + 16 * nt + 4 * q) = w; }
        const int mt = c.wave & 3, nt0 = (c.wave >> 2) * 5, ntn = (c.wave >> 2) ? 4 : 5;
        f32x4 acc[5];
#pragma unroll
        for (int j = 0; j < 5; ++j) if (j < ntn) acc[j] = mm_tile<128>(CT, 136, 16 * (nt0 + j), sq, 136, 16 * mt, c.lane, (f32x4){0.f, 0.f, 0.f, 0.f});
        __syncthreads();
        const int t = 16 * mt + r; const float iw = siw[t];
#pragma unroll
        for (int j = 0; j < 5; ++j) if (j < ntn) acc[j] = mm_tile<64>(vT, 72, 16 * (nt0 + j), sdw, 72, 16 * mt, c.lane, acc[j] * iw);
        if (c.wave >= 4 && q == 0) sden[t] = acc[3][0];
        __syncthreads();
        const float dn = fmaxf(fabsf(sden[t]), semt[t]); const float inv = 1.f / dn; const int tok = dir ? 63 - t : t;
#pragma unroll
        for (int j = 0; j < 5; ++j) if (j < ntn && nt0 + j < 8) { LAS f32x4* hp = (LAS f32x4*)(hbuf + tok * 128 + 16 * (nt0 + j) + 4 * q); const f32x4 hv = acc[j] * inv; if (dir == 0) *hp = hv; else *hp += hv; }
    }
    __syncthreads();
    { const int tok = c.tid >> 3, eg = (c.tid & 7) * 16; const int row = (tb < 4 ? LAT + b * TC + tb * 64 : b * T + (tb - 4) * 64) + tok;
        float hv[16]; float ss = 0.f;
#pragma unroll
        for (int j = 0; j < 4; ++j) { const f32x4 x = *(const LAS f32x4*)(hbuf + tok * 128 + eg + 4 * j); hv[4 * j] = x[0]; hv[4 * j + 1] = x[1]; hv[4 * j + 2] = x[2]; hv[4 * j + 3] = x[3]; ss += (x[0] * x[0] + x[1] * x[1]) + (x[2] * x[2] + x[3] * x[3]); }
        ss = grp_sum<8>(ss); const float rs = rsqrtf(ss * (1.f / 128.f) + 1e-6f);
#pragma unroll
        for (int j = 0; j < 2; ++j) { float g[8], o[8], y[8]; ldf8(p.ml_norm_g + l * 512 + h * 128 + eg + 8 * j, g); ld8(Z + (size_t)row * NZ + MLO + h * 128 + eg + 8 * j, o);
#pragma unroll
            for (int i = 0; i < 8; ++i) y[i] = hv[8 * j + i] * rs * g[i] * sigmoidf_(o[i]);
            st8(Y + (size_t)row * D + 512 + h * 128 + eg + 8 * j, y); } }
}

DI float rw_feat(const bf16* Z, const float* mu, int row, int cz) {
    int base, len, t; seq_of(row, base, len, t); const bf16* zp = Z + (size_t)row * NZ + RWR + cz;
    const float x = bf2f(zp[0]); const float pv = t > 0 ? bf2f(zp[-NZ]) : 0.f; const float nx = t < len - 1 ? bf2f(zp[NZ]) : 0.f;
    return x + mu[cz] * (pv - x) + mu[RWMIX + cz] * (nx - x);
}
template <int K, int NT> DI void lora_nt(const float* Wm, const LAS float* in, int c, float (&acc)[NT]) {
#pragma unroll
    for (int t = 0; t < NT; ++t) acc[t] = 0.f;
    for (int k = 0; k < K; k += 4) { const float w0 = Wm[(k + 0) * 512 + c], w1 = Wm[(k + 1) * 512 + c], w2 = Wm[(k + 2) * 512 + c], w3 = Wm[(k + 3) * 512 + c];
#pragma unroll
        for (int t = 0; t < NT; ++t) { const f32x4 x = *(const LAS f32x4*)(in + t * 448 + k); acc[t] = fmaf(x[0], w0, acc[t]); acc[t] = fmaf(x[1], w1, acc[t]); acc[t] = fmaf(x[2], w2, acc[t]); acc[t] = fmaf(x[3], w3, acc[t]); } }
}
constexpr int RWT = 17;
DI void rwkv_prep_rows(Ctx& c, int l, int row0, const LAS float* in, LAS float* bufA, LAS float* bufB) {
    const Params& p = *c.p; const bf16* Z = (const bf16*)(c.ws + WS_Z); float* SA = (float*)(c.ws + WS_S);
    const float* mu = p.rw_mu + (size_t)l * 2 * RWMIX; const int cc = c.tid; const size_t AS = (size_t)MROWS * 512;
    float acc[RWT];
#pragma unroll
    for (int dir = 0; dir < 2; ++dir) {
        lora_nt<96, RWT>(p.rw_w2 + (size_t)(l * 2 + dir) * 96 * 512, in, cc, acc);
        const float w0 = p.rw_w0[(l * 2 + dir) * 512 + cc];
#pragma unroll
        for (int t = 0; t < RWT; ++t) { const float wl = w0 + acc[t]; SA[(SA_RW0 + dir) * AS + (size_t)(row0 + t) * 512 + cc] = expf(-expf(-softplusf_(-wl) - 0.5f)); }
        lora_nt<96, RWT>(p.rw_a2 + (size_t)(l * 2 + dir) * 96 * 512, in + 96, cc, acc);
        const float a0 = p.rw_a0[(l * 2 + dir) * 512 + cc]; LAS float* bb = dir ? bufB : bufA;
#pragma unroll
        for (int t = 0; t < RWT; ++t) bb[t * 512 + cc] = sigmoidf_(a0 + acc[t]);
    }
    lora_nt<256, RWT>(p.rw_g2 + (size_t)l * 256 * 512, in + 192, cc, acc);
#pragma unroll
    for (int t = 0; t < RWT; ++t) SA[SA_RG * AS + (size_t)(row0 + t) * 512 + cc] = acc[t];
    const float kks = p.rw_kk[l * 512 + cc], kas = p.rw_ka[l * 512 + cc], rks = p.rw_rk[l * 512 + cc];
#pragma unroll 1
    for (int t = 0; t < RWT; ++t) { const int row = row0 + t; const size_t o = (size_t)row * 512 + cc;
        const float rf = rw_feat(Z, mu, row, cc), kf = rw_feat(Z, mu, row, 512 + cc), vf = rw_feat(Z, mu, row, 1024 + cc);
        const float kx = kf * kks; const float kkv = kx * rsqrtf(wave_sum(kx * kx) + 1e-6f);
        const float ic0 = bufA[t * 512 + cc], ic1 = bufB[t * 512 + cc];
        const float km0 = kf * (1.f + (ic0 - 1.f) * kas), km1 = kf * (1.f + (ic1 - 1.f) * kas);
        const float bonus = wave_sum(rf * rks * (km0 + km1));
        SA[SA_RK0 * AS + o] = km0; SA[SA_RK1 * AS + o] = km1; SA[SA_RB0 * AS + o] = kkv * ic0; SA[SA_RB1 * AS + o] = kkv * ic1;
        SA[SA_RAUX * AS + o] = bonus * vf; SA[SA_RR * AS + o] = rf; SA[SA_RV * AS + o] = vf; SA[SA_RA * AS + o] = -kkv; }
}
DI void phase_prep(Ctx& c, int l) {
    const Params& p = *c.p; const bf16* Z = (const bf16*)(c.ws + WS_Z); bf16* Y = (bf16*)(c.ws + WS_Y); const float* G32 = (const float*)(c.ws + WS_G32);
    float* SA = (float*)(c.ws + WS_S); float* SG = (float*)(c.ws + WS_SG);
    const int gw = c.bid * 8 + c.wave, NGW = c.G * 8; const int ch = c.lane * 8;
    for (int row = gw; row < MROWS; row += NGW) {
        int base, len, t; seq_of(row, base, len, t);
        float acc[8];
#pragma unroll
        for (int i = 0; i < 8; ++i) acc[i] = 0.f;
        const float* w = p.conv_dw + (size_t)l * 31 * 512;
        for (int j = 0; j < 31; ++j) { const int tt = t + j - 15; if (tt < 0 || tt >= len) continue;
            const bf16* zr = Z + (size_t)(base + tt) * NZ; float a[8], g[8], wv[8]; ld8(zr + ZA + ch, a); ld8(zr + ZAG + ch, g); ldf8(w + j * 512 + ch, wv);
#pragma unroll
            for (int i = 0; i < 8; ++i) acc[i] = fmaf(a[i] * sigmoidf_(g[i]), wv[i], acc[i]); }
        float bv[8]; ldf8(p.conv_b + l * 512 + ch, bv); float s = 0.f;
#pragma unroll
        for (int i = 0; i < 8; ++i) { acc[i] += bv[i]; s += acc[i]; }
        const float mean = wave_sum(s) * (1.f / 512.f); float q = 0.f;
#pragma unroll
        for (int i = 0; i < 8; ++i) { acc[i] -= mean; q += acc[i] * acc[i]; }
        const float rstd = rsqrtf(wave_sum(q) * (1.f / 512.f) + 1e-6f);
        float lg[8], lb[8], o[8]; ldf8(p.conv_ln_g + l * 512 + ch, lg); ldf8(p.conv_ln_b + l * 512 + ch, lb);
#pragma unroll
        for (int i = 0; i < 8; ++i) o[i] = siluf_(acc[i] * rstd * lg[i] + lb[i]);
        st8(Y + (size_t)row * D + ch, o);
    }
    for (int row = gw; row < MROWS; row += NGW) {
        int base, len, t; seq_of(row, base, len, t);
        const float* w = p.gd_conv + (size_t)l * 5 * 1536;
#pragma unroll
        for (int part = 0; part < 3; ++part) {
            float acc[8];
#pragma unroll
            for (int i = 0; i < 8; ++i) acc[i] = 0.f;
#pragma unroll
            for (int j = 0; j < 5; ++j) { const int tt = t + j - 2; if (tt < 0 || tt >= len) continue;
                float a[8], wv[8]; ld8(Z + (size_t)(base + tt) * NZ + GDQ + part * 512 + ch, a); ldf8(w + j * 1536 + part * 512 + ch, wv);
#pragma unroll
                for (int i = 0; i < 8; ++i) acc[i] = fmaf(a[i], wv[i], acc[i]); }
            float ss = 0.f;
#pragma unroll
            for (int i = 0; i < 8; ++i) { acc[i] = siluf_(acc[i]); ss += acc[i] * acc[i]; }
            if (part < 2) { ss = grp_sum<16>(ss); const float sc = rsqrtf(ss + 1e-6f) * (part == 0 ? 0.08838834764831845f : 1.f);
#pragma unroll
                for (int i = 0; i < 8; ++i) acc[i] *= sc; }
            stf8(SA + (size_t)(SA_GQ + part) * (MROWS * 512) + (size_t)row * 512 + ch, acc);
        }
        if (c.lane < 8) { const int dir = c.lane >> 2, h = c.lane & 3; const float a = G32[(size_t)row * 32 + 16 + dir * 8 + h], bb = G32[(size_t)row * 32 + 16 + dir * 8 + 4 + h];
            SG[(size_t)row * 16 + dir * 4 + h] = -expf(p.gd_a_log[l * 8 + dir * 4 + h]) * softplusf_(a + p.gd_dt_bias[l * 8 + dir * 4 + h]);
            SG[(size_t)row * 16 + 8 + dir * 4 + h] = sigmoidf_(bb); }
    }
    {
        LAS float* in = (LAS float*)c.lds;
        const float* mu = p.rw_mu + (size_t)l * 2 * RWMIX;
        for (int u = c.bid; u < MROWS / 34; u += c.G) {
            const int row0 = u * 34;
            __syncthreads();
            for (int i = c.tid; i < 34 * 448; i += 512) { const int t = i / 448, k = i % 448; float f = rw_feat(Z, mu, row0 + t, 1536 + k);
                if (k < 96) f = tanhf(f); else if (k >= 192) f = sigmoidf_(f); in[i] = f; }
            __syncthreads();
            for (int hf = 0; hf < 34 / RWT; ++hf) rwkv_prep_rows(c, l, row0 + hf * RWT, in + hf * RWT * 448, in + 34 * 448, in + 34 * 448 + RWT * 512);
        }
        __syncthreads();
    }
    for (int u = c.bid; u < ML_NU; u += c.G) mlstm_local(c, l, u);
    __syncthreads();
}


DI void scan_mlstm(Ctx& c, int l, int chain) {
    const Params& p = *c.p; const bf16* Z = (const bf16*)(c.ws + WS_Z); const float* G32 = (const float*)(c.ws + WS_G32); float* SA = (float*)(c.ws + WS_S);
    const int g = chain >> 2, h = chain & 3, dir = g >> 1, b = g & 1; const int e = c.tid >> 2, dq = c.tid & 3;
    LAS float* sq = (LAS float*)c.lds; LAS float* sk = sq + 64 * 144; LAS float* sv = sk + 64 * 144; LAS float* sg = sv + 64 * 128;
    float* HM = SA + (size_t)(SA_HM0 + dir) * ((size_t)MROWS * 512);
    float C[32], nn[32], m = 0.f;
#pragma unroll
    for (int i = 0; i < 32; ++i) { C[i] = 0.f; nn[i] = 0.f; }
    const float gbi = p.ml_gate_b[((l * 2 + dir) * 2 + 0) * 4 + h], gbf = p.ml_gate_b[((l * 2 + dir) * 2 + 1) * 4 + h];
    for (int blk = 0; blk < (TC + T) / 64; ++blk) {
        __syncthreads();
        for (int it = c.tid; it < 64 * 48; it += 512) { const int tt = it / 48, r = it % 48, part = r >> 4, c8 = (r & 15) * 8; const int row = scan_row(dir, b, blk * 64 + tt);
            float v[8]; ld8(Z + (size_t)row * NZ + MLQ + part * 512 + h * 128 + c8, v);
            if (part == 2) {
#pragma unroll
                for (int i = 0; i < 8; ++i) sv[tt * 128 + c8 + i] = v[i]; }
            else { LAS float* d = (part == 0 ? sq : sk) + tt * 144 + (c8 >> 5) * 36 + (c8 & 31); const float sc = part == 0 ? 0.08838834764831845f : 1.f;
#pragma unroll
                for (int i = 0; i < 8; ++i) d[i] = v[i] * sc; } }
        if (c.tid < 64) { const int row = scan_row(dir, b, blk * 64 + c.tid); sg[c.tid * 2] = G32[(size_t)row * 32 + dir * 8 + h] + gbi; sg[c.tid * 2 + 1] = logsigmoidf_(G32[(size_t)row * 32 + dir * 8 + 4 + h] + gbf); }
        __syncthreads();
        for (int tt = 0; tt < 64; ++tt) {
            const float li = sg[2 * tt], lf = sg[2 * tt + 1]; const float mn = fmaxf(lf + m, li); const float fs = expf(lf + m - mn), is = expf(li - mn); m = mn;
            const float iv = is * sv[tt * 128 + e]; float hp = 0.f, dp = 0.f;
#pragma unroll
            for (int i4 = 0; i4 < 8; ++i4) { const f32x4 k4 = *(const LAS f32x4*)(sk + tt * 144 + dq * 36 + i4 * 4), q4 = *(const LAS f32x4*)(sq + tt * 144 + dq * 36 + i4 * 4);
#pragma unroll
                for (int j = 0; j < 4; ++j) { const int i = i4 * 4 + j; C[i] = fmaf(C[i], fs, iv * k4[j]); hp = fmaf(C[i], q4[j], hp); nn[i] = fmaf(nn[i], fs, is * k4[j]); dp = fmaf(nn[i], q4[j], dp); } }
            hp += __shfl_xor(hp, 1); hp += __shfl_xor(hp, 2); dp += __shfl_xor(dp, 1); dp += __shfl_xor(dp, 2);
            if (dq == 0) HM[(size_t)scan_row(dir, b, blk * 64 + tt) * 512 + h * 128 + e] = hp / fmaxf(fabsf(dp), expf(-m));
        }
    }
}
DI void scan_gdn(Ctx& c, int l, int chain) {
    float* SA = (float*)(c.ws + WS_S); const float* SG = (const float*)(c.ws + WS_SG); const size_t AS = (size_t)MROWS * 512;
    const int g = chain >> 2, h = chain & 3, dir = g >> 1, b = g & 1; const int e = c.tid >> 2, dq = c.tid & 3;
    LAS float* sq = (LAS float*)c.lds; LAS float* sk = sq + 64 * 144; LAS float* sv = sk + 64 * 144; LAS float* sg = sv + 64 * 128;
    float* HG = SA + (size_t)(SA_HG0 + dir) * AS;
    float S[32];
#pragma unroll
    for (int i = 0; i < 32; ++i) S[i] = 0.f;
    for (int blk = 0; blk < (TC + T) / 64; ++blk) {
        __syncthreads();
        for (int it = c.tid; it < 64 * 48; it += 512) { const int tt = it / 48, r = it % 48, part = r >> 4, c8 = (r & 15) * 8; const int row = scan_row(dir, b, blk * 64 + tt);
            float v[8]; ldf8(SA + (size_t)(SA_GQ + part) * AS + (size_t)row * 512 + h * 128 + c8, v);
            LAS float* d = part == 2 ? sv + tt * 128 + c8 : (part == 0 ? sq : sk) + tt * 144 + (c8 >> 5) * 36 + (c8 & 31);
#pragma unroll
            for (int i = 0; i < 8; ++i) d[i] = v[i]; }
        if (c.tid < 64) { const int row = scan_row(dir, b, blk * 64 + c.tid); sg[c.tid * 2] = expf(SG[(size_t)row * 16 + dir * 4 + h]); sg[c.tid * 2 + 1] = SG[(size_t)row * 16 + 8 + dir * 4 + h]; }
        __syncthreads();
        for (int tt = 0; tt < 64; ++tt) {
            const float a = sg[2 * tt], be = sg[2 * tt + 1]; float pp = 0.f; f32x4 k4[8];
#pragma unroll
            for (int i4 = 0; i4 < 8; ++i4) { k4[i4] = *(const LAS f32x4*)(sk + tt * 144 + dq * 36 + i4 * 4);
#pragma unroll
                for (int j = 0; j < 4; ++j) { const int i = i4 * 4 + j; S[i] *= a; pp = fmaf(k4[i4][j], S[i], pp); } }
            pp += __shfl_xor(pp, 1); pp += __shfl_xor(pp, 2);
            const float vn = be * (sv[tt * 128 + e] - pp); float o = 0.f;
#pragma unroll
            for (int i4 = 0; i4 < 8; ++i4) { const f32x4 q4 = *(const LAS f32x4*)(sq + tt * 144 + dq * 36 + i4 * 4);
#pragma unroll
                for (int j = 0; j < 4; ++j) { const int i = i4 * 4 + j; S[i] = fmaf(k4[i4][j], vn, S[i]); o = fmaf(q4[j], S[i], o); } }
            o += __shfl_xor(o, 1); o += __shfl_xor(o, 2);
            if (dq == 0) HG[(size_t)scan_row(dir, b, blk * 64 + tt) * 512 + h * 128 + e] = o;
        }
    }
}
DI void scan_rwkv(Ctx& c, int l, int chain) {
    float* SA = (float*)(c.ws + WS_S); const size_t AS = (size_t)MROWS * 512;
    const int g = chain >> 3, h = chain & 7, dir = g >> 1, b = g & 1; const int i = c.tid >> 3, part = c.tid & 7;
    LAS float* sr = (LAS float*)c.lds;
    float* HR = SA + (size_t)(SA_HR0 + dir) * AS;
    float S[8];
#pragma unroll
    for (int j = 0; j < 8; ++j) S[j] = 0.f;
    for (int blk = 0; blk < (TC + T) / 64; ++blk) {
        __syncthreads();
        for (int it = c.tid; it < 6 * 64 * 8; it += 512) { const int arr = it / 512, r = it % 512, tt = r >> 3, c8 = (r & 7) * 8; const int row = scan_row(dir, b, blk * 64 + tt);
            const int sa = arr == 0 ? SA_RR : arr == 1 ? SA_RW0 + dir : arr == 2 ? SA_RK0 + dir : arr == 3 ? SA_RV : arr == 4 ? SA_RA : SA_RB0 + dir;
            float v[8]; ldf8(SA + (size_t)sa * AS + (size_t)row * 512 + h * 64 + c8, v); LAS float* d = sr + arr * 4096 + tt * 64 + c8;
#pragma unroll
            for (int j = 0; j < 8; ++j) d[j] = v[j]; }
        __syncthreads();
        for (int tt = 0; tt < 64; ++tt) {
            const LAS float* bp = sr + tt * 64 + part * 8;
            float r8[8], w8[8], k8[8], a8[8], b8[8];
#pragma unroll
            for (int j = 0; j < 8; j += 4) { const f32x4 x0 = *(const LAS f32x4*)(bp + j), x1 = *(const LAS f32x4*)(bp + 4096 + j), x2 = *(const LAS f32x4*)(bp + 8192 + j), x4 = *(const LAS f32x4*)(bp + 16384 + j), x5 = *(const LAS f32x4*)(bp + 20480 + j);
#pragma unroll
                for (int q = 0; q < 4; ++q) { r8[j + q] = x0[q]; w8[j + q] = x1[q]; k8[j + q] = x2[q]; a8[j + q] = x4[q]; b8[j + q] = x5[q]; } }
            const float vi = sr[3 * 4096 + tt * 64 + i];
            float sa = 0.f;
#pragma unroll
            for (int j = 0; j < 8; ++j) sa = fmaf(S[j], a8[j], sa);
            sa += __shfl_xor(sa, 1); sa += __shfl_xor(sa, 2); sa += __shfl_xor(sa, 4);
            float y = 0.f;
#pragma unroll
            for (int j = 0; j < 8; ++j) { S[j] = fmaf(S[j], w8[j], fmaf(sa, b8[j], vi * k8[j])); y = fmaf(S[j], r8[j], y); }
            y += __shfl_xor(y, 1); y += __shfl_xor(y, 2); y += __shfl_xor(y, 4);
            if (part == 0) HR[(size_t)scan_row(dir, b, blk * 64 + tt) * 512 + h * 64 + i] = y;
        }
    }
}
DI void phase_scan(Ctx& c, int l) {
    mlstm_prefix(c);
    for (int u = c.bid; u < 48; u += c.G) {
        if (u < 16) scan_gdn(c, l, u); else scan_rwkv(c, l, u - 16);
    }
    __syncthreads();
}
DI void phase_finish(Ctx& c, int l) {
    const Params& p = *c.p; const bf16* Z = (const bf16*)(c.ws + WS_Z); bf16* Y = (bf16*)(c.ws + WS_Y); const float* SA = (const float*)(c.ws + WS_S); const size_t AS = (size_t)MROWS * 512;
    const int gw = c.bid * 8 + c.wave, NGW = c.G * 8; const int ch = c.lane * 8;
    for (int row = gw; row < MROWS; row += NGW) {
        const size_t ro = (size_t)row * 512 + ch;
        { float a[8], b[8], g[8], o[8], y[8]; ldf8(SA + SA_HG0 * AS + ro, a); ldf8(SA + SA_HG1 * AS + ro, b); float ss = 0.f;
#pragma unroll
          for (int i = 0; i < 8; ++i) { a[i] += b[i]; ss += a[i] * a[i]; }
          const float rs = rsqrtf(grp_sum<16>(ss) * (1.f / 128.f) + 1e-6f); ldf8(p.gd_norm_g + l * 512 + ch, g); ld8(Z + (size_t)row * NZ + GDZ + ch, o);
#pragma unroll
          for (int i = 0; i < 8; ++i) y[i] = a[i] * rs * g[i] * siluf_(o[i]);
          st8(Y + (size_t)row * D + 1024 + ch, y); }
        { float a[8], b[8], g[8], bb[8], ax[8], gg[8], y[8]; ldf8(SA + SA_HR0 * AS + ro, a); ldf8(SA + SA_HR1 * AS + ro, b); float s = 0.f;
#pragma unroll
          for (int i = 0; i < 8; ++i) { a[i] += b[i]; s += a[i]; }
          const float mean = grp_sum<8>(s) * (1.f / 64.f); float q = 0.f;
#pragma unroll
          for (int i = 0; i < 8; ++i) { a[i] -= mean; q += a[i] * a[i]; }
          const float rs = rsqrtf(grp_sum<8>(q) * (1.f / 64.f) + 64e-5f);
          ldf8(p.rw_ln_g + l * 512 + ch, g); ldf8(p.rw_ln_b + l * 512 + ch, bb); ldf8(SA + SA_RAUX * AS + ro, ax); ldf8(SA + SA_RG * AS + ro, gg);
#pragma unroll
          for (int i = 0; i < 8; ++i) y[i] = (a[i] * rs * g[i] + bb[i] + ax[i]) * gg[i];
          st8(Y + (size_t)row * D + 1536 + ch, y); }
    }
    for (int u = c.bid; u < NB * 4 * 68; u += c.G) mlstm_out(c, l, u);
    __syncthreads();
}
DI void phase_ffnconv(Ctx& c, int l) {
    const Params& p = *c.p; const bf16* UP = (const bf16*)(c.ws + WS_Z); bf16* H = (bf16*)(c.ws + WS_S); const float* w = p.ffn_dw + (size_t)l * 9 * DFF;
    constexpr int CPR = DFF / 8;
    for (int it = c.bid * 512 + c.tid; it < MROWS * CPR; it += c.G * 512) {
        const int row = it / CPR, ch = (it % CPR) * 8; float acc[8];
#pragma unroll
        for (int i = 0; i < 8; ++i) acc[i] = 0.f;
        if (row < LAT) { const int bb = row >> 12, t = row & 4095, gy = t >> 6, gx = t & 63;
#pragma unroll
            for (int dy = 0; dy < 3; ++dy)
#pragma unroll
                for (int dx = 0; dx < 3; ++dx) { const int yy = gy + dy - 1, xx = gx + dx - 1; if (yy < 0 || yy >= 64 || xx < 0 || xx >= 64) continue;
                    float a[8], wv[8]; ld8(UP + (size_t)(bb * T + yy * 64 + xx) * (2 * DFF) + ch, a); ldf8(w + (dy * 3 + dx) * DFF + ch, wv);
#pragma unroll
                    for (int i = 0; i < 8; ++i) acc[i] = fmaf(a[i], wv[i], acc[i]); } }
        else { const int r = row - LAT, t = r & (TC - 1);
#pragma unroll
            for (int dx = 0; dx < 3; ++dx) { const int tt = t + dx - 1; if (tt < 0 || tt >= TC) continue;
                float a[8], wv[8]; ld8(UP + (size_t)(row + dx - 1) * (2 * DFF) + ch, a); ldf8(w + (3 + dx) * DFF + ch, wv);
#pragma unroll
                for (int i = 0; i < 8; ++i) acc[i] = fmaf(a[i], wv[i], acc[i]); } }
        float v[8], o[8]; ld8(UP + (size_t)row * (2 * DFF) + DFF + ch, v);
#pragma unroll
        for (int i = 0; i < 8; ++i) o[i] = gelu_tanh(acc[i]) * v[i];
        st8(H + (size_t)row * DFF + ch, o);
    }
}

constexpr int PH_PRO = 3, PH_PER_LAYER = 11, NPHASE = PH_PRO + NL * PH_PER_LAYER;
#ifndef MK_PER_PHASE
#define MK_PER_PHASE 0
#endif
constexpr int CW_BAR = 4096;

__global__ void __launch_bounds__(512, 2) fwd_kernel(Params p) {
    extern __shared__ __attribute__((aligned(16))) unsigned char lds_raw[];
    Ctx c; c.lds = (LAS unsigned char*)lds_raw; c.tid = threadIdx.x; c.lane = c.tid & 63; c.wave = __builtin_amdgcn_readfirstlane(c.tid >> 6); c.G = gridDim.x; c.bid = blockIdx.x; c.p = &p; c.ws = p.ws;
    volatile LAS unsigned* MISC = (volatile LAS unsigned*)(c.lds + LDS_MISC);
    if (c.tid < 32) MISC[c.tid] = 0u;
    __syncthreads();
    const int lo = p.ph_lo, hi = p.ph_hi;
    XcdBarrier bar; bar.bar = (unsigned*)(p.ws + WS_CTL) + CW_BAR; bar.x = 0; bar.st = MISC + 8;
    if (hi - lo > 1) bar = xcd_barrier_post((unsigned*)(p.ws + WS_CTL) + CW_BAR, MISC + 8);
#ifndef PH_MASK
#define PH_MASK 0xFFFFFFFFu
#endif
#define IN(k) (lo <= (k) && (k) < hi)
#define EN(b) ((PH_MASK >> (b)) & 1u)
#define RF() do { int t_ = threadIdx.x; asm volatile("" : "+v"(t_)); c.tid = t_; c.lane = t_ & 63; } while (0)
#define SEAM(k) do { if (IN((k) + 1)) xcd_barrier(bar); } while (0)
    if (EN(0) && IN(0)) { RF(); phase_pro0(c); SEAM(0); }
    if (EN(1) && IN(1)) { RF(); phase_pro1(c); SEAM(1); }
    if (EN(2) && IN(2)) { RF(); phase_pro2(c); SEAM(2); }
    bf16* U = (bf16*)(p.ws + WS_U); bf16* Y = (bf16*)(p.ws + WS_Y); bf16* MB = (bf16*)(p.ws + WS_MB); float* G32 = (float*)(p.ws + WS_G32); float* F = (float*)(p.ws + WS_F);
    bf16* Z = (bf16*)(p.ws + WS_Z); bf16* H = (bf16*)(p.ws + WS_S);
    for (int l = 0; l < NL; ++l) {
        const int pb = PH_PRO + l * PH_PER_LAYER; unsigned char* wl = p.ws + WS_W + (size_t)l * WL_SIZE;
        if (EN(3) && IN(pb + 0)) { pg8::Gemm g{U, (const bf16*)(wl + WL_IN), D, D, D}; pg8::StdOrder S; S.init(MROWS / 256, NZ / 256, c.G, c.bid); pg8::EpiBf16 E{Z, NZ, G32, (ZSM - 192) / 256};
            pg8::gemm_phase(c.lds, g, S, E); SEAM(pb + 0); }
        if (EN(4) && IN(pb + 1)) { RF(); phase_prep(c, l); SEAM(pb + 1); }
        if (EN(5) && IN(pb + 2)) { RF(); phase_scan(c, l); SEAM(pb + 2); }
        if (EN(6) && IN(pb + 3)) { RF(); phase_finish(c, l); SEAM(pb + 3); }
        if (EN(7) && IN(pb + 4)) { pg8::Gemm g{Y, (const bf16*)(wl + WL_BR), D, MIXW, MIXW}; pg8::MergeOrder S; S.init(MROWS / 256, D / 256, c.G, c.bid); pg8::EpiMerge E{Z, NZ, ZG, F, MB, D};
            pg8::gemm_phase(c.lds, g, S, E); SEAM(pb + 4); }
        if (EN(8) && IN(pb + 5)) { pg8::Gemm g{MB, (const bf16*)(wl + WL_OUT), D, D, D}; pg8::StdOrder S; S.init(MROWS / 256, D / 256, c.G, c.bid); pg8::EpiF32 E{F, D};
            pg8::gemm_phase(c.lds, g, S, E); SEAM(pb + 5); }
        if (EN(9) && IN(pb + 6)) { RF(); phase_resid(c, l, 0); SEAM(pb + 6); }
        if (EN(10) && IN(pb + 7)) { pg8::Gemm g{U, (const bf16*)(wl + WL_UP), D, D, D}; pg8::StdOrder S; S.init(MROWS / 256, 2 * DFF / 256, c.G, c.bid); pg8::EpiBf16 E{Z, 2 * DFF, nullptr, -1};
            pg8::gemm_phase(c.lds, g, S, E); SEAM(pb + 7); }
        if (EN(11) && IN(pb + 8)) { RF(); phase_ffnconv(c, l); SEAM(pb + 8); }
        if (EN(12) && IN(pb + 9)) { pg8::Gemm g{H, (const bf16*)(wl + WL_DN), DFF, DFF, DFF}; pg8::StdOrder S; S.init(MROWS / 256, D / 256, c.G, c.bid); pg8::EpiF32 E{F, D};
            pg8::gemm_phase(c.lds, g, S, E); SEAM(pb + 9); }
        if (EN(13) && IN(pb + 10)) { RF(); phase_resid(c, l, 1); SEAM(pb + 10); }
    }
#undef IN
#undef SEAM
}

extern "C" void kernel_launch(void* const* d_in, const int* in_sizes, int n_in, void* d_out, int out_size, void* d_ws, size_t ws_size, hipStream_t stream) {
    static int grid = 0;
    if (grid == 0) {
        if (n_in != 34 || ws_size < WS_END) { fprintf(stderr, "kernel_launch: unexpected n_in %d / ws %zu (need %zu)\n", n_in, ws_size, (size_t)WS_END); grid = -1; return; }
        int dev = 0, cus = 0;
        if (hipGetDevice(&dev) != hipSuccess || hipDeviceGetAttribute(&cus, hipDeviceAttributeMultiprocessorCount, dev) != hipSuccess) { grid = -1; return; }
        if (hipFuncSetAttribute((const void*)fwd_kernel, hipFuncAttributeMaxDynamicSharedMemorySize, LDS_BYTES) != hipSuccess) { fprintf(stderr, "kernel_launch: hipFuncSetAttribute failed\n"); grid = -1; return; }
        int per_cu = 0;
        if (hipOccupancyMaxActiveBlocksPerMultiprocessor(&per_cu, (const void*)fwd_kernel, 512, LDS_BYTES) != hipSuccess || per_cu < 1) { fprintf(stderr, "kernel_launch: occupancy query says %d\n", per_cu); }
        (void)hipGetLastError();
        grid = cus;
    }
    if (grid < 0) return;
    (void)hipMemsetAsync((char*)d_ws + WS_CTL, 0, CTL_BYTES, stream);
    Params p{};
    const float** pp = (const float**)&p;
    for (int i = 0; i < 34; ++i) pp[i] = (const float*)d_in[i];
    p.out = (float*)d_out; p.ws = (unsigned char*)d_ws;
#if MK_PER_PHASE
    for (int k = 0; k < NPHASE; ++k) { p.ph_lo = k; p.ph_hi = k + 1; hipLaunchKernelGGL(fwd_kernel, dim3(grid), dim3(512), LDS_BYTES, stream, p); }
#else
    p.ph_lo = 0; p.ph_hi = NPHASE; hipLaunchKernelGGL(fwd_kernel, dim3(grid), dim3(512), LDS_BYTES, stream, p);
#endif
}
```

```cpp
#include <hip/hip_runtime.h>
#include <cstdio>
#include <cstdint>

#define GAS __attribute__((address_space(1)))
#define LAS __attribute__((address_space(3)))
#define DI __device__ __forceinline__
typedef unsigned short bf16;
typedef float f32x4 __attribute__((ext_vector_type(4)));
typedef float f32x2 __attribute__((ext_vector_type(2)));
typedef unsigned u32x4 __attribute__((ext_vector_type(4)));
typedef unsigned u32x2 __attribute__((ext_vector_type(2)));
typedef short bf16x8 __attribute__((ext_vector_type(8)));

constexpr int D = 2048, NB = 2, T = 4096, TC = 256, NL = 4;
constexpr int LAT = NB * T;
constexpr int MROWS = LAT + NB * TC;
constexpr int MIXW = 512, DFF = 5632;
constexpr int NIN = 15328, NZ = 15360;
constexpr int ZA = 0, ZAG = 512, MLQ = 1024, MLK = 1536, MLV = 2048, MLO = 2560, GDQ = 3072, GDK = 3584, GDV = 4096, GDZ = 4608;
constexpr int RWR = 5120, RWK = 5632, RWV = 6144, RWXW = 6656, RWXA = 6752, RWXG = 6848, ZG = 7104, ZSM = 15296;
constexpr int RWMIX = 1984;

namespace pg8 {
typedef unsigned short bf16_t;
constexpr int BM = 256, BK = 64, HALF = 128, HTB = HALF * BK * 2, STAGE_BYTES = 8 * HTB, NXCD = 8, WGM = 8;
__host__ __device__ __forceinline__ int lds_byte(int r, int c) { const int st = (r >> 4) * 2 + (c >> 5), rr = r & 15, cc = c & 31, ob = rr * 64 + cc * 2; return st * 1024 + (ob ^ (((ob >> 9) & 1) << 5)); }
__host__ __device__ __forceinline__ void stage_rc(int b, int& R, int& C) { const int st = b / 1024, sb = b % 1024, swz = sb ^ (((sb >> 9) & 1) << 5); R = (st >> 1) * 16 + swz / 64; C = (st & 1) * 32 + (swz % 64) / 2; }
__host__ __device__ __forceinline__ int perm32(int rho) { const int n = rho >> 4, i = rho & 15; return 8 * (i >> 2) + 4 * n + (i & 3); }

struct Unit { int pm, pn, sub; };
struct Gemm { const bf16_t* A; const bf16_t* Bt; int lda, ldb, K; };

struct StdOrder {
    int nM, nN, nwg, G, c;
    DI void init(int nM_, int nN_, int G_, int c_) { nM = nM_; nN = nN_; nwg = nM * nN; G = G_; c = c_; }
    DI bool map(int i, Unit& u) const {
        const long L = (long)i * G + c; if (L >= nwg) return false;
        int wgid = (int)L; { const int q = nwg / NXCD, r = nwg % NXCD, xcd = wgid % NXCD, off = wgid / NXCD; wgid = (xcd < r ? xcd * (q + 1) : r * (q + 1) + (xcd - r) * q) + off; }
        const int nig = WGM * nN, gid = wgid / nig, fm = gid * WGM, gsz = (nM - fm) < WGM ? (nM - fm) : WGM;
        u.pm = fm + ((wgid % nig) % gsz); u.pn = (wgid % nig) / gsz; return true;
    }
    DI bool next(int i, Unit& u) const { u.sub = 0; return map(i, u); }
    DI const char* a_ptr(const Gemm& g, const Unit& u) const { return (const char*)g.A + (size_t)u.pm * BM * g.lda * 2; }
    DI const char* b_ptr(const Gemm& g, const Unit& u) const { return (const char*)g.Bt + (size_t)u.pn * BM * g.ldb * 2; }
};
struct MergeOrder : StdOrder {
    DI bool next(int i4, Unit& u) const { u.sub = i4 & 3; return map(i4 >> 2, u); }
    DI const char* a_ptr(const Gemm& g, const Unit& u) const { return (const char*)g.A + (size_t)u.pm * BM * g.lda * 2 + (size_t)u.sub * 512 * 2; }
    DI const char* b_ptr(const Gemm& g, const Unit& u) const { return (const char*)g.Bt + ((size_t)u.sub * 2048 + (size_t)u.pn * BM) * g.ldb * 2; }
};

DI unsigned cvt_pk_bf16(float lo, float hi) { unsigned r; asm volatile("v_cvt_pk_bf16_f32 %0, %1, %2" : "=v"(r) : "v"(lo), "v"(hi)); return r; }

struct EpiF32 {
    static constexpr bool PERM = false;
    float* C; int ldc;
    DI void operator()(const f32x4 (&acc)[2][2][4][2], const Unit& u, int wr, int wc, int fr, int fq) const {
        const int row0 = u.pm * BM + wr * 64 + fr, col0 = u.pn * BM + wc * 32 + 4 * fq;
#pragma unroll
        for (int ai = 0; ai < 2; ++ai)
#pragma unroll
            for (int m = 0; m < 4; ++m) { float* rowp = C + (size_t)(row0 + ai * HALF + m * 16) * ldc + col0;
#pragma unroll
                for (int bj = 0; bj < 2; ++bj)
#pragma unroll
                    for (int n = 0; n < 2; ++n) *(f32x4*)(rowp + bj * HALF + n * 16) = acc[ai][bj][m][n]; }
    }
};
struct EpiBf16 {
    static constexpr bool PERM = true;
    bf16_t* O; int ldc; float* G32; int gtile;
    DI void operator()(const f32x4 (&acc)[2][2][4][2], const Unit& u, int wr, int wc, int fr, int fq) const {
        const int row0 = u.pm * BM + wr * 64 + fr; const int col0 = u.pn * BM + wc * 32 + 8 * fq;
#pragma unroll
        for (int ai = 0; ai < 2; ++ai)
#pragma unroll
            for (int m = 0; m < 4; ++m) { const int row = row0 + ai * HALF + m * 16; bf16_t* rowp = O + (size_t)row * ldc + col0;
#pragma unroll
                for (int bj = 0; bj < 2; ++bj) { const f32x4 v0 = acc[ai][bj][m][0], v1 = acc[ai][bj][m][1];
                    u32x4 w; w.x = cvt_pk_bf16(v0[0], v0[1]); w.y = cvt_pk_bf16(v0[2], v0[3]); w.z = cvt_pk_bf16(v1[0], v1[1]); w.w = cvt_pk_bf16(v1[2], v1[3]);
                    *(u32x4*)(rowp + bj * HALF) = w;
                    if (bj == 1 && G32 != nullptr && u.pn == gtile && wc == 2) { float* gp = G32 + (size_t)row * 32 + 8 * fq; *(f32x4*)gp = v0; *(f32x4*)(gp + 4) = v1; } } }
    }
};
struct EpiMerge {
    static constexpr bool PERM = true;
    const bf16_t* Z; int ldz; int zg; float* P; bf16_t* Mb; int ldc;
    DI void operator()(const f32x4 (&acc)[2][2][4][2], const Unit& u, int wr, int wc, int fr, int fq) const {
        const int row0 = u.pm * BM + wr * 64 + fr; const int col0 = u.pn * BM + wc * 32 + 8 * fq;
#pragma unroll
        for (int ai = 0; ai < 2; ++ai)
#pragma unroll
            for (int m = 0; m < 4; ++m) { const int row = row0 + ai * HALF + m * 16;
#pragma unroll
                for (int bj = 0; bj < 2; ++bj) { const int col = col0 + bj * HALF;
                    const u32x4 gw = *(const u32x4*)(Z + (size_t)row * ldz + zg + u.sub * 2048 + col);
                    float gt[8];
#pragma unroll
                    for (int j = 0; j < 4; ++j) { gt[2 * j] = __uint_as_float(gw[j] << 16); gt[2 * j + 1] = __uint_as_float(gw[j] & 0xffff0000u); }
                    f32x4 v0 = acc[ai][bj][m][0], v1 = acc[ai][bj][m][1];
#pragma unroll
                    for (int j = 0; j < 4; ++j) { v0[j] *= 1.f / (1.f + __expf(-gt[j])); v1[j] *= 1.f / (1.f + __expf(-gt[4 + j])); }
                    float* pp = P + (size_t)row * ldc + col;
                    if (u.sub > 0) { v0 += *(const f32x4*)pp; v1 += *(const f32x4*)(pp + 4); }
                    if (u.sub < 3) { *(f32x4*)pp = v0; *(f32x4*)(pp + 4) = v1; }
                    else { u32x4 w; w.x = cvt_pk_bf16(v0[0], v0[1]); w.y = cvt_pk_bf16(v0[2], v0[3]); w.z = cvt_pk_bf16(v1[0], v1[1]); w.w = cvt_pk_bf16(v1[2], v1[3]);
                        *(u32x4*)(Mb + (size_t)row * ldc + col) = w; } } }
    }
};

template <class Epi, class Sched>
DI void gemm_phase(LAS unsigned char* lds, const Gemm g, const Sched& S, const Epi& E) {
    int tid_ = threadIdx.x; asm volatile("" : "+v"(tid_));
    const int tid = tid_, wid = __builtin_amdgcn_readfirstlane(tid >> 6), lane = tid & 63, wr = wid >> 2, wc = wid & 3, fr = lane & 15, fq = lane >> 4;
    const int K = g.K, nt = K / BK;
    unsigned voffA[2], voffB[2];
#pragma unroll
    for (int i = 0; i < 2; ++i) { int R, C; stage_rc(tid * 16 + i * 8192, R, C); const int Rb = Epi::PERM ? ((R & ~31) + perm32(R & 31)) : R;
        voffA[i] = (unsigned)(R * g.lda + C) * 2u; voffB[i] = (unsigned)(Rb * g.ldb + C) * 2u; }
    const size_t kstep = (size_t)(BK * 2);
    const size_t hstepA = (size_t)HALF * g.lda * 2, hstepB = (size_t)HALF * g.ldb * 2;
    const unsigned ldsw = (unsigned)wid * 1024u;
    const int aoff = lds_byte(wr * 64 + fr, fq * 8), boff = lds_byte(wc * 32 + fr, fq * 8);
#define PG8_SA(b, h) (((b) * 2 + (h)) * HTB)
#define PG8_SB(b, h) ((4 + (b) * 2 + (h)) * HTB)
#define PG8_STAGE(bufoff, gbase, voff) do { _Pragma("unroll") for (int _i = 0; _i < 2; ++_i) \
        __builtin_amdgcn_global_load_lds((const unsigned*)((const char*)(gbase) + (voff)[_i]), (LAS unsigned*)(lds + (bufoff) + ldsw + _i * 8192), 16, 0, 0); } while (0)
#define PG8_LDA(dst, b, h) do { _Pragma("unroll") for (int m = 0; m < 4; ++m) _Pragma("unroll") for (int k = 0; k < 2; ++k) dst[m][k] = *(const LAS bf16x8*)(lds + PG8_SA(b, h) + aoff + m * 2048 + k * 1024); } while (0)
#define PG8_LDB(dst, b, h) do { _Pragma("unroll") for (int n = 0; n < 2; ++n) _Pragma("unroll") for (int k = 0; k < 2; ++k) dst[n][k] = *(const LAS bf16x8*)(lds + PG8_SB(b, h) + boff + n * 2048 + k * 1024); } while (0)
#define PG8_MMA(ai, bj, At, Bt) do { __builtin_amdgcn_s_setprio(1); _Pragma("unroll") for (int m = 0; m < 4; ++m) _Pragma("unroll") for (int n = 0; n < 2; ++n) _Pragma("unroll") for (int k = 0; k < 2; ++k) \
        acc[ai][bj][m][n] = __builtin_amdgcn_mfma_f32_16x16x32_bf16(Bt[n][k], At[m][k], acc[ai][bj][m][n], 0, 0, 0); __builtin_amdgcn_s_setprio(0); } while (0)
#define PG8_WAIT_V(n) asm volatile("s_waitcnt vmcnt(" #n ")" ::: "memory")
#define PG8_WAIT_L(n) asm volatile("s_waitcnt lgkmcnt(" #n ")" ::: "memory")
#define PG8_BAR __builtin_amdgcn_s_barrier()
#define PG8_SCHED __builtin_amdgcn_sched_barrier(0)
    Unit cur, nxt; int ui = 0;
    if (!S.next(0, cur)) return;
    f32x4 acc[2][2][4][2];
#pragma unroll
    for (int a = 0; a < 2; ++a)
#pragma unroll
        for (int b = 0; b < 2; ++b)
#pragma unroll
            for (int m = 0; m < 4; ++m)
#pragma unroll
                for (int n = 0; n < 2; ++n) acc[a][b][m][n] = (f32x4){0.f, 0.f, 0.f, 0.f};
    bf16x8 At[4][2], B0[2][2], B1[2][2];
    const char* cA = S.a_ptr(g, cur); const char* cB = S.b_ptr(g, cur);
    PG8_STAGE(PG8_SB(0, 0), cB, voffB); PG8_STAGE(PG8_SB(0, 1), cB + hstepB, voffB); PG8_STAGE(PG8_SA(0, 0), cA, voffA); PG8_STAGE(PG8_SA(0, 1), cA + hstepA, voffA);
    if (wr == 1) PG8_BAR;
    PG8_WAIT_V(2); PG8_BAR;
    PG8_STAGE(PG8_SB(1, 0), cB + kstep, voffB); PG8_STAGE(PG8_SA(1, 0), cA + kstep, voffA); PG8_STAGE(PG8_SB(1, 1), cB + hstepB + kstep, voffB);
    PG8_WAIT_V(6); PG8_BAR;
    for (;;) {
        const bool has_next = S.next(ui + 1, nxt);
        const char* nA = has_next ? S.a_ptr(g, nxt) : cA; const char* nB = has_next ? S.b_ptr(g, nxt) : cB;
        for (int t = 0; t < nt; t += 2) {
            const bool last = (t == nt - 2);
            const char* a1 = cA + (size_t)(t + 1) * kstep;
            const char* a2 = last ? nA : cA + (size_t)(t + 2) * kstep; const char* b2 = last ? nB : cB + (size_t)(t + 2) * kstep;
            const char* a3 = a2 + kstep; const char* b3 = b2 + kstep;
            PG8_LDB(B0, 0, 0); PG8_LDB(B1, 0, 1); PG8_SCHED; PG8_LDA(At, 0, 0); PG8_STAGE(PG8_SA(1, 1), a1 + hstepA, voffA);
            PG8_WAIT_V(8); PG8_WAIT_L(0); PG8_BAR; PG8_MMA(0, 0, At, B0); PG8_MMA(0, 1, At, B1); PG8_BAR; PG8_SCHED;
            PG8_LDA(At, 0, 1); PG8_STAGE(PG8_SB(0, 0), b2, voffB); PG8_STAGE(PG8_SB(0, 1), b2 + hstepB, voffB); PG8_STAGE(PG8_SA(0, 0), a2, voffA);
            PG8_WAIT_V(8); PG8_WAIT_L(0); PG8_BAR; PG8_MMA(1, 0, At, B0); PG8_MMA(1, 1, At, B1); PG8_BAR; PG8_SCHED;
            PG8_LDB(B0, 1, 0); PG8_LDB(B1, 1, 1); PG8_SCHED; PG8_LDA(At, 1, 0); PG8_STAGE(PG8_SA(0, 1), a2 + hstepA, voffA);
            PG8_WAIT_V(8); PG8_WAIT_L(0); PG8_BAR; PG8_MMA(0, 0, At, B0); PG8_MMA(0, 1, At, B1); PG8_BAR; PG8_SCHED;
            PG8_LDA(At, 1, 1); PG8_STAGE(PG8_SB(1, 0), b3, voffB); PG8_STAGE(PG8_SB(1, 1), b3 + hstepB, voffB); PG8_STAGE(PG8_SA(1, 0), a3, voffA);
            PG8_WAIT_V(8); PG8_WAIT_L(0); PG8_BAR; PG8_MMA(1, 0, At, B0); PG8_MMA(1, 1, At, B1); PG8_BAR; PG8_SCHED;
        }
        if (wr == 0) PG8_BAR;
        E(acc, cur, wr, wc, fr, fq);
        if (!has_next) break;
#pragma unroll
        for (int a = 0; a < 2; ++a)
#pragma unroll
            for (int b = 0; b < 2; ++b)
#pragma unroll
                for (int m = 0; m < 4; ++m)
#pragma unroll
                    for (int n = 0; n < 2; ++n) acc[a][b][m][n] = (f32x4){0.f, 0.f, 0.f, 0.f};
        cur = nxt; cA = nA; cB = nB; ++ui;
        if (wr == 1) PG8_BAR;
    }
    PG8_WAIT_V(0);
    PG8_BAR;
#undef PG8_SA
#undef PG8_SB
#undef PG8_STAGE
#undef PG8_LDA
#undef PG8_LDB
#undef PG8_MMA
#undef PG8_WAIT_V
#undef PG8_WAIT_L
#undef PG8_BAR
#undef PG8_SCHED
}
}

constexpr size_t al256(size_t x) { return (x + 255) & ~(size_t)255; }
constexpr size_t WS_CTL = 0, CTL_BYTES = 1u << 20;
constexpr size_t WS_MODP = WS_CTL + CTL_BYTES;
constexpr size_t WS_MOD = WS_MODP + al256((size_t)NL * 8 * 3 * 12288 * 4);
constexpr size_t WS_W = WS_MOD + al256((size_t)NL * 3 * 12288 * 4);
constexpr size_t WL_IN = 0, WL_BR = WL_IN + (size_t)NZ * D * 2, WL_OUT = WL_BR + (size_t)4 * D * MIXW * 2, WL_UP = WL_OUT + (size_t)D * D * 2,
                 WL_DN = WL_UP + (size_t)2 * DFF * D * 2, WL_SIZE = WL_DN + (size_t)D * DFF * 2;
constexpr size_t WS_U = WS_W + WL_SIZE;
constexpr size_t WS_Y = WS_U + (size_t)MROWS * D * 2;
constexpr size_t WS_MB = WS_Y + (size_t)MROWS * D * 2;
constexpr size_t WS_G32 = WS_MB + (size_t)MROWS * D * 2;
constexpr size_t WS_X = WS_G32 + (size_t)MROWS * 32 * 4;
constexpr size_t WS_F = WS_X + (size_t)MROWS * D * 4;
constexpr size_t WS_Z = WS_F + (size_t)MROWS * D * 4;
constexpr size_t WS_S = WS_Z + (size_t)MROWS * NZ * 2;
constexpr size_t SARR = (size_t)MROWS * MIXW * 4;
constexpr int N_SARR = 20;
constexpr size_t WS_SG = WS_S + N_SARR * SARR;
constexpr size_t WS_ML = WS_SG + (size_t)MROWS * 16 * 4;
constexpr int ML_US = 16640, ML_NL = 16384, ML_HDR = 16512, ML_NU = 16 * 68;
constexpr size_t WS_MLC = WS_ML + (size_t)ML_NU * ML_US * 4;
constexpr int MLC_US = 144 * 128;
constexpr size_t WS_MLM = WS_MLC + (size_t)ML_NU * MLC_US * 2;
constexpr size_t WS_GDA = WS_MLM + al256((size_t)ML_NU * 4);
constexpr int GD_NU = 16 * 68;
constexpr size_t WS_GDB = WS_GDA + (size_t)GD_NU * 16384 * 2;
constexpr size_t WS_GDU = WS_GDB + (size_t)GD_NU * 16384 * 4;
constexpr size_t WS_GDW = WS_GDU + (size_t)GD_NU * 8192 * 4;
constexpr size_t WS_GDAT = WS_GDW + (size_t)GD_NU * 8192 * 2;
constexpr size_t WS_GDQ = WS_GDAT + (size_t)GD_NU * 4096 * 2;
constexpr size_t WS_GDS = WS_GDQ + (size_t)GD_NU * 8192 * 2;
constexpr size_t WS_END = WS_GDS + (size_t)GD_NU * 16384 * 2;
static_assert((size_t)MROWS * DFF * 2 <= N_SARR * SARR && (size_t)MROWS * 2 * DFF * 2 <= (size_t)MROWS * NZ * 2, "aliases");
static_assert(WS_END < 1590000000ull, "workspace budget");
enum { SA_GQ = 0, SA_GK, SA_GV, SA_RR, SA_RV, SA_RA, SA_RW0, SA_RW1, SA_RK0, SA_RK1, SA_RB0, SA_RB1, SA_RAUX, SA_RG, SA_HM0, SA_HM1, SA_HG0, SA_HG1, SA_HR0, SA_HR1 };

constexpr int LDS_RING = 131072, LDS_BYTES = 147456, LDS_MISC = LDS_BYTES - 128;

#define XB_TMO      128
#define XB_XCNT(j)  (256  + 64 * (j))
#define XB_XSUB(j)  (1280 + 64 * (j))
#define XB_XGEN(j)  (2304 + 64 * (j))
#define XB_TOP      3328
#define XB_TOPGEN   3392
#define XCD_BAR_WORDS 3456
#define XB_SPIN_CAP (1u << 18)
__device__ __forceinline__ unsigned xb_ld(unsigned* p)              { return __hip_atomic_load(p, __ATOMIC_RELAXED, __HIP_MEMORY_SCOPE_AGENT); }
__device__ __forceinline__ unsigned xb_add(unsigned* p, unsigned v) { return __hip_atomic_fetch_add(p, v, __ATOMIC_RELAXED, __HIP_MEMORY_SCOPE_AGENT); }
__device__ __forceinline__ unsigned xb_xcc_id() { return (unsigned)__builtin_amdgcn_s_getreg((3 << 11) | 20) & 0xFu; }
#define XB_SPIN(cond, bar) do { unsigned _sp = 0; while (cond) { __builtin_amdgcn_s_sleep(1); \
    if ((++_sp & 255u) == 0u) { if (xb_ld(&(bar)[XB_TMO])) break; if (_sp > XB_SPIN_CAP) { atomicAdd(&(bar)[XB_TMO], 1u); break; } } } } while (0)
struct XcdBarrier { unsigned* bar; unsigned x; volatile LAS unsigned* st; };
__device__ __forceinline__ XcdBarrier xcd_barrier_post(unsigned* bar, volatile LAS unsigned* st) {
    XcdBarrier b; b.bar = bar; b.x = xb_xcc_id(); b.st = st;
    if (threadIdx.x == 0) (void)xb_add(&bar[XB_XCNT(b.x)], 1u);
    return b;
}
__device__ __forceinline__ void xcd_barrier_complete(unsigned* bar, unsigned x, unsigned& nloc, unsigned& nx) {
    const unsigned G = gridDim.x * gridDim.y * gridDim.z;
    unsigned sum, cnt, mine, sp = 0u;
    for (;;) {
        sum = 0u; cnt = 0u; mine = 0u;
#pragma unroll
        for (unsigned j = 0; j < 16; ++j) { const unsigned c = xb_ld(&bar[XB_XCNT(j)]); sum += c; cnt += (c > 0u) ? 1u : 0u; mine = (j == x) ? c : mine; }
        if (sum == G) break;
        __builtin_amdgcn_s_sleep(1);
        if ((++sp & 255u) == 0u) { if (xb_ld(&bar[XB_TMO])) break; if (sp > XB_SPIN_CAP) { atomicAdd(&bar[XB_TMO], 1u); break; } }
    }
    nloc = mine > 0u ? mine : 1u; nx = cnt > 0u ? cnt : 1u;
}
__device__ __forceinline__ void xcd_barrier(const XcdBarrier& b) {
    asm volatile("s_waitcnt vmcnt(0)" ::: "memory");
    __syncthreads();
    if (threadIdx.x == 0) {
        unsigned* bar = b.bar;
        __builtin_amdgcn_s_waitcnt(0);
        unsigned nloc = b.st[0], nx = b.st[1];
        if (nloc == 0u) { xcd_barrier_complete(bar, b.x, nloc, nx); b.st[0] = nloc; b.st[1] = nx; }
        const unsigned old = xb_add(&bar[XB_XSUB(b.x)], 1u);
        const unsigned gen = old / nloc;
        if (old + 1u == (gen + 1u) * nloc) {
            __builtin_amdgcn_fence(__ATOMIC_RELEASE, "agent");
            asm volatile("s_waitcnt vmcnt(0)" ::: "memory");
            const unsigned og = xb_add(&bar[XB_TOP], 1u);
            const unsigned tg = og / nx;
            if (og + 1u == (tg + 1u) * nx) xb_add(&bar[XB_TOPGEN], 1u);
            else XB_SPIN(xb_ld(&bar[XB_TOPGEN]) == tg, bar);
            __builtin_amdgcn_fence(__ATOMIC_ACQUIRE, "agent");
            xb_add(&bar[XB_XGEN(b.x)], 1u);
            asm volatile("s_waitcnt vmcnt(0)" ::: "memory");
        } else {
            XB_SPIN(xb_ld(&bar[XB_XGEN(b.x)]) == gen, bar);
            __builtin_amdgcn_fence(__ATOMIC_ACQUIRE, "agent");
            asm volatile("s_waitcnt vmcnt(0)" ::: "memory");
        }
    }
    __syncthreads();
}

struct Params {
    const float *x, *c, *ctx, *c_ctx, *w_mod, *b_mod, *norm_g, *w_in, *conv_dw, *conv_b, *conv_ln_g, *conv_ln_b, *ml_gate_b, *ml_norm_g,
        *gd_conv, *gd_a_log, *gd_dt_bias, *gd_norm_g, *rw_mu, *rw_w0, *rw_w2, *rw_a0, *rw_a2, *rw_g2, *rw_kk, *rw_ka, *rw_rk, *rw_ln_g, *rw_ln_b,
        *w_br, *w_out, *ffn_up, *ffn_dw, *ffn_down;
    float* out; unsigned char* ws; int ph_lo, ph_hi;
};

DI float bf2f(unsigned short u) { return __uint_as_float(((unsigned)u) << 16); }
DI unsigned f2bf(float f) { unsigned u = __float_as_uint(f); return (u + 0x7fffu + ((u >> 16) & 1u)) >> 16; }
DI unsigned pk2(float lo, float hi) { return f2bf(lo) | (f2bf(hi) << 16); }
DI void ld8(const bf16* p, float (&o)[8]) { const u32x4 w = *(const u32x4*)p;
#pragma unroll
    for (int j = 0; j < 4; ++j) { o[2 * j] = __uint_as_float(w[j] << 16); o[2 * j + 1] = __uint_as_float(w[j] & 0xffff0000u); } }
DI void st8(bf16* p, const float (&v)[8]) { u32x4 w; w.x = pk2(v[0], v[1]); w.y = pk2(v[2], v[3]); w.z = pk2(v[4], v[5]); w.w = pk2(v[6], v[7]); *(u32x4*)p = w; }
DI void ldf8(const float* p, float (&o)[8]) { const f32x4 a = *(const f32x4*)p, b = *(const f32x4*)(p + 4);
    o[0] = a[0]; o[1] = a[1]; o[2] = a[2]; o[3] = a[3]; o[4] = b[0]; o[5] = b[1]; o[6] = b[2]; o[7] = b[3]; }
DI void stf8(float* p, const float (&v)[8]) { *(f32x4*)p = (f32x4){v[0], v[1], v[2], v[3]}; *(f32x4*)(p + 4) = (f32x4){v[4], v[5], v[6], v[7]}; }
DI float wave_sum(float v) {
#pragma unroll
    for (int o = 1; o < 64; o <<= 1) v += __shfl_xor(v, o);
    return v; }
template <int W> DI float grp_sum(float v) {
#pragma unroll
    for (int o = 1; o < W; o <<= 1) v += __shfl_xor(v, o);
    return v; }
DI float sigmoidf_(float x) { return 1.f / (1.f + __expf(-x)); }
DI float siluf_(float x) { return x / (1.f + __expf(-x)); }
DI float softplusf_(float x) { return fmaxf(x, 0.f) + log1pf(__expf(-fabsf(x))); }
DI float logsigmoidf_(float x) { return fminf(x, 0.f) - log1pf(__expf(-fabsf(x))); }
DI float gelu_tanh(float x) { const float u = 0.7978845608028654f * (x + 0.044715f * x * x * x); return 0.5f * x * (1.f + tanhf(u)); }

DI void seq_of(int row, int& base, int& len, int& t) { if (row < LAT) { base = row & ~(T - 1); len = T; t = row & (T - 1); } else { const int r = row - LAT; base = LAT + (r & ~(TC - 1)); len = TC; t = r & (TC - 1); } }
DI int scan_row(int dir, int b, int j) { if (j < TC) { const int tok = dir ? (TC - 1 - j) : j; return LAT + b * TC + tok; } const int jj = j - TC; const int tok = dir ? (T - 1 - jj) : jj; return b * T + tok; }

struct Ctx {
    LAS unsigned char* lds; int tid, lane, wave, G, bid;
    const Params* p; unsigned char* ws;
};

DI int zcol_src(int j) { if (j < 3072) return j; if (j < 5120) return j + 16; if (j < ZSM) return j + 32; if (j < ZSM + 16) return 3072 + (j - ZSM); if (j < ZSM + 32) return 5136 + (j - ZSM - 16); return -1; }
template <bool ZMAP> DI void transpose_item(const float* W, int K, int N, bf16* WT, LAS float* scr, int kb, int nb, int lane) {
    const int k0 = 64 * kb, n0 = 32 * nb; const int nn = n0 + (lane & 31); const int src = ZMAP ? zcol_src(nn) : nn;
#pragma unroll 8
    for (int i = 0; i < 32; ++i) { const int kk = 2 * i + (lane >> 5); scr[kk * 33 + (lane & 31)] = (src >= 0) ? W[(size_t)(k0 + kk) * N + src] : 0.f; }
    asm volatile("s_waitcnt lgkmcnt(0)" ::: "memory");
    const int c = lane & 7;
#pragma unroll
    for (int j = 0; j < 4; ++j) { const int n = (lane >> 3) + 8 * j; const LAS float* s = scr + (8 * c) * 33 + n;
        u32x4 o; o.x = pk2(s[0 * 33], s[1 * 33]); o.y = pk2(s[2 * 33], s[3 * 33]); o.z = pk2(s[4 * 33], s[5 * 33]); o.w = pk2(s[6 * 33], s[7 * 33]);
        *(u32x4*)(WT + (size_t)(n0 + n) * K + k0 + 8 * c) = o; }
    asm volatile("s_waitcnt lgkmcnt(0)" ::: "memory");
}
DI void phase_pro0(Ctx& c) {
    const Params& p = *c.p;
    {
        LAS float* red = (LAS float*)c.lds;
        float* MODP = (float*)(c.ws + WS_MODP);
        for (int u = c.bid; u < NL * 48 * 8; u += c.G) {
            const int l = u / 384, cb = (u >> 3) % 48, ks = u & 7; const int col = cb * 256 + c.lane * 4;
            f32x4 a0 = {0.f, 0.f, 0.f, 0.f}, a1 = a0, a2 = a0;
            const float* wp = p.w_mod + ((size_t)l * D + ks * 256 + c.wave * 32) * 12288 + col;
            const int kb = ks * 256 + c.wave * 32;
#pragma unroll 8
            for (int i = 0; i < 32; ++i) { const f32x4 w = *(const f32x4*)(wp + (size_t)i * 12288);
                const float s0 = siluf_(p.c[kb + i]), s1 = siluf_(p.c[D + kb + i]), s2 = siluf_(p.c_ctx[kb + i]);
                a0 += w * s0; a1 += w * s1; a2 += w * s2; }
            __syncthreads();
            *(LAS f32x4*)(red + (c.wave * 3 + 0) * 256 + c.lane * 4) = a0; *(LAS f32x4*)(red + (c.wave * 3 + 1) * 256 + c.lane * 4) = a1; *(LAS f32x4*)(red + (c.wave * 3 + 2) * 256 + c.lane * 4) = a2;
            __syncthreads();
            for (int o = c.tid; o < 768; o += 512) { float s = 0.f;
#pragma unroll
                for (int w = 0; w < 8; ++w) s += red[w * 768 + o];
                MODP[((size_t)(l * 8 + ks) * 3 + o / 256) * 12288 + cb * 256 + (o & 255)] = s; }
        }
        __syncthreads();
    }
}
DI void phase_wconv(Ctx& c, int l) {
    const Params& p = *c.p;
    {
        LAS float* scr = (LAS float*)(c.lds + c.wave * 16384);
        const int gw = c.bid * 8 + c.wave, NGW = c.G * 8;
        constexpr int I_IN = 32 * 480, I_BR = 8 * 64, I_OUT = 32 * 64, I_UP = 32 * 352, I_DN = 88 * 64, I_L = I_IN + 4 * I_BR + I_OUT + I_UP + I_DN;
        unsigned char* wl = c.ws + WS_W;
        for (int it = gw; it < I_L; it += NGW) {
            int r = it;
            if (r < I_IN) { transpose_item<true>(p.w_in + (size_t)l * D * NIN, D, NIN, (bf16*)(wl + WL_IN), scr, r / 480, r % 480, c.lane); continue; } r -= I_IN;
            if (r < 4 * I_BR) { const int nb = r / I_BR; r %= I_BR; transpose_item<false>(p.w_br + ((size_t)l * 4 + nb) * MIXW * D, MIXW, D, (bf16*)(wl + WL_BR) + (size_t)nb * D * MIXW, scr, r / 64, r % 64, c.lane); continue; } r -= 4 * I_BR;
            if (r < I_OUT) { transpose_item<false>(p.w_out + (size_t)l * D * D, D, D, (bf16*)(wl + WL_OUT), scr, r / 64, r % 64, c.lane); continue; } r -= I_OUT;
            if (r < I_UP) { transpose_item<false>(p.ffn_up + (size_t)l * D * 2 * DFF, D, 2 * DFF, (bf16*)(wl + WL_UP), scr, r / 352, r % 352, c.lane); continue; } r -= I_UP;
            transpose_item<false>(p.ffn_down + (size_t)l * DFF * D, DFF, D, (bf16*)(wl + WL_DN), scr, r / 64, r % 64, c.lane);
        }
    }
    __syncthreads();
}
DI void phase_pro1(Ctx& c) {
    const Params& p = *c.p; const float* MODP = (const float*)(c.ws + WS_MODP); float* MOD = (float*)(c.ws + WS_MOD);
    for (int i = c.bid * 512 + c.tid; i < NL * 3 * 12288; i += c.G * 512) { const int l = i / 36864, v = (i / 12288) % 3, n = i % 12288;
        float s = p.b_mod[l * 12288 + n];
#pragma unroll
        for (int ks = 0; ks < 8; ++ks) s += MODP[((size_t)(l * 8 + ks) * 3 + v) * 12288 + n];
        MOD[i] = s; }
}
DI void row_load(const float* r, int lane, f32x4 (&v)[8]) {
#pragma unroll
    for (int j = 0; j < 8; ++j) v[j] = *(const f32x4*)(r + 4 * lane + 256 * j); }
DI float row_rstd(const f32x4 (&v)[8]) { float s = 0.f;
#pragma unroll
    for (int j = 0; j < 8; ++j) s += (v[j][0] * v[j][0] + v[j][1] * v[j][1]) + (v[j][2] * v[j][2] + v[j][3] * v[j][3]);
    return rsqrtf(wave_sum(s) * (1.f / D) + 1e-6f); }
DI void norm_mod_store(const f32x4 (&v)[8], float rstd, const float* g, const float* sh, const float* sc, bf16* o, int lane) {
#pragma unroll
    for (int j = 0; j < 8; ++j) { const int cc = 4 * lane + 256 * j; const f32x4 g4 = *(const f32x4*)(g + cc), s4 = *(const f32x4*)(sh + cc), c4 = *(const f32x4*)(sc + cc);
        const f32x4 r = v[j] * rstd * g4 * (c4 + 1.f) + s4; u32x2 w; w.x = pk2(r[0], r[1]); w.y = pk2(r[2], r[3]); *(u32x2*)(o + cc) = w; } }
DI int mod_vec(int row) { return row < LAT ? (row >> 12) : 2; }
DI void phase_pro2(Ctx& c) {
    const Params& p = *c.p; const float* MOD = (const float*)(c.ws + WS_MOD); bf16* U = (bf16*)(c.ws + WS_U);
    const int gw = c.bid * 8 + c.wave, NGW = c.G * 8;
    for (int row = gw; row < MROWS; row += NGW) { const float* xr = row < LAT ? p.x + (size_t)row * D : p.ctx + (size_t)(row - LAT) * D;
        f32x4 v[8]; row_load(xr, c.lane, v); const float rs = row_rstd(v); const float* mv = MOD + (size_t)(0 * 3 + mod_vec(row)) * 12288;
        norm_mod_store(v, rs, p.norm_g, mv, mv + 2048, U + (size_t)row * D, c.lane); }
}
DI void phase_resid(Ctx& c, int l, int which) {
    const Params& p = *c.p; const float* MOD = (const float*)(c.ws + WS_MOD); bf16* U = (bf16*)(c.ws + WS_U); float* X = (float*)(c.ws + WS_X); const float* F = (const float*)(c.ws + WS_F);
    const int gw = c.bid * 8 + c.wave, NGW = c.G * 8;
    for (int row = gw; row < MROWS; row += NGW) {
        const float* xr = (l == 0 && which == 0) ? (row < LAT ? p.x + (size_t)row * D : p.ctx + (size_t)(row - LAT) * D) : X + (size_t)row * D;
        f32x4 fv[8], xv[8]; row_load(F + (size_t)row * D, c.lane, fv); row_load(xr, c.lane, xv);
        const float rs = row_rstd(fv); const float* mv = MOD + (size_t)(l * 3 + mod_vec(row)) * 12288;
        const float* g = p.norm_g + (size_t)(l * 4 + (which ? 3 : 1)) * D; const float* gt = mv + (which ? 10240 : 4096);
#pragma unroll
        for (int j = 0; j < 8; ++j) { const int cc = 4 * c.lane + 256 * j; xv[j] += *(const f32x4*)(gt + cc) * (fv[j] * rs * *(const f32x4*)(g + cc)); }
        const bool fin = (which == 1 && l == NL - 1);
        if (fin) { if (row < LAT) {
#pragma unroll
            for (int j = 0; j < 8; ++j) *(f32x4*)(p.out + (size_t)row * D + 4 * c.lane + 256 * j) = xv[j]; } continue; }
#pragma unroll
        for (int j = 0; j < 8; ++j) *(f32x4*)(X + (size_t)row * D + 4 * c.lane + 256 * j) = xv[j];
        const float rs2 = row_rstd(xv);
        if (which == 0) norm_mod_store(xv, rs2, p.norm_g + (size_t)(l * 4 + 2) * D, mv + 6144, mv + 8192, U + (size_t)row * D, c.lane);
        else { const float* mv2 = MOD + (size_t)((l + 1) * 3 + mod_vec(row)) * 12288; norm_mod_store(xv, rs2, p.norm_g + (size_t)((l + 1) * 4) * D, mv2, mv2 + 2048, U + (size_t)row * D, c.lane); }
    }
}

DI f32x4 mfma16(bf16x8 a, bf16x8 b, f32x4 c) { return __builtin_amdgcn_mfma_f32_16x16x32_bf16(a, b, c, 0, 0, 0); }
DI bf16x8 ldfrag(const LAS bf16* base, int ld, int r0, int k0, int lane) { return *(const LAS bf16x8*)(base + (r0 + (lane & 15)) * ld + k0 + 8 * (lane >> 4)); }
template <int K> DI f32x4 mm_tile(const LAS bf16* X, int ldx, int xr0, const LAS bf16* Yt, int ldy, int yr0, int lane, f32x4 acc) {
#pragma unroll
    for (int k0 = 0; k0 < K; k0 += 32) acc = mfma16(ldfrag(X, ldx, xr0, k0, lane), ldfrag(Yt, ldy, yr0, k0, lane), acc);
    return acc; }
DI float wave_scan_add(float v, int lane) {
#pragma unroll
    for (int o = 1; o < 64; o <<= 1) { const float t = __shfl_up(v, o); if (lane >= o) v += t; }
    return v; }
DI float wave_scan_max(float v, int lane) {
#pragma unroll
    for (int o = 1; o < 64; o <<= 1) { const float t = __shfl_up(v, o); if (lane >= o) v = fmaxf(v, t); }
    return v; }
DI float wave_max(float v) {
#pragma unroll
    for (int o = 1; o < 64; o <<= 1) v = fmaxf(v, __shfl_xor(v, o));
    return v; }
constexpr float QSC = 0.08838834764831845f;

DI void mlstm_local(Ctx& c, int l, int u) {
    const Params& p = *c.p; const bf16* Z = (const bf16*)(c.ws + WS_Z); const float* G32 = (const float*)(c.ws + WS_G32); float* ML = (float*)(c.ws + WS_ML) + (size_t)u * ML_US;
    const int chain = u / 68, cc = u % 68, g = chain >> 2, h = chain & 3, dir = g >> 1, b = g & 1;
    LAS bf16* kT = (LAS bf16*)c.lds; LAS bf16* vT = kT + 128 * 72; LAS float* sw = (LAS float*)(vT + 128 * 72);
    __syncthreads();
    if (c.wave == 0) { const int row = scan_row(dir, b, cc * 64 + c.lane);
        const float li = G32[(size_t)row * 32 + dir * 8 + h] + p.ml_gate_b[((l * 2 + dir) * 2 + 0) * 4 + h];
        const float lf = logsigmoidf_(G32[(size_t)row * 32 + dir * 8 + 4 + h] + p.ml_gate_b[((l * 2 + dir) * 2 + 1) * 4 + h]);
        const float bt = wave_scan_add(lf, c.lane); const float bl = __shfl(bt, 63); const float wl = bl - bt + li; const float mloc = wave_max(wl);
        sw[c.lane] = expf(wl - mloc); if (c.lane == 0) { ML[ML_HDR] = mloc; ML[ML_HDR + 1] = bl; } }
    __syncthreads();
    for (int it = c.tid; it < 64 * 32; it += 512) { const int s = it & 63, r = it >> 6, mat = r >> 4, ch = (r & 15) * 8; const int row = scan_row(dir, b, cc * 64 + s);
        float v[8]; ld8(Z + (size_t)row * NZ + (mat ? MLV : MLK) + h * 128 + ch, v); const float sc = mat ? 1.f : sw[s]; LAS bf16* dst = (mat ? vT : kT) + ch * 72 + s;
#pragma unroll
        for (int i = 0; i < 8; ++i) dst[i * 72] = (bf16)f2bf(v[i] * sc); }
    __syncthreads();
    f32x4 acc[8];
#pragma unroll
    for (int nt = 0; nt < 8; ++nt) acc[nt] = mm_tile<64>(kT, 72, 16 * c.wave, vT, 72, 16 * nt, c.lane, (f32x4){0.f, 0.f, 0.f, 0.f});
    const int q = c.lane >> 4, r = c.lane & 15;
#pragma unroll
    for (int nt = 0; nt < 8; ++nt) *(f32x4*)(ML + (size_t)(16 * nt + r) * 128 + 16 * c.wave + 4 * q) = acc[nt];
    if (c.tid < 128) { float s = 0.f;
#pragma unroll
        for (int j = 0; j < 64; j += 8) { const u32x4 w = *(const LAS u32x4*)(kT + c.tid * 72 + j);
#pragma unroll
            for (int i = 0; i < 4; ++i) s += __uint_as_float(w[i] << 16) + __uint_as_float(w[i] & 0xffff0000u); }
        ML[ML_NL + c.tid] = s; }
}
DI void mlstm_prefix(Ctx& c) {
    const float* ML = (const float*)(c.ws + WS_ML); bf16* CT = (bf16*)(c.ws + WS_MLC); float* MS = (float*)(c.ws + WS_MLM);
    for (int item = c.bid * 512 + c.tid; item < 65536 + 512; item += c.G * 512) {
        int chain, e, dq; if (item < 65536) { chain = item >> 12; e = (item >> 5) & 127; dq = item & 31; } else { const int j = item - 65536; chain = j >> 5; e = 128; dq = j & 31; }
        const size_t so = (e < 128 ? (size_t)e * 128 : (size_t)ML_NL) + 4 * dq; const size_t dofs = (size_t)e * 128 + 4 * dq;
        f32x4 C = {0.f, 0.f, 0.f, 0.f}; float m = 0.f;
#pragma unroll 4
        for (int cc = 0; cc < 68; ++cc) { const size_t u = (size_t)chain * 68 + cc; const float* mu = ML + u * ML_US;
            const f32x4 L = *(const f32x4*)(mu + so); const float mloc = mu[ML_HDR], bl = mu[ML_HDR + 1];
            u32x2 w; w.x = pk2(C[0], C[1]); w.y = pk2(C[2], C[3]); *(u32x2*)(CT + u * MLC_US + dofs) = w;
            if (e == 0 && dq == 0) MS[u] = m;
            const float mn = fmaxf(bl + m, mloc); const float dec = expf(bl + m - mn), wl = expf(mloc - mn); m = mn;
            C = C * dec + L * wl; }
    }
}
DI void mlstm_out(Ctx& c, int l, int u) {
    const Params& p = *c.p; const bf16* Z = (const bf16*)(c.ws + WS_Z); const float* G32 = (const float*)(c.ws + WS_G32); bf16* Y = (bf16*)(c.ws + WS_Y);
    const bf16* CTg = (const bf16*)(c.ws + WS_MLC); const float* MS = (const float*)(c.ws + WS_MLM);
    const int b = u / (4 * 68), h = (u / 68) & 3, tb = u % 68;
    LAS bf16* sq = (LAS bf16*)c.lds; LAS bf16* sk = sq + 64 * 136; LAS bf16* vT = sk + 64 * 136; LAS bf16* CT = vT + 144 * 72; LAS bf16* sdw = CT + 144 * 136;
    LAS float* hbuf = (LAS float*)(sdw + 64 * 72); LAS float* sAt = hbuf + 64 * 128; LAS float* sBs = sAt + 64; LAS float* siw = sBs + 64; LAS float* semt = siw + 64; LAS float* sden = semt + 64;
    const int q = c.lane >> 4, r = c.lane & 15;
    for (int dir = 0; dir < 2; ++dir) {
        const int cc = dir == 0 ? tb : (tb < 4 ? 3 - tb : 71 - tb); const int chain = (dir * 2 + b) * 4 + h; const size_t un = (size_t)chain * 68 + cc;
        __syncthreads();
        if (c.wave == 0) { const int row = scan_row(dir, b, cc * 64 + c.lane); const float mc = MS[un];
            const float li = G32[(size_t)row * 32 + dir * 8 + h] + p.ml_gate_b[((l * 2 + dir) * 2 + 0) * 4 + h];
            const float lf = logsigmoidf_(G32[(size_t)row * 32 + dir * 8 + 4 + h] + p.ml_gate_b[((l * 2 + dir) * 2 + 1) * 4 + h]);
            const float bt = wave_scan_add(lf, c.lane); const float x = li - bt; const float cm = wave_scan_max(x, c.lane); const float mt = bt + fmaxf(mc, cm);
            sAt[c.lane] = bt - mt; sBs[c.lane] = x; siw[c.lane] = expf(bt + mc - mt) * QSC; semt[c.lane] = expf(-mt); }
        for (int it = c.tid; it < 64 * 32; it += 512) { const int s = it >> 5, r2 = it & 31, mat = r2 >> 4, ch = (r2 & 15) * 8; const int row = scan_row(dir, b, cc * 64 + s);
            *(LAS u32x4*)((mat ? sk : sq) + s * 136 + ch) = *(const u32x4*)(Z + (size_t)row * NZ + (mat ? MLK : MLQ) + h * 128 + ch); }
        for (int it = c.tid; it < 64 * 16; it += 512) { const int s = it & 63, ch = (it >> 6) * 8; const int row = scan_row(dir, b, cc * 64 + s);
            const u32x4 w = *(const u32x4*)(Z + (size_t)row * NZ + MLV + h * 128 + ch); LAS bf16* dst = vT + ch * 72 + s;
#pragma unroll
            for (int i = 0; i < 4; ++i) { dst[(2 * i) * 72] = (bf16)(w[i] & 0xffffu); dst[(2 * i + 1) * 72] = (bf16)(w[i] >> 16); } }
        if (c.tid < 64) vT[128 * 72 + c.tid] = (bf16)0x3F80u;
        for (int it = c.tid; it < 129 * 16; it += 512) { const int e = it >> 4, ch = (it & 15) * 8; *(LAS u32x4*)(CT + e * 136 + ch) = *(const u32x4*)(CTg + un * MLC_US + (size_t)e * 128 + ch); }
        __syncthreads();
#pragma unroll
        for (int j = 0; j < 2; ++j) { const int ti = 2 * c.wave + j, mt = ti >> 2, nt = ti & 3;
            const f32x4 a = mm_tile<128>(sk, 136, 16 * nt, sq, 136, 16 * mt, c.lane, (f32x4){0.f, 0.f, 0.f, 0.f});
            const int t = 16 * mt + r; const float At = sAt[t]; float d[4];
#pragma unroll
            for (int i = 0; i < 4; ++i) { const int s = 16 * nt + 4 * q + i; d[i] = (s <= t) ? a[i] * QSC * expf(At + sBs[s]) : 0.f; }
            u32x2 w; w.x = pk2(d[0], d[1]); w.y = pk2(d[2], d[3]); *(LAS u32x2*)(sdw + t * 72 + 16 * nt + 4 * q) = w; }
        const int mt = c.wave & 3, nt0 = (c.wave >> 2) * 5, ntn = (c.wave >> 2) ? 4 : 5;
        f32x4 acc[5];
#pragma unroll
        for (int j = 0; j < 5; ++j) if (j < ntn) acc[j] = mm_tile<128>(CT, 136, 16 * (nt0 + j), sq, 136, 16 * mt, c.lane, (f32x4){0.f, 0.f, 0.f, 0.f});
        __syncthreads();
        const int t = 16 * mt + r; const float iw = siw[t];
#pragma unroll
        for (int j = 0; j < 5; ++j) if (j < ntn) acc[j] = mm_tile<64>(vT, 72, 16 * (nt0 + j), sdw, 72, 16 * mt, c.lane, acc[j] * iw);
        if (c.wave >= 4 && q == 0) sden[t] = acc[3][0];
        __syncthreads();
        const float dn = fmaxf(fabsf(sden[t]), semt[t]); const float inv = 1.f / dn; const int tok = dir ? 63 - t : t;
#pragma unroll
        for (int j = 0; j < 5; ++j) if (j < ntn && nt0 + j < 8) { LAS f32x4* hp = (LAS f32x4*)(hbuf + tok * 128 + 16 * (nt0 + j) + 4 * q); const f32x4 hv = acc[j] * inv; if (dir == 0) *hp = hv; else *hp += hv; }
    }
    __syncthreads();
    { const int tok = c.tid >> 3, eg = (c.tid & 7) * 16; const int row = (tb < 4 ? LAT + b * TC + tb * 64 : b * T + (tb - 4) * 64) + tok;
        float hv[16]; float ss = 0.f;
#pragma unroll
        for (int j = 0; j < 4; ++j) { const f32x4 x = *(const LAS f32x4*)(hbuf + tok * 128 + eg + 4 * j); hv[4 * j] = x[0]; hv[4 * j + 1] = x[1]; hv[4 * j + 2] = x[2]; hv[4 * j + 3] = x[3]; ss += (x[0] * x[0] + x[1] * x[1]) + (x[2] * x[2] + x[3] * x[3]); }
        ss = grp_sum<8>(ss); const float rs = rsqrtf(ss * (1.f / 128.f) + 1e-6f);
#pragma unroll
        for (int j = 0; j < 2; ++j) { float g[8], o[8], y[8]; ldf8(p.ml_norm_g + l * 512 + h * 128 + eg + 8 * j, g); ld8(Z + (size_t)row * NZ + MLO + h * 128 + eg + 8 * j, o);
#pragma unroll
            for (int i = 0; i < 8; ++i) y[i] = hv[8 * j + i] * rs * g[i] * sigmoidf_(o[i]);
            st8(Y + (size_t)row * D + 512 + h * 128 + eg + 8 * j, y); } }
}


DI bf16x8 gfrag(const bf16* base, int ld, int r0, int k0, int lane) { return *(const bf16x8*)(base + (size_t)(r0 + (lane & 15)) * ld + k0 + 8 * (lane >> 4)); }
DI void gdn_local(Ctx& c, int l, int u) {
    const Params& p = *c.p; const bf16* Z = (const bf16*)(c.ws + WS_Z); const float* G32 = (const float*)(c.ws + WS_G32);
    const int chain = u / 68, cc = u % 68, g = chain >> 2, h = chain & 3, dir = g >> 1, b = g & 1;
    bf16* gA = (bf16*)(c.ws + WS_GDA) + (size_t)u * 16384; float* gB = (float*)(c.ws + WS_GDB) + (size_t)u * 16384; float* gU = (float*)(c.ws + WS_GDU) + (size_t)u * 8192;
    bf16* gW = (bf16*)(c.ws + WS_GDW) + (size_t)u * 8192; bf16* gAT = (bf16*)(c.ws + WS_GDAT) + (size_t)u * 4096; bf16* gQD = (bf16*)(c.ws + WS_GDQ) + (size_t)u * 8192;
    LAS bf16* sq = (LAS bf16*)c.lds; LAS bf16* sk = sq + 64 * 136; LAS bf16* skb = sk + 64 * 136; LAS bf16* uT = sq; LAS bf16* wT = uT + 128 * 72;
    LAS bf16* kdT = (LAS bf16*)(c.lds + 52224); LAS bf16* vbT = kdT + 128 * 72; LAS bf16* kbgT = vbT + 128 * 72;
    LAS float* Nf = (LAS float*)(c.lds + 107520); LAS bf16* Tm = (LAS bf16*)(c.lds + 124928); LAS float* sm = (LAS float*)(c.lds + 134144);
    const int q = c.lane >> 4, r = c.lane & 15;
    __syncthreads();
    if (c.wave == 0) { const int row = scan_row(dir, b, cc * 64 + c.lane); const float a = G32[(size_t)row * 32 + 16 + dir * 8 + h], bb = G32[(size_t)row * 32 + 16 + dir * 8 + 4 + h];
        const float lg = -expf(p.gd_a_log[l * 8 + dir * 4 + h]) * softplusf_(a + p.gd_dt_bias[l * 8 + dir * 4 + h]);
        const float gc = wave_scan_add(lg, c.lane); const float gl = __shfl(gc, 63);
        sm[c.lane] = gc; sm[64 + c.lane] = sigmoidf_(bb); sm[128 + c.lane] = expf(gc); sm[192 + c.lane] = expf(gl - gc); if (c.lane == 0) sm[256] = expf(gl); }
    __syncthreads();
    { const float* cw = p.gd_conv + (size_t)l * 5 * 1536;
      for (int it = c.tid; it < 64 * 48; it += 512) { const int s = it / 48, rr = it % 48, mat = rr >> 4, ch = (rr & 15) * 8; const int row = scan_row(dir, b, cc * 64 + s);
        int base, len, t; seq_of(row, base, len, t);
        float acc[8];
#pragma unroll
        for (int i = 0; i < 8; ++i) acc[i] = 0.f;
#pragma unroll
        for (int j = 0; j < 5; ++j) { const int tt = t + j - 2; if (tt < 0 || tt >= len) continue;
            float a[8], wv[8]; ld8(Z + (size_t)(base + tt) * NZ + GDQ + mat * 512 + h * 128 + ch, a); ldf8(cw + j * 1536 + mat * 512 + h * 128 + ch, wv);
#pragma unroll
            for (int i = 0; i < 8; ++i) acc[i] = fmaf(a[i], wv[i], acc[i]); }
        float ss = 0.f;
#pragma unroll
        for (int i = 0; i < 8; ++i) { acc[i] = siluf_(acc[i]); ss += acc[i] * acc[i]; }
        ss = grp_sum<16>(ss);
        const float be = sm[64 + s], egc = sm[128 + s], ekd = sm[192 + s];
        if (mat == 0) { const float sc = rsqrtf(ss + 1e-6f) * QSC; float o[8], o2[8];
#pragma unroll
            for (int i = 0; i < 8; ++i) { o[i] = acc[i] * sc; o2[i] = o[i] * egc; }
            u32x4 w; w.x = pk2(o[0], o[1]); w.y = pk2(o[2], o[3]); w.z = pk2(o[4], o[5]); w.w = pk2(o[6], o[7]); *(LAS u32x4*)(sq + s * 136 + ch) = w; st8(gQD + s * 128 + ch, o2); }
        else if (mat == 1) { const float sc = rsqrtf(ss + 1e-6f); float o[8];
#pragma unroll
            for (int i = 0; i < 8; ++i) o[i] = acc[i] * sc;
            u32x4 w; w.x = pk2(o[0], o[1]); w.y = pk2(o[2], o[3]); w.z = pk2(o[4], o[5]); w.w = pk2(o[6], o[7]); *(LAS u32x4*)(sk + s * 136 + ch) = w;
            w.x = pk2(o[0] * be, o[1] * be); w.y = pk2(o[2] * be, o[3] * be); w.z = pk2(o[4] * be, o[5] * be); w.w = pk2(o[6] * be, o[7] * be); *(LAS u32x4*)(skb + s * 136 + ch) = w;
#pragma unroll
            for (int i = 0; i < 8; ++i) { kdT[(ch + i) * 72 + s] = (bf16)f2bf(o[i] * ekd); kbgT[(ch + i) * 72 + s] = (bf16)f2bf(o[i] * be * egc); } }
        else {
#pragma unroll
            for (int i = 0; i < 8; ++i) vbT[(ch + i) * 72 + s] = (bf16)f2bf(acc[i] * be); } } }
    __syncthreads();
#pragma unroll
    for (int j = 0; j < 2; ++j) { const int ti = 2 * c.wave + j, mt = ti >> 2, nt = ti & 3;
        { const f32x4 a = mm_tile<128>(skb, 136, 16 * mt, sk, 136, 16 * nt, c.lane, (f32x4){0.f, 0.f, 0.f, 0.f}); const int s = 16 * nt + r; const float gs = sm[s];
#pragma unroll
          for (int i = 0; i < 4; ++i) { const int t = 16 * mt + 4 * q + i; Nf[t * 68 + s] = (s < t) ? a[i] * expf(sm[t] - gs) : 0.f; } }
        { const f32x4 a = mm_tile<128>(sk, 136, 16 * nt, sq, 136, 16 * mt, c.lane, (f32x4){0.f, 0.f, 0.f, 0.f}); const int t = 16 * mt + r; const float gt = sm[t]; float d[4];
#pragma unroll
          for (int i = 0; i < 4; ++i) { const int s = 16 * nt + 4 * q + i; d[i] = (s <= t) ? a[i] * expf(gt - sm[s]) : 0.f; }
          u32x2 w; w.x = pk2(d[0], d[1]); w.y = pk2(d[2], d[3]); *(u32x2*)(gAT + t * 64 + 16 * nt + 4 * q) = w; } }
    __syncthreads();
    if (c.wave == 0) { float x[64]; int zo = 0; asm volatile("" : "+v"(zo));
        const LAS float* Nz = Nf + zo;
#pragma unroll
        for (int t = 0; t < 64; ++t) { float a = (t == c.lane) ? 1.f : 0.f;
#pragma unroll
            for (int s4 = 0; s4 < (t + 3) / 4; ++s4) { const f32x4 n4 = *(const LAS f32x4*)(Nz + t * 68 + 4 * s4);
#pragma unroll
                for (int i = 0; i < 4; ++i) if (4 * s4 + i < t) a = fmaf(-n4[i], x[4 * s4 + i], a); }
            x[t] = a; Tm[t * 72 + c.lane] = (bf16)f2bf(a); } }
    __syncthreads();
    { const int mt = c.wave & 3;
#pragma unroll
      for (int j = 0; j < 4; ++j) { const int nt = (c.wave >> 2) * 4 + j;
        const f32x4 au = mm_tile<64>(Tm, 72, 16 * mt, vbT, 72, 16 * nt, c.lane, (f32x4){0.f, 0.f, 0.f, 0.f});
        { u32x2 w; w.x = pk2(au[0], au[1]); w.y = pk2(au[2], au[3]); *(LAS u32x2*)(uT + (16 * nt + r) * 72 + 16 * mt + 4 * q) = w; *(f32x4*)(gU + (16 * nt + r) * 64 + 16 * mt + 4 * q) = au; }
        const f32x4 aw = mm_tile<64>(Tm, 72, 16 * mt, kbgT, 72, 16 * nt, c.lane, (f32x4){0.f, 0.f, 0.f, 0.f});
        { u32x2 w; w.x = pk2(aw[0], aw[1]); w.y = pk2(aw[2], aw[3]); *(LAS u32x2*)(wT + (16 * nt + r) * 72 + 16 * mt + 4 * q) = w; }
        const f32x4 aw2 = mm_tile<64>(kbgT, 72, 16 * nt, Tm, 72, 16 * mt, c.lane, (f32x4){0.f, 0.f, 0.f, 0.f});
        { u32x2 w; w.x = pk2(aw2[0], aw2[1]); w.y = pk2(aw2[2], aw2[3]); *(u32x2*)(gW + (16 * mt + r) * 128 + 16 * nt + 4 * q) = w; } } }
    __syncthreads();
    { const float egl = sm[256]; const int yt = c.wave;
#pragma unroll
      for (int xt = 0; xt < 8; ++xt) {
        const f32x4 a = mm_tile<64>(wT, 72, 16 * xt, kdT, 72, 16 * yt, c.lane, (f32x4){0.f, 0.f, 0.f, 0.f}); const int d = 16 * yt + r; float v[4];
#pragma unroll
        for (int i = 0; i < 4; ++i) v[i] = ((16 * xt + 4 * q + i) == d ? egl : 0.f) - a[i];
        u32x2 w; w.x = pk2(v[0], v[1]); w.y = pk2(v[2], v[3]); *(u32x2*)(gA + d * 128 + 16 * xt + 4 * q) = w;
        const f32x4 bq = mm_tile<64>(kdT, 72, 16 * xt, uT, 72, 16 * yt, c.lane, (f32x4){0.f, 0.f, 0.f, 0.f});
        *(f32x4*)(gB + (16 * yt + r) * 128 + 16 * xt + 4 * q) = bq; } }
}
DI void gdn_prefix(Ctx& c, int u2) {
    const int chain = u2 >> 3, sl = u2 & 7; const int w = c.wave, q = c.lane >> 4, r = c.lane & 15;
    const bf16* gA = (const bf16*)(c.ws + WS_GDA) + (size_t)chain * 68 * 16384; const float* gB = (const float*)(c.ws + WS_GDB) + (size_t)chain * 68 * 16384; bf16* gS = (bf16*)(c.ws + WS_GDS) + (size_t)chain * 68 * 16384;
    LAS bf16* ST = (LAS bf16*)c.lds;
    __syncthreads();
    { const u32x2 z = {0u, 0u}; *(LAS u32x2*)(ST + r * 136 + 16 * w + 4 * q) = z; *(u32x2*)(gS + (size_t)(16 * sl + r) * 128 + 16 * w + 4 * q) = z; }
    bf16x8 a[4], an[4]; f32x4 Bc, Bn;
#pragma unroll
    for (int kk = 0; kk < 4; ++kk) a[kk] = gfrag(gA, 128, 16 * w, 32 * kk, c.lane);
    Bc = *(const f32x4*)(gB + (size_t)(16 * sl + r) * 128 + 16 * w + 4 * q);
    __syncthreads();
    for (int cc = 0; cc < 67; ++cc) {
        const bf16* nA = gA + (size_t)(cc + 1) * 16384; const float* nB = gB + (size_t)(cc + 1) * 16384;
#pragma unroll
        for (int kk = 0; kk < 4; ++kk) an[kk] = gfrag(nA, 128, 16 * w, 32 * kk, c.lane);
        Bn = *(const f32x4*)(nB + (size_t)(16 * sl + r) * 128 + 16 * w + 4 * q);
        f32x4 acc = Bc;
#pragma unroll
        for (int kk = 0; kk < 4; ++kk) acc = mfma16(a[kk], ldfrag(ST, 136, 0, 32 * kk, c.lane), acc);
        __syncthreads();
        u32x2 wv; wv.x = pk2(acc[0], acc[1]); wv.y = pk2(acc[2], acc[3]);
        *(LAS u32x2*)(ST + r * 136 + 16 * w + 4 * q) = wv; *(u32x2*)(gS + (size_t)(cc + 1) * 16384 + (size_t)(16 * sl + r) * 128 + 16 * w + 4 * q) = wv;
        __syncthreads();
#pragma unroll
        for (int kk = 0; kk < 4; ++kk) a[kk] = an[kk];
        Bc = Bn;
    }
}
DI void gdn_out(Ctx& c, int l, int u) {
    const Params& p = *c.p; const bf16* Z = (const bf16*)(c.ws + WS_Z); bf16* Y = (bf16*)(c.ws + WS_Y);
    const int b = u / (4 * 68), h = (u / 68) & 3, tb = u % 68;
    LAS bf16* ST = (LAS bf16*)c.lds; LAS bf16* vnT = ST + 128 * 136; LAS float* hbuf = (LAS float*)(vnT + 128 * 72);
    const int q = c.lane >> 4, r = c.lane & 15; const int mt = c.wave & 3, ntb = (c.wave >> 2) * 4;
    for (int dir = 0; dir < 2; ++dir) {
        const int cc = dir == 0 ? tb : (tb < 4 ? 3 - tb : 71 - tb); const int chain = (dir * 2 + b) * 4 + h; const size_t un = (size_t)chain * 68 + cc;
        const bf16* gS = (const bf16*)(c.ws + WS_GDS) + un * 16384; const float* gU = (const float*)(c.ws + WS_GDU) + un * 8192; const bf16* gW = (const bf16*)(c.ws + WS_GDW) + un * 8192;
        const bf16* gAT = (const bf16*)(c.ws + WS_GDAT) + un * 4096; const bf16* gQD = (const bf16*)(c.ws + WS_GDQ) + un * 8192;
        __syncthreads();
        for (int it = c.tid; it < 128 * 16; it += 512) { const int e = it >> 4, ch = (it & 15) * 8; *(LAS u32x4*)(ST + e * 136 + ch) = *(const u32x4*)(gS + (size_t)e * 128 + ch); }
        bf16x8 wf[4], qf[4], af[2];
#pragma unroll
        for (int kk = 0; kk < 4; ++kk) { wf[kk] = gfrag(gW, 128, 16 * mt, 32 * kk, c.lane); qf[kk] = gfrag(gQD, 128, 16 * mt, 32 * kk, c.lane); }
#pragma unroll
        for (int kk = 0; kk < 2; ++kk) af[kk] = gfrag(gAT, 64, 16 * mt, 32 * kk, c.lane);
        __syncthreads();
#pragma unroll
        for (int j = 0; j < 4; ++j) { const int nt = ntb + j; f32x4 acc = {0.f, 0.f, 0.f, 0.f};
#pragma unroll
            for (int kk = 0; kk < 4; ++kk) acc = mfma16(wf[kk], ldfrag(ST, 136, 16 * nt, 32 * kk, c.lane), acc);
            const f32x4 uv = *(const f32x4*)(gU + (16 * nt + r) * 64 + 16 * mt + 4 * q); const f32x4 vn = uv - acc;
            u32x2 wv; wv.x = pk2(vn[0], vn[1]); wv.y = pk2(vn[2], vn[3]); *(LAS u32x2*)(vnT + (16 * nt + r) * 72 + 16 * mt + 4 * q) = wv; }
        __syncthreads();
        const int t = 16 * mt + r, tok = dir ? 63 - t : t;
#pragma unroll
        for (int j = 0; j < 4; ++j) { const int nt = ntb + j; f32x4 acc = {0.f, 0.f, 0.f, 0.f};
#pragma unroll
            for (int kk = 0; kk < 4; ++kk) acc = mfma16(ldfrag(ST, 136, 16 * nt, 32 * kk, c.lane), qf[kk], acc);
#pragma unroll
            for (int kk = 0; kk < 2; ++kk) acc = mfma16(ldfrag(vnT, 72, 16 * nt, 32 * kk, c.lane), af[kk], acc);
            LAS f32x4* hp = (LAS f32x4*)(hbuf + tok * 128 + 16 * nt + 4 * q); if (dir == 0) *hp = acc; else *hp += acc; }
    }
    __syncthreads();
    { const int tok = c.tid >> 3, eg = (c.tid & 7) * 16; const int row = (tb < 4 ? LAT + b * TC + tb * 64 : b * T + (tb - 4) * 64) + tok;
        float hv[16]; float ss = 0.f;
#pragma unroll
        for (int j = 0; j < 4; ++j) { const f32x4 x = *(const LAS f32x4*)(hbuf + tok * 128 + eg + 4 * j); hv[4 * j] = x[0]; hv[4 * j + 1] = x[1]; hv[4 * j + 2] = x[2]; hv[4 * j + 3] = x[3]; ss += (x[0] * x[0] + x[1] * x[1]) + (x[2] * x[2] + x[3] * x[3]); }
        ss = grp_sum<8>(ss); const float rs = rsqrtf(ss * (1.f / 128.f) + 1e-6f);
#pragma unroll
        for (int j = 0; j < 2; ++j) { float g[8], o[8], y[8]; ldf8(p.gd_norm_g + l * 512 + h * 128 + eg + 8 * j, g); ld8(Z + (size_t)row * NZ + GDZ + h * 128 + eg + 8 * j, o);
#pragma unroll
            for (int i = 0; i < 8; ++i) y[i] = hv[8 * j + i] * rs * g[i] * siluf_(o[i]);
            st8(Y + (size_t)row * D + 1024 + h * 128 + eg + 8 * j, y); } }
}

DI float rw_feat(const bf16* Z, const float* mu, int row, int cz) {
    int base, len, t; seq_of(row, base, len, t); const bf16* zp = Z + (size_t)row * NZ + RWR + cz;
    const float x = bf2f(zp[0]); const float pv = t > 0 ? bf2f(zp[-NZ]) : 0.f; const float nx = t < len - 1 ? bf2f(zp[NZ]) : 0.f;
    return x + mu[cz] * (pv - x) + mu[RWMIX + cz] * (nx - x);
}
template <int K, int NT> DI void lora_nt(const float* Wm, const LAS float* in, int c, float (&acc)[NT]) {
#pragma unroll
    for (int t = 0; t < NT; ++t) acc[t] = 0.f;
    for (int k = 0; k < K; k += 4) { const float w0 = Wm[(k + 0) * 512 + c], w1 = Wm[(k + 1) * 512 + c], w2 = Wm[(k + 2) * 512 + c], w3 = Wm[(k + 3) * 512 + c];
#pragma unroll
        for (int t = 0; t < NT; ++t) { const f32x4 x = *(const LAS f32x4*)(in + t * 448 + k); acc[t] = fmaf(x[0], w0, acc[t]); acc[t] = fmaf(x[1], w1, acc[t]); acc[t] = fmaf(x[2], w2, acc[t]); acc[t] = fmaf(x[3], w3, acc[t]); } }
}
constexpr int RWT = 17;
DI void rwkv_prep_rows(Ctx& c, int l, int row0, const LAS float* in, LAS float* bufA, LAS float* bufB) {
    const Params& p = *c.p; const bf16* Z = (const bf16*)(c.ws + WS_Z); float* SA = (float*)(c.ws + WS_S);
    const float* mu = p.rw_mu + (size_t)l * 2 * RWMIX; const int cc = c.tid; const size_t AS = (size_t)MROWS * 512;
    float acc[RWT];
#pragma unroll
    for (int dir = 0; dir < 2; ++dir) {
        lora_nt<96, RWT>(p.rw_w2 + (size_t)(l * 2 + dir) * 96 * 512, in, cc, acc);
        const float w0 = p.rw_w0[(l * 2 + dir) * 512 + cc];
#pragma unroll
        for (int t = 0; t < RWT; ++t) { const float wl = w0 + acc[t]; SA[(SA_RW0 + dir) * AS + (size_t)(row0 + t) * 512 + cc] = expf(-expf(-softplusf_(-wl) - 0.5f)); }
        lora_nt<96, RWT>(p.rw_a2 + (size_t)(l * 2 + dir) * 96 * 512, in + 96, cc, acc);
        const float a0 = p.rw_a0[(l * 2 + dir) * 512 + cc]; LAS float* bb = dir ? bufB : bufA;
#pragma unroll
        for (int t = 0; t < RWT; ++t) bb[t * 512 + cc] = sigmoidf_(a0 + acc[t]);
    }
    lora_nt<256, RWT>(p.rw_g2 + (size_t)l * 256 * 512, in + 192, cc, acc);
#pragma unroll
    for (int t = 0; t < RWT; ++t) SA[SA_RG * AS + (size_t)(row0 + t) * 512 + cc] = acc[t];
    const float kks = p.rw_kk[l * 512 + cc], kas = p.rw_ka[l * 512 + cc], rks = p.rw_rk[l * 512 + cc];
#pragma unroll 1
    for (int t = 0; t < RWT; ++t) { const int row = row0 + t; const size_t o = (size_t)row * 512 + cc;
        const float rf = rw_feat(Z, mu, row, cc), kf = rw_feat(Z, mu, row, 512 + cc), vf = rw_feat(Z, mu, row, 1024 + cc);
        const float kx = kf * kks; const float kkv = kx * rsqrtf(wave_sum(kx * kx) + 1e-6f);
        const float ic0 = bufA[t * 512 + cc], ic1 = bufB[t * 512 + cc];
        const float km0 = kf * (1.f + (ic0 - 1.f) * kas), km1 = kf * (1.f + (ic1 - 1.f) * kas);
        const float bonus = wave_sum(rf * rks * (km0 + km1));
        SA[SA_RK0 * AS + o] = km0; SA[SA_RK1 * AS + o] = km1; SA[SA_RB0 * AS + o] = kkv * ic0; SA[SA_RB1 * AS + o] = kkv * ic1;
        SA[SA_RAUX * AS + o] = bonus * vf; SA[SA_RR * AS + o] = rf; SA[SA_RV * AS + o] = vf; SA[SA_RA * AS + o] = -kkv; }
}
DI void phase_prep(Ctx& c, int l) {
    const Params& p = *c.p; const bf16* Z = (const bf16*)(c.ws + WS_Z); bf16* Y = (bf16*)(c.ws + WS_Y); const float* G32 = (const float*)(c.ws + WS_G32);
    float* SA = (float*)(c.ws + WS_S); float* SG = (float*)(c.ws + WS_SG);
    const int gw = c.bid * 8 + c.wave, NGW = c.G * 8; const int ch = c.lane * 8;
    for (int row = gw; row < MROWS; row += NGW) {
        int base, len, t; seq_of(row, base, len, t);
        float acc[8];
#pragma unroll
        for (int i = 0; i < 8; ++i) acc[i] = 0.f;
        const float* w = p.conv_dw + (size_t)l * 31 * 512;
        for (int j = 0; j < 31; ++j) { const int tt = t + j - 15; if (tt < 0 || tt >= len) continue;
            const bf16* zr = Z + (size_t)(base + tt) * NZ; float a[8], g[8], wv[8]; ld8(zr + ZA + ch, a); ld8(zr + ZAG + ch, g); ldf8(w + j * 512 + ch, wv);
#pragma unroll
            for (int i = 0; i < 8; ++i) acc[i] = fmaf(a[i] * sigmoidf_(g[i]), wv[i], acc[i]); }
        float bv[8]; ldf8(p.conv_b + l * 512 + ch, bv); float s = 0.f;
#pragma unroll
        for (int i = 0; i < 8; ++i) { acc[i] += bv[i]; s += acc[i]; }
        const float mean = wave_sum(s) * (1.f / 512.f); float q = 0.f;
#pragma unroll
        for (int i = 0; i < 8; ++i) { acc[i] -= mean; q += acc[i] * acc[i]; }
        const float rstd = rsqrtf(wave_sum(q) * (1.f / 512.f) + 1e-6f);
        float lg[8], lb[8], o[8]; ldf8(p.conv_ln_g + l * 512 + ch, lg); ldf8(p.conv_ln_b + l * 512 + ch, lb);
#pragma unroll
        for (int i = 0; i < 8; ++i) o[i] = siluf_(acc[i] * rstd * lg[i] + lb[i]);
        st8(Y + (size_t)row * D + ch, o);
    }
    {
        LAS float* in = (LAS float*)c.lds;
        const float* mu = p.rw_mu + (size_t)l * 2 * RWMIX;
        for (int u = c.bid; u < MROWS / 34; u += c.G) {
            const int row0 = u * 34;
            __syncthreads();
            for (int i = c.tid; i < 34 * 448; i += 512) { const int t = i / 448, k = i % 448; float f = rw_feat(Z, mu, row0 + t, 1536 + k);
                if (k < 96) f = tanhf(f); else if (k >= 192) f = sigmoidf_(f); in[i] = f; }
            __syncthreads();
            for (int hf = 0; hf < 34 / RWT; ++hf) rwkv_prep_rows(c, l, row0 + hf * RWT, in + hf * RWT * 448, in + 34 * 448, in + 34 * 448 + RWT * 512);
        }
        __syncthreads();
    }
    for (int u = c.bid; u < ML_NU; u += c.G) mlstm_local(c, l, u);
    for (int u = c.bid; u < GD_NU; u += c.G) gdn_local(c, l, u);
    __syncthreads();
}


DI void scan_mlstm(Ctx& c, int l, int chain) {
    const Params& p = *c.p; const bf16* Z = (const bf16*)(c.ws + WS_Z); const float* G32 = (const float*)(c.ws + WS_G32); float* SA = (float*)(c.ws + WS_S);
    const int g = chain >> 2, h = chain & 3, dir = g >> 1, b = g & 1; const int e = c.tid >> 2, dq = c.tid & 3;
    LAS float* sq = (LAS float*)c.lds; LAS float* sk = sq + 64 * 144; LAS float* sv = sk + 64 * 144; LAS float* sg = sv + 64 * 128;
    float* HM = SA + (size_t)(SA_HM0 + dir) * ((size_t)MROWS * 512);
    float C[32], nn[32], m = 0.f;
#pragma unroll
    for (int i = 0; i < 32; ++i) { C[i] = 0.f; nn[i] = 0.f; }
    const float gbi = p.ml_gate_b[((l * 2 + dir) * 2 + 0) * 4 + h], gbf = p.ml_gate_b[((l * 2 + dir) * 2 + 1) * 4 + h];
    for (int blk = 0; blk < (TC + T) / 64; ++blk) {
        __syncthreads();
        for (int it = c.tid; it < 64 * 48; it += 512) { const int tt = it / 48, r = it % 48, part = r >> 4, c8 = (r & 15) * 8; const int row = scan_row(dir, b, blk * 64 + tt);
            float v[8]; ld8(Z + (size_t)row * NZ + MLQ + part * 512 + h * 128 + c8, v);
            if (part == 2) {
#pragma unroll
                for (int i = 0; i < 8; ++i) sv[tt * 128 + c8 + i] = v[i]; }
            else { LAS float* d = (part == 0 ? sq : sk) + tt * 144 + (c8 >> 5) * 36 + (c8 & 31); const float sc = part == 0 ? 0.08838834764831845f : 1.f;
#pragma unroll
                for (int i = 0; i < 8; ++i) d[i] = v[i] * sc; } }
        if (c.tid < 64) { const int row = scan_row(dir, b, blk * 64 + c.tid); sg[c.tid * 2] = G32[(size_t)row * 32 + dir * 8 + h] + gbi; sg[c.tid * 2 + 1] = logsigmoidf_(G32[(size_t)row * 32 + dir * 8 + 4 + h] + gbf); }
        __syncthreads();
        for (int tt = 0; tt < 64; ++tt) {
            const float li = sg[2 * tt], lf = sg[2 * tt + 1]; const float mn = fmaxf(lf + m, li); const float fs = expf(lf + m - mn), is = expf(li - mn); m = mn;
            const float iv = is * sv[tt * 128 + e]; float hp = 0.f, dp = 0.f;
#pragma unroll
            for (int i4 = 0; i4 < 8; ++i4) { const f32x4 k4 = *(const LAS f32x4*)(sk + tt * 144 + dq * 36 + i4 * 4), q4 = *(const LAS f32x4*)(sq + tt * 144 + dq * 36 + i4 * 4);
#pragma unroll
                for (int j = 0; j < 4; ++j) { const int i = i4 * 4 + j; C[i] = fmaf(C[i], fs, iv * k4[j]); hp = fmaf(C[i], q4[j], hp); nn[i] = fmaf(nn[i], fs, is * k4[j]); dp = fmaf(nn[i], q4[j], dp); } }
            hp += __shfl_xor(hp, 1); hp += __shfl_xor(hp, 2); dp += __shfl_xor(dp, 1); dp += __shfl_xor(dp, 2);
            if (dq == 0) HM[(size_t)scan_row(dir, b, blk * 64 + tt) * 512 + h * 128 + e] = hp / fmaxf(fabsf(dp), expf(-m));
        }
    }
}
DI void scan_gdn(Ctx& c, int l, int chain) {
    float* SA = (float*)(c.ws + WS_S); const float* SG = (const float*)(c.ws + WS_SG); const size_t AS = (size_t)MROWS * 512;
    const int g = chain >> 2, h = chain & 3, dir = g >> 1, b = g & 1; const int e = c.tid >> 2, dq = c.tid & 3;
    LAS float* sq = (LAS float*)c.lds; LAS float* sk = sq + 64 * 144; LAS float* sv = sk + 64 * 144; LAS float* sg = sv + 64 * 128;
    float* HG = SA + (size_t)(SA_HG0 + dir) * AS;
    float S[32];
#pragma unroll
    for (int i = 0; i < 32; ++i) S[i] = 0.f;
    for (int blk = 0; blk < (TC + T) / 64; ++blk) {
        __syncthreads();
        for (int it = c.tid; it < 64 * 48; it += 512) { const int tt = it / 48, r = it % 48, part = r >> 4, c8 = (r & 15) * 8; const int row = scan_row(dir, b, blk * 64 + tt);
            float v[8]; ldf8(SA + (size_t)(SA_GQ + part) * AS + (size_t)row * 512 + h * 128 + c8, v);
            LAS float* d = part == 2 ? sv + tt * 128 + c8 : (part == 0 ? sq : sk) + tt * 144 + (c8 >> 5) * 36 + (c8 & 31);
#pragma unroll
            for (int i = 0; i < 8; ++i) d[i] = v[i]; }
        if (c.tid < 64) { const int row = scan_row(dir, b, blk * 64 + c.tid); sg[c.tid * 2] = expf(SG[(size_t)row * 16 + dir * 4 + h]); sg[c.tid * 2 + 1] = SG[(size_t)row * 16 + 8 + dir * 4 + h]; }
        __syncthreads();
        for (int tt = 0; tt < 64; ++tt) {
            const float a = sg[2 * tt], be = sg[2 * tt + 1]; float pp = 0.f; f32x4 k4[8];
#pragma unroll
            for (int i4 = 0; i4 < 8; ++i4) { k4[i4] = *(const LAS f32x4*)(sk + tt * 144 + dq * 36 + i4 * 4);
#pragma unroll
                for (int j = 0; j < 4; ++j) { const int i = i4 * 4 + j; S[i] *= a; pp = fmaf(k4[i4][j], S[i], pp); } }
            pp += __shfl_xor(pp, 1); pp += __shfl_xor(pp, 2);
            const float vn = be * (sv[tt * 128 + e] - pp); float o = 0.f;
#pragma unroll
            for (int i4 = 0; i4 < 8; ++i4) { const f32x4 q4 = *(const LAS f32x4*)(sq + tt * 144 + dq * 36 + i4 * 4);
#pragma unroll
                for (int j = 0; j < 4; ++j) { const int i = i4 * 4 + j; S[i] = fmaf(k4[i4][j], vn, S[i]); o = fmaf(q4[j], S[i], o); } }
            o += __shfl_xor(o, 1); o += __shfl_xor(o, 2);
            if (dq == 0) HG[(size_t)scan_row(dir, b, blk * 64 + tt) * 512 + h * 128 + e] = o;
        }
    }
}
DI void scan_rwkv(Ctx& c, int l, int chain) {
    float* SA = (float*)(c.ws + WS_S); const size_t AS = (size_t)MROWS * 512;
    const int g = chain >> 3, h = chain & 7, dir = g >> 1, b = g & 1; const int i = c.tid >> 3, part = c.tid & 7;
    LAS float* sr = (LAS float*)c.lds;
    float* HR = SA + (size_t)(SA_HR0 + dir) * AS;
    float S[8];
#pragma unroll
    for (int j = 0; j < 8; ++j) S[j] = 0.f;
    for (int blk = 0; blk < (TC + T) / 64; ++blk) {
        __syncthreads();
        for (int it = c.tid; it < 6 * 64 * 8; it += 512) { const int arr = it / 512, r = it % 512, tt = r >> 3, c8 = (r & 7) * 8; const int row = scan_row(dir, b, blk * 64 + tt);
            const int sa = arr == 0 ? SA_RR : arr == 1 ? SA_RW0 + dir : arr == 2 ? SA_RK0 + dir : arr == 3 ? SA_RV : arr == 4 ? SA_RA : SA_RB0 + dir;
            float v[8]; ldf8(SA + (size_t)sa * AS + (size_t)row * 512 + h * 64 + c8, v); LAS float* d = sr + arr * 4096 + tt * 64 + c8;
#pragma unroll
            for (int j = 0; j < 8; ++j) d[j] = v[j]; }
        __syncthreads();
        for (int tt = 0; tt < 64; ++tt) {
            const LAS float* bp = sr + tt * 64 + part * 8;
            float r8[8], w8[8], k8[8], a8[8], b8[8];
#pragma unroll
            for (int j = 0; j < 8; j += 4) { const f32x4 x0 = *(const LAS f32x4*)(bp + j), x1 = *(const LAS f32x4*)(bp + 4096 + j), x2 = *(const LAS f32x4*)(bp + 8192 + j), x4 = *(const LAS f32x4*)(bp + 16384 + j), x5 = *(const LAS f32x4*)(bp + 20480 + j);
#pragma unroll
                for (int q = 0; q < 4; ++q) { r8[j + q] = x0[q]; w8[j + q] = x1[q]; k8[j + q] = x2[q]; a8[j + q] = x4[q]; b8[j + q] = x5[q]; } }
            const float vi = sr[3 * 4096 + tt * 64 + i];
            float sa = 0.f;
#pragma unroll
            for (int j = 0; j < 8; ++j) sa = fmaf(S[j], a8[j], sa);
            sa += __shfl_xor(sa, 1); sa += __shfl_xor(sa, 2); sa += __shfl_xor(sa, 4);
            float y = 0.f;
#pragma unroll
            for (int j = 0; j < 8; ++j) { S[j] = fmaf(S[j], w8[j], fmaf(sa, b8[j], vi * k8[j])); y = fmaf(S[j], r8[j], y); }
            y += __shfl_xor(y, 1); y += __shfl_xor(y, 2); y += __shfl_xor(y, 4);
            if (part == 0) HR[(size_t)scan_row(dir, b, blk * 64 + tt) * 512 + h * 64 + i] = y;
        }
    }
}
DI void phase_scan(Ctx& c, int l) {
    mlstm_prefix(c);
    for (int u = c.bid; u < 32; u += c.G) scan_rwkv(c, l, u);
    for (int u = c.bid - 32; u < 128; u += c.G) if (u >= 0) gdn_prefix(c, u);
    __syncthreads();
}
DI void phase_finish(Ctx& c, int l) {
    const Params& p = *c.p; const bf16* Z = (const bf16*)(c.ws + WS_Z); bf16* Y = (bf16*)(c.ws + WS_Y); const float* SA = (const float*)(c.ws + WS_S); const size_t AS = (size_t)MROWS * 512;
    const int gw = c.bid * 8 + c.wave, NGW = c.G * 8; const int ch = c.lane * 8;
    for (int row = gw; row < MROWS; row += NGW) {
        const size_t ro = (size_t)row * 512 + ch;
        { float a[8], b[8], g[8], bb[8], ax[8], gg[8], y[8]; ldf8(SA + SA_HR0 * AS + ro, a); ldf8(SA + SA_HR1 * AS + ro, b); float s = 0.f;
#pragma unroll
          for (int i = 0; i < 8; ++i) { a[i] += b[i]; s += a[i]; }
          const float mean = grp_sum<8>(s) * (1.f / 64.f); float q = 0.f;
#pragma unroll
          for (int i = 0; i < 8; ++i) { a[i] -= mean; q += a[i] * a[i]; }
          const float rs = rsqrtf(grp_sum<8>(q) * (1.f / 64.f) + 64e-5f);
          ldf8(p.rw_ln_g + l * 512 + ch, g); ldf8(p.rw_ln_b + l * 512 + ch, bb); ldf8(SA + SA_RAUX * AS + ro, ax); ldf8(SA + SA_RG * AS + ro, gg);
#pragma unroll
          for (int i = 0; i < 8; ++i) y[i] = (a[i] * rs * g[i] + bb[i] + ax[i]) * gg[i];
          st8(Y + (size_t)row * D + 1536 + ch, y); }
    }
    for (int u = c.bid; u < NB * 4 * 68; u += c.G) mlstm_out(c, l, u);
    for (int u = c.bid; u < NB * 4 * 68; u += c.G) gdn_out(c, l, u);
    __syncthreads();
}
DI void phase_ffnconv(Ctx& c, int l) {
    const Params& p = *c.p; const bf16* UP = (const bf16*)(c.ws + WS_Z); bf16* H = (bf16*)(c.ws + WS_S); const float* w = p.ffn_dw + (size_t)l * 9 * DFF;
    constexpr int CPR = DFF / 8;
    for (int it = c.bid * 512 + c.tid; it < MROWS * CPR; it += c.G * 512) {
        const int row = it / CPR, ch = (it % CPR) * 8; float acc[8];
#pragma unroll
        for (int i = 0; i < 8; ++i) acc[i] = 0.f;
        if (row < LAT) { const int bb = row >> 12, t = row & 4095, gy = t >> 6, gx = t & 63;
#pragma unroll
            for (int dy = 0; dy < 3; ++dy)
#pragma unroll
                for (int dx = 0; dx < 3; ++dx) { const int yy = gy + dy - 1, xx = gx + dx - 1; if (yy < 0 || yy >= 64 || xx < 0 || xx >= 64) continue;
                    float a[8], wv[8]; ld8(UP + (size_t)(bb * T + yy * 64 + xx) * (2 * DFF) + ch, a); ldf8(w + (dy * 3 + dx) * DFF + ch, wv);
#pragma unroll
                    for (int i = 0; i < 8; ++i) acc[i] = fmaf(a[i], wv[i], acc[i]); } }
        else { const int r = row - LAT, t = r & (TC - 1);
#pragma unroll
            for (int dx = 0; dx < 3; ++dx) { const int tt = t + dx - 1; if (tt < 0 || tt >= TC) continue;
                float a[8], wv[8]; ld8(UP + (size_t)(row + dx - 1) * (2 * DFF) + ch, a); ldf8(w + (3 + dx) * DFF + ch, wv);
#pragma unroll
                for (int i = 0; i < 8; ++i) acc[i] = fmaf(a[i], wv[i], acc[i]); } }
        float v[8], o[8]; ld8(UP + (size_t)row * (2 * DFF) + DFF + ch, v);
#pragma unroll
        for (int i = 0; i < 8; ++i) o[i] = gelu_tanh(acc[i]) * v[i];
        st8(H + (size_t)row * DFF + ch, o);
    }
}

constexpr int PH_PRO = 3, PH_PER_LAYER = 11, NPHASE = PH_PRO + NL * PH_PER_LAYER;
#ifndef MK_PER_PHASE
#define MK_PER_PHASE 0
#endif
constexpr int CW_BAR = 4096;

__global__ void __launch_bounds__(512, 2) fwd_kernel(Params p) {
    extern __shared__ __attribute__((aligned(16))) unsigned char lds_raw[];
    Ctx c; c.lds = (LAS unsigned char*)lds_raw; c.tid = threadIdx.x; c.lane = c.tid & 63; c.wave = __builtin_amdgcn_readfirstlane(c.tid >> 6); c.G = gridDim.x; c.bid = blockIdx.x; c.p = &p; c.ws = p.ws;
    volatile LAS unsigned* MISC = (volatile LAS unsigned*)(c.lds + LDS_MISC);
    if (c.tid < 32) MISC[c.tid] = 0u;
    __syncthreads();
    const int lo = p.ph_lo, hi = p.ph_hi;
    XcdBarrier bar; bar.bar = (unsigned*)(p.ws + WS_CTL) + CW_BAR; bar.x = 0; bar.st = MISC + 8;
    if (hi - lo > 1) bar = xcd_barrier_post((unsigned*)(p.ws + WS_CTL) + CW_BAR, MISC + 8);
#ifndef PH_MASK
#define PH_MASK 0xFFFFFFFFu
#endif
#define IN(k) (lo <= (k) && (k) < hi)
#define EN(b) ((PH_MASK >> (b)) & 1u)
#define RF() do { int t_ = threadIdx.x; asm volatile("" : "+v"(t_)); c.tid = t_; c.lane = t_ & 63; } while (0)
#define SEAM(k) do { if (IN((k) + 1)) xcd_barrier(bar); } while (0)
    if (EN(0) && IN(0)) { RF(); phase_pro0(c); SEAM(0); }
    if (EN(1) && IN(1)) { RF(); phase_pro1(c); SEAM(1); }
    if (EN(2) && IN(2)) { RF(); phase_pro2(c); phase_wconv(c, 0); SEAM(2); }
    bf16* U = (bf16*)(p.ws + WS_U); bf16* Y = (bf16*)(p.ws + WS_Y); bf16* MB = (bf16*)(p.ws + WS_MB); float* G32 = (float*)(p.ws + WS_G32); float* F = (float*)(p.ws + WS_F);
    bf16* Z = (bf16*)(p.ws + WS_Z); bf16* H = (bf16*)(p.ws + WS_S);
    for (int l = 0; l < NL; ++l) {
        const int pb = PH_PRO + l * PH_PER_LAYER; unsigned char* wl = p.ws + WS_W;
        if (EN(3) && IN(pb + 0)) { pg8::Gemm g{U, (const bf16*)(wl + WL_IN), D, D, D}; pg8::StdOrder S; S.init(MROWS / 256, NZ / 256, c.G, c.bid); pg8::EpiBf16 E{Z, NZ, G32, (ZSM - 192) / 256};
            pg8::gemm_phase(c.lds, g, S, E); SEAM(pb + 0); }
        if (EN(4) && IN(pb + 1)) { RF(); phase_prep(c, l); SEAM(pb + 1); }
        if (EN(5) && IN(pb + 2)) { RF(); phase_scan(c, l); SEAM(pb + 2); }
        if (EN(6) && IN(pb + 3)) { RF(); phase_finish(c, l); SEAM(pb + 3); }
        if (EN(7) && IN(pb + 4)) { pg8::Gemm g{Y, (const bf16*)(wl + WL_BR), D, MIXW, MIXW}; pg8::MergeOrder S; S.init(MROWS / 256, D / 256, c.G, c.bid); pg8::EpiMerge E{Z, NZ, ZG, F, MB, D};
            pg8::gemm_phase(c.lds, g, S, E); SEAM(pb + 4); }
        if (EN(8) && IN(pb + 5)) { pg8::Gemm g{MB, (const bf16*)(wl + WL_OUT), D, D, D}; pg8::StdOrder S; S.init(MROWS / 256, D / 256, c.G, c.bid); pg8::EpiF32 E{F, D};
            pg8::gemm_phase(c.lds, g, S, E); SEAM(pb + 5); }
        if (EN(9) && IN(pb + 6)) { RF(); phase_resid(c, l, 0); SEAM(pb + 6); }
        if (EN(10) && IN(pb + 7)) { pg8::Gemm g{U, (const bf16*)(wl + WL_UP), D, D, D}; pg8::StdOrder S; S.init(MROWS / 256, 2 * DFF / 256, c.G, c.bid); pg8::EpiBf16 E{Z, 2 * DFF, nullptr, -1};
            pg8::gemm_phase(c.lds, g, S, E); SEAM(pb + 7); }
        if (EN(11) && IN(pb + 8)) { RF(); phase_ffnconv(c, l); SEAM(pb + 8); }
        if (EN(12) && IN(pb + 9)) { pg8::Gemm g{H, (const bf16*)(wl + WL_DN), DFF, DFF, DFF}; pg8::StdOrder S; S.init(MROWS / 256, D / 256, c.G, c.bid); pg8::EpiF32 E{F, D};
            pg8::gemm_phase(c.lds, g, S, E); SEAM(pb + 9); }
        if (EN(13) && IN(pb + 10)) { RF(); phase_resid(c, l, 1); if (l + 1 < NL) phase_wconv(c, l + 1); SEAM(pb + 10); }
    }
#undef IN
#undef SEAM
}

extern "C" void kernel_launch(void* const* d_in, const int* in_sizes, int n_in, void* d_out, int out_size, void* d_ws, size_t ws_size, hipStream_t stream) {
    static int grid = 0;
    if (grid == 0) {
        if (n_in != 34 || ws_size < WS_END) { fprintf(stderr, "kernel_launch: unexpected n_in %d / ws %zu (need %zu)\n", n_in, ws_size, (size_t)WS_END); grid = -1; return; }
        int dev = 0, cus = 0;
        if (hipGetDevice(&dev) != hipSuccess || hipDeviceGetAttribute(&cus, hipDeviceAttributeMultiprocessorCount, dev) != hipSuccess) { grid = -1; return; }
        if (hipFuncSetAttribute((const void*)fwd_kernel, hipFuncAttributeMaxDynamicSharedMemorySize, LDS_BYTES) != hipSuccess) { fprintf(stderr, "kernel_launch: hipFuncSetAttribute failed\n"); grid = -1; return; }
        int per_cu = 0;
        if (hipOccupancyMaxActiveBlocksPerMultiprocessor(&per_cu, (const void*)fwd_kernel, 512, LDS_BYTES) != hipSuccess || per_cu < 1) { fprintf(stderr, "kernel_launch: occupancy query says %d\n", per_cu); }
        (void)hipGetLastError();
        grid = cus;
    }
    if (grid < 0) return;
    (void)hipMemsetAsync((char*)d_ws + WS_CTL, 0, CTL_BYTES, stream);
    Params p{};
    const float** pp = (const float**)&p;
    for (int i = 0; i < 34; ++i) pp[i] = (const float*)d_in[i];
    p.out = (float*)d_out; p.ws = (unsigned char*)d_ws;
#if MK_PER_PHASE
    for (int k = 0; k < NPHASE; ++k) { p.ph_lo = k; p.ph_hi = k + 1; hipLaunchKernelGGL(fwd_kernel, dim3(grid), dim3(512), LDS_BYTES, stream, p); }
#else
    p.ph_lo = 0; p.ph_hi = NPHASE; hipLaunchKernelGGL(fwd_kernel, dim3(grid), dim3(512), LDS_BYTES, stream, p);
#endif
}
```

```cpp
#include <hip/hip_runtime.h>
#include <cstdio>
#include <cstdint>

#define GAS __attribute__((address_space(1)))
#define LAS __attribute__((address_space(3)))
#define DI __device__ __forceinline__
typedef unsigned short bf16;
typedef float f32x4 __attribute__((ext_vector_type(4)));
typedef float f32x2 __attribute__((ext_vector_type(2)));
typedef unsigned u32x4 __attribute__((ext_vector_type(4)));
typedef unsigned u32x2 __attribute__((ext_vector_type(2)));
typedef short bf16x8 __attribute__((ext_vector_type(8)));

constexpr int D = 2048, NB = 2, T = 4096, TC = 256, NL = 4;
constexpr int LAT = NB * T;
constexpr int MROWS = LAT + NB * TC;
constexpr int MIXW = 512, DFF = 5632;
constexpr int NIN = 15328, NZ = 15360;
constexpr int ZA = 0, ZAG = 512, MLQ = 1024, MLK = 1536, MLV = 2048, MLO = 2560, GDQ = 3072, GDK = 3584, GDV = 4096, GDZ = 4608;
constexpr int RWR = 5120, RWK = 5632, RWV = 6144, RWXW = 6656, RWXA = 6752, RWXG = 6848, ZG = 7104, ZSM = 15296;
constexpr int RWMIX = 1984;

namespace pg8 {
typedef unsigned short bf16_t;
constexpr int BM = 256, BK = 64, HALF = 128, HTB = HALF * BK * 2, STAGE_BYTES = 8 * HTB, NXCD = 8, WGM = 8;
__host__ __device__ __forceinline__ int lds_byte(int r, int c) { const int st = (r >> 4) * 2 + (c >> 5), rr = r & 15, cc = c & 31, ob = rr * 64 + cc * 2; return st * 1024 + (ob ^ (((ob >> 9) & 1) << 5)); }
__host__ __device__ __forceinline__ void stage_rc(int b, int& R, int& C) { const int st = b / 1024, sb = b % 1024, swz = sb ^ (((sb >> 9) & 1) << 5); R = (st >> 1) * 16 + swz / 64; C = (st & 1) * 32 + (swz % 64) / 2; }
__host__ __device__ __forceinline__ int perm32(int rho) { const int n = rho >> 4, i = rho & 15; return 8 * (i >> 2) + 4 * n + (i & 3); }

struct Unit { int pm, pn, sub; };
struct Gemm { const bf16_t* A; const bf16_t* Bt; int lda, ldb, K; };

struct StdOrder {
    int nM, nN, nwg, G, c;
    DI void init(int nM_, int nN_, int G_, int c_) { nM = nM_; nN = nN_; nwg = nM * nN; G = G_; c = c_; }
    DI bool map(int i, Unit& u) const {
        const long L = (long)i * G + c; if (L >= nwg) return false;
        int wgid = (int)L; { const int q = nwg / NXCD, r = nwg % NXCD, xcd = wgid % NXCD, off = wgid / NXCD; wgid = (xcd < r ? xcd * (q + 1) : r * (q + 1) + (xcd - r) * q) + off; }
        const int nig = WGM * nN, gid = wgid / nig, fm = gid * WGM, gsz = (nM - fm) < WGM ? (nM - fm) : WGM;
        u.pm = fm + ((wgid % nig) % gsz); u.pn = (wgid % nig) / gsz; return true;
    }
    DI bool next(int i, Unit& u) const { u.sub = 0; return map(i, u); }
    DI const char* a_ptr(const Gemm& g, const Unit& u) const { return (const char*)g.A + (size_t)u.pm * BM * g.lda * 2; }
    DI const char* b_ptr(const Gemm& g, const Unit& u) const { return (const char*)g.Bt + (size_t)u.pn * BM * g.ldb * 2; }
};
struct MergeOrder : StdOrder {
    DI bool next(int i4, Unit& u) const { u.sub = i4 & 3; return map(i4 >> 2, u); }
    DI const char* a_ptr(const Gemm& g, const Unit& u) const { return (const char*)g.A + (size_t)u.pm * BM * g.lda * 2 + (size_t)u.sub * 512 * 2; }
    DI const char* b_ptr(const Gemm& g, const Unit& u) const { return (const char*)g.Bt + ((size_t)u.sub * 2048 + (size_t)u.pn * BM) * g.ldb * 2; }
};

DI unsigned cvt_pk_bf16(float lo, float hi) { unsigned r; asm volatile("v_cvt_pk_bf16_f32 %0, %1, %2" : "=v"(r) : "v"(lo), "v"(hi)); return r; }

struct EpiF32 {
    static constexpr bool PERM = false;
    float* C; int ldc;
    DI void operator()(const f32x4 (&acc)[2][2][4][2], const Unit& u, int wr, int wc, int fr, int fq) const {
        const int row0 = u.pm * BM + wr * 64 + fr, col0 = u.pn * BM + wc * 32 + 4 * fq;
#pragma unroll
        for (int ai = 0; ai < 2; ++ai)
#pragma unroll
            for (int m = 0; m < 4; ++m) { float* rowp = C + (size_t)(row0 + ai * HALF + m * 16) * ldc + col0;
#pragma unroll
                for (int bj = 0; bj < 2; ++bj)
#pragma unroll
                    for (int n = 0; n < 2; ++n) *(f32x4*)(rowp + bj * HALF + n * 16) = acc[ai][bj][m][n]; }
    }
};
struct EpiBf16 {
    static constexpr bool PERM = true;
    bf16_t* O; int ldc; float* G32; int gtile;
    DI void operator()(const f32x4 (&acc)[2][2][4][2], const Unit& u, int wr, int wc, int fr, int fq) const {
        const int row0 = u.pm * BM + wr * 64 + fr; const int col0 = u.pn * BM + wc * 32 + 8 * fq;
#pragma unroll
        for (int ai = 0; ai < 2; ++ai)
#pragma unroll
            for (int m = 0; m < 4; ++m) { const int row = row0 + ai * HALF + m * 16; bf16_t* rowp = O + (size_t)row * ldc + col0;
#pragma unroll
                for (int bj = 0; bj < 2; ++bj) { const f32x4 v0 = acc[ai][bj][m][0], v1 = acc[ai][bj][m][1];
                    u32x4 w; w.x = cvt_pk_bf16(v0[0], v0[1]); w.y = cvt_pk_bf16(v0[2], v0[3]); w.z = cvt_pk_bf16(v1[0], v1[1]); w.w = cvt_pk_bf16(v1[2], v1[3]);
                    *(u32x4*)(rowp + bj * HALF) = w;
                    if (bj == 1 && G32 != nullptr && u.pn == gtile && wc == 2) { float* gp = G32 + (size_t)row * 32 + 8 * fq; *(f32x4*)gp = v0; *(f32x4*)(gp + 4) = v1; } } }
    }
};
struct EpiMerge {
    static constexpr bool PERM = true;
    const bf16_t* Z; int ldz; int zg; float* P; bf16_t* Mb; int ldc;
    DI void operator()(const f32x4 (&acc)[2][2][4][2], const Unit& u, int wr, int wc, int fr, int fq) const {
        const int row0 = u.pm * BM + wr * 64 + fr; const int col0 = u.pn * BM + wc * 32 + 8 * fq;
#pragma unroll
        for (int ai = 0; ai < 2; ++ai)
#pragma unroll
            for (int m = 0; m < 4; ++m) { const int row = row0 + ai * HALF + m * 16;
#pragma unroll
                for (int bj = 0; bj < 2; ++bj) { const int col = col0 + bj * HALF;
                    const u32x4 gw = *(const u32x4*)(Z + (size_t)row * ldz + zg + u.sub * 2048 + col);
                    float gt[8];
#pragma unroll
                    for (int j = 0; j < 4; ++j) { gt[2 * j] = __uint_as_float(gw[j] << 16); gt[2 * j + 1] = __uint_as_float(gw[j] & 0xffff0000u); }
                    f32x4 v0 = acc[ai][bj][m][0], v1 = acc[ai][bj][m][1];
#pragma unroll
                    for (int j = 0; j < 4; ++j) { v0[j] *= 1.f / (1.f + __expf(-gt[j])); v1[j] *= 1.f / (1.f + __expf(-gt[4 + j])); }
                    float* pp = P + (size_t)row * ldc + col;
                    if (u.sub > 0) { v0 += *(const f32x4*)pp; v1 += *(const f32x4*)(pp + 4); }
                    if (u.sub < 3) { *(f32x4*)pp = v0; *(f32x4*)(pp + 4) = v1; }
                    else { u32x4 w; w.x = cvt_pk_bf16(v0[0], v0[1]); w.y = cvt_pk_bf16(v0[2], v0[3]); w.z = cvt_pk_bf16(v1[0], v1[1]); w.w = cvt_pk_bf16(v1[2], v1[3]);
                        *(u32x4*)(Mb + (size_t)row * ldc + col) = w; } } }
    }
};

template <class Epi, class Sched>
DI void gemm_phase(LAS unsigned char* lds, const Gemm g, const Sched& S, const Epi& E) {
    int tid_ = threadIdx.x; asm volatile("" : "+v"(tid_));
    const int tid = tid_, wid = __builtin_amdgcn_readfirstlane(tid >> 6), lane = tid & 63, wr = wid >> 2, wc = wid & 3, fr = lane & 15, fq = lane >> 4;
    const int K = g.K, nt = K / BK;
    unsigned voffA[2], voffB[2];
#pragma unroll
    for (int i = 0; i < 2; ++i) { int R, C; stage_rc(tid * 16 + i * 8192, R, C); const int Rb = Epi::PERM ? ((R & ~31) + perm32(R & 31)) : R;
        voffA[i] = (unsigned)(R * g.lda + C) * 2u; voffB[i] = (unsigned)(Rb * g.ldb + C) * 2u; }
    const size_t kstep = (size_t)(BK * 2);
    const size_t hstepA = (size_t)HALF * g.lda * 2, hstepB = (size_t)HALF * g.ldb * 2;
    const unsigned ldsw = (unsigned)wid * 1024u;
    const int aoff = lds_byte(wr * 64 + fr, fq * 8), boff = lds_byte(wc * 32 + fr, fq * 8);
#define PG8_SA(b, h) (((b) * 2 + (h)) * HTB)
#define PG8_SB(b, h) ((4 + (b) * 2 + (h)) * HTB)
#define PG8_STAGE(bufoff, gbase, voff) do { _Pragma("unroll") for (int _i = 0; _i < 2; ++_i) \
        __builtin_amdgcn_global_load_lds((const unsigned*)((const char*)(gbase) + (voff)[_i]), (LAS unsigned*)(lds + (bufoff) + ldsw + _i * 8192), 16, 0, 0); } while (0)
#define PG8_LDA(dst, b, h) do { _Pragma("unroll") for (int m = 0; m < 4; ++m) _Pragma("unroll") for (int k = 0; k < 2; ++k) dst[m][k] = *(const LAS bf16x8*)(lds + PG8_SA(b, h) + aoff + m * 2048 + k * 1024); } while (0)
#define PG8_LDB(dst, b, h) do { _Pragma("unroll") for (int n = 0; n < 2; ++n) _Pragma("unroll") for (int k = 0; k < 2; ++k) dst[n][k] = *(const LAS bf16x8*)(lds + PG8_SB(b, h) + boff + n * 2048 + k * 1024); } while (0)
#define PG8_MMA(ai, bj, At, Bt) do { __builtin_amdgcn_s_setprio(1); _Pragma("unroll") for (int m = 0; m < 4; ++m) _Pragma("unroll") for (int n = 0; n < 2; ++n) _Pragma("unroll") for (int k = 0; k < 2; ++k) \
        acc[ai][bj][m][n] = __builtin_amdgcn_mfma_f32_16x16x32_bf16(Bt[n][k], At[m][k], acc[ai][bj][m][n], 0, 0, 0); __builtin_amdgcn_s_setprio(0); } while (0)
#define PG8_WAIT_V(n) asm volatile("s_waitcnt vmcnt(" #n ")" ::: "memory")
#define PG8_WAIT_L(n) asm volatile("s_waitcnt lgkmcnt(" #n ")" ::: "memory")
#define PG8_BAR __builtin_amdgcn_s_barrier()
#define PG8_SCHED __builtin_amdgcn_sched_barrier(0)
    Unit cur, nxt; int ui = 0;
    if (!S.next(0, cur)) return;
    f32x4 acc[2][2][4][2];
#pragma unroll
    for (int a = 0; a < 2; ++a)
#pragma unroll
        for (int b = 0; b < 2; ++b)
#pragma unroll
            for (int m = 0; m < 4; ++m)
#pragma unroll
                for (int n = 0; n < 2; ++n) acc[a][b][m][n] = (f32x4){0.f, 0.f, 0.f, 0.f};
    bf16x8 At[4][2], B0[2][2], B1[2][2];
    const char* cA = S.a_ptr(g, cur); const char* cB = S.b_ptr(g, cur);
    PG8_STAGE(PG8_SB(0, 0), cB, voffB); PG8_STAGE(PG8_SB(0, 1), cB + hstepB, voffB); PG8_STAGE(PG8_SA(0, 0), cA, voffA); PG8_STAGE(PG8_SA(0, 1), cA + hstepA, voffA);
    if (wr == 1) PG8_BAR;
    PG8_WAIT_V(2); PG8_BAR;
    PG8_STAGE(PG8_SB(1, 0), cB + kstep, voffB); PG8_STAGE(PG8_SA(1, 0), cA + kstep, voffA); PG8_STAGE(PG8_SB(1, 1), cB + hstepB + kstep, voffB);
    PG8_WAIT_V(6); PG8_BAR;
    for (;;) {
        const bool has_next = S.next(ui + 1, nxt);
        const char* nA = has_next ? S.a_ptr(g, nxt) : cA; const char* nB = has_next ? S.b_ptr(g, nxt) : cB;
        for (int t = 0; t < nt; t += 2) {
            const bool last = (t == nt - 2);
            const char* a1 = cA + (size_t)(t + 1) * kstep;
            const char* a2 = last ? nA : cA + (size_t)(t + 2) * kstep; const char* b2 = last ? nB : cB + (size_t)(t + 2) * kstep;
            const char* a3 = a2 + kstep; const char* b3 = b2 + kstep;
            PG8_LDB(B0, 0, 0); PG8_LDB(B1, 0, 1); PG8_SCHED; PG8_LDA(At, 0, 0); PG8_STAGE(PG8_SA(1, 1), a1 + hstepA, voffA);
            PG8_WAIT_V(8); PG8_WAIT_L(0); PG8_BAR; PG8_MMA(0, 0, At, B0); PG8_MMA(0, 1, At, B1); PG8_BAR; PG8_SCHED;
            PG8_LDA(At, 0, 1); PG8_STAGE(PG8_SB(0, 0), b2, voffB); PG8_STAGE(PG8_SB(0, 1), b2 + hstepB, voffB); PG8_STAGE(PG8_SA(0, 0), a2, voffA);
            PG8_WAIT_V(8); PG8_WAIT_L(0); PG8_BAR; PG8_MMA(1, 0, At, B0); PG8_MMA(1, 1, At, B1); PG8_BAR; PG8_SCHED;
            PG8_LDB(B0, 1, 0); PG8_LDB(B1, 1, 1); PG8_SCHED; PG8_LDA(At, 1, 0); PG8_STAGE(PG8_SA(0, 1), a2 + hstepA, voffA);
            PG8_WAIT_V(8); PG8_WAIT_L(0); PG8_BAR; PG8_MMA(0, 0, At, B0); PG8_MMA(0, 1, At, B1); PG8_BAR; PG8_SCHED;
            PG8_LDA(At, 1, 1); PG8_STAGE(PG8_SB(1, 0), b3, voffB); PG8_STAGE(PG8_SB(1, 1), b3 + hstepB, voffB); PG8_STAGE(PG8_SA(1, 0), a3, voffA);
            PG8_WAIT_V(8); PG8_WAIT_L(0); PG8_BAR; PG8_MMA(1, 0, At, B0); PG8_MMA(1, 1, At, B1); PG8_BAR; PG8_SCHED;
        }
        if (wr == 0) PG8_BAR;
        E(acc, cur, wr, wc, fr, fq);
        if (!has_next) break;
#pragma unroll
        for (int a = 0; a < 2; ++a)
#pragma unroll
            for (int b = 0; b < 2; ++b)
#pragma unroll
                for (int m = 0; m < 4; ++m)
#pragma unroll
                    for (int n = 0; n < 2; ++n) acc[a][b][m][n] = (f32x4){0.f, 0.f, 0.f, 0.f};
        cur = nxt; cA = nA; cB = nB; ++ui;
        if (wr == 1) PG8_BAR;
    }
    PG8_WAIT_V(0);
    PG8_BAR;
#undef PG8_SA
#undef PG8_SB
#undef PG8_STAGE
#undef PG8_LDA
#undef PG8_LDB
#undef PG8_MMA
#undef PG8_WAIT_V
#undef PG8_WAIT_L
#undef PG8_BAR
#undef PG8_SCHED
}
}

constexpr size_t al256(size_t x) { return (x + 255) & ~(size_t)255; }
constexpr size_t WS_CTL = 0, CTL_BYTES = 1u << 20;
constexpr size_t WS_MODP = WS_CTL + CTL_BYTES;
constexpr size_t WS_MOD = WS_MODP + al256((size_t)NL * 8 * 3 * 12288 * 4);
constexpr size_t WS_W = WS_MOD + al256((size_t)NL * 3 * 12288 * 4);
constexpr size_t WL_IN = 0, WL_BR = WL_IN + (size_t)NZ * D * 2, WL_OUT = WL_BR + (size_t)4 * D * MIXW * 2, WL_UP = WL_OUT + (size_t)D * D * 2,
                 WL_DN = WL_UP + (size_t)2 * DFF * D * 2, WL_SIZE = WL_DN + (size_t)D * DFF * 2;
constexpr size_t WS_U = WS_W + WL_SIZE;
constexpr size_t WS_Y = WS_U + (size_t)MROWS * D * 2;
constexpr size_t WS_MB = WS_Y + (size_t)MROWS * D * 2;
constexpr size_t WS_G32 = WS_MB + (size_t)MROWS * D * 2;
constexpr size_t WS_X = WS_G32 + (size_t)MROWS * 32 * 4;
constexpr size_t WS_F = WS_X + (size_t)MROWS * D * 4;
constexpr size_t WS_Z = WS_F + (size_t)MROWS * D * 4;
constexpr size_t WS_S = WS_Z + (size_t)MROWS * NZ * 2;
constexpr size_t SARR = (size_t)MROWS * MIXW * 4;
constexpr int N_SARR = 20;
constexpr size_t WS_SG = WS_S + N_SARR * SARR;
constexpr size_t WS_ML = WS_SG + (size_t)MROWS * 16 * 4;
constexpr int ML_US = 16640, ML_NL = 16384, ML_HDR = 16512, ML_NU = 16 * 68;
constexpr size_t WS_MLC = WS_ML + (size_t)ML_NU * ML_US * 4;
constexpr int MLC_US = 144 * 128;
constexpr size_t WS_MLM = WS_MLC + (size_t)ML_NU * MLC_US * 2;
constexpr size_t WS_GDA = WS_MLM + al256((size_t)ML_NU * 4);
constexpr int GD_NU = 16 * 68;
constexpr size_t WS_GDB = WS_GDA + (size_t)GD_NU * 16384 * 2;
constexpr size_t WS_GDU = WS_GDB + (size_t)GD_NU * 16384 * 4;
constexpr size_t WS_GDW = WS_GDU + (size_t)GD_NU * 8192 * 4;
constexpr size_t WS_GDAT = WS_GDW + (size_t)GD_NU * 8192 * 2;
constexpr size_t WS_GDQ = WS_GDAT + (size_t)GD_NU * 4096 * 2;
constexpr size_t WS_GDS = WS_GDQ + (size_t)GD_NU * 8192 * 2;
constexpr int RW_NU = 32 * 68;
constexpr size_t WS_RQE = WS_GDS + (size_t)GD_NU * 16384 * 2;
constexpr size_t WS_RYL = WS_RQE + (size_t)RW_NU * 4096 * 2;
constexpr size_t WS_RAC = WS_RYL + (size_t)RW_NU * 4096 * 4;
constexpr size_t WS_RBC = WS_RAC + (size_t)RW_NU * 4096 * 2;
constexpr size_t WS_RPT = WS_RBC + (size_t)RW_NU * 4096 * 4;
constexpr size_t WS_END = WS_RPT + (size_t)RW_NU * 4096 * 2;
static_assert((size_t)MROWS * DFF * 2 <= N_SARR * SARR && (size_t)MROWS * 2 * DFF * 2 <= (size_t)MROWS * NZ * 2, "aliases");
static_assert(WS_END < 1590000000ull, "workspace budget");
enum { SA_GQ = 0, SA_GK, SA_GV, SA_RR, SA_RV, SA_RA, SA_RW0, SA_RW1, SA_RK0, SA_RK1, SA_RB0, SA_RB1, SA_RAUX, SA_RG, SA_HM0, SA_HM1, SA_HG0, SA_HG1, SA_HR0, SA_HR1 };

constexpr int LDS_RING = 131072, LDS_BYTES = 147456, LDS_MISC = LDS_BYTES - 128;

#define XB_TMO      128
#define XB_XCNT(j)  (256  + 64 * (j))
#define XB_XSUB(j)  (1280 + 64 * (j))
#define XB_XGEN(j)  (2304 + 64 * (j))
#define XB_TOP      3328
#define XB_TOPGEN   3392
#define XCD_BAR_WORDS 3456
#define XB_SPIN_CAP (1u << 18)
__device__ __forceinline__ unsigned xb_ld(unsigned* p)              { return __hip_atomic_load(p, __ATOMIC_RELAXED, __HIP_MEMORY_SCOPE_AGENT); }
__device__ __forceinline__ unsigned xb_add(unsigned* p, unsigned v) { return __hip_atomic_fetch_add(p, v, __ATOMIC_RELAXED, __HIP_MEMORY_SCOPE_AGENT); }
__device__ __forceinline__ unsigned xb_xcc_id() { return (unsigned)__builtin_amdgcn_s_getreg((3 << 11) | 20) & 0xFu; }
#define XB_SPIN(cond, bar) do { unsigned _sp = 0; while (cond) { __builtin_amdgcn_s_sleep(1); \
    if ((++_sp & 255u) == 0u) { if (xb_ld(&(bar)[XB_TMO])) break; if (_sp > XB_SPIN_CAP) { atomicAdd(&(bar)[XB_TMO], 1u); break; } } } } while (0)
struct XcdBarrier { unsigned* bar; unsigned x; volatile LAS unsigned* st; };
__device__ __forceinline__ XcdBarrier xcd_barrier_post(unsigned* bar, volatile LAS unsigned* st) {
    XcdBarrier b; b.bar = bar; b.x = xb_xcc_id(); b.st = st;
    if (threadIdx.x == 0) (void)xb_add(&bar[XB_XCNT(b.x)], 1u);
    return b;
}
__device__ __forceinline__ void xcd_barrier_complete(unsigned* bar, unsigned x, unsigned& nloc, unsigned& nx) {
    const unsigned G = gridDim.x * gridDim.y * gridDim.z;
    unsigned sum, cnt, mine, sp = 0u;
    for (;;) {
        sum = 0u; cnt = 0u; mine = 0u;
#pragma unroll
        for (unsigned j = 0; j < 16; ++j) { const unsigned c = xb_ld(&bar[XB_XCNT(j)]); sum += c; cnt += (c > 0u) ? 1u : 0u; mine = (j == x) ? c : mine; }
        if (sum == G) break;
        __builtin_amdgcn_s_sleep(1);
        if ((++sp & 255u) == 0u) { if (xb_ld(&bar[XB_TMO])) break; if (sp > XB_SPIN_CAP) { atomicAdd(&bar[XB_TMO], 1u); break; } }
    }
    nloc = mine > 0u ? mine : 1u; nx = cnt > 0u ? cnt : 1u;
}
__device__ __forceinline__ void xcd_barrier(const XcdBarrier& b) {
    asm volatile("s_waitcnt vmcnt(0)" ::: "memory");
    __syncthreads();
    if (threadIdx.x == 0) {
        unsigned* bar = b.bar;
        __builtin_amdgcn_s_waitcnt(0);
        unsigned nloc = b.st[0], nx = b.st[1];
        if (nloc == 0u) { xcd_barrier_complete(bar, b.x, nloc, nx); b.st[0] = nloc; b.st[1] = nx; }
        const unsigned old = xb_add(&bar[XB_XSUB(b.x)], 1u);
        const unsigned gen = old / nloc;
        if (old + 1u == (gen + 1u) * nloc) {
            __builtin_amdgcn_fence(__ATOMIC_RELEASE, "agent");
            asm volatile("s_waitcnt vmcnt(0)" ::: "memory");
            const unsigned og = xb_add(&bar[XB_TOP], 1u);
            const unsigned tg = og / nx;
            if (og + 1u == (tg + 1u) * nx) xb_add(&bar[XB_TOPGEN], 1u);
            else XB_SPIN(xb_ld(&bar[XB_TOPGEN]) == tg, bar);
            __builtin_amdgcn_fence(__ATOMIC_ACQUIRE, "agent");
            xb_add(&bar[XB_XGEN(b.x)], 1u);
            asm volatile("s_waitcnt vmcnt(0)" ::: "memory");
        } else {
            XB_SPIN(xb_ld(&bar[XB_XGEN(b.x)]) == gen, bar);
            __builtin_amdgcn_fence(__ATOMIC_ACQUIRE, "agent");
            asm volatile("s_waitcnt vmcnt(0)" ::: "memory");
        }
    }
    __syncthreads();
}

struct Params {
    const float *x, *c, *ctx, *c_ctx, *w_mod, *b_mod, *norm_g, *w_in, *conv_dw, *conv_b, *conv_ln_g, *conv_ln_b, *ml_gate_b, *ml_norm_g,
        *gd_conv, *gd_a_log, *gd_dt_bias, *gd_norm_g, *rw_mu, *rw_w0, *rw_w2, *rw_a0, *rw_a2, *rw_g2, *rw_kk, *rw_ka, *rw_rk, *rw_ln_g, *rw_ln_b,
        *w_br, *w_out, *ffn_up, *ffn_dw, *ffn_down;
    float* out; unsigned char* ws; int ph_lo, ph_hi;
};

DI float bf2f(unsigned short u) { return __uint_as_float(((unsigned)u) << 16); }
DI unsigned f2bf(float f) { unsigned u = __float_as_uint(f); return (u + 0x7fffu + ((u >> 16) & 1u)) >> 16; }
DI unsigned pk2(float lo, float hi) { return f2bf(lo) | (f2bf(hi) << 16); }
DI void ld8(const bf16* p, float (&o)[8]) { const u32x4 w = *(const u32x4*)p;
#pragma unroll
    for (int j = 0; j < 4; ++j) { o[2 * j] = __uint_as_float(w[j] << 16); o[2 * j + 1] = __uint_as_float(w[j] & 0xffff0000u); } }
DI void st8(bf16* p, const float (&v)[8]) { u32x4 w; w.x = pk2(v[0], v[1]); w.y = pk2(v[2], v[3]); w.z = pk2(v[4], v[5]); w.w = pk2(v[6], v[7]); *(u32x4*)p = w; }
DI void ldf8(const float* p, float (&o)[8]) { const f32x4 a = *(const f32x4*)p, b = *(const f32x4*)(p + 4);
    o[0] = a[0]; o[1] = a[1]; o[2] = a[2]; o[3] = a[3]; o[4] = b[0]; o[5] = b[1]; o[6] = b[2]; o[7] = b[3]; }
DI void stf8(float* p, const float (&v)[8]) { *(f32x4*)p = (f32x4){v[0], v[1], v[2], v[3]}; *(f32x4*)(p + 4) = (f32x4){v[4], v[5], v[6], v[7]}; }
DI float wave_sum(float v) {
#pragma unroll
    for (int o = 1; o < 64; o <<= 1) v += __shfl_xor(v, o);
    return v; }
template <int W> DI float grp_sum(float v) {
#pragma unroll
    for (int o = 1; o < W; o <<= 1) v += __shfl_xor(v, o);
    return v; }
DI float sigmoidf_(float x) { return 1.f / (1.f + __expf(-x)); }
DI float siluf_(float x) { return x / (1.f + __expf(-x)); }
DI float softplusf_(float x) { return fmaxf(x, 0.f) + log1pf(__expf(-fabsf(x))); }
DI float logsigmoidf_(float x) { return fminf(x, 0.f) - log1pf(__expf(-fabsf(x))); }
DI float gelu_tanh(float x) { const float u = 0.7978845608028654f * (x + 0.044715f * x * x * x); return 0.5f * x * (1.f + tanhf(u)); }

DI void seq_of(int row, int& base, int& len, int& t) { if (row < LAT) { base = row & ~(T - 1); len = T; t = row & (T - 1); } else { const int r = row - LAT; base = LAT + (r & ~(TC - 1)); len = TC; t = r & (TC - 1); } }
DI int scan_row(int dir, int b, int j) { if (j < TC) { const int tok = dir ? (TC - 1 - j) : j; return LAT + b * TC + tok; } const int jj = j - TC; const int tok = dir ? (T - 1 - jj) : jj; return b * T + tok; }

struct Ctx {
    LAS unsigned char* lds; int tid, lane, wave, G, bid;
    const Params* p; unsigned char* ws;
};

DI int zcol_src(int j) { if (j < 3072) return j; if (j < 5120) return j + 16; if (j < ZSM) return j + 32; if (j < ZSM + 16) return 3072 + (j - ZSM); if (j < ZSM + 32) return 5136 + (j - ZSM - 16); return -1; }
template <bool ZMAP> DI void transpose_item(const float* W, int K, int N, bf16* WT, LAS float* scr, int kb, int nb, int lane) {
    const int k0 = 64 * kb, n0 = 32 * nb; const int nn = n0 + (lane & 31); const int src = ZMAP ? zcol_src(nn) : nn;
#pragma unroll 8
    for (int i = 0; i < 32; ++i) { const int kk = 2 * i + (lane >> 5); scr[kk * 33 + (lane & 31)] = (src >= 0) ? W[(size_t)(k0 + kk) * N + src] : 0.f; }
    asm volatile("s_waitcnt lgkmcnt(0)" ::: "memory");
    const int c = lane & 7;
#pragma unroll
    for (int j = 0; j < 4; ++j) { const int n = (lane >> 3) + 8 * j; const LAS float* s = scr + (8 * c) * 33 + n;
        u32x4 o; o.x = pk2(s[0 * 33], s[1 * 33]); o.y = pk2(s[2 * 33], s[3 * 33]); o.z = pk2(s[4 * 33], s[5 * 33]); o.w = pk2(s[6 * 33], s[7 * 33]);
        *(u32x4*)(WT + (size_t)(n0 + n) * K + k0 + 8 * c) = o; }
    asm volatile("s_waitcnt lgkmcnt(0)" ::: "memory");
}
DI void phase_pro0(Ctx& c) {
    const Params& p = *c.p;
    {
        LAS float* red = (LAS float*)c.lds;
        float* MODP = (float*)(c.ws + WS_MODP);
        for (int u = c.bid; u < NL * 48 * 8; u += c.G) {
            const int l = u / 384, cb = (u >> 3) % 48, ks = u & 7; const int col = cb * 256 + c.lane * 4;
            f32x4 a0 = {0.f, 0.f, 0.f, 0.f}, a1 = a0, a2 = a0;
            const float* wp = p.w_mod + ((size_t)l * D + ks * 256 + c.wave * 32) * 12288 + col;
            const int kb = ks * 256 + c.wave * 32;
#pragma unroll 8
            for (int i = 0; i < 32; ++i) { const f32x4 w = *(const f32x4*)(wp + (size_t)i * 12288);
                const float s0 = siluf_(p.c[kb + i]), s1 = siluf_(p.c[D + kb + i]), s2 = siluf_(p.c_ctx[kb + i]);
                a0 += w * s0; a1 += w * s1; a2 += w * s2; }
            __syncthreads();
            *(LAS f32x4*)(red + (c.wave * 3 + 0) * 256 + c.lane * 4) = a0; *(LAS f32x4*)(red + (c.wave * 3 + 1) * 256 + c.lane * 4) = a1; *(LAS f32x4*)(red + (c.wave * 3 + 2) * 256 + c.lane * 4) = a2;
            __syncthreads();
            for (int o = c.tid; o < 768; o += 512) { float s = 0.f;
#pragma unroll
                for (int w = 0; w < 8; ++w) s += red[w * 768 + o];
                MODP[((size_t)(l * 8 + ks) * 3 + o / 256) * 12288 + cb * 256 + (o & 255)] = s; }
        }
        __syncthreads();
    }
}
DI void phase_wconv(Ctx& c, int l) {
    const Params& p = *c.p;
    {
        LAS float* scr = (LAS float*)(c.lds + c.wave * 16384);
        const int gw = c.bid * 8 + c.wave, NGW = c.G * 8;
        constexpr int I_IN = 32 * 480, I_BR = 8 * 64, I_OUT = 32 * 64, I_UP = 32 * 352, I_DN = 88 * 64, I_L = I_IN + 4 * I_BR + I_OUT + I_UP + I_DN;
        unsigned char* wl = c.ws + WS_W;
        for (int it = gw; it < I_L; it += NGW) {
            int r = it;
            if (r < I_IN) { transpose_item<true>(p.w_in + (size_t)l * D * NIN, D, NIN, (bf16*)(wl + WL_IN), scr, r / 480, r % 480, c.lane); continue; } r -= I_IN;
            if (r < 4 * I_BR) { const int nb = r / I_BR; r %= I_BR; transpose_item<false>(p.w_br + ((size_t)l * 4 + nb) * MIXW * D, MIXW, D, (bf16*)(wl + WL_BR) + (size_t)nb * D * MIXW, scr, r / 64, r % 64, c.lane); continue; } r -= 4 * I_BR;
            if (r < I_OUT) { transpose_item<false>(p.w_out + (size_t)l * D * D, D, D, (bf16*)(wl + WL_OUT), scr, r / 64, r % 64, c.lane); continue; } r -= I_OUT;
            if (r < I_UP) { transpose_item<false>(p.ffn_up + (size_t)l * D * 2 * DFF, D, 2 * DFF, (bf16*)(wl + WL_UP), scr, r / 352, r % 352, c.lane); continue; } r -= I_UP;
            transpose_item<false>(p.ffn_down + (size_t)l * DFF * D, DFF, D, (bf16*)(wl + WL_DN), scr, r / 64, r % 64, c.lane);
        }
    }
    __syncthreads();
}
DI void phase_pro1(Ctx& c) {
    const Params& p = *c.p; const float* MODP = (const float*)(c.ws + WS_MODP); float* MOD = (float*)(c.ws + WS_MOD);
    for (int i = c.bid * 512 + c.tid; i < NL * 3 * 12288; i += c.G * 512) { const int l = i / 36864, v = (i / 12288) % 3, n = i % 12288;
        float s = p.b_mod[l * 12288 + n];
#pragma unroll
        for (int ks = 0; ks < 8; ++ks) s += MODP[((size_t)(l * 8 + ks) * 3 + v) * 12288 + n];
        MOD[i] = s; }
}
DI void row_load(const float* r, int lane, f32x4 (&v)[8]) {
#pragma unroll
    for (int j = 0; j < 8; ++j) v[j] = *(const f32x4*)(r + 4 * lane + 256 * j); }
DI float row_rstd(const f32x4 (&v)[8]) { float s = 0.f;
#pragma unroll
    for (int j = 0; j < 8; ++j) s += (v[j][0] * v[j][0] + v[j][1] * v[j][1]) + (v[j][2] * v[j][2] + v[j][3] * v[j][3]);
    return rsqrtf(wave_sum(s) * (1.f / D) + 1e-6f); }
DI void norm_mod_store(const f32x4 (&v)[8], float rstd, const float* g, const float* sh, const float* sc, bf16* o, int lane) {
#pragma unroll
    for (int j = 0; j < 8; ++j) { const int cc = 4 * lane + 256 * j; const f32x4 g4 = *(const f32x4*)(g + cc), s4 = *(const f32x4*)(sh + cc), c4 = *(const f32x4*)(sc + cc);
        const f32x4 r = v[j] * rstd * g4 * (c4 + 1.f) + s4; u32x2 w; w.x = pk2(r[0], r[1]); w.y = pk2(r[2], r[3]); *(u32x2*)(o + cc) = w; } }
DI int mod_vec(int row) { return row < LAT ? (row >> 12) : 2; }
DI void phase_pro2(Ctx& c) {
    const Params& p = *c.p; const float* MOD = (const float*)(c.ws + WS_MOD); bf16* U = (bf16*)(c.ws + WS_U);
    const int gw = c.bid * 8 + c.wave, NGW = c.G * 8;
    for (int row = gw; row < MROWS; row += NGW) { const float* xr = row < LAT ? p.x + (size_t)row * D : p.ctx + (size_t)(row - LAT) * D;
        f32x4 v[8]; row_load(xr, c.lane, v); const float rs = row_rstd(v); const float* mv = MOD + (size_t)(0 * 3 + mod_vec(row)) * 12288;
        norm_mod_store(v, rs, p.norm_g, mv, mv + 2048, U + (size_t)row * D, c.lane); }
}
DI void phase_resid(Ctx& c, int l, int which) {
    const Params& p = *c.p; const float* MOD = (const float*)(c.ws + WS_MOD); bf16* U = (bf16*)(c.ws + WS_U); float* X = (float*)(c.ws + WS_X); const float* F = (const float*)(c.ws + WS_F);
    const int gw = c.bid * 8 + c.wave, NGW = c.G * 8;
    for (int row = gw; row < MROWS; row += NGW) {
        const float* xr = (l == 0 && which == 0) ? (row < LAT ? p.x + (size_t)row * D : p.ctx + (size_t)(row - LAT) * D) : X + (size_t)row * D;
        f32x4 fv[8], xv[8]; row_load(F + (size_t)row * D, c.lane, fv); row_load(xr, c.lane, xv);
        const float rs = row_rstd(fv); const float* mv = MOD + (size_t)(l * 3 + mod_vec(row)) * 12288;
        const float* g = p.norm_g + (size_t)(l * 4 + (which ? 3 : 1)) * D; const float* gt = mv + (which ? 10240 : 4096);
#pragma unroll
        for (int j = 0; j < 8; ++j) { const int cc = 4 * c.lane + 256 * j; xv[j] += *(const f32x4*)(gt + cc) * (fv[j] * rs * *(const f32x4*)(g + cc)); }
        const bool fin = (which == 1 && l == NL - 1);
        if (fin) { if (row < LAT) {
#pragma unroll
            for (int j = 0; j < 8; ++j) *(f32x4*)(p.out + (size_t)row * D + 4 * c.lane + 256 * j) = xv[j]; } continue; }
#pragma unroll
        for (int j = 0; j < 8; ++j) *(f32x4*)(X + (size_t)row * D + 4 * c.lane + 256 * j) = xv[j];
        const float rs2 = row_rstd(xv);
        if (which == 0) norm_mod_store(xv, rs2, p.norm_g + (size_t)(l * 4 + 2) * D, mv + 6144, mv + 8192, U + (size_t)row * D, c.lane);
        else { const float* mv2 = MOD + (size_t)((l + 1) * 3 + mod_vec(row)) * 12288; norm_mod_store(xv, rs2, p.norm_g + (size_t)((l + 1) * 4) * D, mv2, mv2 + 2048, U + (size_t)row * D, c.lane); }
    }
}

DI f32x4 mfma16(bf16x8 a, bf16x8 b, f32x4 c) { return __builtin_amdgcn_mfma_f32_16x16x32_bf16(a, b, c, 0, 0, 0); }
DI bf16x8 ldfrag(const LAS bf16* base, int ld, int r0, int k0, int lane) { return *(const LAS bf16x8*)(base + (r0 + (lane & 15)) * ld + k0 + 8 * (lane >> 4)); }
template <int K> DI f32x4 mm_tile(const LAS bf16* X, int ldx, int xr0, const LAS bf16* Yt, int ldy, int yr0, int lane, f32x4 acc) {
#pragma unroll
    for (int k0 = 0; k0 < K; k0 += 32) acc = mfma16(ldfrag(X, ldx, xr0, k0, lane), ldfrag(Yt, ldy, yr0, k0, lane), acc);
    return acc; }
DI float wave_scan_add(float v, int lane) {
#pragma unroll
    for (int o = 1; o < 64; o <<= 1) { const float t = __shfl_up(v, o); if (lane >= o) v += t; }
    return v; }
DI float wave_scan_max(float v, int lane) {
#pragma unroll
    for (int o = 1; o < 64; o <<= 1) { const float t = __shfl_up(v, o); if (lane >= o) v = fmaxf(v, t); }
    return v; }
DI float wave_max(float v) {
#pragma unroll
    for (int o = 1; o < 64; o <<= 1) v = fmaxf(v, __shfl_xor(v, o));
    return v; }
constexpr float QSC = 0.08838834764831845f;

DI void mlstm_local(Ctx& c, int l, int u) {
    const Params& p = *c.p; const bf16* Z = (const bf16*)(c.ws + WS_Z); const float* G32 = (const float*)(c.ws + WS_G32); float* ML = (float*)(c.ws + WS_ML) + (size_t)u * ML_US;
    const int chain = u / 68, cc = u % 68, g = chain >> 2, h = chain & 3, dir = g >> 1, b = g & 1;
    LAS bf16* kT = (LAS bf16*)c.lds; LAS bf16* vT = kT + 128 * 72; LAS float* sw = (LAS float*)(vT + 128 * 72);
    __syncthreads();
    if (c.wave == 0) { const int row = scan_row(dir, b, cc * 64 + c.lane);
        const float li = G32[(size_t)row * 32 + dir * 8 + h] + p.ml_gate_b[((l * 2 + dir) * 2 + 0) * 4 + h];
        const float lf = logsigmoidf_(G32[(size_t)row * 32 + dir * 8 + 4 + h] + p.ml_gate_b[((l * 2 + dir) * 2 + 1) * 4 + h]);
        const float bt = wave_scan_add(lf, c.lane); const float bl = __shfl(bt, 63); const float wl = bl - bt + li; const float mloc = wave_max(wl);
        sw[c.lane] = expf(wl - mloc); if (c.lane == 0) { ML[ML_HDR] = mloc; ML[ML_HDR + 1] = bl; } }
    __syncthreads();
    for (int it = c.tid; it < 64 * 32; it += 512) { const int s = it & 63, r = it >> 6, mat = r >> 4, ch = (r & 15) * 8; const int row = scan_row(dir, b, cc * 64 + s);
        float v[8]; ld8(Z + (size_t)row * NZ + (mat ? MLV : MLK) + h * 128 + ch, v); const float sc = mat ? 1.f : sw[s]; LAS bf16* dst = (mat ? vT : kT) + ch * 72 + s;
#pragma unroll
        for (int i = 0; i < 8; ++i) dst[i * 72] = (bf16)f2bf(v[i] * sc); }
    __syncthreads();
    f32x4 acc[8];
#pragma unroll
    for (int nt = 0; nt < 8; ++nt) acc[nt] = mm_tile<64>(kT, 72, 16 * c.wave, vT, 72, 16 * nt, c.lane, (f32x4){0.f, 0.f, 0.f, 0.f});
    const int q = c.lane >> 4, r = c.lane & 15;
#pragma unroll
    for (int nt = 0; nt < 8; ++nt) *(f32x4*)(ML + (size_t)(16 * nt + r) * 128 + 16 * c.wave + 4 * q) = acc[nt];
    if (c.tid < 128) { float s = 0.f;
#pragma unroll
        for (int j = 0; j < 64; j += 8) { const u32x4 w = *(const LAS u32x4*)(kT + c.tid * 72 + j);
#pragma unroll
            for (int i = 0; i < 4; ++i) s += __uint_as_float(w[i] << 16) + __uint_as_float(w[i] & 0xffff0000u); }
        ML[ML_NL + c.tid] = s; }
}
DI void mlstm_prefix(Ctx& c) {
    const float* ML = (const float*)(c.ws + WS_ML); bf16* CT = (bf16*)(c.ws + WS_MLC); float* MS = (float*)(c.ws + WS_MLM);
    for (int item = c.bid * 512 + c.tid; item < 65536 + 512; item += c.G * 512) {
        int chain, e, dq; if (item < 65536) { chain = item >> 12; e = (item >> 5) & 127; dq = item & 31; } else { const int j = item - 65536; chain = j >> 5; e = 128; dq = j & 31; }
        const size_t so = (e < 128 ? (size_t)e * 128 : (size_t)ML_NL) + 4 * dq; const size_t dofs = (size_t)e * 128 + 4 * dq;
        f32x4 C = {0.f, 0.f, 0.f, 0.f}; float m = 0.f;
#pragma unroll 4
        for (int cc = 0; cc < 68; ++cc) { const size_t u = (size_t)chain * 68 + cc; const float* mu = ML + u * ML_US;
            const f32x4 L = *(const f32x4*)(mu + so); const float mloc = mu[ML_HDR], bl = mu[ML_HDR + 1];
            u32x2 w; w.x = pk2(C[0], C[1]); w.y = pk2(C[2], C[3]); *(u32x2*)(CT + u * MLC_US + dofs) = w;
            if (e == 0 && dq == 0) MS[u] = m;
            const float mn = fmaxf(bl + m, mloc); const float dec = expf(bl + m - mn), wl = expf(mloc - mn); m = mn;
            C = C * dec + L * wl; }
    }
}
DI void mlstm_out(Ctx& c, int l, int u) {
    const Params& p = *c.p; const bf16* Z = (const bf16*)(c.ws + WS_Z); const float* G32 = (const float*)(c.ws + WS_G32); bf16* Y = (bf16*)(c.ws + WS_Y);
    const bf16* CTg = (const bf16*)(c.ws + WS_MLC); const float* MS = (const float*)(c.ws + WS_MLM);
    const int b = u / (4 * 68), h = (u / 68) & 3, tb = u % 68;
    LAS bf16* sq = (LAS bf16*)c.lds; LAS bf16* sk = sq + 64 * 136; LAS bf16* vT = sk + 64 * 136; LAS bf16* CT = vT + 144 * 72; LAS bf16* sdw = CT + 144 * 136;
    LAS float* hbuf = (LAS float*)(sdw + 64 * 72); LAS float* sAt = hbuf + 64 * 128; LAS float* sBs = sAt + 64; LAS float* siw = sBs + 64; LAS float* semt = siw + 64; LAS float* sden = semt + 64;
    const int q = c.lane >> 4, r = c.lane & 15;
    for (int dir = 0; dir < 2; ++dir) {
        const int cc = dir == 0 ? tb : (tb < 4 ? 3 - tb : 71 - tb); const int chain = (dir * 2 + b) * 4 + h; const size_t un = (size_t)chain * 68 + cc;
        __syncthreads();
        if (c.wave == 0) { const int row = scan_row(dir, b, cc * 64 + c.lane); const float mc = MS[un];
            const float li = G32[(size_t)row * 32 + dir * 8 + h] + p.ml_gate_b[((l * 2 + dir) * 2 + 0) * 4 + h];
            const float lf = logsigmoidf_(G32[(size_t)row * 32 + dir * 8 + 4 + h] + p.ml_gate_b[((l * 2 + dir) * 2 + 1) * 4 + h]);
            const float bt = wave_scan_add(lf, c.lane); const float x = li - bt; const float cm = wave_scan_max(x, c.lane); const float mt = bt + fmaxf(mc, cm);
            sAt[c.lane] = bt - mt; sBs[c.lane] = x; siw[c.lane] = expf(bt + mc - mt) * QSC; semt[c.lane] = expf(-mt); }
        for (int it = c.tid; it < 64 * 32; it += 512) { const int s = it >> 5, r2 = it & 31, mat = r2 >> 4, ch = (r2 & 15) * 8; const int row = scan_row(dir, b, cc * 64 + s);
            *(LAS u32x4*)((mat ? sk : sq) + s * 136 + ch) = *(const u32x4*)(Z + (size_t)row * NZ + (mat ? MLK : MLQ) + h * 128 + ch); }
        for (int it = c.tid; it < 64 * 16; it += 512) { const int s = it & 63, ch = (it >> 6) * 8; const int row = scan_row(dir, b, cc * 64 + s);
            const u32x4 w = *(const u32x4*)(Z + (size_t)row * NZ + MLV + h * 128 + ch); LAS bf16* dst = vT + ch * 72 + s;
#pragma unroll
            for (int i = 0; i < 4; ++i) { dst[(2 * i) * 72] = (bf16)(w[i] & 0xffffu); dst[(2 * i + 1) * 72] = (bf16)(w[i] >> 16); } }
        if (c.tid < 64) vT[128 * 72 + c.tid] = (bf16)0x3F80u;
        for (int it = c.tid; it < 129 * 16; it += 512) { const int e = it >> 4, ch = (it & 15) * 8; *(LAS u32x4*)(CT + e * 136 + ch) = *(const u32x4*)(CTg + un * MLC_US + (size_t)e * 128 + ch); }
        __syncthreads();
#pragma unroll
        for (int j = 0; j < 2; ++j) { const int ti = 2 * c.wave + j, mt = ti >> 2, nt = ti & 3;
            const f32x4 a = mm_tile<128>(sk, 136, 16 * nt, sq, 136, 16 * mt, c.lane, (f32x4){0.f, 0.f, 0.f, 0.f});
            const int t = 16 * mt + r; const float At = sAt[t]; float d[4];
#pragma unroll
            for (int i = 0; i < 4; ++i) { const int s = 16 * nt + 4 * q + i; d[i] = (s <= t) ? a[i] * QSC * expf(At + sBs[s]) : 0.f; }
            u32x2 w; w.x = pk2(d[0], d[1]); w.y = pk2(d[2], d[3]); *(LAS u32x2*)(sdw + t * 72 + 16 * nt + 4 * q) = w; }
        const int mt = c.wave & 3, nt0 = (c.wave >> 2) * 5, ntn = (c.wave >> 2) ? 4 : 5;
        f32x4 acc[5];
#pragma unroll
        for (int j = 0; j < 5; ++j) if (j < ntn) acc[j] = mm_tile<128>(CT, 136, 16 * (nt0 + j), sq, 136, 16 * mt, c.lane, (f32x4){0.f, 0.f, 0.f, 0.f});
        __syncthreads();
        const int t = 16 * mt + r; const float iw = siw[t];
#pragma unroll
        for (int j = 0; j < 5; ++j) if (j < ntn) acc[j] = mm_tile<64>(vT, 72, 16 * (nt0 + j), sdw, 72, 16 * mt, c.lane, acc[j] * iw);
        if (c.wave >= 4 && q == 0) sden[t] = acc[3][0];
        __syncthreads();
        const float dn = fmaxf(fabsf(sden[t]), semt[t]); const float inv = 1.f / dn; const int tok = dir ? 63 - t : t;
#pragma unroll
        for (int j = 0; j < 5; ++j) if (j < ntn && nt0 + j < 8) { LAS f32x4* hp = (LAS f32x4*)(hbuf + tok * 128 + 16 * (nt0 + j) + 4 * q); const f32x4 hv = acc[j] * inv; if (dir == 0) *hp = hv; else *hp += hv; }
    }
    __syncthreads();
    { const int tok = c.tid >> 3, eg = (c.tid & 7) * 16; const int row = (tb < 4 ? LAT + b * TC + tb * 64 : b * T + (tb - 4) * 64) + tok;
        float hv[16]; float ss = 0.f;
#pragma unroll
        for (int j = 0; j < 4; ++j) { const f32x4 x = *(const LAS f32x4*)(hbuf + tok * 128 + eg + 4 * j); hv[4 * j] = x[0]; hv[4 * j + 1] = x[1]; hv[4 * j + 2] = x[2]; hv[4 * j + 3] = x[3]; ss += (x[0] * x[0] + x[1] * x[1]) + (x[2] * x[2] + x[3] * x[3]); }
        ss = grp_sum<8>(ss); const float rs = rsqrtf(ss * (1.f / 128.f) + 1e-6f);
#pragma unroll
        for (int j = 0; j < 2; ++j) { float g[8], o[8], y[8]; ldf8(p.ml_norm_g + l * 512 + h * 128 + eg + 8 * j, g); ld8(Z + (size_t)row * NZ + MLO + h * 128 + eg + 8 * j, o);
#pragma unroll
            for (int i = 0; i < 8; ++i) y[i] = hv[8 * j + i] * rs * g[i] * sigmoidf_(o[i]);
            st8(Y + (size_t)row * D + 512 + h * 128 + eg + 8 * j, y); } }
}


DI void tri_inverse64(const LAS float* Nf, const LAS bf16* Nb21, LAS bf16* Tm, LAS bf16* scr, int lane) {
    const int blk = lane >> 5, j = lane & 31, q = lane >> 4, r = lane & 15; LAS bf16* TT11 = scr; LAS bf16* M1T = scr + 1280;
    float x[32]; const LAS float* Nz = Nf + (32 * blk) * 68 + 32 * blk;
#pragma unroll
    for (int t = 0; t < 32; ++t) { float a = (t == j) ? 1.f : 0.f;
#pragma unroll
        for (int s4 = 0; s4 < (t + 3) / 4; ++s4) { const f32x4 n4 = *(const LAS f32x4*)(Nz + t * 68 + 4 * s4);
#pragma unroll
            for (int i = 0; i < 4; ++i) if (4 * s4 + i < t) a = fmaf(-n4[i], x[4 * s4 + i], a); }
        x[t] = a; Tm[(32 * blk + t) * 72 + 32 * blk + j] = (bf16)f2bf(a); if (blk == 0) Tm[t * 72 + 32 + j] = (bf16)0; }
    if (blk == 0) {
#pragma unroll
        for (int k = 0; k < 4; ++k) { u32x4 w; w.x = pk2(x[8 * k], x[8 * k + 1]); w.y = pk2(x[8 * k + 2], x[8 * k + 3]); w.z = pk2(x[8 * k + 4], x[8 * k + 5]); w.w = pk2(x[8 * k + 6], x[8 * k + 7]); *(LAS u32x4*)(TT11 + j * 40 + 8 * k) = w; } }
    asm volatile("s_waitcnt lgkmcnt(0)" ::: "memory");
    const f32x4 z4 = {0.f, 0.f, 0.f, 0.f};
#pragma unroll
    for (int xt = 0; xt < 2; ++xt)
#pragma unroll
        for (int yt = 0; yt < 2; ++yt) { const f32x4 a = mfma16(ldfrag(Nb21, 40, 16 * xt, 0, lane), ldfrag(TT11, 40, 16 * yt, 0, lane), z4);
            u32x2 w; w.x = pk2(a[0], a[1]); w.y = pk2(a[2], a[3]); *(LAS u32x2*)(M1T + (16 * yt + r) * 40 + 16 * xt + 4 * q) = w; }
    asm volatile("s_waitcnt lgkmcnt(0)" ::: "memory");
#pragma unroll
    for (int xt = 0; xt < 2; ++xt)
#pragma unroll
        for (int yt = 0; yt < 2; ++yt) { const f32x4 a = mfma16(ldfrag(M1T, 40, 16 * xt, 0, lane), ldfrag(Tm + 32 * 72 + 32, 72, 16 * yt, 0, lane), z4);
            u32x2 w; w.x = pk2(-a[0], -a[1]); w.y = pk2(-a[2], -a[3]); *(LAS u32x2*)(Tm + (32 + 16 * yt + r) * 72 + 16 * xt + 4 * q) = w; }
}
DI bf16x8 gfrag(const bf16* base, int ld, int r0, int k0, int lane) { return *(const bf16x8*)(base + (size_t)(r0 + (lane & 15)) * ld + k0 + 8 * (lane >> 4)); }
DI void gdn_local(Ctx& c, int l, int u) {
    const Params& p = *c.p; const bf16* Z = (const bf16*)(c.ws + WS_Z); const float* G32 = (const float*)(c.ws + WS_G32);
    const int chain = u / 68, cc = u % 68, g = chain >> 2, h = chain & 3, dir = g >> 1, b = g & 1;
    bf16* gA = (bf16*)(c.ws + WS_GDA) + (size_t)u * 16384; float* gB = (float*)(c.ws + WS_GDB) + (size_t)u * 16384; float* gU = (float*)(c.ws + WS_GDU) + (size_t)u * 8192;
    bf16* gW = (bf16*)(c.ws + WS_GDW) + (size_t)u * 8192; bf16* gAT = (bf16*)(c.ws + WS_GDAT) + (size_t)u * 4096; bf16* gQD = (bf16*)(c.ws + WS_GDQ) + (size_t)u * 8192;
    LAS bf16* sq = (LAS bf16*)c.lds; LAS bf16* sk = sq + 64 * 136; LAS bf16* skb = sk + 64 * 136; LAS bf16* uT = sq; LAS bf16* wT = uT + 128 * 72;
    LAS bf16* kdT = (LAS bf16*)(c.lds + 52224); LAS bf16* vbT = kdT + 128 * 72; LAS bf16* kbgT = vbT + 128 * 72;
    LAS float* Nf = (LAS float*)(c.lds + 107520); LAS bf16* Tm = (LAS bf16*)(c.lds + 124928); LAS float* sm = (LAS float*)(c.lds + 134144);
    LAS bf16* Nb21 = (LAS bf16*)(c.lds + 135424); LAS bf16* tscr = Nb21 + 1280;
    const int q = c.lane >> 4, r = c.lane & 15;
    __syncthreads();
    if (c.wave == 0) { const int row = scan_row(dir, b, cc * 64 + c.lane); const float a = G32[(size_t)row * 32 + 16 + dir * 8 + h], bb = G32[(size_t)row * 32 + 16 + dir * 8 + 4 + h];
        const float lg = -expf(p.gd_a_log[l * 8 + dir * 4 + h]) * softplusf_(a + p.gd_dt_bias[l * 8 + dir * 4 + h]);
        const float gc = wave_scan_add(lg, c.lane); const float gl = __shfl(gc, 63);
        sm[c.lane] = gc; sm[64 + c.lane] = sigmoidf_(bb); sm[128 + c.lane] = expf(gc); sm[192 + c.lane] = expf(gl - gc); if (c.lane == 0) sm[256] = expf(gl); }
    __syncthreads();
    { const float* cw = p.gd_conv + (size_t)l * 5 * 1536;
      for (int it = c.tid; it < 64 * 48; it += 512) { const int s = it / 48, rr = it % 48, mat = rr >> 4, ch = (rr & 15) * 8; const int row = scan_row(dir, b, cc * 64 + s);
        int base, len, t; seq_of(row, base, len, t);
        float acc[8];
#pragma unroll
        for (int i = 0; i < 8; ++i) acc[i] = 0.f;
#pragma unroll
        for (int j = 0; j < 5; ++j) { const int tt = t + j - 2; if (tt < 0 || tt >= len) continue;
            float a[8], wv[8]; ld8(Z + (size_t)(base + tt) * NZ + GDQ + mat * 512 + h * 128 + ch, a); ldf8(cw + j * 1536 + mat * 512 + h * 128 + ch, wv);
#pragma unroll
            for (int i = 0; i < 8; ++i) acc[i] = fmaf(a[i], wv[i], acc[i]); }
        float ss = 0.f;
#pragma unroll
        for (int i = 0; i < 8; ++i) { acc[i] = siluf_(acc[i]); ss += acc[i] * acc[i]; }
        ss = grp_sum<16>(ss);
        const float be = sm[64 + s], egc = sm[128 + s], ekd = sm[192 + s];
        if (mat == 0) { const float sc = rsqrtf(ss + 1e-6f) * QSC; float o[8], o2[8];
#pragma unroll
            for (int i = 0; i < 8; ++i) { o[i] = acc[i] * sc; o2[i] = o[i] * egc; }
            u32x4 w; w.x = pk2(o[0], o[1]); w.y = pk2(o[2], o[3]); w.z = pk2(o[4], o[5]); w.w = pk2(o[6], o[7]); *(LAS u32x4*)(sq + s * 136 + ch) = w; st8(gQD + s * 128 + ch, o2); }
        else if (mat == 1) { const float sc = rsqrtf(ss + 1e-6f); float o[8];
#pragma unroll
            for (int i = 0; i < 8; ++i) o[i] = acc[i] * sc;
            u32x4 w; w.x = pk2(o[0], o[1]); w.y = pk2(o[2], o[3]); w.z = pk2(o[4], o[5]); w.w = pk2(o[6], o[7]); *(LAS u32x4*)(sk + s * 136 + ch) = w;
            w.x = pk2(o[0] * be, o[1] * be); w.y = pk2(o[2] * be, o[3] * be); w.z = pk2(o[4] * be, o[5] * be); w.w = pk2(o[6] * be, o[7] * be); *(LAS u32x4*)(skb + s * 136 + ch) = w;
#pragma unroll
            for (int i = 0; i < 8; ++i) { kdT[(ch + i) * 72 + s] = (bf16)f2bf(o[i] * ekd); kbgT[(ch + i) * 72 + s] = (bf16)f2bf(o[i] * be * egc); } }
        else {
#pragma unroll
            for (int i = 0; i < 8; ++i) vbT[(ch + i) * 72 + s] = (bf16)f2bf(acc[i] * be); } } }
    __syncthreads();
#pragma unroll
    for (int j = 0; j < 2; ++j) { const int ti = 2 * c.wave + j, mt = ti >> 2, nt = ti & 3;
        { const f32x4 a = mm_tile<128>(skb, 136, 16 * mt, sk, 136, 16 * nt, c.lane, (f32x4){0.f, 0.f, 0.f, 0.f}); const int s = 16 * nt + r; const float gs = sm[s];
#pragma unroll
          for (int i = 0; i < 4; ++i) { const int t = 16 * mt + 4 * q + i; const float nv = (s < t) ? a[i] * expf(sm[t] - gs) : 0.f; Nf[t * 68 + s] = nv; if (mt >= 2 && nt < 2) Nb21[(t - 32) * 40 + s] = (bf16)f2bf(nv); } }
        { const f32x4 a = mm_tile<128>(sk, 136, 16 * nt, sq, 136, 16 * mt, c.lane, (f32x4){0.f, 0.f, 0.f, 0.f}); const int t = 16 * mt + r; const float gt = sm[t]; float d[4];
#pragma unroll
          for (int i = 0; i < 4; ++i) { const int s = 16 * nt + 4 * q + i; d[i] = (s <= t) ? a[i] * expf(gt - sm[s]) : 0.f; }
          u32x2 w; w.x = pk2(d[0], d[1]); w.y = pk2(d[2], d[3]); *(u32x2*)(gAT + t * 64 + 16 * nt + 4 * q) = w; } }
    __syncthreads();
    if (c.wave == 0) tri_inverse64(Nf, Nb21, Tm, tscr, c.lane);
    __syncthreads();
    int lz = c.lane; asm volatile("" : "+v"(lz)); c.lane = lz;
    { const int q = lz >> 4, r = lz & 15; const int mt = c.wave & 3;
#pragma unroll
      for (int j = 0; j < 4; ++j) { const int nt = (c.wave >> 2) * 4 + j;
        const f32x4 au = mm_tile<64>(Tm, 72, 16 * mt, vbT, 72, 16 * nt, c.lane, (f32x4){0.f, 0.f, 0.f, 0.f});
        { u32x2 w; w.x = pk2(au[0], au[1]); w.y = pk2(au[2], au[3]); *(LAS u32x2*)(uT + (16 * nt + r) * 72 + 16 * mt + 4 * q) = w; *(f32x4*)(gU + (16 * nt + r) * 64 + 16 * mt + 4 * q) = au; }
        const f32x4 aw = mm_tile<64>(Tm, 72, 16 * mt, kbgT, 72, 16 * nt, c.lane, (f32x4){0.f, 0.f, 0.f, 0.f});
        { u32x2 w; w.x = pk2(aw[0], aw[1]); w.y = pk2(aw[2], aw[3]); *(LAS u32x2*)(wT + (16 * nt + r) * 72 + 16 * mt + 4 * q) = w; }
        const f32x4 aw2 = mm_tile<64>(kbgT, 72, 16 * nt, Tm, 72, 16 * mt, c.lane, (f32x4){0.f, 0.f, 0.f, 0.f});
        { u32x2 w; w.x = pk2(aw2[0], aw2[1]); w.y = pk2(aw2[2], aw2[3]); *(u32x2*)(gW + (16 * mt + r) * 128 + 16 * nt + 4 * q) = w; } } }
    __syncthreads();
    { const int q = lz >> 4, r = lz & 15; const float egl = sm[256]; const int yt = c.wave;
#pragma unroll
      for (int xt = 0; xt < 8; ++xt) {
        const f32x4 a = mm_tile<64>(wT, 72, 16 * xt, kdT, 72, 16 * yt, c.lane, (f32x4){0.f, 0.f, 0.f, 0.f}); const int d = 16 * yt + r; float v[4];
#pragma unroll
        for (int i = 0; i < 4; ++i) v[i] = ((16 * xt + 4 * q + i) == d ? egl : 0.f) - a[i];
        u32x2 w; w.x = pk2(v[0], v[1]); w.y = pk2(v[2], v[3]); *(u32x2*)(gA + d * 128 + 16 * xt + 4 * q) = w;
        const f32x4 bq = mm_tile<64>(kdT, 72, 16 * xt, uT, 72, 16 * yt, c.lane, (f32x4){0.f, 0.f, 0.f, 0.f});
        *(f32x4*)(gB + (16 * yt + r) * 128 + 16 * xt + 4 * q) = bq; } }
}
template <int N> DI void affine_prefix(Ctx& c, const bf16* gA, const float* gB, bf16* gS, int sl) {
    constexpr int NN = N * N, KS = N / 32, LD = N + 8; const int w = c.wave, q = c.lane >> 4, r = c.lane & 15; const bool act = w < N / 16;
    LAS bf16* ST = (LAS bf16*)c.lds;
    __syncthreads();
    if (act) { const u32x2 z = {0u, 0u}; *(LAS u32x2*)(ST + r * LD + 16 * w + 4 * q) = z; *(u32x2*)(gS + (size_t)(16 * sl + r) * N + 16 * w + 4 * q) = z; }
    bf16x8 a[KS], an[KS]; f32x4 Bc = {0.f, 0.f, 0.f, 0.f}, Bn = Bc;
    if (act) {
#pragma unroll
        for (int kk = 0; kk < KS; ++kk) a[kk] = gfrag(gA, N, 16 * w, 32 * kk, c.lane);
        Bc = *(const f32x4*)(gB + (size_t)(16 * sl + r) * N + 16 * w + 4 * q); }
    __syncthreads();
    for (int cc = 0; cc < 67; ++cc) {
        f32x4 acc = Bc;
        if (act) { const bf16* nA = gA + (size_t)(cc + 1) * NN; const float* nB = gB + (size_t)(cc + 1) * NN;
#pragma unroll
            for (int kk = 0; kk < KS; ++kk) an[kk] = gfrag(nA, N, 16 * w, 32 * kk, c.lane);
            Bn = *(const f32x4*)(nB + (size_t)(16 * sl + r) * N + 16 * w + 4 * q);
#pragma unroll
            for (int kk = 0; kk < KS; ++kk) acc = mfma16(a[kk], ldfrag(ST, LD, 0, 32 * kk, c.lane), acc); }
        __syncthreads();
        if (act) { u32x2 wv; wv.x = pk2(acc[0], acc[1]); wv.y = pk2(acc[2], acc[3]);
            *(LAS u32x2*)(ST + r * LD + 16 * w + 4 * q) = wv; *(u32x2*)(gS + (size_t)(cc + 1) * NN + (size_t)(16 * sl + r) * N + 16 * w + 4 * q) = wv; }
        __syncthreads();
#pragma unroll
        for (int kk = 0; kk < KS; ++kk) a[kk] = an[kk];
        Bc = Bn;
    }
}
DI void gdn_prefix(Ctx& c, int u2) { const int chain = u2 >> 3, sl = u2 & 7;
    affine_prefix<128>(c, (const bf16*)(c.ws + WS_GDA) + (size_t)chain * 68 * 16384, (const float*)(c.ws + WS_GDB) + (size_t)chain * 68 * 16384, (bf16*)(c.ws + WS_GDS) + (size_t)chain * 68 * 16384, sl); }
DI void rwkv_prefix(Ctx& c, int u2) { const int chain = u2 >> 2, sl = u2 & 3;
    affine_prefix<64>(c, (const bf16*)(c.ws + WS_RAC) + (size_t)chain * 68 * 4096, (const float*)(c.ws + WS_RBC) + (size_t)chain * 68 * 4096, (bf16*)(c.ws + WS_RPT) + (size_t)chain * 68 * 4096, sl); }
DI void gdn_out(Ctx& c, int l, int u) {
    const Params& p = *c.p; const bf16* Z = (const bf16*)(c.ws + WS_Z); bf16* Y = (bf16*)(c.ws + WS_Y);
    const int b = u / (4 * 68), h = (u / 68) & 3, tb = u % 68;
    LAS bf16* ST = (LAS bf16*)c.lds; LAS bf16* vnT = ST + 128 * 136; LAS float* hbuf = (LAS float*)(vnT + 128 * 72);
    const int q = c.lane >> 4, r = c.lane & 15; const int mt = c.wave & 3, ntb = (c.wave >> 2) * 4;
    for (int dir = 0; dir < 2; ++dir) {
        const int cc = dir == 0 ? tb : (tb < 4 ? 3 - tb : 71 - tb); const int chain = (dir * 2 + b) * 4 + h; const size_t un = (size_t)chain * 68 + cc;
        const bf16* gS = (const bf16*)(c.ws + WS_GDS) + un * 16384; const float* gU = (const float*)(c.ws + WS_GDU) + un * 8192; const bf16* gW = (const bf16*)(c.ws + WS_GDW) + un * 8192;
        const bf16* gAT = (const bf16*)(c.ws + WS_GDAT) + un * 4096; const bf16* gQD = (const bf16*)(c.ws + WS_GDQ) + un * 8192;
        __syncthreads();
        for (int it = c.tid; it < 128 * 16; it += 512) { const int e = it >> 4, ch = (it & 15) * 8; *(LAS u32x4*)(ST + e * 136 + ch) = *(const u32x4*)(gS + (size_t)e * 128 + ch); }
        bf16x8 wf[4], qf[4], af[2];
#pragma unroll
        for (int kk = 0; kk < 4; ++kk) { wf[kk] = gfrag(gW, 128, 16 * mt, 32 * kk, c.lane); qf[kk] = gfrag(gQD, 128, 16 * mt, 32 * kk, c.lane); }
#pragma unroll
        for (int kk = 0; kk < 2; ++kk) af[kk] = gfrag(gAT, 64, 16 * mt, 32 * kk, c.lane);
        __syncthreads();
#pragma unroll
        for (int j = 0; j < 4; ++j) { const int nt = ntb + j; f32x4 acc = {0.f, 0.f, 0.f, 0.f};
#pragma unroll
            for (int kk = 0; kk < 4; ++kk) acc = mfma16(wf[kk], ldfrag(ST, 136, 16 * nt, 32 * kk, c.lane), acc);
            const f32x4 uv = *(const f32x4*)(gU + (16 * nt + r) * 64 + 16 * mt + 4 * q); const f32x4 vn = uv - acc;
            u32x2 wv; wv.x = pk2(vn[0], vn[1]); wv.y = pk2(vn[2], vn[3]); *(LAS u32x2*)(vnT + (16 * nt + r) * 72 + 16 * mt + 4 * q) = wv; }
        __syncthreads();
        const int t = 16 * mt + r, tok = dir ? 63 - t : t;
#pragma unroll
        for (int j = 0; j < 4; ++j) { const int nt = ntb + j; f32x4 acc = {0.f, 0.f, 0.f, 0.f};
#pragma unroll
            for (int kk = 0; kk < 4; ++kk) acc = mfma16(ldfrag(ST, 136, 16 * nt, 32 * kk, c.lane), qf[kk], acc);
#pragma unroll
            for (int kk = 0; kk < 2; ++kk) acc = mfma16(ldfrag(vnT, 72, 16 * nt, 32 * kk, c.lane), af[kk], acc);
            LAS f32x4* hp = (LAS f32x4*)(hbuf + tok * 128 + 16 * nt + 4 * q); if (dir == 0) *hp = acc; else *hp += acc; }
    }
    __syncthreads();
    { const int tok = c.tid >> 3, eg = (c.tid & 7) * 16; const int row = (tb < 4 ? LAT + b * TC + tb * 64 : b * T + (tb - 4) * 64) + tok;
        float hv[16]; float ss = 0.f;
#pragma unroll
        for (int j = 0; j < 4; ++j) { const f32x4 x = *(const LAS f32x4*)(hbuf + tok * 128 + eg + 4 * j); hv[4 * j] = x[0]; hv[4 * j + 1] = x[1]; hv[4 * j + 2] = x[2]; hv[4 * j + 3] = x[3]; ss += (x[0] * x[0] + x[1] * x[1]) + (x[2] * x[2] + x[3] * x[3]); }
        ss = grp_sum<8>(ss); const float rs = rsqrtf(ss * (1.f / 128.f) + 1e-6f);
#pragma unroll
        for (int j = 0; j < 2; ++j) { float g[8], o[8], y[8]; ldf8(p.gd_norm_g + l * 512 + h * 128 + eg + 8 * j, g); ld8(Z + (size_t)row * NZ + GDZ + h * 128 + eg + 8 * j, o);
#pragma unroll
            for (int i = 0; i < 8; ++i) y[i] = hv[8 * j + i] * rs * g[i] * siluf_(o[i]);
            st8(Y + (size_t)row * D + 1024 + h * 128 + eg + 8 * j, y); } }
}


DI u32x4 pack8(const float (&v)[8]) { u32x4 w; w.x = pk2(v[0], v[1]); w.y = pk2(v[2], v[3]); w.z = pk2(v[4], v[5]); w.w = pk2(v[6], v[7]); return w; }
DI void rwkv_local(Ctx& c, int l, int u) {
    const float* SA = (const float*)(c.ws + WS_S); const size_t AS = (size_t)MROWS * 512;
    const int chain = u / 68, cc = u % 68, g = chain >> 3, h = chain & 7, dir = g >> 1, b = g & 1;
    bf16* gQE = (bf16*)(c.ws + WS_RQE) + (size_t)u * 4096; float* gYL = (float*)(c.ws + WS_RYL) + (size_t)u * 4096; bf16* gAC = (bf16*)(c.ws + WS_RAC) + (size_t)u * 4096; float* gBC = (float*)(c.ws + WS_RBC) + (size_t)u * 4096;
    LAS bf16* IM = (LAS bf16*)c.lds;
#define RIM(k) (IM + (k) * 4608)
    LAS bf16 *At = RIM(0), *Tm = RIM(0), *Bt = RIM(1), *X1T = RIM(1), *Kt = RIM(2), *AhT = RIM(2), *Rt = RIM(3), *AtT = RIM(4), *VT = RIM(5), *BhT = RIM(6), *KhT = RIM(7), *NAK = RIM(8), *SgT = RIM(8), *MBR = RIM(9), *MKR = RIM(10);
#undef RIM
    LAS float* Nf = (LAS float*)(c.lds + 101376); LAS float* seg = (LAS float*)(c.lds + 118784); LAS float* W63 = seg + 512;
    LAS bf16* Nb21 = (LAS bf16*)(c.lds + 121088); LAS bf16* tscr = Nb21 + 1280;
    const int q = c.lane >> 4, r = c.lane & 15; const int ch = c.tid & 63, tq = c.tid >> 6;
    __syncthreads();
    {   float w8[8], r8[8], k8[8], v8[8], a8[8], b8[8];
#pragma unroll
        for (int j = 0; j < 8; ++j) { const size_t o = (size_t)scan_row(dir, b, cc * 64 + tq * 8 + j) * 512 + h * 64 + ch;
            w8[j] = SA[(SA_RW0 + dir) * AS + o]; r8[j] = SA[SA_RR * AS + o]; k8[j] = SA[(SA_RK0 + dir) * AS + o]; v8[j] = SA[SA_RV * AS + o]; a8[j] = SA[SA_RA * AS + o]; b8[j] = SA[(SA_RB0 + dir) * AS + o]; }
#pragma unroll
        for (int j = 1; j < 8; ++j) w8[j] *= w8[j - 1];
        seg[tq * 64 + ch] = w8[7];
        __syncthreads();
        float pre = 1.f, tot = 1.f;
#pragma unroll
        for (int s = 0; s < 8; ++s) { const float sv = seg[s * 64 + ch]; if (s < tq) pre *= sv; tot *= sv; }
        if (tq == 0) W63[ch] = tot;
        float aT[8], bhT[8], khT[8];
#pragma unroll
        for (int j = 0; j < 8; ++j) { const float winc = pre * w8[j], wexc = j ? pre * w8[j - 1] : pre; const float iw = 1.f / winc; const int t = tq * 8 + j;
            const float at = a8[j] * wexc, bt = b8[j] * iw, kt = k8[j] * iw, rt = r8[j] * winc;
            At[t * 72 + ch] = (bf16)f2bf(at); Bt[t * 72 + ch] = (bf16)f2bf(bt); Kt[t * 72 + ch] = (bf16)f2bf(kt); Rt[t * 72 + ch] = (bf16)f2bf(rt);
            aT[j] = at; bhT[j] = bt * tot; khT[j] = kt * tot; }
        *(LAS u32x4*)(AtT + ch * 72 + tq * 8) = pack8(aT); *(LAS u32x4*)(VT + ch * 72 + tq * 8) = pack8(v8); *(LAS u32x4*)(BhT + ch * 72 + tq * 8) = pack8(bhT); *(LAS u32x4*)(KhT + ch * 72 + tq * 8) = pack8(khT);
    }
    __syncthreads();
#pragma unroll
    for (int jj = 0; jj < 2; ++jj) { const int ti = 2 * c.wave + jj, mt = ti >> 2, nt = ti & 3; const int t = 16 * mt + r, j0 = 16 * nt + 4 * q; const f32x4 z4 = {0.f, 0.f, 0.f, 0.f};
        const f32x4 p1 = mm_tile<64>(Bt, 72, 16 * nt, At, 72, 16 * mt, c.lane, z4), p2 = mm_tile<64>(Kt, 72, 16 * nt, At, 72, 16 * mt, c.lane, z4);
        const f32x4 p3 = mm_tile<64>(Bt, 72, 16 * nt, Rt, 72, 16 * mt, c.lane, z4), p4 = mm_tile<64>(Kt, 72, 16 * nt, Rt, 72, 16 * mt, c.lane, z4);
        f32x4 n1; float d2[4], d3[4], d4[4];
#pragma unroll
        for (int i = 0; i < 4; ++i) { const bool lt = (j0 + i) < t, le = (j0 + i) <= t; n1[i] = lt ? -p1[i] : 0.f; d2[i] = lt ? p2[i] : 0.f; d3[i] = le ? p3[i] : 0.f; d4[i] = le ? p4[i] : 0.f; }
        *(LAS f32x4*)(Nf + t * 68 + j0) = n1;
        if (mt >= 2 && nt < 2) { u32x2 wn; wn.x = pk2(n1[0], n1[1]); wn.y = pk2(n1[2], n1[3]); *(LAS u32x2*)(Nb21 + (t - 32) * 40 + j0) = wn; }
        u32x2 w; w.x = pk2(d2[0], d2[1]); w.y = pk2(d2[2], d2[3]); *(LAS u32x2*)(NAK + t * 72 + j0) = w;
        w.x = pk2(d3[0], d3[1]); w.y = pk2(d3[2], d3[3]); *(LAS u32x2*)(MBR + t * 72 + j0) = w;
        w.x = pk2(d4[0], d4[1]); w.y = pk2(d4[2], d4[3]); *(LAS u32x2*)(MKR + t * 72 + j0) = w; }
    __syncthreads();
    if (c.wave == 0) tri_inverse64(Nf, Nb21, Tm, tscr, c.lane);
    else { for (int ti = c.wave - 1; ti < 16; ti += 7) { const int mt = ti >> 2, nt = ti & 3;
            const f32x4 a = mm_tile<64>(NAK, 72, 16 * mt, VT, 72, 16 * nt, c.lane, (f32x4){0.f, 0.f, 0.f, 0.f});
            u32x2 w; w.x = pk2(a[0], a[1]); w.y = pk2(a[2], a[3]); *(LAS u32x2*)(X1T + (16 * nt + r) * 72 + 16 * mt + 4 * q) = w; } }
    __syncthreads();
#pragma unroll
    for (int jj = 0; jj < 2; ++jj) { const int ti = 2 * c.wave + jj, mt = ti >> 2, nt = ti & 3; const f32x4 z4 = {0.f, 0.f, 0.f, 0.f};
        const f32x4 a = mm_tile<64>(Tm, 72, 16 * mt, AtT, 72, 16 * nt, c.lane, z4), s = mm_tile<64>(Tm, 72, 16 * mt, X1T, 72, 16 * nt, c.lane, z4);
        u32x2 w; w.x = pk2(a[0], a[1]); w.y = pk2(a[2], a[3]); *(LAS u32x2*)(AhT + (16 * nt + r) * 72 + 16 * mt + 4 * q) = w;
        w.x = pk2(s[0], s[1]); w.y = pk2(s[2], s[3]); *(LAS u32x2*)(SgT + (16 * nt + r) * 72 + 16 * mt + 4 * q) = w; }
    __syncthreads();
#pragma unroll
    for (int jj = 0; jj < 2; ++jj) { const int ti = 2 * c.wave + jj, xt = ti >> 2, yt = ti & 3; const int x0 = 16 * xt + 4 * q, yr = 16 * yt + r; const f32x4 z4 = {0.f, 0.f, 0.f, 0.f};
        { f32x4 a = mm_tile<64>(AhT, 72, 16 * xt, MBR, 72, 16 * yt, c.lane, z4); const u32x2 rw = *(const LAS u32x2*)(Rt + yr * 72 + x0);
          a[0] += __uint_as_float(rw.x << 16); a[1] += __uint_as_float(rw.x & 0xffff0000u); a[2] += __uint_as_float(rw.y << 16); a[3] += __uint_as_float(rw.y & 0xffff0000u);
          u32x2 w; w.x = pk2(a[0], a[1]); w.y = pk2(a[2], a[3]); *(u32x2*)(gQE + yr * 64 + x0) = w; }
        { f32x4 a = mm_tile<64>(SgT, 72, 16 * xt, MBR, 72, 16 * yt, c.lane, z4); a = mm_tile<64>(VT, 72, 16 * xt, MKR, 72, 16 * yt, c.lane, a); *(f32x4*)(gYL + yr * 64 + x0) = a; }
        { f32x4 a = mm_tile<64>(AhT, 72, 16 * xt, BhT, 72, 16 * yt, c.lane, z4); const float wd = W63[yr];
#pragma unroll
          for (int i = 0; i < 4; ++i) if (x0 + i == yr) a[i] += wd;
          u32x2 w; w.x = pk2(a[0], a[1]); w.y = pk2(a[2], a[3]); *(u32x2*)(gAC + yr * 64 + x0) = w; }
        { f32x4 a = mm_tile<64>(BhT, 72, 16 * xt, SgT, 72, 16 * yt, c.lane, z4); a = mm_tile<64>(KhT, 72, 16 * xt, VT, 72, 16 * yt, c.lane, a); *(f32x4*)(gBC + yr * 64 + x0) = a; } }
}
DI void rwkv_out(Ctx& c, int l, int u) {
    const Params& p = *c.p; bf16* Y = (bf16*)(c.ws + WS_Y); const float* SA = (const float*)(c.ws + WS_S); const size_t AS = (size_t)MROWS * 512;
    const int b = u / 136, rem = u % 136, tb = rem >> 1, hg = rem & 1; const int hl = c.wave & 3, dir = c.wave >> 2, head = hg * 4 + hl;
    LAS float* hbuf = (LAS float*)c.lds;
    const int q = c.lane >> 4, r = c.lane & 15;
    __syncthreads();
    { const int cc = dir == 0 ? tb : (tb < 4 ? 3 - tb : 71 - tb); const int chain = (dir * 2 + b) * 8 + head; const size_t un = (size_t)chain * 68 + cc;
      const bf16* gQE = (const bf16*)(c.ws + WS_RQE) + un * 4096; const float* gYL = (const float*)(c.ws + WS_RYL) + un * 4096; const bf16* gPT = (const bf16*)(c.ws + WS_RPT) + un * 4096;
      bf16x8 pf[4][2];
#pragma unroll
      for (int it = 0; it < 4; ++it)
#pragma unroll
          for (int kk = 0; kk < 2; ++kk) pf[it][kk] = gfrag(gPT, 64, 16 * it, 32 * kk, c.lane);
#pragma unroll
      for (int mt = 0; mt < 4; ++mt) { const bf16x8 q0 = gfrag(gQE, 64, 16 * mt, 0, c.lane), q1 = gfrag(gQE, 64, 16 * mt, 32, c.lane); const int t = 16 * mt + r, tok = dir ? 63 - t : t;
#pragma unroll
          for (int it = 0; it < 4; ++it) { f32x4 acc = *(const f32x4*)(gYL + t * 64 + 16 * it + 4 * q); acc = mfma16(pf[it][0], q0, acc); acc = mfma16(pf[it][1], q1, acc);
              *(LAS f32x4*)(hbuf + ((dir * 4 + hl) * 64 + tok) * 64 + 16 * it + 4 * q) = acc; } } }
    __syncthreads();
    { const int pr = c.tid >> 1, hf = c.tid & 1, h2 = pr >> 6, tok = pr & 63, hd = hg * 4 + h2; const int row = (tb < 4 ? LAT + b * TC + tb * 64 : b * T + (tb - 4) * 64) + tok;
      float y[32]; float s = 0.f;
#pragma unroll
      for (int j = 0; j < 8; ++j) { const f32x4 a = *(const LAS f32x4*)(hbuf + (h2 * 64 + tok) * 64 + hf * 32 + 4 * j), bq = *(const LAS f32x4*)(hbuf + ((4 + h2) * 64 + tok) * 64 + hf * 32 + 4 * j);
#pragma unroll
          for (int i = 0; i < 4; ++i) { y[4 * j + i] = a[i] + bq[i]; s += y[4 * j + i]; } }
      s += __shfl_xor(s, 1); const float mean = s * (1.f / 64.f); float qq = 0.f;
#pragma unroll
      for (int i = 0; i < 32; ++i) { y[i] -= mean; qq += y[i] * y[i]; }
      qq += __shfl_xor(qq, 1); const float rs = rsqrtf(qq * (1.f / 64.f) + 64e-5f);
      const int cb = hd * 64 + hf * 32;
#pragma unroll
      for (int j = 0; j < 4; ++j) { float g[8], bb[8], ax[8], gg[8], o[8]; ldf8(p.rw_ln_g + l * 512 + cb + 8 * j, g); ldf8(p.rw_ln_b + l * 512 + cb + 8 * j, bb);
          ldf8(SA + SA_RAUX * AS + (size_t)row * 512 + cb + 8 * j, ax); ldf8(SA + SA_RG * AS + (size_t)row * 512 + cb + 8 * j, gg);
#pragma unroll
          for (int i = 0; i < 8; ++i) o[i] = (y[8 * j + i] * rs * g[i] + bb[i] + ax[i]) * gg[i];
          st8(Y + (size_t)row * D + 1536 + cb + 8 * j, o); } }
}

DI float rw_feat(const bf16* Z, const float* mu, int row, int cz) {
    int base, len, t; seq_of(row, base, len, t); const bf16* zp = Z + (size_t)row * NZ + RWR + cz;
    const float x = bf2f(zp[0]); const float pv = t > 0 ? bf2f(zp[-NZ]) : 0.f; const float nx = t < len - 1 ? bf2f(zp[NZ]) : 0.f;
    return x + mu[cz] * (pv - x) + mu[RWMIX + cz] * (nx - x);
}
template <int K, int NT> DI void lora_nt(const float* Wm, const LAS float* in, int c, float (&acc)[NT]) {
#pragma unroll
    for (int t = 0; t < NT; ++t) acc[t] = 0.f;
    for (int k = 0; k < K; k += 4) { const float w0 = Wm[(k + 0) * 512 + c], w1 = Wm[(k + 1) * 512 + c], w2 = Wm[(k + 2) * 512 + c], w3 = Wm[(k + 3) * 512 + c];
#pragma unroll
        for (int t = 0; t < NT; ++t) { const f32x4 x = *(const LAS f32x4*)(in + t * 448 + k); acc[t] = fmaf(x[0], w0, acc[t]); acc[t] = fmaf(x[1], w1, acc[t]); acc[t] = fmaf(x[2], w2, acc[t]); acc[t] = fmaf(x[3], w3, acc[t]); } }
}
constexpr int RWT = 17;
DI void rwkv_prep_rows(Ctx& c, int l, int row0, const LAS float* in, LAS float* bufA, LAS float* bufB) {
    const Params& p = *c.p; const bf16* Z = (const bf16*)(c.ws + WS_Z); float* SA = (float*)(c.ws + WS_S);
    const float* mu = p.rw_mu + (size_t)l * 2 * RWMIX; const int cc = c.tid; const size_t AS = (size_t)MROWS * 512;
    float acc[RWT];
#pragma unroll
    for (int dir = 0; dir < 2; ++dir) {
        lora_nt<96, RWT>(p.rw_w2 + (size_t)(l * 2 + dir) * 96 * 512, in, cc, acc);
        const float w0 = p.rw_w0[(l * 2 + dir) * 512 + cc];
#pragma unroll
        for (int t = 0; t < RWT; ++t) { const float wl = w0 + acc[t]; SA[(SA_RW0 + dir) * AS + (size_t)(row0 + t) * 512 + cc] = expf(-expf(-softplusf_(-wl) - 0.5f)); }
        lora_nt<96, RWT>(p.rw_a2 + (size_t)(l * 2 + dir) * 96 * 512, in + 96, cc, acc);
        const float a0 = p.rw_a0[(l * 2 + dir) * 512 + cc]; LAS float* bb = dir ? bufB : bufA;
#pragma unroll
        for (int t = 0; t < RWT; ++t) bb[t * 512 + cc] = sigmoidf_(a0 + acc[t]);
    }
    lora_nt<256, RWT>(p.rw_g2 + (size_t)l * 256 * 512, in + 192, cc, acc);
#pragma unroll
    for (int t = 0; t < RWT; ++t) SA[SA_RG * AS + (size_t)(row0 + t) * 512 + cc] = acc[t];
    const float kks = p.rw_kk[l * 512 + cc], kas = p.rw_ka[l * 512 + cc], rks = p.rw_rk[l * 512 + cc];
#pragma unroll 1
    for (int t = 0; t < RWT; ++t) { const int row = row0 + t; const size_t o = (size_t)row * 512 + cc;
        const float rf = rw_feat(Z, mu, row, cc), kf = rw_feat(Z, mu, row, 512 + cc), vf = rw_feat(Z, mu, row, 1024 + cc);
        const float kx = kf * kks; const float kkv = kx * rsqrtf(wave_sum(kx * kx) + 1e-6f);
        const float ic0 = bufA[t * 512 + cc], ic1 = bufB[t * 512 + cc];
        const float km0 = kf * (1.f + (ic0 - 1.f) * kas), km1 = kf * (1.f + (ic1 - 1.f) * kas);
        const float bonus = wave_sum(rf * rks * (km0 + km1));
        SA[SA_RK0 * AS + o] = km0; SA[SA_RK1 * AS + o] = km1; SA[SA_RB0 * AS + o] = kkv * ic0; SA[SA_RB1 * AS + o] = kkv * ic1;
        SA[SA_RAUX * AS + o] = bonus * vf; SA[SA_RR * AS + o] = rf; SA[SA_RV * AS + o] = vf; SA[SA_RA * AS + o] = -kkv; }
}
DI void phase_prep(Ctx& c, int l) {
    const Params& p = *c.p; const bf16* Z = (const bf16*)(c.ws + WS_Z); bf16* Y = (bf16*)(c.ws + WS_Y); const float* G32 = (const float*)(c.ws + WS_G32);
    float* SA = (float*)(c.ws + WS_S); float* SG = (float*)(c.ws + WS_SG);
    const int gw = c.bid * 8 + c.wave, NGW = c.G * 8; const int ch = c.lane * 8;
    for (int row = gw; row < MROWS; row += NGW) {
        int base, len, t; seq_of(row, base, len, t);
        float acc[8];
#pragma unroll
        for (int i = 0; i < 8; ++i) acc[i] = 0.f;
        const float* w = p.conv_dw + (size_t)l * 31 * 512;
        for (int j = 0; j < 31; ++j) { const int tt = t + j - 15; if (tt < 0 || tt >= len) continue;
            const bf16* zr = Z + (size_t)(base + tt) * NZ; float a[8], g[8], wv[8]; ld8(zr + ZA + ch, a); ld8(zr + ZAG + ch, g); ldf8(w + j * 512 + ch, wv);
#pragma unroll
            for (int i = 0; i < 8; ++i) acc[i] = fmaf(a[i] * sigmoidf_(g[i]), wv[i], acc[i]); }
        float bv[8]; ldf8(p.conv_b + l * 512 + ch, bv); float s = 0.f;
#pragma unroll
        for (int i = 0; i < 8; ++i) { acc[i] += bv[i]; s += acc[i]; }
        const float mean = wave_sum(s) * (1.f / 512.f); float q = 0.f;
#pragma unroll
        for (int i = 0; i < 8; ++i) { acc[i] -= mean; q += acc[i] * acc[i]; }
        const float rstd = rsqrtf(wave_sum(q) * (1.f / 512.f) + 1e-6f);
        float lg[8], lb[8], o[8]; ldf8(p.conv_ln_g + l * 512 + ch, lg); ldf8(p.conv_ln_b + l * 512 + ch, lb);
#pragma unroll
        for (int i = 0; i < 8; ++i) o[i] = siluf_(acc[i] * rstd * lg[i] + lb[i]);
        st8(Y + (size_t)row * D + ch, o);
    }
    {
        LAS float* in = (LAS float*)c.lds;
        const float* mu = p.rw_mu + (size_t)l * 2 * RWMIX;
        for (int u = c.bid; u < MROWS / 34; u += c.G) {
            const int row0 = u * 34;
            __syncthreads();
            for (int i = c.tid; i < 34 * 448; i += 512) { const int t = i / 448, k = i % 448; float f = rw_feat(Z, mu, row0 + t, 1536 + k);
                if (k < 96) f = tanhf(f); else if (k >= 192) f = sigmoidf_(f); in[i] = f; }
            __syncthreads();
            for (int hf = 0; hf < 34 / RWT; ++hf) rwkv_prep_rows(c, l, row0 + hf * RWT, in + hf * RWT * 448, in + 34 * 448, in + 34 * 448 + RWT * 512);
        }
        __syncthreads();
    }
    for (int u = c.bid; u < ML_NU; u += c.G) mlstm_local(c, l, u);
    for (int u = c.bid; u < GD_NU; u += c.G) gdn_local(c, l, u);
    __syncthreads();
}


DI void scan_mlstm(Ctx& c, int l, int chain) {
    const Params& p = *c.p; const bf16* Z = (const bf16*)(c.ws + WS_Z); const float* G32 = (const float*)(c.ws + WS_G32); float* SA = (float*)(c.ws + WS_S);
    const int g = chain >> 2, h = chain & 3, dir = g >> 1, b = g & 1; const int e = c.tid >> 2, dq = c.tid & 3;
    LAS float* sq = (LAS float*)c.lds; LAS float* sk = sq + 64 * 144; LAS float* sv = sk + 64 * 144; LAS float* sg = sv + 64 * 128;
    float* HM = SA + (size_t)(SA_HM0 + dir) * ((size_t)MROWS * 512);
    float C[32], nn[32], m = 0.f;
#pragma unroll
    for (int i = 0; i < 32; ++i) { C[i] = 0.f; nn[i] = 0.f; }
    const float gbi = p.ml_gate_b[((l * 2 + dir) * 2 + 0) * 4 + h], gbf = p.ml_gate_b[((l * 2 + dir) * 2 + 1) * 4 + h];
    for (int blk = 0; blk < (TC + T) / 64; ++blk) {
        __syncthreads();
        for (int it = c.tid; it < 64 * 48; it += 512) { const int tt = it / 48, r = it % 48, part = r >> 4, c8 = (r & 15) * 8; const int row = scan_row(dir, b, blk * 64 + tt);
            float v[8]; ld8(Z + (size_t)row * NZ + MLQ + part * 512 + h * 128 + c8, v);
            if (part == 2) {
#pragma unroll
                for (int i = 0; i < 8; ++i) sv[tt * 128 + c8 + i] = v[i]; }
            else { LAS float* d = (part == 0 ? sq : sk) + tt * 144 + (c8 >> 5) * 36 + (c8 & 31); const float sc = part == 0 ? 0.08838834764831845f : 1.f;
#pragma unroll
                for (int i = 0; i < 8; ++i) d[i] = v[i] * sc; } }
        if (c.tid < 64) { const int row = scan_row(dir, b, blk * 64 + c.tid); sg[c.tid * 2] = G32[(size_t)row * 32 + dir * 8 + h] + gbi; sg[c.tid * 2 + 1] = logsigmoidf_(G32[(size_t)row * 32 + dir * 8 + 4 + h] + gbf); }
        __syncthreads();
        for (int tt = 0; tt < 64; ++tt) {
            const float li = sg[2 * tt], lf = sg[2 * tt + 1]; const float mn = fmaxf(lf + m, li); const float fs = expf(lf + m - mn), is = expf(li - mn); m = mn;
            const float iv = is * sv[tt * 128 + e]; float hp = 0.f, dp = 0.f;
#pragma unroll
            for (int i4 = 0; i4 < 8; ++i4) { const f32x4 k4 = *(const LAS f32x4*)(sk + tt * 144 + dq * 36 + i4 * 4), q4 = *(const LAS f32x4*)(sq + tt * 144 + dq * 36 + i4 * 4);
#pragma unroll
                for (int j = 0; j < 4; ++j) { const int i = i4 * 4 + j; C[i] = fmaf(C[i], fs, iv * k4[j]); hp = fmaf(C[i], q4[j], hp); nn[i] = fmaf(nn[i], fs, is * k4[j]); dp = fmaf(nn[i], q4[j], dp); } }
            hp += __shfl_xor(hp, 1); hp += __shfl_xor(hp, 2); dp += __shfl_xor(dp, 1); dp += __shfl_xor(dp, 2);
            if (dq == 0) HM[(size_t)scan_row(dir, b, blk * 64 + tt) * 512 + h * 128 + e] = hp / fmaxf(fabsf(dp), expf(-m));
        }
    }
}
DI void scan_gdn(Ctx& c, int l, int chain) {
    float* SA = (float*)(c.ws + WS_S); const float* SG = (const float*)(c.ws + WS_SG); const size_t AS = (size_t)MROWS * 512;
    const int g = chain >> 2, h = chain & 3, dir = g >> 1, b = g & 1; const int e = c.tid >> 2, dq = c.tid & 3;
    LAS float* sq = (LAS float*)c.lds; LAS float* sk = sq + 64 * 144; LAS float* sv = sk + 64 * 144; LAS float* sg = sv + 64 * 128;
    float* HG = SA + (size_t)(SA_HG0 + dir) * AS;
    float S[32];
#pragma unroll
    for (int i = 0; i < 32; ++i) S[i] = 0.f;
    for (int blk = 0; blk < (TC + T) / 64; ++blk) {
        __syncthreads();
        for (int it = c.tid; it < 64 * 48; it += 512) { const int tt = it / 48, r = it % 48, part = r >> 4, c8 = (r & 15) * 8; const int row = scan_row(dir, b, blk * 64 + tt);
            float v[8]; ldf8(SA + (size_t)(SA_GQ + part) * AS + (size_t)row * 512 + h * 128 + c8, v);
            LAS float* d = part == 2 ? sv + tt * 128 + c8 : (part == 0 ? sq : sk) + tt * 144 + (c8 >> 5) * 36 + (c8 & 31);
#pragma unroll
            for (int i = 0; i < 8; ++i) d[i] = v[i]; }
        if (c.tid < 64) { const int row = scan_row(dir, b, blk * 64 + c.tid); sg[c.tid * 2] = expf(SG[(size_t)row * 16 + dir * 4 + h]); sg[c.tid * 2 + 1] = SG[(size_t)row * 16 + 8 + dir * 4 + h]; }
        __syncthreads();
        for (int tt = 0; tt < 64; ++tt) {
            const float a = sg[2 * tt], be = sg[2 * tt + 1]; float pp = 0.f; f32x4 k4[8];
#pragma unroll
            for (int i4 = 0; i4 < 8; ++i4) { k4[i4] = *(const LAS f32x4*)(sk + tt * 144 + dq * 36 + i4 * 4);
#pragma unroll
                for (int j = 0; j < 4; ++j) { const int i = i4 * 4 + j; S[i] *= a; pp = fmaf(k4[i4][j], S[i], pp); } }
            pp += __shfl_xor(pp, 1); pp += __shfl_xor(pp, 2);
            const float vn = be * (sv[tt * 128 + e] - pp); float o = 0.f;
#pragma unroll
            for (int i4 = 0; i4 < 8; ++i4) { const f32x4 q4 = *(const LAS f32x4*)(sq + tt * 144 + dq * 36 + i4 * 4);
#pragma unroll
                for (int j = 0; j < 4; ++j) { const int i = i4 * 4 + j; S[i] = fmaf(k4[i4][j], vn, S[i]); o = fmaf(q4[j], S[i], o); } }
            o += __shfl_xor(o, 1); o += __shfl_xor(o, 2);
            if (dq == 0) HG[(size_t)scan_row(dir, b, blk * 64 + tt) * 512 + h * 128 + e] = o;
        }
    }
}
DI void scan_rwkv(Ctx& c, int l, int chain) {
    float* SA = (float*)(c.ws + WS_S); const size_t AS = (size_t)MROWS * 512;
    const int g = chain >> 3, h = chain & 7, dir = g >> 1, b = g & 1; const int i = c.tid >> 3, part = c.tid & 7;
    LAS float* sr = (LAS float*)c.lds;
    float* HR = SA + (size_t)(SA_HR0 + dir) * AS;
    float S[8];
#pragma unroll
    for (int j = 0; j < 8; ++j) S[j] = 0.f;
    for (int blk = 0; blk < (TC + T) / 64; ++blk) {
        __syncthreads();
        for (int it = c.tid; it < 6 * 64 * 8; it += 512) { const int arr = it / 512, r = it % 512, tt = r >> 3, c8 = (r & 7) * 8; const int row = scan_row(dir, b, blk * 64 + tt);
            const int sa = arr == 0 ? SA_RR : arr == 1 ? SA_RW0 + dir : arr == 2 ? SA_RK0 + dir : arr == 3 ? SA_RV : arr == 4 ? SA_RA : SA_RB0 + dir;
            float v[8]; ldf8(SA + (size_t)sa * AS + (size_t)row * 512 + h * 64 + c8, v); LAS float* d = sr + arr * 4096 + tt * 64 + c8;
#pragma unroll
            for (int j = 0; j < 8; ++j) d[j] = v[j]; }
        __syncthreads();
        for (int tt = 0; tt < 64; ++tt) {
            const LAS float* bp = sr + tt * 64 + part * 8;
            float r8[8], w8[8], k8[8], a8[8], b8[8];
#pragma unroll
            for (int j = 0; j < 8; j += 4) { const f32x4 x0 = *(const LAS f32x4*)(bp + j), x1 = *(const LAS f32x4*)(bp + 4096 + j), x2 = *(const LAS f32x4*)(bp + 8192 + j), x4 = *(const LAS f32x4*)(bp + 16384 + j), x5 = *(const LAS f32x4*)(bp + 20480 + j);
#pragma unroll
                for (int q = 0; q < 4; ++q) { r8[j + q] = x0[q]; w8[j + q] = x1[q]; k8[j + q] = x2[q]; a8[j + q] = x4[q]; b8[j + q] = x5[q]; } }
            const float vi = sr[3 * 4096 + tt * 64 + i];
            float sa = 0.f;
#pragma unroll
            for (int j = 0; j < 8; ++j) sa = fmaf(S[j], a8[j], sa);
            sa += __shfl_xor(sa, 1); sa += __shfl_xor(sa, 2); sa += __shfl_xor(sa, 4);
            float y = 0.f;
#pragma unroll
            for (int j = 0; j < 8; ++j) { S[j] = fmaf(S[j], w8[j], fmaf(sa, b8[j], vi * k8[j])); y = fmaf(S[j], r8[j], y); }
            y += __shfl_xor(y, 1); y += __shfl_xor(y, 2); y += __shfl_xor(y, 4);
            if (part == 0) HR[(size_t)scan_row(dir, b, blk * 64 + tt) * 512 + h * 64 + i] = y;
        }
    }
}
DI void phase_mid1(Ctx& c, int l) {
    mlstm_prefix(c);
    for (int u = c.bid; u < 128; u += c.G) gdn_prefix(c, u);
    for (int u = c.bid; u < RW_NU; u += c.G) rwkv_local(c, l, u);
    __syncthreads();
}
DI void phase_mid2(Ctx& c, int l) {
    for (int u = c.bid; u < 128; u += c.G) rwkv_prefix(c, u);
    __syncthreads();
}
DI void phase_finish(Ctx& c, int l) {
    for (int u = c.bid; u < NB * 4 * 68; u += c.G) mlstm_out(c, l, u);
    for (int u = c.bid; u < NB * 4 * 68; u += c.G) gdn_out(c, l, u);
    for (int u = c.bid; u < NB * 68 * 2; u += c.G) rwkv_out(c, l, u);
    __syncthreads();
}
DI void phase_ffnconv(Ctx& c, int l) {
    const Params& p = *c.p; const bf16* UP = (const bf16*)(c.ws + WS_Z); bf16* H = (bf16*)(c.ws + WS_S); const float* w = p.ffn_dw + (size_t)l * 9 * DFF;
    constexpr int CPR = DFF / 8;
    for (int it = c.bid * 512 + c.tid; it < MROWS * CPR; it += c.G * 512) {
        const int row = it / CPR, ch = (it % CPR) * 8; float acc[8];
#pragma unroll
        for (int i = 0; i < 8; ++i) acc[i] = 0.f;
        if (row < LAT) { const int bb = row >> 12, t = row & 4095, gy = t >> 6, gx = t & 63;
#pragma unroll
            for (int dy = 0; dy < 3; ++dy)
#pragma unroll
                for (int dx = 0; dx < 3; ++dx) { const int yy = gy + dy - 1, xx = gx + dx - 1; if (yy < 0 || yy >= 64 || xx < 0 || xx >= 64) continue;
                    float a[8], wv[8]; ld8(UP + (size_t)(bb * T + yy * 64 + xx) * (2 * DFF) + ch, a); ldf8(w + (dy * 3 + dx) * DFF + ch, wv);
#pragma unroll
                    for (int i = 0; i < 8; ++i) acc[i] = fmaf(a[i], wv[i], acc[i]); } }
        else { const int r = row - LAT, t = r & (TC - 1);
#pragma unroll
            for (int dx = 0; dx < 3; ++dx) { const int tt = t + dx - 1; if (tt < 0 || tt >= TC) continue;
                float a[8], wv[8]; ld8(UP + (size_t)(row + dx - 1) * (2 * DFF) + ch, a); ldf8(w + (3 + dx) * DFF + ch, wv);
#pragma unroll
                for (int i = 0; i < 8; ++i) acc[i] = fmaf(a[i], wv[i], acc[i]); } }
        float v[8], o[8]; ld8(UP + (size_t)row * (2 * DFF) + DFF + ch, v);
#pragma unroll
        for (int i = 0; i < 8; ++i) o[i] = gelu_tanh(acc[i]) * v[i];
        st8(H + (size_t)row * DFF + ch, o);
    }
}

constexpr int PH_PRO = 3, PH_PER_LAYER = 12, NPHASE = PH_PRO + NL * PH_PER_LAYER;
#ifndef MK_PER_PHASE
#define MK_PER_PHASE 0
#endif
constexpr int CW_BAR = 4096;

__global__ void __launch_bounds__(512, 2) fwd_kernel(Params p) {
    extern __shared__ __attribute__((aligned(16))) unsigned char lds_raw[];
    Ctx c; c.lds = (LAS unsigned char*)lds_raw; c.tid = threadIdx.x; c.lane = c.tid & 63; c.wave = __builtin_amdgcn_readfirstlane(c.tid >> 6); c.G = gridDim.x; c.bid = blockIdx.x; c.p = &p; c.ws = p.ws;
    volatile LAS unsigned* MISC = (volatile LAS unsigned*)(c.lds + LDS_MISC);
    if (c.tid < 32) MISC[c.tid] = 0u;
    __syncthreads();
    const int lo = p.ph_lo, hi = p.ph_hi;
    XcdBarrier bar; bar.bar = (unsigned*)(p.ws + WS_CTL) + CW_BAR; bar.x = 0; bar.st = MISC + 8;
    if (hi - lo > 1) bar = xcd_barrier_post((unsigned*)(p.ws + WS_CTL) + CW_BAR, MISC + 8);
#ifndef PH_MASK
#define PH_MASK 0xFFFFFFFFu
#endif
#define IN(k) (lo <= (k) && (k) < hi)
#define EN(b) ((PH_MASK >> (b)) & 1u)
#define RF() do { int t_ = threadIdx.x; asm volatile("" : "+v"(t_)); c.tid = t_; c.lane = t_ & 63; } while (0)
#define SEAM(k) do { if (IN((k) + 1)) xcd_barrier(bar); } while (0)
    if (EN(0) && IN(0)) { RF(); phase_pro0(c); SEAM(0); }
    if (EN(1) && IN(1)) { RF(); phase_pro1(c); SEAM(1); }
    if (EN(2) && IN(2)) { RF(); phase_pro2(c); phase_wconv(c, 0); SEAM(2); }
    bf16* U = (bf16*)(p.ws + WS_U); bf16* Y = (bf16*)(p.ws + WS_Y); bf16* MB = (bf16*)(p.ws + WS_MB); float* G32 = (float*)(p.ws + WS_G32); float* F = (float*)(p.ws + WS_F);
    bf16* Z = (bf16*)(p.ws + WS_Z); bf16* H = (bf16*)(p.ws + WS_S);
    for (int l = 0; l < NL; ++l) {
        const int pb = PH_PRO + l * PH_PER_LAYER; unsigned char* wl = p.ws + WS_W;
        if (EN(3) && IN(pb + 0)) { pg8::Gemm g{U, (const bf16*)(wl + WL_IN), D, D, D}; pg8::StdOrder S; S.init(MROWS / 256, NZ / 256, c.G, c.bid); pg8::EpiBf16 E{Z, NZ, G32, (ZSM - 192) / 256};
            pg8::gemm_phase(c.lds, g, S, E); SEAM(pb + 0); }
        if (EN(4) && IN(pb + 1)) { RF(); phase_prep(c, l); SEAM(pb + 1); }
        if (EN(5) && IN(pb + 2)) { RF(); phase_mid1(c, l); SEAM(pb + 2); }
        if (EN(6) && IN(pb + 3)) { RF(); phase_mid2(c, l); SEAM(pb + 3); }
        if (EN(7) && IN(pb + 4)) { RF(); phase_finish(c, l); SEAM(pb + 4); }
        if (EN(8) && IN(pb + 5)) { pg8::Gemm g{Y, (const bf16*)(wl + WL_BR), D, MIXW, MIXW}; pg8::MergeOrder S; S.init(MROWS / 256, D / 256, c.G, c.bid); pg8::EpiMerge E{Z, NZ, ZG, F, MB, D};
            pg8::gemm_phase(c.lds, g, S, E); SEAM(pb + 5); }
        if (EN(9) && IN(pb + 6)) { pg8::Gemm g{MB, (const bf16*)(wl + WL_OUT), D, D, D}; pg8::StdOrder S; S.init(MROWS / 256, D / 256, c.G, c.bid); pg8::EpiF32 E{F, D};
            pg8::gemm_phase(c.lds, g, S, E); SEAM(pb + 6); }
        if (EN(10) && IN(pb + 7)) { RF(); phase_resid(c, l, 0); SEAM(pb + 7); }
        if (EN(11) && IN(pb + 8)) { pg8::Gemm g{U, (const bf16*)(wl + WL_UP), D, D, D}; pg8::StdOrder S; S.init(MROWS / 256, 2 * DFF / 256, c.G, c.bid); pg8::EpiBf16 E{Z, 2 * DFF, nullptr, -1};
            pg8::gemm_phase(c.lds, g, S, E); SEAM(pb + 8); }
        if (EN(12) && IN(pb + 9)) { RF(); phase_ffnconv(c, l); SEAM(pb + 9); }
        if (EN(13) && IN(pb + 10)) { pg8::Gemm g{H, (const bf16*)(wl + WL_DN), DFF, DFF, DFF}; pg8::StdOrder S; S.init(MROWS / 256, D / 256, c.G, c.bid); pg8::EpiF32 E{F, D};
            pg8::gemm_phase(c.lds, g, S, E); SEAM(pb + 10); }
        if (EN(14) && IN(pb + 11)) { RF(); phase_resid(c, l, 1); if (l + 1 < NL) phase_wconv(c, l + 1); SEAM(pb + 11); }
    }
#undef IN
#undef SEAM
}

extern "C" void kernel_launch(void* const* d_in, const int* in_sizes, int n_in, void* d_out, int out_size, void* d_ws, size_t ws_size, hipStream_t stream) {
    static int grid = 0;
    if (grid == 0) {
        if (n_in != 34 || ws_size < WS_END) { fprintf(stderr, "kernel_launch: unexpected n_in %d / ws %zu (need %zu)\n", n_in, ws_size, (size_t)WS_END); grid = -1; return; }
        int dev = 0, cus = 0;
        if (hipGetDevice(&dev) != hipSuccess || hipDeviceGetAttribute(&cus, hipDeviceAttributeMultiprocessorCount, dev) != hipSuccess) { grid = -1; return; }
        if (hipFuncSetAttribute((const void*)fwd_kernel, hipFuncAttributeMaxDynamicSharedMemorySize, LDS_BYTES) != hipSuccess) { fprintf(stderr, "kernel_launch: hipFuncSetAttribute failed\n"); grid = -1; return; }
        int per_cu = 0;
        if (hipOccupancyMaxActiveBlocksPerMultiprocessor(&per_cu, (const void*)fwd_kernel, 512, LDS_BYTES) != hipSuccess || per_cu < 1) { fprintf(stderr, "kernel_launch: occupancy query says %d\n", per_cu); }
        (void)hipGetLastError();
        grid = cus;
    }
    if (grid < 0) return;
    (void)hipMemsetAsync((char*)d_ws + WS_CTL, 0, CTL_BYTES, stream);
    Params p{};
    const float** pp = (const float**)&p;
    for (int i = 0; i < 34; ++i) pp[i] = (const float*)d_in[i];
    p.out = (float*)d_out; p.ws = (unsigned char*)d_ws;
#if MK_PER_PHASE
    for (int k = 0; k < NPHASE; ++k) { p.ph_lo = k; p.ph_hi = k + 1; hipLaunchKernelGGL(fwd_kernel, dim3(grid), dim3(512), LDS_BYTES, stream, p); }
#else
    p.ph_lo = 0; p.ph_hi = NPHASE; hipLaunchKernelGGL(fwd_kernel, dim3(grid), dim3(512), LDS_BYTES, stream, p);
#endif
}
```

```cpp
#include <hip/hip_runtime.h>
#include <cstdio>
#include <cstdint>

#ifndef DUP_SUB
#define DUP_SUB 0u
#endif
#define REPS(b) for (int reps_ = 0; reps_ < ((((DUP_SUB) >> (b)) & 1u) ? 2 : 1); ++reps_)
#define GAS __attribute__((address_space(1)))
#define LAS __attribute__((address_space(3)))
#define DI __device__ __forceinline__
typedef unsigned short bf16;
typedef float f32x4 __attribute__((ext_vector_type(4)));
typedef float f32x2 __attribute__((ext_vector_type(2)));
typedef unsigned u32x4 __attribute__((ext_vector_type(4)));
typedef unsigned u32x2 __attribute__((ext_vector_type(2)));
typedef short bf16x8 __attribute__((ext_vector_type(8)));

constexpr int D = 2048, NB = 2, T = 4096, TC = 256, NL = 4;
constexpr int LAT = NB * T;
constexpr int MROWS = LAT + NB * TC;
constexpr int MIXW = 512, DFF = 5632;
constexpr int NIN = 15328, NZ = 15360;
constexpr int ZA = 0, ZAG = 512, MLQ = 1024, MLK = 1536, MLV = 2048, MLO = 2560, GDQ = 3072, GDK = 3584, GDV = 4096, GDZ = 4608;
constexpr int RWR = 5120, RWK = 5632, RWV = 6144, RWXW = 6656, RWXA = 6752, RWXG = 6848, ZSM = 7104, ZG = 7168;
constexpr int RWMIX = 1984;

namespace pg8 {
typedef unsigned short bf16_t;
constexpr int BM = 256, BK = 64, HALF = 128, HTB = HALF * BK * 2, STAGE_BYTES = 8 * HTB, NXCD = 8, WGM = 8;
__host__ __device__ __forceinline__ int lds_byte(int r, int c) { const int st = (r >> 4) * 2 + (c >> 5), rr = r & 15, cc = c & 31, ob = rr * 64 + cc * 2; return st * 1024 + (ob ^ (((ob >> 9) & 1) << 5)); }
__host__ __device__ __forceinline__ void stage_rc(int b, int& R, int& C) { const int st = b / 1024, sb = b % 1024, swz = sb ^ (((sb >> 9) & 1) << 5); R = (st >> 1) * 16 + swz / 64; C = (st & 1) * 32 + (swz % 64) / 2; }
__host__ __device__ __forceinline__ int perm32(int rho) { const int n = rho >> 4, i = rho & 15; return 8 * (i >> 2) + 4 * n + (i & 3); }

struct Unit { int pm, pn, sub; };
struct Gemm { const bf16_t* A; const bf16_t* Bt; int lda, ldb, K; };

struct StdOrder {
    int nM, nN, nwg, G, c;
    DI void init(int nM_, int nN_, int G_, int c_) { nM = nM_; nN = nN_; nwg = nM * nN; G = G_; c = c_; }
    DI bool map(int i, Unit& u) const {
        const long L = (long)i * G + c; if (L >= nwg) return false;
        int wgid = (int)L; { const int q = nwg / NXCD, r = nwg % NXCD, xcd = wgid % NXCD, off = wgid / NXCD; wgid = (xcd < r ? xcd * (q + 1) : r * (q + 1) + (xcd - r) * q) + off; }
        const int nig = WGM * nN, gid = wgid / nig, fm = gid * WGM, gsz = (nM - fm) < WGM ? (nM - fm) : WGM;
        u.pm = fm + ((wgid % nig) % gsz); u.pn = (wgid % nig) / gsz; return true;
    }
    DI bool next(int i, Unit& u) const { u.sub = 0; return map(i, u); }
    DI const char* a_ptr(const Gemm& g, const Unit& u) const { return (const char*)g.A + (size_t)u.pm * BM * g.lda * 2; }
    DI const char* b_ptr(const Gemm& g, const Unit& u) const { return (const char*)g.Bt + (size_t)u.pn * BM * g.ldb * 2; }
    DI int ntiles(const Gemm& g, const Unit&) const { return g.K / BK; }
};
struct MergeOrder : StdOrder {
    int nctx;
    DI void init2(int G_, int c_, bool with_ctx) { init(32, 8, G_, c_); nctx = with_ctx ? 64 : 0; }
    DI bool next(int i4, Unit& u) const {
        if (i4 < 4) { u.sub = i4; return map(0, u); }
        const int j = c + (i4 - 4) * G; if (j >= nctx) return false;
        const int cu = j >> 2; u.sub = 4 + (j & 3); u.pm = 32 + (cu >> 3); u.pn = cu & 7; return true; }
    DI const char* a_ptr(const Gemm& g, const Unit& u) const { return (const char*)g.A + (size_t)u.pm * BM * g.lda * 2 + (size_t)(u.sub & 3) * 512 * 2; }
    DI const char* b_ptr(const Gemm& g, const Unit& u) const { return (const char*)g.Bt + ((size_t)(u.sub & 3) * 2048 + (size_t)u.pn * BM) * g.ldb * 2; }
    DI int ntiles(const Gemm& g, const Unit&) const { return g.K / BK; }
};
struct SplitOrder : StdOrder {
    int SK, KS; const bf16_t* Actx; int kwrap;
    DI void init2(int nN_, int G_, int c_, int SK_, int KS_, const bf16_t* Actx_ = nullptr, int kwrap_ = 0) { init(32, nN_, G_, c_); SK = SK_; KS = KS_; Actx = Actx_; kwrap = kwrap_; }
    DI bool next(int i, Unit& u) const {
        if (i == 0) { u.sub = 0; if (map(0, u)) return true; }
        const int j = c + (i - 1) * G; if (i < 1 || j >= 2 * nN * SK) return false;
        const int cu = j / SK; u.sub = 1 + j % SK; u.pm = 32 + cu / nN; u.pn = cu % nN; return true; }
    DI const char* a_ptr(const Gemm& g, const Unit& u) const {
        if (u.sub && Actx) { const int kk = (u.sub - 1) * KS; return (const char*)Actx + ((size_t)(kk / kwrap) * 512 + (size_t)(u.pm - 32) * BM) * g.lda * 2 + (size_t)(kk % kwrap) * 2; }
        return (const char*)g.A + (size_t)u.pm * BM * g.lda * 2 + (u.sub ? (size_t)(u.sub - 1) * KS * 2 : 0); }
    DI const char* b_ptr(const Gemm& g, const Unit& u) const { const int kk = u.sub ? (u.sub - 1) * KS : 0; return (const char*)g.Bt + (size_t)u.pn * BM * g.ldb * 2 + (size_t)(kwrap ? kk % kwrap : kk) * 2; }
    DI int ntiles(const Gemm& g, const Unit& u) const { return u.sub ? KS / BK : g.K / BK; }
};
DI int lane_id_hw() { int l; asm volatile("v_mbcnt_lo_u32_b32 %0, -1, 0\n\tv_mbcnt_hi_u32_b32 %0, -1, %0" : "=v"(l)); return l; }
DI unsigned cvt_pk_bf16(float lo, float hi) { unsigned r; asm volatile("v_cvt_pk_bf16_f32 %0, %1, %2" : "=v"(r) : "v"(lo), "v"(hi)); return r; }

struct EpiF32 {
    static constexpr bool PERM = false; DI bool keep(const Unit&) const { return false; }
    float* C; int ldc;
    DI void operator()(const f32x4 (&acc)[2][2][4][2], const Unit& u, int wr, int wc, int fr, int fq) const {
        const int row0 = u.pm * BM + wr * 64 + fr, col0 = u.pn * BM + wc * 32 + 4 * fq;
#pragma unroll
        for (int ai = 0; ai < 2; ++ai)
#pragma unroll
            for (int m = 0; m < 4; ++m) { float* rowp = C + (size_t)(row0 + ai * HALF + m * 16) * ldc + col0;
#pragma unroll
                for (int bj = 0; bj < 2; ++bj)
#pragma unroll
                    for (int n = 0; n < 2; ++n) *(f32x4*)(rowp + bj * HALF + n * 16) = acc[ai][bj][m][n]; }
    }
};
struct EpiF32Split {
    static constexpr bool PERM = false; DI bool keep(const Unit&) const { return false; }
    float* C; float* PART; int ldc;
    DI void operator()(const f32x4 (&acc)[2][2][4][2], const Unit& u, int wr, int wc, int fr, int fq) const {
        float* base = u.sub ? PART + ((long)(u.sub - 1) * 512 - 8192) * (long)ldc : C;
        const int row0 = u.pm * BM + wr * 64 + fr, col0 = u.pn * BM + wc * 32 + 4 * fq;
#pragma unroll
        for (int ai = 0; ai < 2; ++ai)
#pragma unroll
            for (int m = 0; m < 4; ++m) { float* rowp = base + (size_t)(row0 + ai * HALF + m * 16) * ldc + col0;
#pragma unroll
                for (int bj = 0; bj < 2; ++bj)
#pragma unroll
                    for (int n = 0; n < 2; ++n) *(f32x4*)(rowp + bj * HALF + n * 16) = acc[ai][bj][m][n]; }
    }
};
struct EpiMixSplit {
    static constexpr bool PERM = true; DI bool keep(const Unit&) const { return false; }
    bf16_t* Fh; float* PART; int ldc;
    DI void operator()(const f32x4 (&acc)[2][2][4][2], const Unit& u, int wr, int wc, int fr, int fq) const {
        const int row0 = u.pm * BM + wr * 64 + fr, col0 = u.pn * BM + wc * 32 + 8 * fq;
        float* pb = PART + ((long)(u.sub - 1) * 512 - 8192) * (long)ldc;
#pragma unroll
        for (int ai = 0; ai < 2; ++ai)
#pragma unroll
            for (int m = 0; m < 4; ++m) { const size_t ro = (size_t)(row0 + ai * HALF + m * 16) * ldc + col0;
#pragma unroll
                for (int bj = 0; bj < 2; ++bj) { const f32x4 v0 = acc[ai][bj][m][0], v1 = acc[ai][bj][m][1];
                    if (u.sub) { *(f32x4*)(pb + ro + bj * HALF) = v0; *(f32x4*)(pb + ro + bj * HALF + 4) = v1; }
                    else { u32x4 w; w.x = cvt_pk_bf16(v0[0], v0[1]); w.y = cvt_pk_bf16(v0[2], v0[3]); w.z = cvt_pk_bf16(v1[0], v1[1]); w.w = cvt_pk_bf16(v1[2], v1[3]); *(u32x4*)(Fh + ro + bj * HALF) = w; } } }
    }
};
struct EpiBf16 {
    static constexpr bool PERM = true; DI bool keep(const Unit&) const { return false; }
    bf16_t* O; int ldc; float* G32; int gtile; bf16_t* GT; int gt0;
    DI void operator()(const f32x4 (&acc)[2][2][4][2], const Unit& u, int wr, int wc, int fr, int fq) const {
        const int row0 = u.pm * BM + wr * 64 + fr; const int col0 = u.pn * BM + wc * 32 + 8 * fq;
#pragma unroll
        for (int ai = 0; ai < 2; ++ai)
#pragma unroll
            for (int m = 0; m < 4; ++m) { const int row = row0 + ai * HALF + m * 16; bf16_t* rowp = O + (size_t)row * ldc + col0;
#pragma unroll
                for (int bj = 0; bj < 2; ++bj) { f32x4 v0 = acc[ai][bj][m][0], v1 = acc[ai][bj][m][1];
                    if (GT != nullptr && u.pn >= gt0) {
#pragma unroll
                        for (int j = 0; j < 4; ++j) { v0[j] = fmaxf(__builtin_amdgcn_rcpf(1.f + __expf(-v0[j])), 1e-13f); v1[j] = fmaxf(__builtin_amdgcn_rcpf(1.f + __expf(-v1[j])), 1e-13f); }
                        u32x4 w; w.x = cvt_pk_bf16(v0[0], v0[1]); w.y = cvt_pk_bf16(v0[2], v0[3]); w.z = cvt_pk_bf16(v1[0], v1[1]); w.w = cvt_pk_bf16(v1[2], v1[3]);
                        *(u32x4*)(GT + ((size_t)(u.pm * 32 + (u.pn - gt0)) << 16) + (wr * 64 + fr + ai * HALF + m * 16) * 256 + wc * 32 + 8 * fq + bj * HALF) = w; continue; }
                    u32x4 w; w.x = cvt_pk_bf16(v0[0], v0[1]); w.y = cvt_pk_bf16(v0[2], v0[3]); w.z = cvt_pk_bf16(v1[0], v1[1]); w.w = cvt_pk_bf16(v1[2], v1[3]);
                    *(u32x4*)(rowp + bj * HALF) = w;
                    if (bj == 1 && G32 != nullptr && u.pn == gtile && wc == 2) { float* gp = G32 + (size_t)row * 32 + 8 * fq; *(f32x4*)gp = v0; *(f32x4*)(gp + 4) = v1; } } }
    }
};
struct EpiMerge {
    static constexpr bool PERM = true;
    const bf16_t* GT; bf16_t* Mb; int ldc; bf16_t* Mbc;
    DI bool keep(const Unit& u) const { return u.sub < 3; }
    DI void operator()(f32x4 (&acc)[2][2][4][2], const Unit& u, int wr, int wc, int fr, int fq) const {
        const int nb = u.sub & 3; const bool lastb = u.sub >= 3; bf16_t* dst = u.sub >= 4 ? Mbc + ((long)nb * 512 - 8192) * (long)ldc : Mb;
        const int row0 = u.pm * BM + wr * 64 + fr; const int col0 = u.pn * BM + wc * 32 + 8 * fq;
#pragma unroll
        for (int a2 = 0; a2 < 4; ++a2) { const int ai = a2 >> 1, mb = (a2 & 1) * 2;
            u32x4 ga[4][2], gb[4][2];
#pragma unroll
            for (int m = mb; m < mb + 2; ++m)
#pragma unroll
                for (int bj = 0; bj < 2; ++bj) { const bf16_t* gp = GT + ((size_t)(u.pm * 32 + nb * 8 + u.pn) << 16) + (wr * 64 + fr + ai * HALF + m * 16) * 256 + wc * 32 + 8 * fq + bj * HALF;
                    ga[m][bj] = *(const u32x4*)gp; gb[m][bj] = lastb ? ga[m][bj] : *(const u32x4*)(gp + ((size_t)8 << 16)); }
#pragma unroll
            for (int m = mb; m < mb + 2; ++m) { const int row = row0 + ai * HALF + m * 16;
#pragma unroll
                for (int bj = 0; bj < 2; ++bj) { const int col = col0 + bj * HALF;
                    float sc[8];
#pragma unroll
                    for (int j = 0; j < 4; ++j) { const float a0 = __uint_as_float(ga[m][bj][j] << 16), a1 = __uint_as_float(ga[m][bj][j] & 0xffff0000u);
                        sc[2 * j] = lastb ? a0 : a0 * __builtin_amdgcn_rcpf(__uint_as_float(gb[m][bj][j] << 16)); sc[2 * j + 1] = lastb ? a1 : a1 * __builtin_amdgcn_rcpf(__uint_as_float(gb[m][bj][j] & 0xffff0000u)); }
                    f32x4& v0 = acc[ai][bj][m][0]; f32x4& v1 = acc[ai][bj][m][1];
#pragma unroll
                    for (int j = 0; j < 4; ++j) { v0[j] *= sc[j]; v1[j] *= sc[4 + j]; }
                    if (lastb) { u32x4 w; w.x = cvt_pk_bf16(v0[0], v0[1]); w.y = cvt_pk_bf16(v0[2], v0[3]); w.z = cvt_pk_bf16(v1[0], v1[1]); w.w = cvt_pk_bf16(v1[2], v1[3]);
                        *(u32x4*)(dst + (size_t)row * ldc + col) = w; } } } }
    }
};

template <class Epi, class Sched>
DI void gemm_phase(LAS unsigned char* lds, const Gemm g, const Sched& S, const Epi& E, int wave_id) {
    int tid_ = wave_id * 64 + lane_id_hw(); asm volatile("" : "+v"(tid_));
    const int tid = tid_, wid = wave_id, lane = tid & 63, wr = wid >> 2, wc = wid & 3, fr = lane & 15, fq = lane >> 4;
    unsigned voffA[2], voffB[2];
#pragma unroll
    for (int i = 0; i < 2; ++i) { int R, C; stage_rc(tid * 16 + i * 8192, R, C); const int Rb = Epi::PERM ? ((R & ~31) + perm32(R & 31)) : R;
        voffA[i] = (unsigned)(R * g.lda + C) * 2u; voffB[i] = (unsigned)(Rb * g.ldb + C) * 2u; }
    const size_t kstep = (size_t)(BK * 2);
    const size_t hstepA = (size_t)HALF * g.lda * 2, hstepB = (size_t)HALF * g.ldb * 2;
    const unsigned ldsw = (unsigned)wid * 1024u;
    const int aoff = lds_byte(wr * 64 + fr, fq * 8), boff = lds_byte(wc * 32 + fr, fq * 8);
#define PG8_SA(b, h) (((b) * 2 + (h)) * HTB)
#define PG8_SB(b, h) ((4 + (b) * 2 + (h)) * HTB)
#define PG8_STAGE(bufoff, gbase, voff) do { _Pragma("unroll") for (int _i = 0; _i < 2; ++_i) \
        __builtin_amdgcn_global_load_lds((const unsigned*)((const char*)(gbase) + (voff)[_i]), (LAS unsigned*)(lds + (bufoff) + ldsw + _i * 8192), 16, 0, 0); } while (0)
#define PG8_LDA(dst, b, h) do { _Pragma("unroll") for (int m = 0; m < 4; ++m) _Pragma("unroll") for (int k = 0; k < 2; ++k) dst[m][k] = *(const LAS bf16x8*)(lds + PG8_SA(b, h) + aoff + m * 2048 + k * 1024); } while (0)
#define PG8_LDB(dst, b, h) do { _Pragma("unroll") for (int n = 0; n < 2; ++n) _Pragma("unroll") for (int k = 0; k < 2; ++k) dst[n][k] = *(const LAS bf16x8*)(lds + PG8_SB(b, h) + boff + n * 2048 + k * 1024); } while (0)
#define PG8_MMA(ai, bj, At, Bt) do { __builtin_amdgcn_s_setprio(1); _Pragma("unroll") for (int m = 0; m < 4; ++m) _Pragma("unroll") for (int n = 0; n < 2; ++n) _Pragma("unroll") for (int k = 0; k < 2; ++k) \
        acc[ai][bj][m][n] = __builtin_amdgcn_mfma_f32_16x16x32_bf16(Bt[n][k], At[m][k], acc[ai][bj][m][n], 0, 0, 0); __builtin_amdgcn_s_setprio(0); } while (0)
#define PG8_WAIT_V(n) asm volatile("s_waitcnt vmcnt(" #n ")" ::: "memory")
#define PG8_WAIT_L(n) asm volatile("s_waitcnt lgkmcnt(" #n ")" ::: "memory")
#define PG8_BAR __builtin_amdgcn_s_barrier()
#define PG8_SCHED __builtin_amdgcn_sched_barrier(0)
    Unit cur, nxt; int ui = 0;
    if (!S.next(0, cur)) return;
    f32x4 acc[2][2][4][2];
#pragma unroll
    for (int a = 0; a < 2; ++a)
#pragma unroll
        for (int b = 0; b < 2; ++b)
#pragma unroll
            for (int m = 0; m < 4; ++m)
#pragma unroll
                for (int n = 0; n < 2; ++n) acc[a][b][m][n] = (f32x4){0.f, 0.f, 0.f, 0.f};
    bf16x8 At[4][2], B0[2][2], B1[2][2];
    const char* cA = S.a_ptr(g, cur); const char* cB = S.b_ptr(g, cur);
    PG8_STAGE(PG8_SB(0, 0), cB, voffB); PG8_STAGE(PG8_SB(0, 1), cB + hstepB, voffB); PG8_STAGE(PG8_SA(0, 0), cA, voffA); PG8_STAGE(PG8_SA(0, 1), cA + hstepA, voffA);
    if (wr == 1) PG8_BAR;
    PG8_WAIT_V(2); PG8_BAR;
    PG8_STAGE(PG8_SB(1, 0), cB + kstep, voffB); PG8_STAGE(PG8_SA(1, 0), cA + kstep, voffA); PG8_STAGE(PG8_SB(1, 1), cB + hstepB + kstep, voffB);
    PG8_WAIT_V(6); PG8_BAR;
    for (;;) {
        const bool has_next = S.next(ui + 1, nxt);
        const char* nA = has_next ? S.a_ptr(g, nxt) : cA; const char* nB = has_next ? S.b_ptr(g, nxt) : cB;
        const int nt = S.ntiles(g, cur);
        for (int t = 0; t < nt; t += 2) {
            const bool last = (t == nt - 2);
            const char* a1 = cA + (size_t)(t + 1) * kstep;
            const char* a2 = last ? nA : cA + (size_t)(t + 2) * kstep; const char* b2 = last ? nB : cB + (size_t)(t + 2) * kstep;
            const char* a3 = a2 + kstep; const char* b3 = b2 + kstep;
            PG8_LDB(B0, 0, 0); PG8_LDB(B1, 0, 1); PG8_SCHED; PG8_LDA(At, 0, 0); PG8_STAGE(PG8_SA(1, 1), a1 + hstepA, voffA);
            PG8_WAIT_V(8); PG8_WAIT_L(0); PG8_BAR; PG8_MMA(0, 0, At, B0); PG8_MMA(0, 1, At, B1); PG8_BAR; PG8_SCHED;
            PG8_LDA(At, 0, 1); PG8_STAGE(PG8_SB(0, 0), b2, voffB); PG8_STAGE(PG8_SB(0, 1), b2 + hstepB, voffB); PG8_STAGE(PG8_SA(0, 0), a2, voffA);
            PG8_WAIT_V(8); PG8_WAIT_L(0); PG8_BAR; PG8_MMA(1, 0, At, B0); PG8_MMA(1, 1, At, B1); PG8_BAR; PG8_SCHED;
            PG8_LDB(B0, 1, 0); PG8_LDB(B1, 1, 1); PG8_SCHED; PG8_LDA(At, 1, 0); PG8_STAGE(PG8_SA(0, 1), a2 + hstepA, voffA);
            PG8_WAIT_V(8); PG8_WAIT_L(0); PG8_BAR; PG8_MMA(0, 0, At, B0); PG8_MMA(0, 1, At, B1); PG8_BAR; PG8_SCHED;
            PG8_LDA(At, 1, 1); PG8_STAGE(PG8_SB(1, 0), b3, voffB); PG8_STAGE(PG8_SB(1, 1), b3 + hstepB, voffB); PG8_STAGE(PG8_SA(1, 0), a3, voffA);
            PG8_WAIT_V(8); PG8_WAIT_L(0); PG8_BAR; PG8_MMA(1, 0, At, B0); PG8_MMA(1, 1, At, B1); PG8_BAR; PG8_SCHED;
        }
        if (wr == 0) PG8_BAR;
        { const int le = lane_id_hw(); E(acc, cur, wr, wc, le & 15, le >> 4); }
        if (!has_next) break;
        if (!E.keep(cur)) {
#pragma unroll
        for (int a = 0; a < 2; ++a)
#pragma unroll
            for (int b = 0; b < 2; ++b)
#pragma unroll
                for (int m = 0; m < 4; ++m)
#pragma unroll
                    for (int n = 0; n < 2; ++n) acc[a][b][m][n] = (f32x4){0.f, 0.f, 0.f, 0.f}; }
        cur = nxt; cA = nA; cB = nB; ++ui;
        if (wr == 1) PG8_BAR;
    }
    PG8_WAIT_V(0);
    PG8_BAR;
#undef PG8_SA
#undef PG8_SB
#undef PG8_STAGE
#undef PG8_LDA
#undef PG8_LDB
#undef PG8_MMA
#undef PG8_WAIT_V
#undef PG8_WAIT_L
#undef PG8_BAR
#undef PG8_SCHED
}
}

constexpr size_t al256(size_t x) { return (x + 255) & ~(size_t)255; }
constexpr size_t WS_CTL = 0, CTL_BYTES = 1u << 20;
constexpr size_t WS_MODP = WS_CTL + CTL_BYTES;
constexpr size_t WS_MOD = WS_MODP + al256((size_t)NL * 8 * 3 * 12288 * 4);
constexpr size_t WS_W = WS_MOD + al256((size_t)NL * 3 * 12288 * 4);
constexpr size_t WL_IN = 0, WL_BR = WL_IN + (size_t)NZ * D * 2, WL_OUT = WL_BR + (size_t)4 * D * MIXW * 2, WL_UP = WL_OUT + (size_t)D * D * 2,
                 WL_DN = WL_UP + (size_t)2 * DFF * D * 2, WL_LORA = WL_DN + (size_t)D * DFF * 2, WL_SIZE = WL_LORA + (size_t)(4 * 512 * 96 + 512 * 256) * 2;
constexpr size_t WS_U = WS_W + WL_SIZE;
constexpr size_t WS_Y = WS_U + (size_t)MROWS * D * 2;
constexpr size_t WS_MB = WS_Y + (size_t)MROWS * D * 2;
constexpr size_t WS_G32 = WS_MB + (size_t)MROWS * D * 2;
constexpr size_t WS_X = WS_G32 + (size_t)MROWS * 32 * 4;
constexpr size_t WS_F = WS_X + (size_t)MROWS * D * 4;
constexpr size_t WS_Z = WS_F + (size_t)MROWS * D * 4;
constexpr size_t WS_S = WS_Z + (size_t)MROWS * NZ * 2;
constexpr size_t SARR = (size_t)MROWS * MIXW * 4;
constexpr int N_SARR = 6;
constexpr size_t WS_SG = WS_S + N_SARR * SARR;
constexpr size_t WS_ML = WS_SG + (size_t)MROWS * 16 * 4;
constexpr int ML_US = 16640, ML_NL = 16384, ML_HDR = 16512, ML_NU = 16 * 68;
constexpr size_t WS_MLC = WS_ML + (size_t)ML_NU * ML_US * 4;
constexpr int MLC_US = 144 * 128;
constexpr size_t WS_MLM = WS_MLC + (size_t)ML_NU * MLC_US * 2;
constexpr size_t WS_GDA = WS_MLM + al256((size_t)ML_NU * 4);
constexpr int GD_NU = 16 * 68;
constexpr size_t WS_GDB = WS_GDA + (size_t)GD_NU * 16384 * 2;
constexpr size_t WS_GDU = WS_GDB + (size_t)GD_NU * 16384 * 4;
constexpr size_t WS_GDW = WS_GDU + (size_t)GD_NU * 8192 * 4;
constexpr size_t WS_GDAT = WS_GDW + (size_t)GD_NU * 8192 * 2;
constexpr size_t WS_GDQ = WS_GDAT + (size_t)GD_NU * 4096 * 2;
constexpr size_t WS_GDS = WS_GDQ + (size_t)GD_NU * 8192 * 2;
constexpr int RW_NU = 32 * 68;
constexpr size_t WS_RQE = WS_GDS + (size_t)GD_NU * 16384 * 2;
constexpr size_t WS_RYL = WS_RQE + (size_t)RW_NU * 4096 * 2;
constexpr size_t WS_RAC = WS_RYL + (size_t)RW_NU * 4096 * 4;
constexpr size_t WS_RBC = WS_RAC + (size_t)RW_NU * 4096 * 2;
constexpr size_t WS_RPT = WS_RBC + (size_t)RW_NU * 4096 * 4;
constexpr size_t WS_PART = WS_RPT + (size_t)RW_NU * 4096 * 2;
constexpr size_t WS_MBC = WS_PART + (size_t)16 * 512 * D * 4;
constexpr size_t WS_BON = WS_MBC + (size_t)4 * 512 * D * 2;
constexpr size_t WS_XG = WS_BON + (size_t)2 * MROWS * 8 * 4;
constexpr size_t WS_GT = WS_XG + (size_t)MROWS * 256 * 2;
constexpr size_t WS_END = WS_GT + (size_t)34 * 32 * 65536 * 2;
static_assert((size_t)MROWS * DFF * 2 <= N_SARR * SARR && (size_t)MROWS * 2 * DFF * 2 <= (size_t)MROWS * NZ * 2, "aliases");
static_assert(WS_END < 1590000000ull, "workspace budget");
enum { SA_RG = 0 };

constexpr int LDS_RING = 131072, LDS_BYTES = 147456, LDS_MISC = LDS_BYTES - 128;

#define XB_TMO      128
#define XB_XCNT(j)  (256  + 64 * (j))
#define XB_XSUB(j)  (1280 + 64 * (j))
#define XB_XGEN(j)  (2304 + 64 * (j))
#define XB_TOP      3328
#define XB_TOPGEN   3392
#define XCD_BAR_WORDS 3456
#define XB_SPIN_CAP (1u << 18)
__device__ __forceinline__ unsigned xb_ld(unsigned* p)              { return __hip_atomic_load(p, __ATOMIC_RELAXED, __HIP_MEMORY_SCOPE_AGENT); }
__device__ __forceinline__ unsigned xb_add(unsigned* p, unsigned v) { return __hip_atomic_fetch_add(p, v, __ATOMIC_RELAXED, __HIP_MEMORY_SCOPE_AGENT); }
__device__ __forceinline__ unsigned xb_xcc_id() { return (unsigned)__builtin_amdgcn_s_getreg((3 << 11) | 20) & 0xFu; }
#define XB_SPIN(cond, bar) do { unsigned _sp = 0; while (cond) { __builtin_amdgcn_s_sleep(1); \
    if ((++_sp & 255u) == 0u) { if (xb_ld(&(bar)[XB_TMO])) break; if (_sp > XB_SPIN_CAP) { atomicAdd(&(bar)[XB_TMO], 1u); break; } } } } while (0)
struct XcdBarrier { unsigned* bar; unsigned x; volatile LAS unsigned* st; };
__device__ __forceinline__ XcdBarrier xcd_barrier_post(unsigned* bar, volatile LAS unsigned* st) {
    XcdBarrier b; b.bar = bar; b.x = xb_xcc_id(); b.st = st;
    if (threadIdx.x == 0) (void)xb_add(&bar[XB_XCNT(b.x)], 1u);
    return b;
}
__device__ __forceinline__ void xcd_barrier_complete(unsigned* bar, unsigned x, unsigned& nloc, unsigned& nx) {
    const unsigned G = gridDim.x * gridDim.y * gridDim.z;
    unsigned sum, cnt, mine, sp = 0u;
    for (;;) {
        sum = 0u; cnt = 0u; mine = 0u;
#pragma unroll
        for (unsigned j = 0; j < 16; ++j) { const unsigned c = xb_ld(&bar[XB_XCNT(j)]); sum += c; cnt += (c > 0u) ? 1u : 0u; mine = (j == x) ? c : mine; }
        if (sum == G) break;
        __builtin_amdgcn_s_sleep(1);
        if ((++sp & 255u) == 0u) { if (xb_ld(&bar[XB_TMO])) break; if (sp > XB_SPIN_CAP) { atomicAdd(&bar[XB_TMO], 1u); break; } }
    }
    nloc = mine > 0u ? mine : 1u; nx = cnt > 0u ? cnt : 1u;
}
__device__ __forceinline__ void xcd_barrier(const XcdBarrier& b, int wave_id) {
    asm volatile("s_waitcnt vmcnt(0)" ::: "memory");
    __syncthreads();
    if (wave_id == 0 && pg8::lane_id_hw() == 0) {
        unsigned* bar = b.bar; const unsigned bx = xb_xcc_id();
        __builtin_amdgcn_s_waitcnt(0);
        unsigned nloc = b.st[0], nx = b.st[1];
        if (nloc == 0u) { xcd_barrier_complete(bar, bx, nloc, nx); b.st[0] = nloc; b.st[1] = nx; }
        const unsigned old = xb_add(&bar[XB_XSUB(bx)], 1u);
        const unsigned gen = old / nloc;
        if (old + 1u == (gen + 1u) * nloc) {
            __builtin_amdgcn_fence(__ATOMIC_RELEASE, "agent");
            asm volatile("s_waitcnt vmcnt(0)" ::: "memory");
            const unsigned og = xb_add(&bar[XB_TOP], 1u);
            const unsigned tg = og / nx;
            if (og + 1u == (tg + 1u) * nx) xb_add(&bar[XB_TOPGEN], 1u);
            else XB_SPIN(xb_ld(&bar[XB_TOPGEN]) == tg, bar);
            __builtin_amdgcn_fence(__ATOMIC_ACQUIRE, "agent");
            xb_add(&bar[XB_XGEN(bx)], 1u);
            asm volatile("s_waitcnt vmcnt(0)" ::: "memory");
        } else {
            XB_SPIN(xb_ld(&bar[XB_XGEN(bx)]) == gen, bar);
            __builtin_amdgcn_fence(__ATOMIC_ACQUIRE, "agent");
            asm volatile("s_waitcnt vmcnt(0)" ::: "memory");
        }
    }
    __syncthreads();
}

struct Params {
    const float *x, *c, *ctx, *c_ctx, *w_mod, *b_mod, *norm_g, *w_in, *conv_dw, *conv_b, *conv_ln_g, *conv_ln_b, *ml_gate_b, *ml_norm_g,
        *gd_conv, *gd_a_log, *gd_dt_bias, *gd_norm_g, *rw_mu, *rw_w0, *rw_w2, *rw_a0, *rw_a2, *rw_g2, *rw_kk, *rw_ka, *rw_rk, *rw_ln_g, *rw_ln_b,
        *w_br, *w_out, *ffn_up, *ffn_dw, *ffn_down;
    float* out; unsigned char* ws; int ph_lo, ph_hi;
};

DI float bf2f(unsigned short u) { return __uint_as_float(((unsigned)u) << 16); }
typedef __bf16 bf16v2_t __attribute__((ext_vector_type(2)));
DI unsigned pk2(float lo, float hi) { bf16v2_t v = {(__bf16)lo, (__bf16)hi}; return __builtin_bit_cast(unsigned, v); }
DI unsigned f2bf(float f) { return pk2(f, 0.f) & 0xffffu; }
DI void ld8(const bf16* p, float (&o)[8]) { const u32x4 w = *(const u32x4*)p;
#pragma unroll
    for (int j = 0; j < 4; ++j) { o[2 * j] = __uint_as_float(w[j] << 16); o[2 * j + 1] = __uint_as_float(w[j] & 0xffff0000u); } }
DI u32x4 pack8(const float (&v)[8]) { u32x4 w; w.x = pk2(v[0], v[1]); w.y = pk2(v[2], v[3]); w.z = pk2(v[4], v[5]); w.w = pk2(v[6], v[7]); return w; }
DI void st8(bf16* p, const float (&v)[8]) { u32x4 w; w.x = pk2(v[0], v[1]); w.y = pk2(v[2], v[3]); w.z = pk2(v[4], v[5]); w.w = pk2(v[6], v[7]); *(u32x4*)p = w; }
DI void ldf8(const float* p, float (&o)[8]) { const f32x4 a = *(const f32x4*)p, b = *(const f32x4*)(p + 4);
    o[0] = a[0]; o[1] = a[1]; o[2] = a[2]; o[3] = a[3]; o[4] = b[0]; o[5] = b[1]; o[6] = b[2]; o[7] = b[3]; }
DI void stf8(float* p, const float (&v)[8]) { *(f32x4*)p = (f32x4){v[0], v[1], v[2], v[3]}; *(f32x4*)(p + 4) = (f32x4){v[4], v[5], v[6], v[7]}; }
template <int X> DI float shx(float v) {
    if constexpr (X < 32) return __builtin_bit_cast(float, __builtin_amdgcn_ds_swizzle(__builtin_bit_cast(int, v), (X << 10) | 0x1f));
    else { int l = pg8::lane_id_hw(); asm volatile("" : "+v"(l)); return __builtin_bit_cast(float, __builtin_amdgcn_ds_bpermute((l ^ 32) << 2, __builtin_bit_cast(int, v))); } }
DI float shup(float v, int o) { int l = pg8::lane_id_hw(); asm volatile("" : "+v"(l)); return __builtin_bit_cast(float, __builtin_amdgcn_ds_bpermute(((l - o) & 63) << 2, __builtin_bit_cast(int, v))); }
DI float rdlane63(float v) { return __builtin_bit_cast(float, __builtin_amdgcn_readlane(__builtin_bit_cast(int, v), 63)); }
template <int CTRL> DI float dppf(float v) { return __builtin_bit_cast(float, __builtin_amdgcn_update_dpp(0, __builtin_bit_cast(int, v), CTRL, 0xF, 0xF, true)); }
DI float row16_sum(float v) { v += dppf<0xB1>(v); v += dppf<0x4E>(v); v += dppf<0x141>(v); v += dppf<0x140>(v); return v; }
DI float rdl(float v, int l) { return __builtin_bit_cast(float, __builtin_amdgcn_readlane(__builtin_bit_cast(int, v), l)); }
DI float wave_sum(float v) { v = row16_sum(v); return (rdl(v, 0) + rdl(v, 16)) + (rdl(v, 32) + rdl(v, 48)); }
template <int W> DI float grp_sum(float v) {
    v += dppf<0xB1>(v); if constexpr (W > 2) v += dppf<0x4E>(v); if constexpr (W > 4) v += dppf<0x141>(v); if constexpr (W > 8) v += dppf<0x140>(v); return v; }
DI float fexp(float x) { return __builtin_amdgcn_exp2f(x * 1.4426950408889634f); }
DI float flog(float x) { return __builtin_amdgcn_logf(x) * 0.6931471805599453f; }
DI float ftanh(float x) { return 1.f - 2.f * __builtin_amdgcn_rcpf(1.f + fexp(2.f * x)); }
DI float sigmoidf_(float x) { return __builtin_amdgcn_rcpf(1.f + fexp(-x)); }
DI float siluf_(float x) { return x * __builtin_amdgcn_rcpf(1.f + fexp(-x)); }
DI float softplusf_(float x) { return fmaxf(x, 0.f) + flog(1.f + fexp(-fabsf(x))); }
DI float logsigmoidf_(float x) { return fminf(x, 0.f) - flog(1.f + fexp(-fabsf(x))); }
DI float gelu_tanh(float x) { const float u = 0.7978845608028654f * (x + 0.044715f * x * x * x); return 0.5f * x * (1.f + ftanh(u)); }

DI void seq_of(int row, int& base, int& len, int& t) { if (row < LAT) { base = row & ~(T - 1); len = T; t = row & (T - 1); } else { const int r = row - LAT; base = LAT + (r & ~(TC - 1)); len = TC; t = r & (TC - 1); } }
DI int scan_row(int dir, int b, int j) { if (j < TC) { const int tok = dir ? (TC - 1 - j) : j; return LAT + b * TC + tok; } const int jj = j - TC; const int tok = dir ? (T - 1 - jj) : jj; return b * T + tok; }

struct Ctx {
    LAS unsigned char* lds; int tid, lane, wave, G, bid;
    const Params* p; unsigned char* ws;
};

DI int zcol_src(int j) { if (j < 3072) return j; if (j < 5120) return j + 16; if (j < ZSM) return j + 32; if (j < ZSM + 16) return 3072 + (j - ZSM); if (j < ZSM + 32) return 5136 + (j - ZSM - 16); if (j < ZG) return -1; return 7136 + (j - ZG); }
template <bool ZMAP> DI void transpose_item(const float* W, int K, int N, bf16* WT, LAS float* scr, int kb, int nb, int lane) {
    const int k0 = 64 * kb, n0 = 32 * nb; const int nn = n0 + (lane & 31); const int src = ZMAP ? zcol_src(nn) : nn;
#pragma unroll 8
    for (int i = 0; i < 32; ++i) { const int kk = 2 * i + (lane >> 5); scr[kk * 33 + (lane & 31)] = (src >= 0) ? W[(size_t)(k0 + kk) * N + src] : 0.f; }
    asm volatile("s_waitcnt lgkmcnt(0)" ::: "memory");
    const int c = lane & 7;
#pragma unroll
    for (int j = 0; j < 4; ++j) { const int n = (lane >> 3) + 8 * j; const LAS float* s = scr + (8 * c) * 33 + n;
        u32x4 o; o.x = pk2(s[0 * 33], s[1 * 33]); o.y = pk2(s[2 * 33], s[3 * 33]); o.z = pk2(s[4 * 33], s[5 * 33]); o.w = pk2(s[6 * 33], s[7 * 33]);
        *(u32x4*)(WT + (size_t)(n0 + n) * K + k0 + 8 * c) = o; }
    asm volatile("s_waitcnt lgkmcnt(0)" ::: "memory");
}
DI void phase_pro0(Ctx& c) {
    const Params& p = *c.p;
    {
        LAS float* red = (LAS float*)c.lds;
        float* MODP = (float*)(c.ws + WS_MODP);
        for (int u = c.bid; u < NL * 48 * 8; u += c.G) {
            const int l = u / 384, cb = (u >> 3) % 48, ks = u & 7; const int col = cb * 256 + c.lane * 4;
            f32x4 a0 = {0.f, 0.f, 0.f, 0.f}, a1 = a0, a2 = a0;
            const float* wp = p.w_mod + ((size_t)l * D + ks * 256 + c.wave * 32) * 12288 + col;
            const int kb = ks * 256 + c.wave * 32;
#pragma unroll 8
            for (int i = 0; i < 32; ++i) { const f32x4 w = __builtin_nontemporal_load((const f32x4*)(wp + (size_t)i * 12288));
                const float s0 = siluf_(p.c[kb + i]), s1 = siluf_(p.c[D + kb + i]), s2 = siluf_(p.c_ctx[kb + i]);
                a0 += w * s0; a1 += w * s1; a2 += w * s2; }
            __syncthreads();
            *(LAS f32x4*)(red + (c.wave * 3 + 0) * 256 + c.lane * 4) = a0; *(LAS f32x4*)(red + (c.wave * 3 + 1) * 256 + c.lane * 4) = a1; *(LAS f32x4*)(red + (c.wave * 3 + 2) * 256 + c.lane * 4) = a2;
            __syncthreads();
            for (int o = c.tid; o < 768; o += 512) { float s = 0.f;
#pragma unroll
                for (int w = 0; w < 8; ++w) s += red[w * 768 + o];
                MODP[((size_t)(l * 8 + ks) * 3 + o / 256) * 12288 + cb * 256 + (o & 255)] = s; }
        }
        __syncthreads();
    }
}
struct WTile { const float* wp; size_t N; bf16* dst; bool zero; };
DI WTile wconv_tile(const Params& p, int l, unsigned char* wl, int r, int lane) {
    constexpr int I_IN = 32 * 240, I_BR = 8 * 32, I_OUT = 32 * 32, I_UP = 32 * 176;
    const float* W; bf16* WT; int K, N, kb, nb; bool zmap = false;
    if (r < I_IN) { W = p.w_in + (size_t)l * D * NIN; K = D; N = NIN; WT = (bf16*)(wl + WL_IN); kb = r / 240; nb = r % 240; zmap = true; }
    else if ((r -= I_IN) < 4 * I_BR) { const int br = r / I_BR; r %= I_BR; W = p.w_br + ((size_t)l * 4 + br) * MIXW * D; K = MIXW; N = D; WT = (bf16*)(wl + WL_BR) + (size_t)br * D * MIXW; kb = r / 32; nb = r % 32; }
    else if ((r -= 4 * I_BR) < I_OUT) { W = p.w_out + (size_t)l * D * D; K = D; N = D; WT = (bf16*)(wl + WL_OUT); kb = r / 32; nb = r % 32; }
    else if ((r -= I_OUT) < I_UP) { W = p.ffn_up + (size_t)l * D * 2 * DFF; K = D; N = 2 * DFF; WT = (bf16*)(wl + WL_UP); kb = r / 176; nb = r % 176; }
    else { r -= I_UP; W = p.ffn_down + (size_t)l * DFF * D; K = DFF; N = D; WT = (bf16*)(wl + WL_DN); kb = r / 32; nb = r % 32; }
    const int n = 64 * nb + lane; const int src = zmap ? zcol_src(n) : n;
    WTile t; t.wp = W + (size_t)(64 * kb) * N + (src >= 0 ? src : 0); t.N = (size_t)N; t.dst = WT + (size_t)n * K + 64 * kb; t.zero = src < 0; return t;
}
DI void wt_load(const WTile& t, int hf, float (&v)[32]) {
#pragma unroll
    for (int i = 0; i < 32; ++i) v[i] = __builtin_nontemporal_load(t.wp + (size_t)(hf * 32 + i) * t.N); }
DI void wt_store(const WTile& t, int hf, const float (&v)[32]) {
#pragma unroll
    for (int j = 0; j < 4; ++j) { u32x4 o; o.x = pk2(v[8 * j], v[8 * j + 1]); o.y = pk2(v[8 * j + 2], v[8 * j + 3]); o.z = pk2(v[8 * j + 4], v[8 * j + 5]); o.w = pk2(v[8 * j + 6], v[8 * j + 7]);
        if (t.zero) o = (u32x4){0u, 0u, 0u, 0u};
        *(u32x4*)(t.dst + hf * 32 + 8 * j) = o; } }
DI void phase_wconv(Ctx& c, int l) {
    const Params& p = *c.p;
    {
        const int gw = c.bid * 8 + c.wave, NGW = c.G * 8;
        constexpr int I_L = 32 * 240 + 4 * 8 * 32 + 32 * 32 + 32 * 176 + 88 * 32;
        unsigned char* wl = c.ws + WS_W;
        if (gw < I_L) { float vA[32], vB[32]; WTile cur = wconv_tile(p, l, wl, gw, c.lane); wt_load(cur, 0, vA);
            for (int it = gw; it < I_L; it += NGW) {
                wt_load(cur, 1, vB); wt_store(cur, 0, vA);
                const int nx = it + NGW; WTile nxt = cur;
                if (nx < I_L) { nxt = wconv_tile(p, l, wl, nx, c.lane); wt_load(nxt, 0, vA); }
                wt_store(cur, 1, vB); cur = nxt; } }
        bf16* lw = (bf16*)(wl + WL_LORA);
        for (int it = c.bid * 512 + c.tid; it < 4 * 6144 + 16384; it += c.G * 512) {
            const float* W; bf16* dst; int K, n, k8;
            if (it < 4 * 6144) { const int m = it / 6144, rr = it % 6144; n = rr & 511; k8 = rr >> 9; K = 96; W = (m < 2 ? p.rw_w2 : p.rw_a2) + (size_t)(l * 2 + (m & 1)) * 96 * 512; dst = lw + (size_t)m * 512 * 96; }
            else { const int rr = it - 4 * 6144; n = rr & 511; k8 = rr >> 9; K = 256; W = p.rw_g2 + (size_t)l * 256 * 512; dst = lw + (size_t)4 * 512 * 96; }
            float v[8];
#pragma unroll
            for (int i = 0; i < 8; ++i) v[i] = W[(size_t)(k8 * 8 + i) * 512 + n];
            st8(dst + (size_t)n * K + k8 * 8, v); }
    }
    __syncthreads();
}
DI void phase_pro1(Ctx& c) {
    const Params& p = *c.p; const float* MODP = (const float*)(c.ws + WS_MODP); float* MOD = (float*)(c.ws + WS_MOD);
    for (int i = c.bid * 512 + c.tid; i < NL * 3 * 12288; i += c.G * 512) { const int l = i / 36864, v = (i / 12288) % 3, n = i % 12288;
        float s = p.b_mod[l * 12288 + n];
#pragma unroll
        for (int ks = 0; ks < 8; ++ks) s += MODP[((size_t)(l * 8 + ks) * 3 + v) * 12288 + n];
        MOD[i] = s; }
}
DI void row_load(const float* r, int lane, f32x4 (&v)[8]) {
#pragma unroll
    for (int j = 0; j < 8; ++j) v[j] = *(const f32x4*)(r + 4 * lane + 256 * j); }
DI float row_rstd(const f32x4 (&v)[8]) { float s = 0.f;
#pragma unroll
    for (int j = 0; j < 8; ++j) s += (v[j][0] * v[j][0] + v[j][1] * v[j][1]) + (v[j][2] * v[j][2] + v[j][3] * v[j][3]);
    return rsqrtf(wave_sum(s) * (1.f / D) + 1e-6f); }
DI void norm_mod_store(const f32x4 (&v)[8], float rstd, const float* g, const float* sh, const float* sc, bf16* o, int lane) {
#pragma unroll
    for (int j = 0; j < 8; ++j) { const int cc = 4 * lane + 256 * j; const f32x4 g4 = *(const f32x4*)(g + cc), s4 = *(const f32x4*)(sh + cc), c4 = *(const f32x4*)(sc + cc);
        const f32x4 r = v[j] * rstd * g4 * (c4 + 1.f) + s4; u32x2 w; w.x = pk2(r[0], r[1]); w.y = pk2(r[2], r[3]); *(u32x2*)(o + cc) = w; } }
DI int mod_vec(int row) { return row < LAT ? (row >> 12) : 2; }
DI void phase_pro2(Ctx& c) {
    const Params& p = *c.p; const float* MOD = (const float*)(c.ws + WS_MOD); bf16* U = (bf16*)(c.ws + WS_U);
    const int gw = c.bid * 8 + c.wave, NGW = c.G * 8;
    for (int row = gw; row < MROWS; row += NGW) { const float* xr = row < LAT ? p.x + (size_t)row * D : p.ctx + (size_t)(row - LAT) * D;
        f32x4 v[8]; row_load(xr, c.lane, v); const float rs = row_rstd(v); const float* mv = MOD + (size_t)(0 * 3 + mod_vec(row)) * 12288;
        norm_mod_store(v, rs, p.norm_g, mv, mv + 2048, U + (size_t)row * D, c.lane); }
}
DI void norm_mod_store_l(const f32x4 (&v)[8], float rstd, const LAS float* g, const LAS float* sh, const LAS float* sc, bf16* o, int lane) {
#pragma unroll
    for (int j = 0; j < 8; ++j) { const int cc = 4 * lane + 256 * j; const f32x4 g4 = *(const LAS f32x4*)(g + cc), s4 = *(const LAS f32x4*)(sh + cc), c4 = *(const LAS f32x4*)(sc + cc);
        const f32x4 r = v[j] * rstd * g4 * (c4 + 1.f) + s4; u32x2 w; w.x = pk2(r[0], r[1]); w.y = pk2(r[2], r[3]); *(u32x2*)(o + cc) = w;
        if (j & 1) asm volatile("" ::: "memory"); } }
template <bool LP>
DI void resid_row(Ctx& c, int l, int which, int row, const f32x4 (&fv)[8], f32x4 (&xv)[8], const LAS float* pl) {
    const Params& p = *c.p; const float* MOD = (const float*)(c.ws + WS_MOD); bf16* U = (bf16*)(c.ws + WS_U); float* X = (float*)(c.ws + WS_X);
    const float rs = row_rstd(fv); const float* mv = MOD + (size_t)(l * 3 + mod_vec(row)) * 12288;
    const float* g = p.norm_g + (size_t)(l * 4 + (which ? 3 : 1)) * D; const float* gt = mv + (which ? 10240 : 4096);
#pragma unroll
    for (int j = 0; j < 8; ++j) { const int cc = 4 * c.lane + 256 * j;
        if (LP) { xv[j] += *(const LAS f32x4*)(pl + 2048 + cc) * (fv[j] * rs * *(const LAS f32x4*)(pl + cc)); if (j & 1) asm volatile("" ::: "memory"); }
        else xv[j] += *(const f32x4*)(gt + cc) * (fv[j] * rs * *(const f32x4*)(g + cc)); }
    if (which == 1 && l == NL - 1) { if (row < LAT) {
#pragma unroll
        for (int j = 0; j < 8; ++j) *(f32x4*)(p.out + (size_t)row * D + 4 * c.lane + 256 * j) = xv[j]; } return; }
#pragma unroll
    for (int j = 0; j < 8; ++j) *(f32x4*)(X + (size_t)row * D + 4 * c.lane + 256 * j) = xv[j];
    const float rs2 = row_rstd(xv);
    if (LP) { norm_mod_store_l(xv, rs2, pl + 2 * 2048, pl + 3 * 2048, pl + 4 * 2048, U + (size_t)row * D, c.lane); return; }
    if (which == 0) norm_mod_store(xv, rs2, p.norm_g + (size_t)(l * 4 + 2) * D, mv + 6144, mv + 8192, U + (size_t)row * D, c.lane);
    else { const float* mv2 = MOD + (size_t)((l + 1) * 3 + mod_vec(row)) * 12288; norm_mod_store(xv, rs2, p.norm_g + (size_t)((l + 1) * 4) * D, mv2, mv2 + 2048, U + (size_t)row * D, c.lane); }
}
DI void frow_load(const bf16* r, int lane, u32x2 (&v)[8]) {
#pragma unroll
    for (int j = 0; j < 8; ++j) v[j] = *(const u32x2*)(r + 4 * lane + 256 * j); }
DI void frow_cvt(const u32x2 (&h)[8], f32x4 (&v)[8]) {
#pragma unroll
    for (int j = 0; j < 8; ++j) v[j] = (f32x4){__uint_as_float(h[j].x << 16), __uint_as_float(h[j].x & 0xffff0000u), __uint_as_float(h[j].y << 16), __uint_as_float(h[j].y & 0xffff0000u)}; }
DI void phase_resid(Ctx& c, int l, int which) {
    const Params& p = *c.p; float* X = (float*)(c.ws + WS_X); const bf16* Fh = (const bf16*)(c.ws + WS_F);
    const int gw = c.bid * 8 + c.wave, NGW = c.G * 8; const bool first = (l == 0 && which == 0);
    if (NGW * 4 == LAT) {
        const int r0 = gw * 4; const float* xb = first ? p.x : X;
        u32x2 hA[8], hB[8], hC[8]; f32x4 xA[8], xB[8], xC[8], fv[8];
        LAS float* pl = (LAS float*)c.lds + 4096; const bool lastp = (which == 1 && l == NL - 1); f32x4 pv[5];
        { const float* MOD = (const float*)(c.ws + WS_MOD); const int bb = c.bid >> 7; const float* mv = MOD + (size_t)(l * 3 + bb) * 12288; const float* mv2 = MOD + (size_t)((l + 1) * 3 + bb) * 12288;
          pv[0] = *(const f32x4*)(p.norm_g + (size_t)(l * 4 + (which ? 3 : 1)) * D + 4 * c.tid);
          pv[1] = *(const f32x4*)(mv + (which ? 10240 : 4096) + 4 * c.tid);
          if (!lastp) { pv[2] = *(const f32x4*)(p.norm_g + (size_t)(which ? (l + 1) * 4 : l * 4 + 2) * D + 4 * c.tid);
                        pv[3] = *(const f32x4*)((which ? mv2 : mv + 6144) + 4 * c.tid);
                        pv[4] = *(const f32x4*)((which ? mv2 + 2048 : mv + 8192) + 4 * c.tid); }
          else { pv[2] = pv[0]; pv[3] = pv[0]; pv[4] = pv[0]; } }
#pragma unroll
        for (int v = 0; v < 5; ++v) *(LAS f32x4*)(pl + v * 2048 + 4 * c.tid) = pv[v];
        asm volatile("" ::: "memory");
        frow_load(Fh + (size_t)r0 * D, c.lane, hA); row_load(xb + (size_t)r0 * D, c.lane, xA);
        frow_load(Fh + (size_t)(r0 + 1) * D, c.lane, hB); row_load(xb + (size_t)(r0 + 1) * D, c.lane, xB);
        frow_load(Fh + (size_t)(r0 + 2) * D, c.lane, hC); row_load(xb + (size_t)(r0 + 2) * D, c.lane, xC);
        asm volatile("s_waitcnt lgkmcnt(0)" ::: "memory"); __builtin_amdgcn_s_barrier(); asm volatile("" ::: "memory");
        frow_cvt(hA, fv); resid_row<true>(c, l, which, r0, fv, xA, pl);
        frow_load(Fh + (size_t)(r0 + 3) * D, c.lane, hA); row_load(xb + (size_t)(r0 + 3) * D, c.lane, xA);
        frow_cvt(hB, fv); resid_row<true>(c, l, which, r0 + 1, fv, xB, pl);
        frow_cvt(hC, fv); resid_row<true>(c, l, which, r0 + 2, fv, xC, pl);
        frow_cvt(hA, fv); resid_row<true>(c, l, which, r0 + 3, fv, xA, pl);
    } else {
        for (int row = gw; row < LAT; row += NGW) { u32x2 h[8]; f32x4 fv[8], xv[8]; frow_load(Fh + (size_t)row * D, c.lane, h); row_load((first ? p.x : X) + (size_t)row * D, c.lane, xv); frow_cvt(h, fv); resid_row<false>(c, l, which, row, fv, xv, nullptr); }
    }
    if (l == NL - 1) return;
    LAS float* rb = (LAS float*)c.lds;
    const int ns = which ? 11 : 16;
    for (int pr2 = c.bid; pr2 < NB * TC / 2; pr2 += c.G) {
        __syncthreads();
        f32x4 xv[8]; if (c.wave < 2) row_load((first ? p.ctx - (size_t)LAT * D : X) + (size_t)(LAT + 2 * pr2 + c.wave) * D, c.lane, xv);
#pragma unroll
        for (int rr = 0; rr < 2; ++rr) { const float* pr = (const float*)(c.ws + WS_PART) + (size_t)(2 * pr2 + rr) * D + 256 * c.wave + 4 * c.lane; f32x4 a = {0.f, 0.f, 0.f, 0.f};
#pragma unroll
            for (int s = 0; s < 16; ++s) if (s < ns) a += *(const f32x4*)(pr + (size_t)s * 512 * D);
            *(LAS f32x4*)(rb + rr * 2048 + 256 * c.wave + 4 * c.lane) = a; }
        __syncthreads();
        if (c.wave < 2) { const int row = LAT + 2 * pr2 + c.wave; f32x4 fv[8];
#pragma unroll
            for (int j = 0; j < 8; ++j) fv[j] = *(const LAS f32x4*)(rb + c.wave * 2048 + 4 * c.lane + 256 * j);
            resid_row<false>(c, l, which, row, fv, xv, nullptr); }
    }
    __syncthreads();
}

DI f32x4 mfma16(bf16x8 a, bf16x8 b, f32x4 c) { return __builtin_amdgcn_mfma_f32_16x16x32_bf16(a, b, c, 0, 0, 0); }
DI bf16x8 ldfrag(const LAS bf16* base, int ld, int r0, int k0, int lane) { return *(const LAS bf16x8*)(base + (r0 + (lane & 15)) * ld + k0 + 8 * (lane >> 4)); }
template <int K> DI f32x4 mm_tile(const LAS bf16* X, int ldx, int xr0, const LAS bf16* Yt, int ldy, int yr0, int lane, f32x4 acc) {
#pragma unroll
    for (int k0 = 0; k0 < K; k0 += 32) acc = mfma16(ldfrag(X, ldx, xr0, k0, lane), ldfrag(Yt, ldy, yr0, k0, lane), acc);
    return acc; }
DI float wave_scan_add(float v, int lane) {
#pragma unroll
    for (int o = 1; o < 64; o <<= 1) { const float t = shup(v, o); if (lane >= o) v += t; }
    return v; }
DI float wave_scan_max(float v, int lane) {
#pragma unroll
    for (int o = 1; o < 64; o <<= 1) { const float t = shup(v, o); if (lane >= o) v = fmaxf(v, t); }
    return v; }
DI float wave_max(float v) { v = fmaxf(v, dppf<0xB1>(v)); v = fmaxf(v, dppf<0x4E>(v)); v = fmaxf(v, dppf<0x141>(v)); v = fmaxf(v, dppf<0x140>(v)); return fmaxf(fmaxf(rdl(v, 0), rdl(v, 16)), fmaxf(rdl(v, 32), rdl(v, 48))); }
constexpr float QSC = 0.08838834764831845f;

DI void mlstm_local(Ctx& c, int l, int u) {
    { int t0_ = pg8::lane_id_hw(); asm volatile("" : "+v"(t0_)); c.lane = t0_; c.tid = c.wave * 64 + t0_; }
    const Params& p = *c.p; const bf16* Z = (const bf16*)(c.ws + WS_Z); const float* G32 = (const float*)(c.ws + WS_G32); float* ML = (float*)(c.ws + WS_ML) + (size_t)u * ML_US;
    const int chain = u / 68, cc = u % 68, g = chain >> 2, h = chain & 3, dir = g >> 1, b = g & 1;
    LAS bf16* kT = (LAS bf16*)c.lds; LAS bf16* vT = kT + 128 * 72; LAS float* sw = (LAS float*)(vT + 128 * 72);
    __syncthreads();
    if (c.wave == 0) { const int row = scan_row(dir, b, cc * 64 + c.lane);
        const float li = G32[(size_t)row * 32 + dir * 8 + h] + p.ml_gate_b[((l * 2 + dir) * 2 + 0) * 4 + h];
        const float lf = logsigmoidf_(G32[(size_t)row * 32 + dir * 8 + 4 + h] + p.ml_gate_b[((l * 2 + dir) * 2 + 1) * 4 + h]);
        const float bt = wave_scan_add(lf, c.lane); const float bl = rdlane63(bt); const float wl = bl - bt + li; const float mloc = wave_max(wl);
        sw[c.lane] = fexp(wl - mloc); if (c.lane == 0) { ML[ML_HDR] = mloc; ML[ML_HDR + 1] = bl; } }
    __syncthreads();
    for (int it = c.tid; it < 64 * 32; it += 512) { const int s = it & 63, r = it >> 6, mat = r >> 4, ch = (r & 15) * 8; const int row = scan_row(dir, b, cc * 64 + s);
        float v[8]; ld8(Z + (size_t)row * NZ + (mat ? MLV : MLK) + h * 128 + ch, v); const float sc = mat ? 1.f : sw[s]; LAS bf16* dst = (mat ? vT : kT) + ch * 72 + s;
#pragma unroll
        for (int i = 0; i < 8; ++i) dst[i * 72] = (bf16)f2bf(v[i] * sc); }
    __syncthreads();
    f32x4 acc[8];
#pragma unroll
    for (int nt = 0; nt < 8; ++nt) acc[nt] = mm_tile<64>(kT, 72, 16 * c.wave, vT, 72, 16 * nt, c.lane, (f32x4){0.f, 0.f, 0.f, 0.f});
    const int q = c.lane >> 4, r = c.lane & 15;
#pragma unroll
    for (int nt = 0; nt < 8; ++nt) *(f32x4*)(ML + (size_t)(16 * nt + r) * 128 + 16 * c.wave + 4 * q) = acc[nt];
    if (c.tid < 128) { float s = 0.f;
#pragma unroll
        for (int j = 0; j < 64; j += 8) { const u32x4 w = *(const LAS u32x4*)(kT + c.tid * 72 + j);
#pragma unroll
            for (int i = 0; i < 4; ++i) s += __uint_as_float(w[i] << 16) + __uint_as_float(w[i] & 0xffff0000u); }
        ML[ML_NL + c.tid] = s; }
}
DI void mlstm_prefix(Ctx& c) {
    const float* ML = (const float*)(c.ws + WS_ML); bf16* CT = (bf16*)(c.ws + WS_MLC); float* MS = (float*)(c.ws + WS_MLM);
    for (int item = c.bid * 512 + c.tid; item < 65536; item += c.G * 512) {
        const int chain = item >> 12, e = (item >> 5) & 127, dq = item & 31; const bool two = (e == 127);
        const size_t so = (size_t)e * 128 + 4 * dq, so2 = (size_t)ML_NL + 4 * dq; const size_t dofs = (size_t)e * 128 + 4 * dq, dofs2 = (size_t)128 * 128 + 4 * dq;
        f32x4 C = {0.f, 0.f, 0.f, 0.f}, C2 = C; float m = 0.f;
#pragma unroll 17
        for (int cc = 0; cc < 68; ++cc) { const size_t u = (size_t)chain * 68 + cc; const float* mu = ML + u * ML_US;
            const f32x4 L = *(const f32x4*)(mu + so); const float mloc = mu[ML_HDR], bl = mu[ML_HDR + 1]; f32x4 L2 = {0.f, 0.f, 0.f, 0.f}; if (two) L2 = *(const f32x4*)(mu + so2);
            u32x2 w; w.x = pk2(C[0], C[1]); w.y = pk2(C[2], C[3]); *(u32x2*)(CT + u * MLC_US + dofs) = w;
            if (two) { u32x2 w2; w2.x = pk2(C2[0], C2[1]); w2.y = pk2(C2[2], C2[3]); *(u32x2*)(CT + u * MLC_US + dofs2) = w2; }
            if (e == 0 && dq == 0) MS[u] = m;
            const float mn = fmaxf(bl + m, mloc); const float dec = fexp(bl + m - mn), wl = fexp(mloc - mn); m = mn;
            C = C * dec + L * wl; C2 = C2 * dec + L2 * wl; }
    }
}
DI void mlstm_out(Ctx& c, int l, int u) {
    const Params& p = *c.p; const bf16* Z = (const bf16*)(c.ws + WS_Z); const float* G32 = (const float*)(c.ws + WS_G32); bf16* Y = (bf16*)(c.ws + WS_Y);
    const bf16* CTg = (const bf16*)(c.ws + WS_MLC); const float* MS = (const float*)(c.ws + WS_MLM);
    const int b = u / (4 * 68), h = (u / 68) & 3, tb = u % 68;
    LAS bf16* sq = (LAS bf16*)c.lds; LAS bf16* sk = sq + 64 * 136; LAS bf16* vT = sk + 64 * 136; LAS bf16* CT = vT + 144 * 72; LAS bf16* sdw = CT + 144 * 136;
    LAS float* hbuf = (LAS float*)(sdw + 64 * 72); LAS float* sAt = hbuf + 64 * 128; LAS float* sBs = sAt + 64; LAS float* siw = sBs + 64; LAS float* semt = siw + 64; LAS float* sden = semt + 64;
    const int q = c.lane >> 4, r = c.lane & 15;
    for (int dir = 0; dir < 2; ++dir) {
        const int cc = dir == 0 ? tb : (tb < 4 ? 3 - tb : 71 - tb); const int chain = (dir * 2 + b) * 4 + h; const size_t un = (size_t)chain * 68 + cc;
        __syncthreads();
        if (c.wave == 0) { const int row = scan_row(dir, b, cc * 64 + c.lane); const float mc = MS[un];
            const float li = G32[(size_t)row * 32 + dir * 8 + h] + p.ml_gate_b[((l * 2 + dir) * 2 + 0) * 4 + h];
            const float lf = logsigmoidf_(G32[(size_t)row * 32 + dir * 8 + 4 + h] + p.ml_gate_b[((l * 2 + dir) * 2 + 1) * 4 + h]);
            const float bt = wave_scan_add(lf, c.lane); const float x = li - bt; const float cm = wave_scan_max(x, c.lane); const float mt = bt + fmaxf(mc, cm);
            sAt[c.lane] = bt - mt; sBs[c.lane] = x; siw[c.lane] = fexp(bt + mc - mt) * QSC; semt[c.lane] = fexp(-mt); }
        for (int it = c.tid; it < 64 * 32; it += 512) { const int s = it >> 5, r2 = it & 31, mat = r2 >> 4, ch = (r2 & 15) * 8; const int row = scan_row(dir, b, cc * 64 + s);
            *(LAS u32x4*)((mat ? sk : sq) + s * 136 + ch) = *(const u32x4*)(Z + (size_t)row * NZ + (mat ? MLK : MLQ) + h * 128 + ch); }
        for (int it = c.tid; it < 64 * 16; it += 512) { const int s = it & 63, ch = (it >> 6) * 8; const int row = scan_row(dir, b, cc * 64 + s);
            const u32x4 w = *(const u32x4*)(Z + (size_t)row * NZ + MLV + h * 128 + ch); LAS bf16* dst = vT + ch * 72 + s;
#pragma unroll
            for (int i = 0; i < 4; ++i) { dst[(2 * i) * 72] = (bf16)(w[i] & 0xffffu); dst[(2 * i + 1) * 72] = (bf16)(w[i] >> 16); } }
        if (c.tid < 64) vT[128 * 72 + c.tid] = (bf16)0x3F80u;
        for (int it = c.tid; it < 129 * 16; it += 512) { const int e = it >> 4, ch = (it & 15) * 8; *(LAS u32x4*)(CT + e * 136 + ch) = *(const u32x4*)(CTg + un * MLC_US + (size_t)e * 128 + ch); }
        __syncthreads();
#pragma unroll
        for (int j = 0; j < 2; ++j) { const int ti = 2 * c.wave + j, mt = ti >> 2, nt = ti & 3;
            const f32x4 a = mm_tile<128>(sk, 136, 16 * nt, sq, 136, 16 * mt, c.lane, (f32x4){0.f, 0.f, 0.f, 0.f});
            const int t = 16 * mt + r; const float At = sAt[t]; float d[4];
#pragma unroll
            for (int i = 0; i < 4; ++i) { const int s = 16 * nt + 4 * q + i; d[i] = (s <= t) ? a[i] * QSC * fexp(At + sBs[s]) : 0.f; }
            u32x2 w; w.x = pk2(d[0], d[1]); w.y = pk2(d[2], d[3]); *(LAS u32x2*)(sdw + t * 72 + 16 * nt + 4 * q) = w; }
        const int mt = c.wave & 3, nt0 = (c.wave >> 2) * 5, ntn = (c.wave >> 2) ? 4 : 5;
        f32x4 acc[5];
#pragma unroll
        for (int j = 0; j < 5; ++j) if (j < ntn) acc[j] = mm_tile<128>(CT, 136, 16 * (nt0 + j), sq, 136, 16 * mt, c.lane, (f32x4){0.f, 0.f, 0.f, 0.f});
        __syncthreads();
        const int t = 16 * mt + r; const float iw = siw[t];
#pragma unroll
        for (int j = 0; j < 5; ++j) if (j < ntn) acc[j] = mm_tile<64>(vT, 72, 16 * (nt0 + j), sdw, 72, 16 * mt, c.lane, acc[j] * iw);
        if (c.wave >= 4 && q == 0) sden[t] = acc[3][0];
        __syncthreads();
        const float dn = fmaxf(fabsf(sden[t]), semt[t]); const float inv = 1.f / dn; const int tok = dir ? 63 - t : t;
#pragma unroll
        for (int j = 0; j < 5; ++j) if (j < ntn && nt0 + j < 8) { LAS f32x4* hp = (LAS f32x4*)(hbuf + tok * 128 + 16 * (nt0 + j) + 4 * q); const f32x4 hv = acc[j] * inv; if (dir == 0) *hp = hv; else *hp += hv; }
    }
    __syncthreads();
    { const int tok = c.tid >> 3, eg = (c.tid & 7) * 16; const int row = (tb < 4 ? LAT + b * TC + tb * 64 : b * T + (tb - 4) * 64) + tok;
        float hv[16]; float ss = 0.f;
#pragma unroll
        for (int j = 0; j < 4; ++j) { const f32x4 x = *(const LAS f32x4*)(hbuf + tok * 128 + eg + 4 * j); hv[4 * j] = x[0]; hv[4 * j + 1] = x[1]; hv[4 * j + 2] = x[2]; hv[4 * j + 3] = x[3]; ss += (x[0] * x[0] + x[1] * x[1]) + (x[2] * x[2] + x[3] * x[3]); }
        ss = grp_sum<8>(ss); const float rs = rsqrtf(ss * (1.f / 128.f) + 1e-6f);
#pragma unroll
        for (int j = 0; j < 2; ++j) { float g[8], o[8], y[8]; ldf8(p.ml_norm_g + l * 512 + h * 128 + eg + 8 * j, g); ld8(Z + (size_t)row * NZ + MLO + h * 128 + eg + 8 * j, o);
#pragma unroll
            for (int i = 0; i < 8; ++i) y[i] = hv[8 * j + i] * rs * g[i] * sigmoidf_(o[i]);
            st8(Y + (size_t)row * D + 512 + h * 128 + eg + 8 * j, y); } }
}


DI bf16x8 frag_f32(const LAS float* base, int ld, int r0, int c0, int lane, int kvalid) {
    const int q = lane >> 4, r = lane & 15; u32x4 o = {0u, 0u, 0u, 0u};
    if (8 * q < kvalid) { const f32x4 a = *(const LAS f32x4*)(base + (r0 + r) * ld + c0 + 8 * q), b = *(const LAS f32x4*)(base + (r0 + r) * ld + c0 + 8 * q + 4);
        o.x = pk2(a[0], a[1]); o.y = pk2(a[2], a[3]); o.z = pk2(b[0], b[1]); o.w = pk2(b[2], b[3]); }
    return __builtin_bit_cast(bf16x8, o); }
DI bf16x8 frag_k16(const LAS bf16* base, int ld, int r0, int lane) {
    const u32x4 z = {0u, 0u, 0u, 0u}; return (lane >> 4) < 2 ? ldfrag(base, ld, r0, 0, lane) : __builtin_bit_cast(bf16x8, z); }
DI void tri_inverse64(const LAS float* Nf, const LAS bf16*  , LAS bf16* Tm, LAS bf16* scr, int lane) {
    const int blk = lane >> 4, j = lane & 15, q = lane >> 4, r = lane & 15; LAS bf16* TT = scr; LAS bf16* M1 = scr + 1280; LAS bf16* TTb2 = M1 + 768;
    unsigned zo = 0u; asm volatile("" : "+v"(zo)); const u32x4 zv = {zo, zo, zo, zo};
#pragma unroll
    for (int i = 0; i < 9; ++i) *(LAS u32x4*)(Tm + (lane * 9 + i) * 8) = zv;
    float x[16]; const LAS float* Nz = Nf + (16 * blk) * 68 + 16 * blk;
#pragma unroll
    for (int t = 0; t < 16; ++t) { float a = (t == j) ? 1.f : 0.f;
#pragma unroll
        for (int s4 = 0; s4 < (t + 3) / 4; ++s4) { const f32x4 n4 = *(const LAS f32x4*)(Nz + t * 68 + 4 * s4);
#pragma unroll
            for (int i = 0; i < 4; ++i) if (4 * s4 + i < t) a = fmaf(-n4[i], x[4 * s4 + i], a); }
        x[t] = a; Tm[(16 * blk + t) * 72 + 16 * blk + j] = (bf16)f2bf(a); }
    {   u32x4 lo, hi; lo.x = pk2(x[0], x[1]); lo.y = pk2(x[2], x[3]); lo.z = pk2(x[4], x[5]); lo.w = pk2(x[6], x[7]); hi.x = pk2(x[8], x[9]); hi.y = pk2(x[10], x[11]); hi.z = pk2(x[12], x[13]); hi.w = pk2(x[14], x[15]);
        if (blk < 2) { *(LAS u32x4*)(TT + (16 * blk + j) * 40 + 16 * blk) = lo; *(LAS u32x4*)(TT + (16 * blk + j) * 40 + 16 * blk + 8) = hi; }
        if (blk == 1) { *(LAS u32x4*)(TT + (16 + j) * 40) = zv; *(LAS u32x4*)(TT + (16 + j) * 40 + 8) = zv; }
        if (blk == 2) { *(LAS u32x4*)(TTb2 + j * 24) = lo; *(LAS u32x4*)(TTb2 + j * 24 + 8) = hi; } }
    asm volatile("s_waitcnt lgkmcnt(0)" ::: "memory");
#pragma unroll
    for (int p = 0; p < 2; ++p) { const f32x4 a = mfma16(frag_f32(Nf, 68, 16 * (2 * p + 1), 16 * (2 * p), lane, 16), frag_k16(p ? TTb2 : TT, p ? 24 : 40, 0, lane), (f32x4){0.f, 0.f, 0.f, 0.f});
        u32x2 w; w.x = pk2(a[0], a[1]); w.y = pk2(a[2], a[3]); *(LAS u32x2*)(M1 + p * 384 + r * 24 + 4 * q) = w; }
    asm volatile("s_waitcnt lgkmcnt(0)" ::: "memory");
#pragma unroll
    for (int p = 0; p < 2; ++p) { const f32x4 a = mfma16(frag_k16(M1 + p * 384, 24, 0, lane), frag_k16(Tm + (16 * (2 * p + 1)) * 72 + 16 * (2 * p + 1), 72, 0, lane), (f32x4){0.f, 0.f, 0.f, 0.f});
        u32x2 w; w.x = pk2(-a[0], -a[1]); w.y = pk2(-a[2], -a[3]); *(LAS u32x2*)(Tm + (16 * (2 * p + 1) + r) * 72 + 16 * (2 * p) + 4 * q) = w;
        if (p == 0) {
#pragma unroll
            for (int i = 0; i < 4; ++i) TT[(4 * q + i) * 40 + 16 + r] = (bf16)f2bf(-a[i]); } }
    asm volatile("s_waitcnt lgkmcnt(0)" ::: "memory");
#pragma unroll
    for (int xt = 0; xt < 2; ++xt)
#pragma unroll
        for (int yt = 0; yt < 2; ++yt) { const f32x4 a = mfma16(frag_f32(Nf, 68, 32 + 16 * xt, 0, lane, 32), ldfrag(TT, 40, 16 * yt, 0, lane), (f32x4){0.f, 0.f, 0.f, 0.f});
            u32x2 w; w.x = pk2(a[0], a[1]); w.y = pk2(a[2], a[3]); *(LAS u32x2*)(M1 + (16 * yt + r) * 40 + 16 * xt + 4 * q) = w; }
    asm volatile("s_waitcnt lgkmcnt(0)" ::: "memory");
#pragma unroll
    for (int xt = 0; xt < 2; ++xt)
#pragma unroll
        for (int yt = 0; yt < 2; ++yt) { const f32x4 a = mfma16(ldfrag(M1, 40, 16 * xt, 0, lane), ldfrag(Tm + 32 * 72 + 32, 72, 16 * yt, 0, lane), (f32x4){0.f, 0.f, 0.f, 0.f});
            u32x2 w; w.x = pk2(-a[0], -a[1]); w.y = pk2(-a[2], -a[3]); *(LAS u32x2*)(Tm + (32 + 16 * yt + r) * 72 + 16 * xt + 4 * q) = w; }
}
DI bf16x8 gfrag(const bf16* base, int ld, int r0, int k0, int lane) { return *(const bf16x8*)(base + (size_t)(r0 + (lane & 15)) * ld + k0 + 8 * (lane >> 4)); }
DI void gdn_local(Ctx& c, int l, int u) {
    { int t0_ = pg8::lane_id_hw(); asm volatile("" : "+v"(t0_)); c.lane = t0_; c.tid = c.wave * 64 + t0_; }
    const Params& p = *c.p; const bf16* Z = (const bf16*)(c.ws + WS_Z); const float* G32 = (const float*)(c.ws + WS_G32);
    const int chain = u / 68, cc = u % 68, g = chain >> 2, h = chain & 3, dir = g >> 1, b = g & 1;
    bf16* gA = (bf16*)(c.ws + WS_GDA) + (size_t)u * 16384; float* gB = (float*)(c.ws + WS_GDB) + (size_t)u * 16384; float* gU = (float*)(c.ws + WS_GDU) + (size_t)u * 8192;
    bf16* gW = (bf16*)(c.ws + WS_GDW) + (size_t)u * 8192; bf16* gAT = (bf16*)(c.ws + WS_GDAT) + (size_t)u * 4096; bf16* gQD = (bf16*)(c.ws + WS_GDQ) + (size_t)u * 8192;
    LAS bf16* sq = (LAS bf16*)c.lds; LAS bf16* sk = sq + 64 * 136; LAS bf16* skb = sk + 64 * 136; LAS bf16* uT = sq; LAS bf16* wT = uT + 128 * 72;
    LAS bf16* kdT = (LAS bf16*)(c.lds + 52224); LAS bf16* vbT = kdT + 128 * 72; LAS bf16* kbgT = vbT + 128 * 72;
    LAS float* Nf = (LAS float*)(c.lds + 107520); LAS bf16* Tm = (LAS bf16*)(c.lds + 124928); LAS float* sm = (LAS float*)(c.lds + 134144);
    LAS bf16* Nb21 = (LAS bf16*)(c.lds + 135424); LAS bf16* tscr = Nb21 + 1280;
    const int q = c.lane >> 4, r = c.lane & 15;
    __syncthreads();
    if (c.wave == 0) { const int row = scan_row(dir, b, cc * 64 + c.lane); const float a = G32[(size_t)row * 32 + 16 + dir * 8 + h], bb = G32[(size_t)row * 32 + 16 + dir * 8 + 4 + h];
        const float lg = -fexp(p.gd_a_log[l * 8 + dir * 4 + h]) * softplusf_(a + p.gd_dt_bias[l * 8 + dir * 4 + h]);
        const float gc = wave_scan_add(lg, c.lane); const float gl = rdlane63(gc);
        sm[c.lane] = gc; sm[64 + c.lane] = sigmoidf_(bb); sm[128 + c.lane] = fexp(gc); sm[192 + c.lane] = fexp(gl - gc); if (c.lane == 0) sm[256] = fexp(gl); }
    __syncthreads();
    if (c.tid < 384) { const float* cw = p.gd_conv + (size_t)l * 5 * 1536; const int sr = c.tid / 48, rr = c.tid % 48, mat = rr >> 4, ch = (rr & 15) * 8;
        const int row_first = scan_row(dir, b, cc * 64); int sbase, slen, tp0; seq_of(row_first, sbase, slen, tp0);
        const int rj0 = row_first + (dir ? -(sr * 8) : sr * 8); const int lo = dir ? rj0 - 7 : rj0;
        u32x4 xin[12]; float wv[5][8];
#pragma unroll
        for (int m = 0; m < 12; ++m) { const int row = lo - 2 + m; const bool ok = row >= sbase && row < sbase + slen;
            xin[m] = ok ? *(const u32x4*)(Z + (size_t)row * NZ + GDQ + mat * 512 + h * 128 + ch) : (u32x4){0u, 0u, 0u, 0u}; }
#pragma unroll
        for (int j = 0; j < 5; ++j) ldf8(cw + j * 1536 + mat * 512 + h * 128 + ch, wv[j]);
#pragma unroll
        for (int m = 0; m < 8; ++m) { const int s = sr * 8 + (dir ? 7 - m : m);
            float acc[8];
#pragma unroll
            for (int i = 0; i < 8; ++i) acc[i] = 0.f;
#pragma unroll
            for (int j = 0; j < 5; ++j) { const u32x4 a = xin[m + j];
#pragma unroll
                for (int i = 0; i < 4; ++i) { acc[2 * i] = fmaf(__uint_as_float(a[i] << 16), wv[j][2 * i], acc[2 * i]); acc[2 * i + 1] = fmaf(__uint_as_float(a[i] & 0xffff0000u), wv[j][2 * i + 1], acc[2 * i + 1]); } }
            float ss = 0.f;
#pragma unroll
            for (int i = 0; i < 8; ++i) { acc[i] = siluf_(acc[i]); ss += acc[i] * acc[i]; }
            ss = grp_sum<16>(ss);
            const float be = sm[64 + s], egc = sm[128 + s], ekd = sm[192 + s];
            if (mat == 0) { const float sc = rsqrtf(ss + 1e-6f) * QSC; float o[8], o2[8];
#pragma unroll
                for (int i = 0; i < 8; ++i) { o[i] = acc[i] * sc; o2[i] = o[i] * egc; }
                *(LAS u32x4*)(sq + s * 136 + ch) = pack8(o); st8(gQD + s * 128 + ch, o2); }
            else if (mat == 1) { const float sc = rsqrtf(ss + 1e-6f); float o[8], ob[8];
#pragma unroll
                for (int i = 0; i < 8; ++i) { o[i] = acc[i] * sc; ob[i] = o[i] * be; }
                *(LAS u32x4*)(sk + s * 136 + ch) = pack8(o); *(LAS u32x4*)(skb + s * 136 + ch) = pack8(ob);
#pragma unroll
                for (int i = 0; i < 8; ++i) { kdT[(ch + i) * 72 + s] = (bf16)f2bf(o[i] * ekd); kbgT[(ch + i) * 72 + s] = (bf16)f2bf(ob[i] * egc); } }
            else {
#pragma unroll
                for (int i = 0; i < 8; ++i) vbT[(ch + i) * 72 + s] = (bf16)f2bf(acc[i] * be); } } }
    __syncthreads();
#pragma unroll
    for (int j = 0; j < 2; ++j) { const int ti = 2 * c.wave + j, mt = ti >> 2, nt = ti & 3;
        { const f32x4 a = mm_tile<128>(skb, 136, 16 * mt, sk, 136, 16 * nt, c.lane, (f32x4){0.f, 0.f, 0.f, 0.f}); const int s = 16 * nt + r; const float gs = sm[s];
#pragma unroll
          for (int i = 0; i < 4; ++i) { const int t = 16 * mt + 4 * q + i; const float nv = (s < t) ? a[i] * fexp(sm[t] - gs) : 0.f; Nf[t * 68 + s] = nv; if (mt >= 2 && nt < 2) Nb21[(t - 32) * 40 + s] = (bf16)f2bf(nv); } }
        { const f32x4 a = mm_tile<128>(sk, 136, 16 * nt, sq, 136, 16 * mt, c.lane, (f32x4){0.f, 0.f, 0.f, 0.f}); const int t = 16 * mt + r; const float gt = sm[t]; float d[4];
#pragma unroll
          for (int i = 0; i < 4; ++i) { const int s = 16 * nt + 4 * q + i; d[i] = (s <= t) ? a[i] * fexp(gt - sm[s]) : 0.f; }
          u32x2 w; w.x = pk2(d[0], d[1]); w.y = pk2(d[2], d[3]); *(u32x2*)(gAT + t * 64 + 16 * nt + 4 * q) = w; } }
    __syncthreads();
    if (c.wave == 0) tri_inverse64(Nf, Nb21, Tm, tscr, c.lane);
    __syncthreads();
    int lz = c.lane; asm volatile("" : "+v"(lz)); c.lane = lz;
    { const int q = lz >> 4, r = lz & 15; const int mt = c.wave & 3;
#pragma unroll
      for (int j = 0; j < 4; ++j) { const int nt = (c.wave >> 2) * 4 + j;
        const f32x4 au = mm_tile<64>(Tm, 72, 16 * mt, vbT, 72, 16 * nt, c.lane, (f32x4){0.f, 0.f, 0.f, 0.f});
        { u32x2 w; w.x = pk2(au[0], au[1]); w.y = pk2(au[2], au[3]); *(LAS u32x2*)(uT + (16 * nt + r) * 72 + 16 * mt + 4 * q) = w; *(f32x4*)(gU + (16 * nt + r) * 64 + 16 * mt + 4 * q) = au; }
        const f32x4 aw = mm_tile<64>(Tm, 72, 16 * mt, kbgT, 72, 16 * nt, c.lane, (f32x4){0.f, 0.f, 0.f, 0.f});
        { u32x2 w; w.x = pk2(aw[0], aw[1]); w.y = pk2(aw[2], aw[3]); *(LAS u32x2*)(wT + (16 * nt + r) * 72 + 16 * mt + 4 * q) = w; }
        const f32x4 aw2 = mm_tile<64>(kbgT, 72, 16 * nt, Tm, 72, 16 * mt, c.lane, (f32x4){0.f, 0.f, 0.f, 0.f});
        { u32x2 w; w.x = pk2(aw2[0], aw2[1]); w.y = pk2(aw2[2], aw2[3]); *(u32x2*)(gW + (16 * mt + r) * 128 + 16 * nt + 4 * q) = w; } } }
    __syncthreads();
    { const int q = lz >> 4, r = lz & 15; const float egl = sm[256]; const int yt = c.wave;
#pragma unroll
      for (int xt = 0; xt < 8; ++xt) {
        const f32x4 a = mm_tile<64>(wT, 72, 16 * xt, kdT, 72, 16 * yt, c.lane, (f32x4){0.f, 0.f, 0.f, 0.f}); const int d = 16 * yt + r; float v[4];
#pragma unroll
        for (int i = 0; i < 4; ++i) v[i] = ((16 * xt + 4 * q + i) == d ? egl : 0.f) - a[i];
        u32x2 w; w.x = pk2(v[0], v[1]); w.y = pk2(v[2], v[3]); *(u32x2*)(gA + ((yt * 4 + (xt >> 1)) * 64 + (2 * (xt & 1) + (q >> 1)) * 16 + r) * 8 + 4 * (q & 1)) = w;
        const f32x4 bq = mm_tile<64>(kdT, 72, 16 * xt, uT, 72, 16 * yt, c.lane, (f32x4){0.f, 0.f, 0.f, 0.f});
        *(f32x4*)(gB + ((yt * 8 + xt) * 64 + 16 * q + r) * 4) = bq; } }
}
template <int N, int PD, bool SWZ = false> DI void affine_prefix(Ctx& c, const bf16* gA, const float* gB, bf16* gS, int sl) {
    constexpr int NN = N * N, KS = N / 32, LD = N + 8; const int w = c.wave, q = c.lane >> 4, r = c.lane & 15;
    static_assert((67 - 1) % PD == 0, "67 steps = whole trips of PD + one peeled step");
    LAS bf16* ST = (LAS bf16*)c.lds;
    __syncthreads();
    if (w < N / 16) {
        { unsigned z0 = 0u; asm volatile("" : "+v"(z0)); const u32x2 z = {z0, z0};     *(LAS u32x2*)(ST + r * LD + 16 * w + 4 * q) = z; if (!SWZ) *(u32x2*)(gS + (size_t)(16 * sl + r) * N + 16 * w + 4 * q) = z; }
        bf16x8 a[PD][KS]; f32x4 B[PD];
        bf16* pfs = gS + (size_t)(16 * sl + 2 * w + (c.lane >> 5)) * N + 4 * (c.lane & 31);
        constexpr int KOFF = SWZ ? 512 : 32;
        const bf16* pa = SWZ ? gA + ((size_t)(w * KS) * 64 + c.lane) * 8 : gA + (size_t)(16 * w + r) * N + 8 * q; const float* pb = SWZ ? gB + ((size_t)(sl * (N / 16) + w) * 64 + c.lane) * 4 : gB + (size_t)(16 * sl + r) * N + 16 * w + 4 * q; bf16* ps = gS + (size_t)(16 * sl + r) * N + 16 * w + 4 * q;
#pragma unroll
        for (int s = 0; s < PD; ++s) {
#pragma unroll
            for (int kk = 0; kk < KS; ++kk) a[s][kk] = *(const bf16x8*)(pa + (size_t)s * NN + KOFF * kk);
            B[s] = *(const f32x4*)(pb + (size_t)s * NN); }
        asm volatile("s_waitcnt lgkmcnt(0)" ::: "memory"); __builtin_amdgcn_s_barrier(); asm volatile("" ::: "memory");
        for (int cc0 = 0; cc0 < 66; cc0 += PD) {
#pragma unroll
            for (int s = 0; s < PD; ++s) { const int cc = cc0 + s; const LAS bf16* Sr = ST + (s & 1) * (16 * LD); LAS bf16* Sw = ST + ((s + 1) & 1) * (16 * LD);
                f32x4 acc = B[s]; bf16x8 sf[KS];
#pragma unroll
                for (int kk = 0; kk < KS; ++kk) sf[kk] = ldfrag(Sr, LD, 0, 32 * kk, c.lane);
                if (KS == 4) asm volatile("" : "+v"(sf[0]), "+v"(sf[1]), "+v"(sf[2]), "+v"(sf[3])); else asm volatile("" : "+v"(sf[0]), "+v"(sf[1]));
#pragma unroll
                for (int kk = 0; kk < KS; ++kk) acc = mfma16(a[s][kk], sf[kk], acc);
                asm volatile("" : "+v"(acc) :: "memory");
                { const size_t o = (size_t)(cc + PD) * NN;
#pragma unroll
                  for (int kk = 0; kk < KS; ++kk) a[s][kk] = *(const bf16x8*)(pa + o + KOFF * kk);
                  B[s] = *(const f32x4*)(pb + o); }
                u32x2 wv; wv.x = pk2(acc[0], acc[1]); wv.y = pk2(acc[2], acc[3]);
                *(LAS u32x2*)(Sw + r * LD + 16 * w + 4 * q) = wv;
                if (SWZ) { const u32x2 t = *(const LAS u32x2*)(Sr + (2 * w + (c.lane >> 5)) * LD + 4 * (c.lane & 31)); *(u32x2*)(pfs + (size_t)cc * NN) = t; }
                else *(u32x2*)(ps + (size_t)(cc + 1) * NN) = wv;
                asm volatile("s_waitcnt lgkmcnt(0)" ::: "memory"); __builtin_amdgcn_s_barrier(); asm volatile("" ::: "memory"); } }
        {
            f32x4 acc = B[0];
#pragma unroll
            for (int kk = 0; kk < KS; ++kk) acc = mfma16(a[0][kk], ldfrag(ST, LD, 0, 32 * kk, c.lane), acc);
            u32x2 wv; wv.x = pk2(acc[0], acc[1]); wv.y = pk2(acc[2], acc[3]); *(u32x2*)(ps + (size_t)67 * NN) = wv;
            if (SWZ) { const u32x2 t = *(const LAS u32x2*)(ST + (2 * w + (c.lane >> 5)) * LD + 4 * (c.lane & 31)); *(u32x2*)(pfs + (size_t)66 * NN) = t; } }
    } else {
        asm volatile("" ::: "memory"); __builtin_amdgcn_s_barrier();
        for (int cc = 0; cc < 66; ++cc) { asm volatile("" ::: "memory"); __builtin_amdgcn_s_barrier(); }
    }
    __syncthreads();
}
DI void gdn_prefix(Ctx& c, int u2) { const int chain = (u2 & 7) + 8 * (u2 >> 6), sl = (u2 >> 3) & 7;
    affine_prefix<128, 6, true>(c, (const bf16*)(c.ws + WS_GDA) + (size_t)chain * 68 * 16384, (const float*)(c.ws + WS_GDB) + (size_t)chain * 68 * 16384, (bf16*)(c.ws + WS_GDS) + (size_t)chain * 68 * 16384, sl); }
DI void rwkv_prefix(Ctx& c, int u2) { const int chain = (u2 & 7) + 8 * (u2 >> 5), sl = (u2 >> 3) & 3;
    affine_prefix<64, 6>(c, (const bf16*)(c.ws + WS_RAC) + (size_t)chain * 68 * 4096, (const float*)(c.ws + WS_RBC) + (size_t)chain * 68 * 4096, (bf16*)(c.ws + WS_RPT) + (size_t)chain * 68 * 4096, sl); }
DI void gdn_out(Ctx& c, int l, int u) {
    const Params& p = *c.p; const bf16* Z = (const bf16*)(c.ws + WS_Z); bf16* Y = (bf16*)(c.ws + WS_Y);
    const int b = u / (4 * 68), h = (u / 68) & 3, tb = u % 68;
    LAS bf16* ST = (LAS bf16*)c.lds; LAS bf16* vnT = ST + 128 * 136; LAS float* hbuf = (LAS float*)(vnT + 128 * 72);
    const int q = c.lane >> 4, r = c.lane & 15; const int mt = c.wave & 3, ntb = (c.wave >> 2) * 4;
    for (int dir = 0; dir < 2; ++dir) {
        const int cc = dir == 0 ? tb : (tb < 4 ? 3 - tb : 71 - tb); const int chain = (dir * 2 + b) * 4 + h; const size_t un = (size_t)chain * 68 + cc;
        const bf16* gS = (const bf16*)(c.ws + WS_GDS) + un * 16384; const float* gU = (const float*)(c.ws + WS_GDU) + un * 8192; const bf16* gW = (const bf16*)(c.ws + WS_GDW) + un * 8192;
        const bf16* gAT = (const bf16*)(c.ws + WS_GDAT) + un * 4096; const bf16* gQD = (const bf16*)(c.ws + WS_GDQ) + un * 8192;
        __syncthreads();
        for (int it = c.tid; it < 128 * 16; it += 512) { const int e = it >> 4, ch = (it & 15) * 8; *(LAS u32x4*)(ST + e * 136 + ch) = *(const u32x4*)(gS + (size_t)e * 128 + ch); }
        bf16x8 wf[4], qf[4], af[2];
#pragma unroll
        for (int kk = 0; kk < 4; ++kk) { wf[kk] = gfrag(gW, 128, 16 * mt, 32 * kk, c.lane); qf[kk] = gfrag(gQD, 128, 16 * mt, 32 * kk, c.lane); }
#pragma unroll
        for (int kk = 0; kk < 2; ++kk) af[kk] = gfrag(gAT, 64, 16 * mt, 32 * kk, c.lane);
        __syncthreads();
#pragma unroll
        for (int j = 0; j < 4; ++j) { const int nt = ntb + j; f32x4 acc = {0.f, 0.f, 0.f, 0.f};
#pragma unroll
            for (int kk = 0; kk < 4; ++kk) acc = mfma16(wf[kk], ldfrag(ST, 136, 16 * nt, 32 * kk, c.lane), acc);
            const f32x4 uv = *(const f32x4*)(gU + (16 * nt + r) * 64 + 16 * mt + 4 * q); const f32x4 vn = uv - acc;
            u32x2 wv; wv.x = pk2(vn[0], vn[1]); wv.y = pk2(vn[2], vn[3]); *(LAS u32x2*)(vnT + (16 * nt + r) * 72 + 16 * mt + 4 * q) = wv; }
        __syncthreads();
        const int t = 16 * mt + r, tok = dir ? 63 - t : t;
#pragma unroll
        for (int j = 0; j < 4; ++j) { const int nt = ntb + j; f32x4 acc = {0.f, 0.f, 0.f, 0.f};
#pragma unroll
            for (int kk = 0; kk < 4; ++kk) acc = mfma16(ldfrag(ST, 136, 16 * nt, 32 * kk, c.lane), qf[kk], acc);
#pragma unroll
            for (int kk = 0; kk < 2; ++kk) acc = mfma16(ldfrag(vnT, 72, 16 * nt, 32 * kk, c.lane), af[kk], acc);
            LAS f32x4* hp = (LAS f32x4*)(hbuf + tok * 128 + 16 * nt + 4 * q); if (dir == 0) *hp = acc; else *hp += acc; }
    }
    __syncthreads();
    { const int tok = c.tid >> 3, eg = (c.tid & 7) * 16; const int row = (tb < 4 ? LAT + b * TC + tb * 64 : b * T + (tb - 4) * 64) + tok;
        float hv[16]; float ss = 0.f;
#pragma unroll
        for (int j = 0; j < 4; ++j) { const f32x4 x = *(const LAS f32x4*)(hbuf + tok * 128 + eg + 4 * j); hv[4 * j] = x[0]; hv[4 * j + 1] = x[1]; hv[4 * j + 2] = x[2]; hv[4 * j + 3] = x[3]; ss += (x[0] * x[0] + x[1] * x[1]) + (x[2] * x[2] + x[3] * x[3]); }
        ss = grp_sum<8>(ss); const float rs = rsqrtf(ss * (1.f / 128.f) + 1e-6f);
#pragma unroll
        for (int j = 0; j < 2; ++j) { float g[8], o[8], y[8]; ldf8(p.gd_norm_g + l * 512 + h * 128 + eg + 8 * j, g); ld8(Z + (size_t)row * NZ + GDZ + h * 128 + eg + 8 * j, o);
#pragma unroll
            for (int i = 0; i < 8; ++i) y[i] = hv[8 * j + i] * rs * g[i] * siluf_(o[i]);
            st8(Y + (size_t)row * D + 1024 + h * 128 + eg + 8 * j, y); } }
}


DI void rwkv_local(Ctx& c, int l, int u) {
    { int t0_ = pg8::lane_id_hw(); asm volatile("" : "+v"(t0_)); c.lane = t0_; c.tid = c.wave * 64 + t0_; }
    const Params& p = *c.p; const bf16* Z = (const bf16*)(c.ws + WS_Z); const float* mu = p.rw_mu + (size_t)l * 2 * RWMIX; const bf16* lw = (const bf16*)(c.ws + WS_W + WL_LORA);
    const int chain = u / 68, cc = u % 68, g = chain >> 3, h = chain & 7, dir = g >> 1, b = g & 1;
    bf16* gQE = (bf16*)(c.ws + WS_RQE) + (size_t)u * 4096; float* gYL = (float*)(c.ws + WS_RYL) + (size_t)u * 4096; bf16* gAC = (bf16*)(c.ws + WS_RAC) + (size_t)u * 4096; float* gBC = (float*)(c.ws + WS_RBC) + (size_t)u * 4096;
    LAS bf16* IM = (LAS bf16*)c.lds;
#define RIM(k) (IM + (k) * 4608)
    LAS bf16 *At = RIM(0), *Tm = RIM(0), *Bt = RIM(1), *X1T = RIM(1), *Kt = RIM(2), *AhT = RIM(2), *Rt = RIM(3), *AtT = RIM(4), *VT = RIM(5), *BhT = RIM(6), *KhT = RIM(7), *NAK = RIM(8), *SgT = RIM(8), *MBR = RIM(9), *MKR = RIM(10);
#undef RIM
    LAS float* Nf = (LAS float*)(c.lds + 101376); LAS float* seg = (LAS float*)(c.lds + 118784); LAS float* W63 = seg + 512;
    LAS bf16* Nb21 = (LAS bf16*)(c.lds + 121088); LAS bf16* tscr = Nb21 + 1280;
    LAS bf16* in = (LAS bf16*)c.lds; LAS bf16* wTw = in + 64 * 200; LAS bf16* wTa = wTw + 64 * 104; LAS float* Ldec = (LAS float*)(c.lds + 52224); LAS float* Lic = Ldec + 4096;
    const int q = c.lane >> 4, r = c.lane & 15; const int ch = c.tid & 63, tq = c.tid >> 6;
    const int row_first = scan_row(dir, b, cc * 64); int sbase, slen, tp0; seq_of(row_first, sbase, slen, tp0);
    float xr[10], xk[10], xv[10];
    const int rj0 = row_first + (dir ? -(tq * 8) : tq * 8); const int lo = dir ? rj0 - 7 : rj0; const int cz = h * 64 + ch;
#pragma unroll
    for (int m = 0; m < 10; ++m) { const int row = lo - 1 + m; const bool ok = row >= sbase && row < sbase + slen; const bf16* zp = Z + (size_t)row * NZ + RWR + cz;
        xr[m] = ok ? bf2f(zp[0]) : 0.f; xk[m] = ok ? bf2f(zp[512]) : 0.f; xv[m] = ok ? bf2f(zp[1024]) : 0.f; }
    const float mr0 = mu[cz], mr1 = mu[RWMIX + cz], mk0 = mu[512 + cz], mk1 = mu[RWMIX + 512 + cz], mv0 = mu[1024 + cz], mv1 = mu[RWMIX + 1024 + cz];
    const float kks = p.rw_kk[l * 512 + cz], kas = p.rw_ka[l * 512 + cz], rks = p.rw_rk[l * 512 + cz]; float* BON = (float*)(c.ws + WS_BON);
    const int pc0 = h * 64 + 16 * ((c.wave >> 2) * 2) + 4 * q;
    const f32x4 pw0 = *(const f32x4*)(p.rw_w0 + (l * 2 + dir) * 512 + pc0), pw1 = *(const f32x4*)(p.rw_w0 + (l * 2 + dir) * 512 + pc0 + 16);
    const f32x4 pa0 = *(const f32x4*)(p.rw_a0 + (l * 2 + dir) * 512 + pc0), pa1 = *(const f32x4*)(p.rw_a0 + (l * 2 + dir) * 512 + pc0 + 16);
    __syncthreads();
    for (int it = c.tid; it < 64 * 24; it += 512) { const int t = it / 24, k8 = it % 24; const int row = row_first + (dir ? -t : t); const int tp = row - sbase;
        const bf16* zp = Z + (size_t)row * NZ + RWXW + k8 * 8; float x[8], pv[8], nx[8], m0[8], m1[8], f[8];
        ld8(zp, x);
        if (tp > 0) ld8(zp - NZ, pv); else {
#pragma unroll
            for (int i = 0; i < 8; ++i) pv[i] = 0.f; }
        if (tp < slen - 1) ld8(zp + NZ, nx); else {
#pragma unroll
            for (int i = 0; i < 8; ++i) nx[i] = 0.f; }
        ldf8(mu + 1536 + k8 * 8, m0); ldf8(mu + RWMIX + 1536 + k8 * 8, m1);
#pragma unroll
        for (int i = 0; i < 8; ++i) { const float v = x[i] + m0[i] * (pv[i] - x[i]) + m1[i] * (nx[i] - x[i]); f[i] = k8 < 12 ? ftanh(v) : v; }
        *(LAS u32x4*)(in + t * 200 + k8 * 8) = pack8(f); }
    for (int it = c.tid; it < 2 * 64 * 12; it += 512) { const int m = it / 768, rr = it % 768, n = rr / 12, k8 = rr % 12;
        *(LAS u32x4*)((m ? wTa : wTw) + n * 104 + k8 * 8) = *(const u32x4*)(lw + (size_t)((m ? 2 : 0) + dir) * 512 * 96 + (size_t)(h * 64 + n) * 96 + k8 * 8); }
    float r8[8], kf8[8], v8[8];
#pragma unroll
    for (int j = 0; j < 8; ++j) { const int m = (dir ? 7 - j : j) + 1;
        r8[j] = xr[m] + mr0 * (xr[m - 1] - xr[m]) + mr1 * (xr[m + 1] - xr[m]); kf8[j] = xk[m] + mk0 * (xk[m - 1] - xk[m]) + mk1 * (xk[m + 1] - xk[m]); v8[j] = xv[m] + mv0 * (xv[m - 1] - xv[m]) + mv1 * (xv[m + 1] - xv[m]); }
    __syncthreads();
    { const int mt = c.wave & 3;
#pragma unroll
      for (int jj = 0; jj < 2; ++jj) { const int nt = (c.wave >> 2) * 2 + jj; f32x4 aw = {0.f, 0.f, 0.f, 0.f}, aa = aw;
#pragma unroll
        for (int kk = 0; kk < 3; ++kk) { aw = mfma16(ldfrag(wTw, 104, 16 * nt, 32 * kk, c.lane), ldfrag(in, 200, 16 * mt, 32 * kk, c.lane), aw); aa = mfma16(ldfrag(wTa, 104, 16 * nt, 32 * kk, c.lane), ldfrag(in + 96, 200, 16 * mt, 32 * kk, c.lane), aa); }
        const f32x4 w0 = jj ? pw1 : pw0, a0 = jj ? pa1 : pa0; f32x4 dv, iv;
#pragma unroll
        for (int i = 0; i < 4; ++i) { dv[i] = fexp(-fexp(-softplusf_(-(w0[i] + aw[i])) - 0.5f)); iv[i] = sigmoidf_(a0[i] + aa[i]); }
        *(LAS f32x4*)(Ldec + (16 * mt + r) * 64 + 16 * nt + 4 * q) = dv; *(LAS f32x4*)(Lic + (16 * mt + r) * 64 + 16 * nt + 4 * q) = iv; } }
    __syncthreads();
    {   float w8[8], k8[8], a8[8], b8[8];
#pragma unroll
        for (int j = 0; j < 8; ++j) { const float kf = kf8[j]; const float ic = Lic[(tq * 8 + j) * 64 + ch]; w8[j] = Ldec[(tq * 8 + j) * 64 + ch];
            const float kx = kf * kks; const float kkv = kx * rsqrtf(wave_sum(kx * kx) + 1e-6f);
            k8[j] = kf * (1.f + (ic - 1.f) * kas); a8[j] = -kkv; b8[j] = kkv * ic;
            const float bo = wave_sum(r8[j] * k8[j] * rks); if (c.lane == 0) BON[((size_t)dir * MROWS + (row_first + (dir ? -(tq * 8 + j) : (tq * 8 + j)))) * 8 + h] = bo; }
        __syncthreads();
#pragma unroll
        for (int j = 1; j < 8; ++j) w8[j] *= w8[j - 1];
        seg[tq * 64 + ch] = w8[7];
        __syncthreads();
        float pre = 1.f, tot = 1.f;
#pragma unroll
        for (int s = 0; s < 8; ++s) { const float sv = seg[s * 64 + ch]; if (s < tq) pre *= sv; tot *= sv; }
        if (tq == 0) W63[ch] = tot;
        float aT[8], bhT[8], khT[8];
#pragma unroll
        for (int j = 0; j < 8; ++j) { const float winc = pre * w8[j], wexc = j ? pre * w8[j - 1] : pre; const float iw = 1.f / winc; const int t = tq * 8 + j;
            const float at = a8[j] * wexc, bt = b8[j] * iw, kt = k8[j] * iw, rt = r8[j] * winc;
            At[t * 72 + ch] = (bf16)f2bf(at); Bt[t * 72 + ch] = (bf16)f2bf(bt); Kt[t * 72 + ch] = (bf16)f2bf(kt); Rt[t * 72 + ch] = (bf16)f2bf(rt);
            aT[j] = at; bhT[j] = bt * tot; khT[j] = kt * tot; }
        *(LAS u32x4*)(AtT + ch * 72 + tq * 8) = pack8(aT); *(LAS u32x4*)(VT + ch * 72 + tq * 8) = pack8(v8); *(LAS u32x4*)(BhT + ch * 72 + tq * 8) = pack8(bhT); *(LAS u32x4*)(KhT + ch * 72 + tq * 8) = pack8(khT);
    }
    __syncthreads();
#pragma unroll
    for (int jj = 0; jj < 2; ++jj) { const int ti = 2 * c.wave + jj, mt = ti >> 2, nt = ti & 3; const int t = 16 * mt + r, j0 = 16 * nt + 4 * q; const f32x4 z4 = {0.f, 0.f, 0.f, 0.f};
        const f32x4 p1 = mm_tile<64>(Bt, 72, 16 * nt, At, 72, 16 * mt, c.lane, z4), p2 = mm_tile<64>(Kt, 72, 16 * nt, At, 72, 16 * mt, c.lane, z4);
        const f32x4 p3 = mm_tile<64>(Bt, 72, 16 * nt, Rt, 72, 16 * mt, c.lane, z4), p4 = mm_tile<64>(Kt, 72, 16 * nt, Rt, 72, 16 * mt, c.lane, z4);
        f32x4 n1; float d2[4], d3[4], d4[4];
#pragma unroll
        for (int i = 0; i < 4; ++i) { const bool lt = (j0 + i) < t, le = (j0 + i) <= t; n1[i] = lt ? -p1[i] : 0.f; d2[i] = lt ? p2[i] : 0.f; d3[i] = le ? p3[i] : 0.f; d4[i] = le ? p4[i] : 0.f; }
        *(LAS f32x4*)(Nf + t * 68 + j0) = n1;
        if (mt >= 2 && nt < 2) { u32x2 wn; wn.x = pk2(n1[0], n1[1]); wn.y = pk2(n1[2], n1[3]); *(LAS u32x2*)(Nb21 + (t - 32) * 40 + j0) = wn; }
        u32x2 w; w.x = pk2(d2[0], d2[1]); w.y = pk2(d2[2], d2[3]); *(LAS u32x2*)(NAK + t * 72 + j0) = w;
        w.x = pk2(d3[0], d3[1]); w.y = pk2(d3[2], d3[3]); *(LAS u32x2*)(MBR + t * 72 + j0) = w;
        w.x = pk2(d4[0], d4[1]); w.y = pk2(d4[2], d4[3]); *(LAS u32x2*)(MKR + t * 72 + j0) = w; }
    __syncthreads();
    if (c.wave == 0) tri_inverse64(Nf, Nb21, Tm, tscr, c.lane);
    else { for (int ti = c.wave - 1; ti < 16; ti += 7) { const int mt = ti >> 2, nt = ti & 3;
            const f32x4 a = mm_tile<64>(NAK, 72, 16 * mt, VT, 72, 16 * nt, c.lane, (f32x4){0.f, 0.f, 0.f, 0.f});
            u32x2 w; w.x = pk2(a[0], a[1]); w.y = pk2(a[2], a[3]); *(LAS u32x2*)(X1T + (16 * nt + r) * 72 + 16 * mt + 4 * q) = w; } }
    __syncthreads();
    int lz = c.lane; asm volatile("" : "+v"(lz)); c.lane = lz;
    { const int q = lz >> 4, r = lz & 15;
#pragma unroll
    for (int jj = 0; jj < 2; ++jj) { const int ti = 2 * c.wave + jj, mt = ti >> 2, nt = ti & 3; const f32x4 z4 = {0.f, 0.f, 0.f, 0.f};
        const f32x4 a = mm_tile<64>(Tm, 72, 16 * mt, AtT, 72, 16 * nt, c.lane, z4), s = mm_tile<64>(Tm, 72, 16 * mt, X1T, 72, 16 * nt, c.lane, z4);
        u32x2 w; w.x = pk2(a[0], a[1]); w.y = pk2(a[2], a[3]); *(LAS u32x2*)(AhT + (16 * nt + r) * 72 + 16 * mt + 4 * q) = w;
        w.x = pk2(s[0], s[1]); w.y = pk2(s[2], s[3]); *(LAS u32x2*)(SgT + (16 * nt + r) * 72 + 16 * mt + 4 * q) = w; } }
    __syncthreads();
    int lz2 = c.lane; asm volatile("" : "+v"(lz2)); c.lane = lz2;
    { const int q = lz2 >> 4, r = lz2 & 15;
#pragma unroll
    for (int jj = 0; jj < 2; ++jj) { const int ti = 2 * c.wave + jj, xt = ti >> 2, yt = ti & 3; const int x0 = 16 * xt + 4 * q, yr = 16 * yt + r; const f32x4 z4 = {0.f, 0.f, 0.f, 0.f};
        { f32x4 a = mm_tile<64>(AhT, 72, 16 * xt, MBR, 72, 16 * yt, c.lane, z4); const u32x2 rw = *(const LAS u32x2*)(Rt + yr * 72 + x0);
          a[0] += __uint_as_float(rw.x << 16); a[1] += __uint_as_float(rw.x & 0xffff0000u); a[2] += __uint_as_float(rw.y << 16); a[3] += __uint_as_float(rw.y & 0xffff0000u);
          u32x2 w; w.x = pk2(a[0], a[1]); w.y = pk2(a[2], a[3]); *(u32x2*)(gQE + yr * 64 + x0) = w; }
        { f32x4 a = mm_tile<64>(SgT, 72, 16 * xt, MBR, 72, 16 * yt, c.lane, z4); a = mm_tile<64>(VT, 72, 16 * xt, MKR, 72, 16 * yt, c.lane, a); *(f32x4*)(gYL + yr * 64 + x0) = a; }
        { f32x4 a = mm_tile<64>(AhT, 72, 16 * xt, BhT, 72, 16 * yt, c.lane, z4); const float wd = W63[yr];
#pragma unroll
          for (int i = 0; i < 4; ++i) if (x0 + i == yr) a[i] += wd;
          u32x2 w; w.x = pk2(a[0], a[1]); w.y = pk2(a[2], a[3]); *(u32x2*)(gAC + yr * 64 + x0) = w; }
        { f32x4 a = mm_tile<64>(BhT, 72, 16 * xt, SgT, 72, 16 * yt, c.lane, z4); a = mm_tile<64>(KhT, 72, 16 * xt, VT, 72, 16 * yt, c.lane, a); *(f32x4*)(gBC + yr * 64 + x0) = a; } } }
}
DI void rwkv_out(Ctx& c, int l, int u) {
    const Params& p = *c.p; bf16* Y = (bf16*)(c.ws + WS_Y); const bf16* Z = (const bf16*)(c.ws + WS_Z); const float* SA = (const float*)(c.ws + WS_S); const size_t AS = (size_t)MROWS * 512;
    const int b = u / 136, rem = u % 136, tb = rem >> 1, hg = rem & 1; const int hl = c.wave & 3, dir = c.wave >> 2, head = hg * 4 + hl;
    LAS float* hbuf = (LAS float*)c.lds;
    const int q = c.lane >> 4, r = c.lane & 15;
    __syncthreads();
    { const int cc = dir == 0 ? tb : (tb < 4 ? 3 - tb : 71 - tb); const int chain = (dir * 2 + b) * 8 + head; const size_t un = (size_t)chain * 68 + cc;
      const bf16* gQE = (const bf16*)(c.ws + WS_RQE) + un * 4096; const float* gYL = (const float*)(c.ws + WS_RYL) + un * 4096; const bf16* gPT = (const bf16*)(c.ws + WS_RPT) + un * 4096;
      bf16x8 pf[4][2];
#pragma unroll
      for (int it = 0; it < 4; ++it)
#pragma unroll
          for (int kk = 0; kk < 2; ++kk) pf[it][kk] = gfrag(gPT, 64, 16 * it, 32 * kk, c.lane);
#pragma unroll
      for (int mt = 0; mt < 4; ++mt) { const bf16x8 q0 = gfrag(gQE, 64, 16 * mt, 0, c.lane), q1 = gfrag(gQE, 64, 16 * mt, 32, c.lane); const int t = 16 * mt + r, tok = dir ? 63 - t : t;
#pragma unroll
          for (int it = 0; it < 4; ++it) { f32x4 acc = *(const f32x4*)(gYL + t * 64 + 16 * it + 4 * q); acc = mfma16(pf[it][0], q0, acc); acc = mfma16(pf[it][1], q1, acc);
              *(LAS f32x4*)(hbuf + ((dir * 4 + hl) * 64 + tok) * 64 + 16 * it + 4 * q) = acc; } } }
    __syncthreads();
    { const int pr = c.tid >> 1, hf = c.tid & 1, h2 = pr >> 6, tok = pr & 63, hd = hg * 4 + h2; const int row = (tb < 4 ? LAT + b * TC + tb * 64 : b * T + (tb - 4) * 64) + tok;
      float y[32]; float s = 0.f;
#pragma unroll
      for (int j = 0; j < 8; ++j) { const f32x4 a = *(const LAS f32x4*)(hbuf + (h2 * 64 + tok) * 64 + hf * 32 + 4 * j), bq = *(const LAS f32x4*)(hbuf + ((4 + h2) * 64 + tok) * 64 + hf * 32 + 4 * j);
#pragma unroll
          for (int i = 0; i < 4; ++i) { y[4 * j + i] = a[i] + bq[i]; s += y[4 * j + i]; } }
      s += shx<1>(s); const float mean = s * (1.f / 64.f); float qq = 0.f;
#pragma unroll
      for (int i = 0; i < 32; ++i) { y[i] -= mean; qq += y[i] * y[i]; }
      qq += shx<1>(qq); const float rs = rsqrtf(qq * (1.f / 64.f) + 64e-5f);
      const int cb = hd * 64 + hf * 32; int bases, lens, tps; seq_of(row, bases, lens, tps); const float* BON = (const float*)(c.ws + WS_BON);
      const float bonus = BON[(size_t)row * 8 + hd] + BON[((size_t)MROWS + row) * 8 + hd]; const float* mu = p.rw_mu + (size_t)l * 2 * RWMIX;
#pragma unroll
      for (int j = 0; j < 4; ++j) { float g[8], bb[8], ax[8], gg[8], o[8]; ldf8(p.rw_ln_g + l * 512 + cb + 8 * j, g); ldf8(p.rw_ln_b + l * 512 + cb + 8 * j, bb);
          { float x[8], pv[8], nx[8], m0[8], m1[8]; const bf16* zp = Z + (size_t)row * NZ + RWV + cb + 8 * j; ld8(zp, x);
            if (tps > 0) ld8(zp - NZ, pv); else {
#pragma unroll
                for (int i = 0; i < 8; ++i) pv[i] = 0.f; }
            if (tps < lens - 1) ld8(zp + NZ, nx); else {
#pragma unroll
                for (int i = 0; i < 8; ++i) nx[i] = 0.f; }
            ldf8(mu + 1024 + cb + 8 * j, m0); ldf8(mu + RWMIX + 1024 + cb + 8 * j, m1);
#pragma unroll
            for (int i = 0; i < 8; ++i) ax[i] = bonus * (x[i] + m0[i] * (pv[i] - x[i]) + m1[i] * (nx[i] - x[i])); }
          ldf8(SA + SA_RG * AS + (size_t)row * 512 + cb + 8 * j, gg);
#pragma unroll
          for (int i = 0; i < 8; ++i) o[i] = (y[8 * j + i] * rs * g[i] + bb[i] + ax[i]) * gg[i];
          st8(Y + (size_t)row * D + 1536 + cb + 8 * j, o); } }
}

DI float rw_feat(const bf16* Z, const float* mu, int row, int cz) {
    int base, len, t; seq_of(row, base, len, t); const bf16* zp = Z + (size_t)row * NZ + RWR + cz;
    const float x = bf2f(zp[0]); const float pv = t > 0 ? bf2f(zp[-NZ]) : 0.f; const float nx = t < len - 1 ? bf2f(zp[NZ]) : 0.f;
    return x + mu[cz] * (pv - x) + mu[RWMIX + cz] * (nx - x);
}
DI void ld4(const bf16* p, float (&o)[4]) { const u32x2 w = *(const u32x2*)p; o[0] = __uint_as_float(w.x << 16); o[1] = __uint_as_float(w.x & 0xffff0000u); o[2] = __uint_as_float(w.y << 16); o[3] = __uint_as_float(w.y & 0xffff0000u); }
DI void rw_feat4(const bf16* Z, const float* mu, int row, int tpos, int len, int cz, float (&f)[4]) {
    const bf16* zp = Z + (size_t)row * NZ + RWR + cz; float x[4], pv[4] = {0.f, 0.f, 0.f, 0.f}, nx[4] = {0.f, 0.f, 0.f, 0.f}; ld4(zp, x); if (tpos > 0) ld4(zp - NZ, pv); if (tpos < len - 1) ld4(zp + NZ, nx);
    const f32x4 m0 = *(const f32x4*)(mu + cz), m1 = *(const f32x4*)(mu + RWMIX + cz);
#pragma unroll
    for (int i = 0; i < 4; ++i) f[i] = x[i] + m0[i] * (pv[i] - x[i]) + m1[i] * (nx[i] - x[i]);
}
DI void conv_unit(Ctx& c, int l, int u) {
    { int t0_ = pg8::lane_id_hw(); asm volatile("" : "+v"(t0_)); c.lane = t0_; c.tid = c.wave * 64 + t0_; }
    const Params& p = *c.p; const bf16* Z = (const bf16*)(c.ws + WS_Z); bf16* Y = (bf16*)(c.ws + WS_Y);
    LAS bf16* ys = (LAS bf16*)c.lds; LAS bf16* wq = ys + 64 * 520;
    const int r0 = 34 * u - 15;
    __syncthreads();
    for (int it = c.tid; it < 64 * 64; it += 512) { const int cg = it & 63, rr = it >> 6; const int grow = r0 + rr; float y[8];
        if (grow >= 0 && grow < MROWS) { float a[8], g[8]; ld8(Z + (size_t)grow * NZ + ZA + cg * 8, a); ld8(Z + (size_t)grow * NZ + ZAG + cg * 8, g);
#pragma unroll
            for (int i = 0; i < 8; ++i) y[i] = a[i] * sigmoidf_(g[i]); }
        else {
#pragma unroll
            for (int i = 0; i < 8; ++i) y[i] = 0.f; }
        *(LAS u32x4*)(ys + rr * 520 + cg * 8) = pack8(y); }
    for (int it = c.tid; it < 31 * 64; it += 512) { float w8[8]; ldf8(p.conv_dw + (size_t)l * 31 * 512 + it * 8, w8); *(LAS u32x4*)(wq + it * 8) = pack8(w8); }
    __syncthreads();
    const int ch = c.lane * 8;
    for (int tl = c.wave; tl < 34; tl += 8) { const int row = 34 * u + tl; int base, len, t; seq_of(row, base, len, t);
        float acc[8];
#pragma unroll
        for (int i = 0; i < 8; ++i) acc[i] = 0.f;
#pragma unroll
        for (int j = 0; j < 31; ++j) { const int tt = t + j - 15; if (tt < 0 || tt >= len) continue;
            const u32x4 yv = *(const LAS u32x4*)(ys + (tl + j) * 520 + ch), wv = *(const LAS u32x4*)(wq + j * 512 + ch);
#pragma unroll
            for (int i = 0; i < 4; ++i) { acc[2 * i] = fmaf(__uint_as_float(yv[i] << 16), __uint_as_float(wv[i] << 16), acc[2 * i]); acc[2 * i + 1] = fmaf(__uint_as_float(yv[i] & 0xffff0000u), __uint_as_float(wv[i] & 0xffff0000u), acc[2 * i + 1]); } }
        float bv[8]; ldf8(p.conv_b + l * 512 + ch, bv); float s = 0.f;
#pragma unroll
        for (int i = 0; i < 8; ++i) { acc[i] += bv[i]; s += acc[i]; }
        const float mean = wave_sum(s) * (1.f / 512.f); float qv = 0.f;
#pragma unroll
        for (int i = 0; i < 8; ++i) { acc[i] -= mean; qv += acc[i] * acc[i]; }
        const float rstd = rsqrtf(wave_sum(qv) * (1.f / 512.f) + 1e-6f);
        float lg[8], lb[8], o[8]; ldf8(p.conv_ln_g + l * 512 + ch, lg); ldf8(p.conv_ln_b + l * 512 + ch, lb);
#pragma unroll
        for (int i = 0; i < 8; ++i) o[i] = siluf_(acc[i] * rstd * lg[i] + lb[i]);
        st8(Y + (size_t)row * D + ch, o); }
}
DI void phase_prep(Ctx& c, int l) {
    const Params& p = *c.p; const bf16* Z = (const bf16*)(c.ws + WS_Z); bf16* Y = (bf16*)(c.ws + WS_Y); const float* G32 = (const float*)(c.ws + WS_G32);
    float* SA = (float*)(c.ws + WS_S); float* SG = (float*)(c.ws + WS_SG);
    const int gw = c.bid * 8 + c.wave, NGW = c.G * 8; const int ch = c.lane * 8;
    { const float* mu = p.rw_mu + (size_t)l * 2 * RWMIX; bf16* XG = (bf16*)(c.ws + WS_XG);
      for (int it = c.bid * 512 + c.tid; it < MROWS * 32; it += c.G * 512) { const int row = it >> 5, k8 = it & 31; int base, len, tp; seq_of(row, base, len, tp);
        const bf16* zp = Z + (size_t)row * NZ + RWXG + k8 * 8; float x[8], pv[8], nx[8], m0[8], m1[8], f[8]; ld8(zp, x);
        if (tp > 0) ld8(zp - NZ, pv); else {
#pragma unroll
            for (int i = 0; i < 8; ++i) pv[i] = 0.f; }
        if (tp < len - 1) ld8(zp + NZ, nx); else {
#pragma unroll
            for (int i = 0; i < 8; ++i) nx[i] = 0.f; }
        ldf8(mu + 1728 + k8 * 8, m0); ldf8(mu + RWMIX + 1728 + k8 * 8, m1);
#pragma unroll
        for (int i = 0; i < 8; ++i) f[i] = sigmoidf_(x[i] + m0[i] * (pv[i] - x[i]) + m1[i] * (nx[i] - x[i]));
        st8(XG + (size_t)row * 256 + k8 * 8, f); } }
    REPS(6) for (int u = (c.bid + c.G - 128) % c.G; u < RW_NU; u += c.G) rwkv_local(c, l, u);
    __syncthreads();
    REPS(2) for (int u = c.bid; u < ML_NU; u += c.G) mlstm_local(c, l, u);
    REPS(3) for (int u = (c.bid + c.G - 64) % c.G; u < GD_NU; u += c.G) gdn_local(c, l, u);
    __syncthreads();
}


DI void phase_mid(Ctx& c, int l) {
    REPS(4) mlstm_prefix(c);
    REPS(5) { for (int u = c.bid; u < 128; u += c.G) gdn_prefix(c, u);
              for (int u = c.bid - 128; u < 128; u += c.G) if (u >= 0) rwkv_prefix(c, u); }
    if (c.G == 256) { if (c.bid >= 128) for (int u = c.bid - 128; u < MROWS / 34; u += 128) conv_unit(c, l, u); }
    else for (int u = c.bid; u < MROWS / 34; u += c.G) conv_unit(c, l, u);
    __syncthreads();
}
DI void phase_finish(Ctx& c, int l) {
    if (l == NL - 1) {
        for (int v = c.bid; v < NB * 4 * 64; v += c.G) mlstm_out(c, l, (v >> 8) * 272 + ((v >> 6) & 3) * 68 + 4 + (v & 63));
        for (int v = c.bid; v < NB * 4 * 64; v += c.G) gdn_out(c, l, (v >> 8) * 272 + ((v >> 6) & 3) * 68 + 4 + (v & 63));
        for (int v = c.bid; v < NB * 64 * 2; v += c.G) rwkv_out(c, l, (v >> 7) * 136 + (4 + ((v & 127) >> 1)) * 2 + (v & 1));
        __syncthreads(); return; }
    REPS(7) for (int u = c.bid; u < NB * 4 * 68; u += c.G) mlstm_out(c, l, u);
    REPS(8) for (int u = (c.bid + c.G - 32) % c.G; u < NB * 4 * 68; u += c.G) gdn_out(c, l, u);
    REPS(9) for (int u = (c.bid + c.G - 64) % c.G; u < NB * 68 * 2; u += c.G) rwkv_out(c, l, u);
    __syncthreads();
}
DI void phase_ffnconv(Ctx& c, int l) {
    const Params& p = *c.p; const bf16* UP = (const bf16*)(c.ws + WS_Z); bf16* H = (bf16*)(c.ws + WS_S); const float* w = p.ffn_dw + (size_t)l * 9 * DFF;
    constexpr int CPR = DFF / 8;
    for (int it = c.bid * 512 + c.tid; it < NB * 4 * 64 * CPR; it += c.G * 512) {
        const int cg = it % CPR; int r1 = it / CPR; const int gx = r1 & 63; r1 >>= 6; const int seg = r1 & 3, bb = r1 >> 2; const int ch = cg * 8, gy0 = seg * 16;
        u32x4 wv[9];
#pragma unroll
        for (int k = 0; k < 9; ++k) { float t8[8]; ldf8(w + k * DFF + ch, t8); wv[k] = pack8(t8); }
        const bf16* base = UP + (size_t)bb * T * (2 * DFF) + ch; const u32x4 z4 = {0u, 0u, 0u, 0u};
        u32x4 ring[6][3], vr[4];
#define FC_ROW(slot, j) do { const int yy = gy0 - 1 + (j); _Pragma("unroll") for (int dx = 0; dx < 3; ++dx) { const int xx = gx + dx - 1; \
            ring[slot][dx] = (yy >= 0 && yy < 64 && xx >= 0 && xx < 64) ? *(const u32x4*)(base + (size_t)(yy * 64 + xx) * (2 * DFF)) : z4; } } while (0)
#define FC_V(slot, dy_) do { vr[slot] = *(const u32x4*)(UP + ((size_t)bb * T + (gy0 + (dy_)) * 64 + gx) * (2 * DFF) + DFF + ch); } while (0)
        FC_ROW(0, 0); FC_ROW(1, 1); FC_ROW(2, 2); FC_ROW(3, 3); FC_ROW(4, 4); FC_V(0, 0); FC_V(1, 1); FC_V(2, 2);
#pragma unroll
        for (int dy = 0; dy < 16; ++dy) {
            if (dy + 5 < 18) FC_ROW((dy + 5) % 6, dy + 5);
            if (dy + 3 < 16) FC_V((dy + 3) % 4, dy + 3);
            const size_t row = (size_t)bb * T + (gy0 + dy) * 64 + gx; float acc[8];
#pragma unroll
            for (int i = 0; i < 8; ++i) acc[i] = 0.f;
#pragma unroll
            for (int k = 0; k < 3; ++k)
#pragma unroll
                for (int dx = 0; dx < 3; ++dx) { const u32x4 a = ring[(dy + k) % 6][dx];
#pragma unroll
                    for (int j = 0; j < 4; ++j) { const unsigned ww = wv[k * 3 + dx][j]; acc[2 * j] = fmaf(__uint_as_float(a[j] << 16), __uint_as_float(ww << 16), acc[2 * j]); acc[2 * j + 1] = fmaf(__uint_as_float(a[j] & 0xffff0000u), __uint_as_float(ww & 0xffff0000u), acc[2 * j + 1]); } }
            const u32x4 vw = vr[dy % 4]; float o[8];
#pragma unroll
            for (int j = 0; j < 4; ++j) { o[2 * j] = gelu_tanh(acc[2 * j]) * __uint_as_float(vw[j] << 16); o[2 * j + 1] = gelu_tanh(acc[2 * j + 1]) * __uint_as_float(vw[j] & 0xffff0000u); }
            st8(H + row * DFF + ch, o); asm volatile("" ::: "memory"); }
#undef FC_ROW
#undef FC_V
    }
    if (l < NL - 1) for (int it = c.bid * 512 + c.tid; it < NB * TC * CPR; it += c.G * 512) {
        const int row = LAT + it / CPR, ch = (it % CPR) * 8; float acc[8];
#pragma unroll
        for (int i = 0; i < 8; ++i) acc[i] = 0.f;
        const int t = (row - LAT) & (TC - 1);
#pragma unroll
        for (int dx = 0; dx < 3; ++dx) { const int tt = t + dx - 1; if (tt < 0 || tt >= TC) continue;
            float a[8], wv[8]; ld8(UP + (size_t)(row + dx - 1) * (2 * DFF) + ch, a); ldf8(w + (3 + dx) * DFF + ch, wv);
#pragma unroll
            for (int i = 0; i < 8; ++i) acc[i] = fmaf(a[i], wv[i], acc[i]); }
        float v[8], o[8]; ld8(UP + (size_t)row * (2 * DFF) + DFF + ch, v);
#pragma unroll
        for (int i = 0; i < 8; ++i) o[i] = gelu_tanh(acc[i]) * v[i];
        st8(H + (size_t)row * DFF + ch, o);
    }
}

constexpr int PH_PRO = 3, PH_PER_LAYER = 11, NPHASE = PH_PRO + NL * PH_PER_LAYER;
#ifndef MK_PER_PHASE
#define MK_PER_PHASE 0
#endif
#ifndef DUP_MASK
#define DUP_MASK 0u
#endif
#define REP(ty) for (int rep_ = 0; rep_ < ((((DUP_MASK) >> (ty)) & 1u) ? 2 : 1); ++rep_)
#ifndef PROBE_MASK
#define PROBE_MASK 0u
#endif
constexpr int CW_BAR = 4096;

__global__ void __launch_bounds__(512, 2) fwd_kernel(Params p) {
    extern __shared__ __attribute__((aligned(16))) unsigned char lds_raw[];
    Ctx c; c.lds = (LAS unsigned char*)lds_raw; c.tid = threadIdx.x; c.lane = c.tid & 63; c.wave = __builtin_amdgcn_readfirstlane(c.tid >> 6); asm volatile("" : "+s"(c.wave));     c.G = gridDim.x; c.bid = blockIdx.x; c.p = &p; c.ws = p.ws;
    volatile LAS unsigned* MISC = (volatile LAS unsigned*)(c.lds + LDS_MISC);
    if (c.tid < 32) MISC[c.tid] = 0u;
    __syncthreads();
    const int lo = MK_PER_PHASE ? p.ph_lo : 0, hi = MK_PER_PHASE ? p.ph_hi : NPHASE;
    XcdBarrier bar; bar.bar = (unsigned*)(p.ws + WS_CTL) + CW_BAR; bar.x = 0; bar.st = MISC + 8;
    if (hi - lo > 1) bar = xcd_barrier_post((unsigned*)(p.ws + WS_CTL) + CW_BAR, MISC + 8);
#ifndef PH_MASK
#define PH_MASK 0xFFFFFFFFu
#endif
#define IN(k) (lo <= (k) && (k) < hi)
#define EN(b) ((PH_MASK >> (b)) & 1u)
#define RF() do { asm volatile("" : "+s"(c.wave)); int t_ = pg8::lane_id_hw(); c.lane = t_; c.tid = c.wave * 64 + t_; int b_ = blockIdx.x; asm volatile("" : "+s"(b_)); c.bid = b_; unsigned long long w_ = (unsigned long long)p.ws; asm volatile("" : "+s"(w_)); c.ws = (unsigned char*)(GAS unsigned char*)w_; } while (0)
#define SEAM(k) do { if (IN((k) + 1)) xcd_barrier(bar, c.wave); } while (0)
    unsigned long long tp_ = PROBE_MASK ? __builtin_amdgcn_s_memrealtime() : 0ull; unsigned pacc_ = 0u;
#define STAMP(ty) do { if (PROBE_MASK) { const unsigned long long tn_ = __builtin_amdgcn_s_memrealtime(); if ((PROBE_MASK >> (ty)) & 1u) pacc_ += (unsigned)(tn_ - tp_); tp_ = tn_; } } while (0)
    if (EN(0) && IN(0)) { REP(0) { RF(); phase_pro0(c); } SEAM(0); STAMP(0); }
    if (EN(1) && IN(1)) { REP(1) { RF(); phase_pro1(c); } SEAM(1); STAMP(1); }
    if (EN(2) && IN(2)) { REP(2) { RF(); phase_pro2(c); phase_wconv(c, 0); } SEAM(2); STAMP(2); }
#define U ((bf16*)(c.ws + WS_U))
#define Y ((bf16*)(c.ws + WS_Y))
#define MB ((bf16*)(c.ws + WS_MB))
#define G32 ((float*)(c.ws + WS_G32))
#define F ((float*)(c.ws + WS_F))
#define Z ((bf16*)(c.ws + WS_Z))
#define H ((bf16*)(c.ws + WS_S))
    for (int l = 0; l < NL; ++l) {
        const int pb = PH_PRO + l * PH_PER_LAYER;
#define wl (c.ws + WS_W)
        if (EN(3) && IN(pb + 0)) { RF(); pg8::Gemm g{U, (const bf16*)(wl + WL_IN), D, D, D}; pg8::StdOrder S; S.init(MROWS / 256, NZ / 256, c.G, c.bid); pg8::EpiBf16 E{Z, NZ, G32, (ZSM - 192) / 256, (bf16*)(c.ws + WS_GT), ZG / 256};
            REP(3) pg8::gemm_phase(c.lds, g, S, E, c.wave); SEAM(pb + 0); STAMP(3); }
        if (EN(4) && IN(pb + 1)) { REP(4) { RF(); phase_prep(c, l); } SEAM(pb + 1); STAMP(4); }
        if (EN(5) && IN(pb + 2)) { REP(5) { RF(); phase_mid(c, l); }
            { RF(); pg8::Gemm g{(const bf16*)(c.ws + WS_XG), (const bf16*)(wl + WL_LORA) + (size_t)4 * 512 * 96, 256, 256, 256}; pg8::StdOrder S; S.init(MROWS / 256, 2, c.G, c.G - 1 - c.bid);
              pg8::EpiF32 E{(float*)(c.ws + WS_S) + (size_t)SA_RG * MROWS * 512, 512}; REPS(1) pg8::gemm_phase(c.lds, g, S, E, c.wave); }
            SEAM(pb + 2); STAMP(5); }
        if (EN(7) && IN(pb + 3)) { REP(7) { RF(); phase_finish(c, l); } SEAM(pb + 3); STAMP(7); }
        if (EN(8) && IN(pb + 4)) { RF(); pg8::Gemm g{Y, (const bf16*)(wl + WL_BR), D, MIXW, MIXW}; pg8::MergeOrder S; S.init2(c.G, c.bid, l < NL - 1); pg8::EpiMerge E{(const bf16*)(c.ws + WS_GT), MB, D, (bf16*)(c.ws + WS_MBC)};
            REP(8) pg8::gemm_phase(c.lds, g, S, E, c.wave); SEAM(pb + 4); STAMP(8); }
        if (EN(9) && IN(pb + 5)) { RF(); pg8::Gemm g{MB, (const bf16*)(wl + WL_OUT), D, D, D}; pg8::SplitOrder S; S.init2(D / 256, c.G, c.bid, l < NL - 1 ? 16 : 0, 512, (const bf16*)(c.ws + WS_MBC), 2048); pg8::EpiMixSplit E{(bf16*)F, (float*)(c.ws + WS_PART), D};
            REP(9) pg8::gemm_phase(c.lds, g, S, E, c.wave); SEAM(pb + 5); STAMP(9); }
        if (EN(10) && IN(pb + 6)) { REP(10) { RF(); phase_resid(c, l, 0); } SEAM(pb + 6); STAMP(10); }
        if (EN(11) && IN(pb + 7)) { RF(); pg8::Gemm g{U, (const bf16*)(wl + WL_UP), D, D, D}; pg8::StdOrder S; S.init(l < NL - 1 ? MROWS / 256 : LAT / 256, 2 * DFF / 256, c.G, c.bid); pg8::EpiBf16 E{Z, 2 * DFF, nullptr, -1, nullptr, 0};
            REP(11) pg8::gemm_phase(c.lds, g, S, E, c.wave); SEAM(pb + 7); STAMP(11); }
        if (EN(12) && IN(pb + 8)) { REP(12) { RF(); phase_ffnconv(c, l); } SEAM(pb + 8); STAMP(12); }
        if (EN(13) && IN(pb + 9)) { RF(); pg8::Gemm g{H, (const bf16*)(wl + WL_DN), DFF, DFF, DFF}; pg8::SplitOrder S; S.init2(D / 256, c.G, c.bid, l < NL - 1 ? 11 : 0, 512); pg8::EpiMixSplit E{(bf16*)F, (float*)(c.ws + WS_PART), D};
            REP(13) pg8::gemm_phase(c.lds, g, S, E, c.wave); SEAM(pb + 9); STAMP(13); }
        if (EN(14) && IN(pb + 10)) { REP(14) { RF(); phase_resid(c, l, 1); if (l + 1 < NL) phase_wconv(c, l + 1); } SEAM(pb + 10); STAMP(14); }
    }
    if (PROBE_MASK) { asm volatile("s_waitcnt vmcnt(0)" ::: "memory"); __syncthreads(); if (c.bid == 0 && threadIdx.x == 0) p.out[0] += (float)pacc_ * 1e-4f;     }
#undef IN
#undef SEAM
#undef U
#undef Y
#undef MB
#undef G32
#undef F
#undef Z
#undef H
#undef wl
}

extern "C" void kernel_launch(void* const* d_in, const int* in_sizes, int n_in, void* d_out, int out_size, void* d_ws, size_t ws_size, hipStream_t stream) {
    static int grid = 0;
    if (grid == 0) {
        if (n_in != 34 || ws_size < WS_END) { fprintf(stderr, "kernel_launch: unexpected n_in %d / ws %zu (need %zu)\n", n_in, ws_size, (size_t)WS_END); grid = -1; return; }
        int dev = 0, cus = 0;
        if (hipGetDevice(&dev) != hipSuccess || hipDeviceGetAttribute(&cus, hipDeviceAttributeMultiprocessorCount, dev) != hipSuccess) { grid = -1; return; }
        if (hipFuncSetAttribute((const void*)fwd_kernel, hipFuncAttributeMaxDynamicSharedMemorySize, LDS_BYTES) != hipSuccess) { fprintf(stderr, "kernel_launch: hipFuncSetAttribute failed\n"); grid = -1; return; }
        int per_cu = 0;
        if (hipOccupancyMaxActiveBlocksPerMultiprocessor(&per_cu, (const void*)fwd_kernel, 512, LDS_BYTES) != hipSuccess || per_cu < 1) { fprintf(stderr, "kernel_launch: occupancy query says %d\n", per_cu); }
        (void)hipGetLastError();
        grid = cus;
    }
    if (grid < 0) return;
    (void)hipMemsetAsync((char*)d_ws + WS_CTL, 0, 32768, stream);
    Params p{};
    const float** pp = (const float**)&p;
    for (int i = 0; i < 34; ++i) pp[i] = (const float*)d_in[i];
    p.out = (float*)d_out; p.ws = (unsigned char*)d_ws;
#if MK_PER_PHASE
    for (int k = 0; k < NPHASE; ++k) { p.ph_lo = k; p.ph_hi = k + 1; hipLaunchKernelGGL(fwd_kernel, dim3(grid), dim3(512), LDS_BYTES, stream, p); }
#else
    p.ph_lo = 0; p.ph_hi = NPHASE; hipLaunchKernelGGL(fwd_kernel, dim3(grid), dim3(512), LDS_BYTES, stream, p);
#endif
}
```

```cpp
#include <hip/hip_runtime.h>
#include <cstdio>
#include <cstdint>

#ifndef DUP_SUB
#define DUP_SUB 0u
#endif
#define REPS(b) for (int reps_ = 0; reps_ < ((((DUP_SUB) >> (b)) & 1u) ? 2 : 1); ++reps_)
#define GAS __attribute__((address_space(1)))
#define LAS __attribute__((address_space(3)))
#define DI __device__ __forceinline__
typedef unsigned short bf16;
typedef float f32x4 __attribute__((ext_vector_type(4)));
typedef float f32x2 __attribute__((ext_vector_type(2)));
typedef unsigned u32x4 __attribute__((ext_vector_type(4)));
typedef unsigned u32x2 __attribute__((ext_vector_type(2)));
typedef short bf16x8 __attribute__((ext_vector_type(8)));

constexpr int D = 2048, NB = 2, T = 4096, TC = 256, NL = 4;
constexpr int LAT = NB * T;
constexpr int MROWS = LAT + NB * TC;
constexpr int MIXW = 512, DFF = 5632;
constexpr int NIN = 15328, NZ = 15360;
constexpr int ZA = 0, ZAG = 512, MLQ = 1024, MLK = 1536, MLV = 2048, MLO = 2560, GDQ = 3072, GDK = 3584, GDV = 4096, GDZ = 4608;
constexpr int RWR = 5120, RWK = 5632, RWV = 6144, RWXW = 6656, RWXA = 6752, RWXG = 6848, ZSM = 7104, ZG = 7168;
constexpr int RWMIX = 1984;

namespace pg8 {
typedef unsigned short bf16_t;
constexpr int BM = 256, BK = 64, HALF = 128, HTB = HALF * BK * 2, STAGE_BYTES = 8 * HTB, NXCD = 8, WGM = 8;
__host__ __device__ __forceinline__ int lds_byte(int r, int c) { const int st = (r >> 4) * 2 + (c >> 5), rr = r & 15, cc = c & 31, ob = rr * 64 + cc * 2; return st * 1024 + (ob ^ (((ob >> 9) & 1) << 5)); }
__host__ __device__ __forceinline__ void stage_rc(int b, int& R, int& C) { const int st = b / 1024, sb = b % 1024, swz = sb ^ (((sb >> 9) & 1) << 5); R = (st >> 1) * 16 + swz / 64; C = (st & 1) * 32 + (swz % 64) / 2; }
__host__ __device__ __forceinline__ int perm32(int rho) { const int n = rho >> 4, i = rho & 15; return 8 * (i >> 2) + 4 * n + (i & 3); }

struct Unit { int pm, pn, sub; };
struct Gemm { const bf16_t* A; const bf16_t* Bt; int lda, ldb, K; };

struct StdOrder {
    int nM, nN, nwg, G, c;
    DI void init(int nM_, int nN_, int G_, int c_) { nM = nM_; nN = nN_; nwg = nM * nN; G = G_; c = c_; }
    DI bool map(int i, Unit& u) const {
        const long L = (long)i * G + c; if (L >= nwg) return false;
        int wgid = (int)L; { const int q = nwg / NXCD, r = nwg % NXCD, xcd = wgid % NXCD, off = wgid / NXCD; wgid = (xcd < r ? xcd * (q + 1) : r * (q + 1) + (xcd - r) * q) + off; }
        const int nig = WGM * nN, gid = wgid / nig, fm = gid * WGM, gsz = (nM - fm) < WGM ? (nM - fm) : WGM;
        u.pm = fm + ((wgid % nig) % gsz); u.pn = (wgid % nig) / gsz; return true;
    }
    DI bool next(int i, Unit& u) const { u.sub = 0; return map(i, u); }
    DI const char* a_ptr(const Gemm& g, const Unit& u) const { return (const char*)g.A + (size_t)u.pm * BM * g.lda * 2; }
    DI const char* b_ptr(const Gemm& g, const Unit& u) const { return (const char*)g.Bt + (size_t)u.pn * BM * g.ldb * 2; }
    DI int ntiles(const Gemm& g, const Unit&) const { return g.K / BK; }
};
struct MergeOrder : StdOrder {
    int nctx;
    DI void init2(int G_, int c_, bool with_ctx) { init(32, 8, G_, c_); nctx = with_ctx ? 64 : 0; }
    DI bool next(int i4, Unit& u) const {
        if (i4 < 4) { u.sub = i4; return map(0, u); }
        const int j = c + (i4 - 4) * G; if (j >= nctx) return false;
        const int cu = j >> 2; u.sub = 4 + (j & 3); u.pm = 32 + (cu >> 3); u.pn = cu & 7; return true; }
    DI const char* a_ptr(const Gemm& g, const Unit& u) const { return (const char*)g.A + (size_t)u.pm * BM * g.lda * 2 + (size_t)(u.sub & 3) * 512 * 2; }
    DI const char* b_ptr(const Gemm& g, const Unit& u) const { return (const char*)g.Bt + ((size_t)(u.sub & 3) * 2048 + (size_t)u.pn * BM) * g.ldb * 2; }
    DI int ntiles(const Gemm& g, const Unit&) const { return g.K / BK; }
};
struct SplitOrder : StdOrder {
    int SK, KS; const bf16_t* Actx; int kwrap;
    DI void init2(int nN_, int G_, int c_, int SK_, int KS_, const bf16_t* Actx_ = nullptr, int kwrap_ = 0) { init(32, nN_, G_, c_); SK = SK_; KS = KS_; Actx = Actx_; kwrap = kwrap_; }
    DI bool next(int i, Unit& u) const {
        if (i == 0) { u.sub = 0; if (map(0, u)) return true; }
        const int j = c + (i - 1) * G; if (i < 1 || j >= 2 * nN * SK) return false;
        const int cu = j / SK; u.sub = 1 + j % SK; u.pm = 32 + cu / nN; u.pn = cu % nN; return true; }
    DI const char* a_ptr(const Gemm& g, const Unit& u) const {
        if (u.sub && Actx) { const int kk = (u.sub - 1) * KS; return (const char*)Actx + ((size_t)(kk / kwrap) * 512 + (size_t)(u.pm - 32) * BM) * g.lda * 2 + (size_t)(kk % kwrap) * 2; }
        return (const char*)g.A + (size_t)u.pm * BM * g.lda * 2 + (u.sub ? (size_t)(u.sub - 1) * KS * 2 : 0); }
    DI const char* b_ptr(const Gemm& g, const Unit& u) const { const int kk = u.sub ? (u.sub - 1) * KS : 0; return (const char*)g.Bt + (size_t)u.pn * BM * g.ldb * 2 + (size_t)(kwrap ? kk % kwrap : kk) * 2; }
    DI int ntiles(const Gemm& g, const Unit& u) const { return u.sub ? KS / BK : g.K / BK; }
};
DI int lane_id_hw() { int l; asm volatile("v_mbcnt_lo_u32_b32 %0, -1, 0\n\tv_mbcnt_hi_u32_b32 %0, -1, %0" : "=v"(l)); return l; }
DI unsigned cvt_pk_bf16(float lo, float hi) { unsigned r; asm volatile("v_cvt_pk_bf16_f32 %0, %1, %2" : "=v"(r) : "v"(lo), "v"(hi)); return r; }

struct EpiF32 {
    static constexpr bool PERM = false; DI bool keep(const Unit&) const { return false; }
    float* C; int ldc;
    DI void operator()(const f32x4 (&acc)[2][2][4][2], const Unit& u, int wr, int wc, int fr, int fq) const {
        const int row0 = u.pm * BM + wr * 64 + fr, col0 = u.pn * BM + wc * 32 + 4 * fq;
#pragma unroll
        for (int ai = 0; ai < 2; ++ai)
#pragma unroll
            for (int m = 0; m < 4; ++m) { float* rowp = C + (size_t)(row0 + ai * HALF + m * 16) * ldc + col0;
#pragma unroll
                for (int bj = 0; bj < 2; ++bj)
#pragma unroll
                    for (int n = 0; n < 2; ++n) *(f32x4*)(rowp + bj * HALF + n * 16) = acc[ai][bj][m][n]; }
    }
};
struct EpiF32Split {
    static constexpr bool PERM = false; DI bool keep(const Unit&) const { return false; }
    float* C; float* PART; int ldc;
    DI void operator()(const f32x4 (&acc)[2][2][4][2], const Unit& u, int wr, int wc, int fr, int fq) const {
        float* base = u.sub ? PART + ((long)(u.sub - 1) * 512 - 8192) * (long)ldc : C;
        const int row0 = u.pm * BM + wr * 64 + fr, col0 = u.pn * BM + wc * 32 + 4 * fq;
#pragma unroll
        for (int ai = 0; ai < 2; ++ai)
#pragma unroll
            for (int m = 0; m < 4; ++m) { float* rowp = base + (size_t)(row0 + ai * HALF + m * 16) * ldc + col0;
#pragma unroll
                for (int bj = 0; bj < 2; ++bj)
#pragma unroll
                    for (int n = 0; n < 2; ++n) *(f32x4*)(rowp + bj * HALF + n * 16) = acc[ai][bj][m][n]; }
    }
};
struct EpiMixSplit {
    static constexpr bool PERM = true; DI bool keep(const Unit&) const { return false; }
    bf16_t* Fh; float* PART; int ldc;
    DI void operator()(const f32x4 (&acc)[2][2][4][2], const Unit& u, int wr, int wc, int fr, int fq) const {
        const int row0 = u.pm * BM + wr * 64 + fr, col0 = u.pn * BM + wc * 32 + 8 * fq;
        float* pb = PART + ((long)(u.sub - 1) * 512 - 8192) * (long)ldc;
#pragma unroll
        for (int ai = 0; ai < 2; ++ai)
#pragma unroll
            for (int m = 0; m < 4; ++m) { const size_t ro = (size_t)(row0 + ai * HALF + m * 16) * ldc + col0;
#pragma unroll
                for (int bj = 0; bj < 2; ++bj) { const f32x4 v0 = acc[ai][bj][m][0], v1 = acc[ai][bj][m][1];
                    if (u.sub) { *(f32x4*)(pb + ro + bj * HALF) = v0; *(f32x4*)(pb + ro + bj * HALF + 4) = v1; }
                    else { u32x4 w; w.x = cvt_pk_bf16(v0[0], v0[1]); w.y = cvt_pk_bf16(v0[2], v0[3]); w.z = cvt_pk_bf16(v1[0], v1[1]); w.w = cvt_pk_bf16(v1[2], v1[3]); *(u32x4*)(Fh + ro + bj * HALF) = w; } } }
    }
};
struct EpiBf16 {
    static constexpr bool PERM = true; DI bool keep(const Unit&) const { return false; }
    bf16_t* O; int ldc; float* G32; int gtile; bf16_t* GT; int gt0;
    DI void operator()(const f32x4 (&acc)[2][2][4][2], const Unit& u, int wr, int wc, int fr, int fq) const {
        const int row0 = u.pm * BM + wr * 64 + fr; const int col0 = u.pn * BM + wc * 32 + 8 * fq;
#pragma unroll
        for (int ai = 0; ai < 2; ++ai)
#pragma unroll
            for (int m = 0; m < 4; ++m) { const int row = row0 + ai * HALF + m * 16; bf16_t* rowp = O + (size_t)row * ldc + col0;
#pragma unroll
                for (int bj = 0; bj < 2; ++bj) { f32x4 v0 = acc[ai][bj][m][0], v1 = acc[ai][bj][m][1];
                    if (GT != nullptr && u.pn >= gt0) {
#pragma unroll
                        for (int j = 0; j < 4; ++j) { v0[j] = fmaxf(__builtin_amdgcn_rcpf(1.f + __expf(-v0[j])), 1e-13f); v1[j] = fmaxf(__builtin_amdgcn_rcpf(1.f + __expf(-v1[j])), 1e-13f); }
                        u32x4 w; w.x = cvt_pk_bf16(v0[0], v0[1]); w.y = cvt_pk_bf16(v0[2], v0[3]); w.z = cvt_pk_bf16(v1[0], v1[1]); w.w = cvt_pk_bf16(v1[2], v1[3]);
                        *(u32x4*)(GT + ((size_t)(u.pm * 32 + (u.pn - gt0)) << 16) + (wr * 64 + fr + ai * HALF + m * 16) * 256 + wc * 32 + 8 * fq + bj * HALF) = w; continue; }
                    u32x4 w; w.x = cvt_pk_bf16(v0[0], v0[1]); w.y = cvt_pk_bf16(v0[2], v0[3]); w.z = cvt_pk_bf16(v1[0], v1[1]); w.w = cvt_pk_bf16(v1[2], v1[3]);
                    *(u32x4*)(rowp + bj * HALF) = w;
                    if (bj == 1 && G32 != nullptr && u.pn == gtile && wc == 2) { float* gp = G32 + (size_t)row * 32 + 8 * fq; *(f32x4*)gp = v0; *(f32x4*)(gp + 4) = v1; } } }
    }
};
struct EpiMerge {
    static constexpr bool PERM = true;
    const bf16_t* GT; bf16_t* Mb; int ldc; bf16_t* Mbc;
    DI bool keep(const Unit& u) const { return u.sub < 3; }
    DI void operator()(f32x4 (&acc)[2][2][4][2], const Unit& u, int wr, int wc, int fr, int fq) const {
        const int nb = u.sub & 3; const bool lastb = u.sub >= 3; bf16_t* dst = u.sub >= 4 ? Mbc + ((long)nb * 512 - 8192) * (long)ldc : Mb;
        const int row0 = u.pm * BM + wr * 64 + fr; const int col0 = u.pn * BM + wc * 32 + 8 * fq;
#pragma unroll
        for (int a2 = 0; a2 < 4; ++a2) { const int ai = a2 >> 1, mb = (a2 & 1) * 2;
            u32x4 ga[4][2], gb[4][2];
#pragma unroll
            for (int m = mb; m < mb + 2; ++m)
#pragma unroll
                for (int bj = 0; bj < 2; ++bj) { const bf16_t* gp = GT + ((size_t)(u.pm * 32 + nb * 8 + u.pn) << 16) + (wr * 64 + fr + ai * HALF + m * 16) * 256 + wc * 32 + 8 * fq + bj * HALF;
                    ga[m][bj] = *(const u32x4*)gp; gb[m][bj] = lastb ? ga[m][bj] : *(const u32x4*)(gp + ((size_t)8 << 16)); }
#pragma unroll
            for (int m = mb; m < mb + 2; ++m) { const int row = row0 + ai * HALF + m * 16;
#pragma unroll
                for (int bj = 0; bj < 2; ++bj) { const int col = col0 + bj * HALF;
                    float sc[8];
#pragma unroll
                    for (int j = 0; j < 4; ++j) { const float a0 = __uint_as_float(ga[m][bj][j] << 16), a1 = __uint_as_float(ga[m][bj][j] & 0xffff0000u);
                        sc[2 * j] = lastb ? a0 : a0 * __builtin_amdgcn_rcpf(__uint_as_float(gb[m][bj][j] << 16)); sc[2 * j + 1] = lastb ? a1 : a1 * __builtin_amdgcn_rcpf(__uint_as_float(gb[m][bj][j] & 0xffff0000u)); }
                    f32x4& v0 = acc[ai][bj][m][0]; f32x4& v1 = acc[ai][bj][m][1];
#pragma unroll
                    for (int j = 0; j < 4; ++j) { v0[j] *= sc[j]; v1[j] *= sc[4 + j]; }
                    if (lastb) { u32x4 w; w.x = cvt_pk_bf16(v0[0], v0[1]); w.y = cvt_pk_bf16(v0[2], v0[3]); w.z = cvt_pk_bf16(v1[0], v1[1]); w.w = cvt_pk_bf16(v1[2], v1[3]);
                        *(u32x4*)(dst + (size_t)row * ldc + col) = w; } } } }
    }
};

template <class Epi, class Sched>
DI void gemm_phase(LAS unsigned char* lds, const Gemm g, const Sched& S, const Epi& E, int wave_id) {
    int tid_ = wave_id * 64 + lane_id_hw(); asm volatile("" : "+v"(tid_));
    const int tid = tid_, wid = wave_id, lane = tid & 63, wr = wid >> 2, wc = wid & 3, fr = lane & 15, fq = lane >> 4;
    unsigned voffA[2], voffB[2];
#pragma unroll
    for (int i = 0; i < 2; ++i) { int R, C; stage_rc(tid * 16 + i * 8192, R, C); const int Rb = Epi::PERM ? ((R & ~31) + perm32(R & 31)) : R;
        voffA[i] = (unsigned)(R * g.lda + C) * 2u; voffB[i] = (unsigned)(Rb * g.ldb + C) * 2u; }
    const size_t kstep = (size_t)(BK * 2);
    const size_t hstepA = (size_t)HALF * g.lda * 2, hstepB = (size_t)HALF * g.ldb * 2;
    const unsigned ldsw = (unsigned)wid * 1024u;
    const int aoff = lds_byte(wr * 64 + fr, fq * 8), boff = lds_byte(wc * 32 + fr, fq * 8);
#define PG8_SA(b, h) (((b) * 2 + (h)) * HTB)
#define PG8_SB(b, h) ((4 + (b) * 2 + (h)) * HTB)
#define PG8_STAGE(bufoff, gbase, voff) do { _Pragma("unroll") for (int _i = 0; _i < 2; ++_i) \
        __builtin_amdgcn_global_load_lds((const unsigned*)((const char*)(gbase) + (voff)[_i]), (LAS unsigned*)(lds + (bufoff) + ldsw + _i * 8192), 16, 0, 0); } while (0)
#define PG8_LDA(dst, b, h) do { _Pragma("unroll") for (int m = 0; m < 4; ++m) _Pragma("unroll") for (int k = 0; k < 2; ++k) dst[m][k] = *(const LAS bf16x8*)(lds + PG8_SA(b, h) + aoff + m * 2048 + k * 1024); } while (0)
#define PG8_LDB(dst, b, h) do { _Pragma("unroll") for (int n = 0; n < 2; ++n) _Pragma("unroll") for (int k = 0; k < 2; ++k) dst[n][k] = *(const LAS bf16x8*)(lds + PG8_SB(b, h) + boff + n * 2048 + k * 1024); } while (0)
#define PG8_MMA(ai, bj, At, Bt) do { __builtin_amdgcn_s_setprio(1); _Pragma("unroll") for (int m = 0; m < 4; ++m) _Pragma("unroll") for (int n = 0; n < 2; ++n) _Pragma("unroll") for (int k = 0; k < 2; ++k) \
        acc[ai][bj][m][n] = __builtin_amdgcn_mfma_f32_16x16x32_bf16(Bt[n][k], At[m][k], acc[ai][bj][m][n], 0, 0, 0); __builtin_amdgcn_s_setprio(0); } while (0)
#define PG8_WAIT_V(n) asm volatile("s_waitcnt vmcnt(" #n ")" ::: "memory")
#define PG8_WAIT_L(n) asm volatile("s_waitcnt lgkmcnt(" #n ")" ::: "memory")
#define PG8_BAR __builtin_amdgcn_s_barrier()
#define PG8_SCHED __builtin_amdgcn_sched_barrier(0)
    Unit cur, nxt; int ui = 0;
    if (!S.next(0, cur)) return;
    f32x4 acc[2][2][4][2];
#pragma unroll
    for (int a = 0; a < 2; ++a)
#pragma unroll
        for (int b = 0; b < 2; ++b)
#pragma unroll
            for (int m = 0; m < 4; ++m)
#pragma unroll
                for (int n = 0; n < 2; ++n) acc[a][b][m][n] = (f32x4){0.f, 0.f, 0.f, 0.f};
    bf16x8 At[4][2], B0[2][2], B1[2][2];
    const char* cA = S.a_ptr(g, cur); const char* cB = S.b_ptr(g, cur);
    PG8_STAGE(PG8_SB(0, 0), cB, voffB); PG8_STAGE(PG8_SB(0, 1), cB + hstepB, voffB); PG8_STAGE(PG8_SA(0, 0), cA, voffA); PG8_STAGE(PG8_SA(0, 1), cA + hstepA, voffA);
    if (wr == 1) PG8_BAR;
    PG8_WAIT_V(2); PG8_BAR;
    PG8_STAGE(PG8_SB(1, 0), cB + kstep, voffB); PG8_STAGE(PG8_SA(1, 0), cA + kstep, voffA); PG8_STAGE(PG8_SB(1, 1), cB + hstepB + kstep, voffB);
    PG8_WAIT_V(6); PG8_BAR;
    for (;;) {
        const bool has_next = S.next(ui + 1, nxt);
        const char* nA = has_next ? S.a_ptr(g, nxt) : cA; const char* nB = has_next ? S.b_ptr(g, nxt) : cB;
        const int nt = S.ntiles(g, cur);
        for (int t = 0; t < nt; t += 2) {
            const bool last = (t == nt - 2);
            const char* a1 = cA + (size_t)(t + 1) * kstep;
            const char* a2 = last ? nA : cA + (size_t)(t + 2) * kstep; const char* b2 = last ? nB : cB + (size_t)(t + 2) * kstep;
            const char* a3 = a2 + kstep; const char* b3 = b2 + kstep;
            PG8_LDB(B0, 0, 0); PG8_LDB(B1, 0, 1); PG8_SCHED; PG8_LDA(At, 0, 0); PG8_STAGE(PG8_SA(1, 1), a1 + hstepA, voffA);
            PG8_WAIT_V(8); PG8_WAIT_L(0); PG8_BAR; PG8_MMA(0, 0, At, B0); PG8_MMA(0, 1, At, B1); PG8_BAR; PG8_SCHED;
            PG8_LDA(At, 0, 1); PG8_STAGE(PG8_SB(0, 0), b2, voffB); PG8_STAGE(PG8_SB(0, 1), b2 + hstepB, voffB); PG8_STAGE(PG8_SA(0, 0), a2, voffA);
            PG8_WAIT_V(8); PG8_WAIT_L(0); PG8_BAR; PG8_MMA(1, 0, At, B0); PG8_MMA(1, 1, At, B1); PG8_BAR; PG8_SCHED;
            PG8_LDB(B0, 1, 0); PG8_LDB(B1, 1, 1); PG8_SCHED; PG8_LDA(At, 1, 0); PG8_STAGE(PG8_SA(0, 1), a2 + hstepA, voffA);
            PG8_WAIT_V(8); PG8_WAIT_L(0); PG8_BAR; PG8_MMA(0, 0, At, B0); PG8_MMA(0, 1, At, B1); PG8_BAR; PG8_SCHED;
            PG8_LDA(At, 1, 1); PG8_STAGE(PG8_SB(1, 0), b3, voffB); PG8_STAGE(PG8_SB(1, 1), b3 + hstepB, voffB); PG8_STAGE(PG8_SA(1, 0), a3, voffA);
            PG8_WAIT_V(8); PG8_WAIT_L(0); PG8_BAR; PG8_MMA(1, 0, At, B0); PG8_MMA(1, 1, At, B1); PG8_BAR; PG8_SCHED;
        }
        if (wr == 0) PG8_BAR;
        { const int le = lane_id_hw(); E(acc, cur, wr, wc, le & 15, le >> 4); }
        if (!has_next) break;
        if (!E.keep(cur)) {
#pragma unroll
        for (int a = 0; a < 2; ++a)
#pragma unroll
            for (int b = 0; b < 2; ++b)
#pragma unroll
                for (int m = 0; m < 4; ++m)
#pragma unroll
                    for (int n = 0; n < 2; ++n) acc[a][b][m][n] = (f32x4){0.f, 0.f, 0.f, 0.f}; }
        cur = nxt; cA = nA; cB = nB; ++ui;
        if (wr == 1) PG8_BAR;
    }
    PG8_WAIT_V(0);
    PG8_BAR;
#undef PG8_SA
#undef PG8_SB
#undef PG8_STAGE
#undef PG8_LDA
#undef PG8_LDB
#undef PG8_MMA
#undef PG8_WAIT_V
#undef PG8_WAIT_L
#undef PG8_BAR
#undef PG8_SCHED
}
}

constexpr size_t al256(size_t x) { return (x + 255) & ~(size_t)255; }
constexpr size_t WS_CTL = 0, CTL_BYTES = 1u << 20;
constexpr size_t WS_MODP = WS_CTL + CTL_BYTES;
constexpr size_t WS_MOD = WS_MODP + al256((size_t)NL * 8 * 3 * 12288 * 4);
constexpr size_t WS_W = WS_MOD + al256((size_t)NL * 3 * 12288 * 4);
constexpr size_t WL_IN = 0, WL_BR = WL_IN + (size_t)NZ * D * 2, WL_OUT = WL_BR + (size_t)4 * D * MIXW * 2, WL_UP = WL_OUT + (size_t)D * D * 2,
                 WL_DN = WL_UP + (size_t)2 * DFF * D * 2, WL_LORA = WL_DN + (size_t)D * DFF * 2, WL_SIZE = WL_LORA + (size_t)(4 * 512 * 96 + 512 * 256) * 2;
constexpr size_t WS_U = WS_W + WL_SIZE;
constexpr size_t WS_Y = WS_U + (size_t)MROWS * D * 2;
constexpr size_t WS_MB = WS_Y + (size_t)MROWS * D * 2;
constexpr size_t WS_G32 = WS_MB + (size_t)MROWS * D * 2;
constexpr size_t WS_X = WS_G32 + (size_t)MROWS * 32 * 4;
constexpr size_t WS_F = WS_X + (size_t)MROWS * D * 4;
constexpr size_t WS_Z = WS_F + (size_t)MROWS * D * 4;
constexpr size_t WS_S = WS_Z + (size_t)MROWS * NZ * 2;
constexpr size_t SARR = (size_t)MROWS * MIXW * 4;
constexpr int N_SARR = 6;
constexpr size_t WS_SG = WS_S + N_SARR * SARR;
constexpr size_t WS_ML = WS_SG + (size_t)MROWS * 16 * 4;
constexpr int ML_US = 16640, ML_NL = 16384, ML_HDR = 16512, ML_NU = 16 * 68;
constexpr size_t WS_MLC = WS_ML + (size_t)ML_NU * ML_US * 4;
constexpr int MLC_US = 144 * 128;
constexpr size_t WS_MLM = WS_MLC + (size_t)ML_NU * MLC_US * 2;
constexpr size_t WS_GDA = WS_MLM + al256((size_t)ML_NU * 4);
constexpr int GD_NU = 16 * 68;
constexpr size_t WS_GDB = WS_GDA + (size_t)GD_NU * 16384 * 2;
constexpr size_t WS_GDU = WS_GDB + (size_t)GD_NU * 16384 * 4;
constexpr size_t WS_GDW = WS_GDU + (size_t)GD_NU * 8192 * 4;
constexpr size_t WS_GDAT = WS_GDW + (size_t)GD_NU * 8192 * 2;
constexpr size_t WS_GDQ = WS_GDAT + (size_t)GD_NU * 4096 * 2;
constexpr size_t WS_GDS = WS_GDQ + (size_t)GD_NU * 8192 * 2;
constexpr int RW_NU = 32 * 68;
constexpr size_t WS_RQE = WS_GDS + (size_t)GD_NU * 16384 * 2;
constexpr size_t WS_RYL = WS_RQE + (size_t)RW_NU * 4096 * 2;
constexpr size_t WS_RAC = WS_RYL + (size_t)RW_NU * 4096 * 4;
constexpr size_t WS_RBC = WS_RAC + (size_t)RW_NU * 4096 * 2;
constexpr size_t WS_RPT = WS_RBC + (size_t)RW_NU * 4096 * 4;
constexpr size_t WS_PART = WS_RPT + (size_t)RW_NU * 4096 * 2;
constexpr size_t WS_MBC = WS_PART + (size_t)16 * 512 * D * 4;
constexpr size_t WS_BON = WS_MBC + (size_t)4 * 512 * D * 2;
constexpr size_t WS_XG = WS_BON + (size_t)2 * MROWS * 8 * 4;
constexpr size_t WS_GT = WS_XG + (size_t)MROWS * 256 * 2;
constexpr size_t WS_END = WS_GT + (size_t)34 * 32 * 65536 * 2;
static_assert((size_t)MROWS * DFF * 2 <= N_SARR * SARR && (size_t)MROWS * 2 * DFF * 2 <= (size_t)MROWS * NZ * 2, "aliases");
static_assert(WS_END < 1590000000ull, "workspace budget");
enum { SA_RG = 0 };

constexpr int LDS_RING = 131072, LDS_BYTES = 147456, LDS_MISC = LDS_BYTES - 128;

#define XB_TMO      128
#define XB_XCNT(j)  (256  + 64 * (j))
#define XB_XSUB(j)  (1280 + 64 * (j))
#define XB_XGEN(j)  (2304 + 64 * (j))
#define XB_TOP      3328
#define XB_TOPGEN   3392
#define XCD_BAR_WORDS 3456
#define XB_SPIN_CAP (1u << 18)
__device__ __forceinline__ unsigned xb_ld(unsigned* p)              { return __hip_atomic_load(p, __ATOMIC_RELAXED, __HIP_MEMORY_SCOPE_AGENT); }
__device__ __forceinline__ unsigned xb_add(unsigned* p, unsigned v) { return __hip_atomic_fetch_add(p, v, __ATOMIC_RELAXED, __HIP_MEMORY_SCOPE_AGENT); }
__device__ __forceinline__ unsigned xb_xcc_id() { return (unsigned)__builtin_amdgcn_s_getreg((3 << 11) | 20) & 0xFu; }
#define XB_SPIN(cond, bar) do { unsigned _sp = 0; while (cond) { __builtin_amdgcn_s_sleep(1); \
    if ((++_sp & 255u) == 0u) { if (xb_ld(&(bar)[XB_TMO])) break; if (_sp > XB_SPIN_CAP) { atomicAdd(&(bar)[XB_TMO], 1u); break; } } } } while (0)
struct XcdBarrier { unsigned* bar; unsigned x; volatile LAS unsigned* st; };
__device__ __forceinline__ XcdBarrier xcd_barrier_post(unsigned* bar, volatile LAS unsigned* st) {
    XcdBarrier b; b.bar = bar; b.x = xb_xcc_id(); b.st = st;
    if (threadIdx.x == 0) (void)xb_add(&bar[XB_XCNT(b.x)], 1u);
    return b;
}
__device__ __forceinline__ void xcd_barrier_complete(unsigned* bar, unsigned x, unsigned& nloc, unsigned& nx) {
    const unsigned G = gridDim.x * gridDim.y * gridDim.z;
    unsigned sum, cnt, mine, sp = 0u;
    for (;;) {
        sum = 0u; cnt = 0u; mine = 0u;
#pragma unroll
        for (unsigned j = 0; j < 16; ++j) { const unsigned c = xb_ld(&bar[XB_XCNT(j)]); sum += c; cnt += (c > 0u) ? 1u : 0u; mine = (j == x) ? c : mine; }
        if (sum == G) break;
        __builtin_amdgcn_s_sleep(1);
        if ((++sp & 255u) == 0u) { if (xb_ld(&bar[XB_TMO])) break; if (sp > XB_SPIN_CAP) { atomicAdd(&bar[XB_TMO], 1u); break; } }
    }
    nloc = mine > 0u ? mine : 1u; nx = cnt > 0u ? cnt : 1u;
}
__device__ __forceinline__ void xcd_barrier(const XcdBarrier& b, int wave_id) {
    asm volatile("s_waitcnt vmcnt(0)" ::: "memory");
    __syncthreads();
    if (wave_id == 0 && pg8::lane_id_hw() == 0) {
        unsigned* bar = b.bar; const unsigned bx = xb_xcc_id();
        __builtin_amdgcn_s_waitcnt(0);
        unsigned nloc = b.st[0], nx = b.st[1];
        if (nloc == 0u) { xcd_barrier_complete(bar, bx, nloc, nx); b.st[0] = nloc; b.st[1] = nx; }
        const unsigned old = xb_add(&bar[XB_XSUB(bx)], 1u);
        const unsigned gen = old / nloc;
        if (old + 1u == (gen + 1u) * nloc) {
            __builtin_amdgcn_fence(__ATOMIC_RELEASE, "agent");
            asm volatile("s_waitcnt vmcnt(0)" ::: "memory");
            const unsigned og = xb_add(&bar[XB_TOP], 1u);
            const unsigned tg = og / nx;
            if (og + 1u == (tg + 1u) * nx) xb_add(&bar[XB_TOPGEN], 1u);
            else XB_SPIN(xb_ld(&bar[XB_TOPGEN]) == tg, bar);
            __builtin_amdgcn_fence(__ATOMIC_ACQUIRE, "agent");
            xb_add(&bar[XB_XGEN(bx)], 1u);
            asm volatile("s_waitcnt vmcnt(0)" ::: "memory");
        } else {
            XB_SPIN(xb_ld(&bar[XB_XGEN(bx)]) == gen, bar);
            __builtin_amdgcn_fence(__ATOMIC_ACQUIRE, "agent");
            asm volatile("s_waitcnt vmcnt(0)" ::: "memory");
        }
    }
    __syncthreads();
}

struct Params {
    const float *x, *c, *ctx, *c_ctx, *w_mod, *b_mod, *norm_g, *w_in, *conv_dw, *conv_b, *conv_ln_g, *conv_ln_b, *ml_gate_b, *ml_norm_g,
        *gd_conv, *gd_a_log, *gd_dt_bias, *gd_norm_g, *rw_mu, *rw_w0, *rw_w2, *rw_a0, *rw_a2, *rw_g2, *rw_kk, *rw_ka, *rw_rk, *rw_ln_g, *rw_ln_b,
        *w_br, *w_out, *ffn_up, *ffn_dw, *ffn_down;
    float* out; unsigned char* ws; int ph_lo, ph_hi;
};

DI float bf2f(unsigned short u) { return __uint_as_float(((unsigned)u) << 16); }
typedef __bf16 bf16v2_t __attribute__((ext_vector_type(2)));
DI unsigned pk2(float lo, float hi) { bf16v2_t v = {(__bf16)lo, (__bf16)hi}; return __builtin_bit_cast(unsigned, v); }
DI unsigned f2bf(float f) { return pk2(f, 0.f) & 0xffffu; }
DI void ld8(const bf16* p, float (&o)[8]) { const u32x4 w = *(const u32x4*)p;
#pragma unroll
    for (int j = 0; j < 4; ++j) { o[2 * j] = __uint_as_float(w[j] << 16); o[2 * j + 1] = __uint_as_float(w[j] & 0xffff0000u); } }
DI u32x4 pack8(const float (&v)[8]) { u32x4 w; w.x = pk2(v[0], v[1]); w.y = pk2(v[2], v[3]); w.z = pk2(v[4], v[5]); w.w = pk2(v[6], v[7]); return w; }
DI void st8(bf16* p, const float (&v)[8]) { u32x4 w; w.x = pk2(v[0], v[1]); w.y = pk2(v[2], v[3]); w.z = pk2(v[4], v[5]); w.w = pk2(v[6], v[7]); *(u32x4*)p = w; }
DI void ldf8(const float* p, float (&o)[8]) { const f32x4 a = *(const f32x4*)p, b = *(const f32x4*)(p + 4);
    o[0] = a[0]; o[1] = a[1]; o[2] = a[2]; o[3] = a[3]; o[4] = b[0]; o[5] = b[1]; o[6] = b[2]; o[7] = b[3]; }
DI void stf8(float* p, const float (&v)[8]) { *(f32x4*)p = (f32x4){v[0], v[1], v[2], v[3]}; *(f32x4*)(p + 4) = (f32x4){v[4], v[5], v[6], v[7]}; }
template <int X> DI float shx(float v) {
    if constexpr (X < 32) return __builtin_bit_cast(float, __builtin_amdgcn_ds_swizzle(__builtin_bit_cast(int, v), (X << 10) | 0x1f));
    else { int l = pg8::lane_id_hw(); asm volatile("" : "+v"(l)); return __builtin_bit_cast(float, __builtin_amdgcn_ds_bpermute((l ^ 32) << 2, __builtin_bit_cast(int, v))); } }
DI float shup(float v, int o) { int l = pg8::lane_id_hw(); asm volatile("" : "+v"(l)); return __builtin_bit_cast(float, __builtin_amdgcn_ds_bpermute(((l - o) & 63) << 2, __builtin_bit_cast(int, v))); }
DI float rdlane63(float v) { return __builtin_bit_cast(float, __builtin_amdgcn_readlane(__builtin_bit_cast(int, v), 63)); }
template <int CTRL> DI float dppf(float v) { return __builtin_bit_cast(float, __builtin_amdgcn_update_dpp(0, __builtin_bit_cast(int, v), CTRL, 0xF, 0xF, true)); }
DI float row16_sum(float v) { v += dppf<0xB1>(v); v += dppf<0x4E>(v); v += dppf<0x141>(v); v += dppf<0x140>(v); return v; }
DI float rdl(float v, int l) { return __builtin_bit_cast(float, __builtin_amdgcn_readlane(__builtin_bit_cast(int, v), l)); }
DI float wave_sum(float v) { v = row16_sum(v); return (rdl(v, 0) + rdl(v, 16)) + (rdl(v, 32) + rdl(v, 48)); }
template <int W> DI float grp_sum(float v) {
    v += dppf<0xB1>(v); if constexpr (W > 2) v += dppf<0x4E>(v); if constexpr (W > 4) v += dppf<0x141>(v); if constexpr (W > 8) v += dppf<0x140>(v); return v; }
DI float fexp(float x) { return __builtin_amdgcn_exp2f(x * 1.4426950408889634f); }
DI float flog(float x) { return __builtin_amdgcn_logf(x) * 0.6931471805599453f; }
DI float ftanh(float x) { return 1.f - 2.f * __builtin_amdgcn_rcpf(1.f + fexp(2.f * x)); }
DI float sigmoidf_(float x) { return __builtin_amdgcn_rcpf(1.f + fexp(-x)); }
DI float siluf_(float x) { return x * __builtin_amdgcn_rcpf(1.f + fexp(-x)); }
DI float softplusf_(float x) { return fmaxf(x, 0.f) + flog(1.f + fexp(-fabsf(x))); }
DI float logsigmoidf_(float x) { return fminf(x, 0.f) - flog(1.f + fexp(-fabsf(x))); }
DI float gelu_tanh(float x) { const float u = 0.7978845608028654f * (x + 0.044715f * x * x * x); return 0.5f * x * (1.f + ftanh(u)); }

DI void seq_of(int row, int& base, int& len, int& t) { if (row < LAT) { base = row & ~(T - 1); len = T; t = row & (T - 1); } else { const int r = row - LAT; base = LAT + (r & ~(TC - 1)); len = TC; t = r & (TC - 1); } }
DI int scan_row(int dir, int b, int j) { if (j < TC) { const int tok = dir ? (TC - 1 - j) : j; return LAT + b * TC + tok; } const int jj = j - TC; const int tok = dir ? (T - 1 - jj) : jj; return b * T + tok; }

struct Ctx {
    LAS unsigned char* lds; int tid, lane, wave, G, bid;
    const Params* p; unsigned char* ws;
};

DI int zcol_src(int j) { if (j < 3072) return j; if (j < 5120) return j + 16; if (j < ZSM) return j + 32; if (j < ZSM + 16) return 3072 + (j - ZSM); if (j < ZSM + 32) return 5136 + (j - ZSM - 16); if (j < ZG) return -1; return 7136 + (j - ZG); }
template <bool ZMAP> DI void transpose_item(const float* W, int K, int N, bf16* WT, LAS float* scr, int kb, int nb, int lane) {
    const int k0 = 64 * kb, n0 = 32 * nb; const int nn = n0 + (lane & 31); const int src = ZMAP ? zcol_src(nn) : nn;
#pragma unroll 8
    for (int i = 0; i < 32; ++i) { const int kk = 2 * i + (lane >> 5); scr[kk * 33 + (lane & 31)] = (src >= 0) ? W[(size_t)(k0 + kk) * N + src] : 0.f; }
    asm volatile("s_waitcnt lgkmcnt(0)" ::: "memory");
    const int c = lane & 7;
#pragma unroll
    for (int j = 0; j < 4; ++j) { const int n = (lane >> 3) + 8 * j; const LAS float* s = scr + (8 * c) * 33 + n;
        u32x4 o; o.x = pk2(s[0 * 33], s[1 * 33]); o.y = pk2(s[2 * 33], s[3 * 33]); o.z = pk2(s[4 * 33], s[5 * 33]); o.w = pk2(s[6 * 33], s[7 * 33]);
        *(u32x4*)(WT + (size_t)(n0 + n) * K + k0 + 8 * c) = o; }
    asm volatile("s_waitcnt lgkmcnt(0)" ::: "memory");
}
DI void phase_pro0(Ctx& c) {
    const Params& p = *c.p;
    {
        LAS float* red = (LAS float*)c.lds;
        float* MODP = (float*)(c.ws + WS_MODP);
        for (int u = c.bid; u < NL * 48 * 8; u += c.G) {
            const int l = u / 384, cb = (u >> 3) % 48, ks = u & 7; const int col = cb * 256 + c.lane * 4;
            f32x4 a0 = {0.f, 0.f, 0.f, 0.f}, a1 = a0, a2 = a0;
            const float* wp = p.w_mod + ((size_t)l * D + ks * 256 + c.wave * 32) * 12288 + col;
            const int kb = ks * 256 + c.wave * 32;
#pragma unroll 8
            for (int i = 0; i < 32; ++i) { const f32x4 w = __builtin_nontemporal_load((const f32x4*)(wp + (size_t)i * 12288));
                const float s0 = siluf_(p.c[kb + i]), s1 = siluf_(p.c[D + kb + i]), s2 = siluf_(p.c_ctx[kb + i]);
                a0 += w * s0; a1 += w * s1; a2 += w * s2; }
            __syncthreads();
            *(LAS f32x4*)(red + (c.wave * 3 + 0) * 256 + c.lane * 4) = a0; *(LAS f32x4*)(red + (c.wave * 3 + 1) * 256 + c.lane * 4) = a1; *(LAS f32x4*)(red + (c.wave * 3 + 2) * 256 + c.lane * 4) = a2;
            __syncthreads();
            for (int o = c.tid; o < 768; o += 512) { float s = 0.f;
#pragma unroll
                for (int w = 0; w < 8; ++w) s += red[w * 768 + o];
                MODP[((size_t)(l * 8 + ks) * 3 + o / 256) * 12288 + cb * 256 + (o & 255)] = s; }
        }
        __syncthreads();
    }
}
struct WTile { const float* wp; size_t N; bf16* dst; bool zero; };
DI WTile wconv_tile(const Params& p, int l, unsigned char* wl, int r, int lane) {
    constexpr int I_IN = 32 * 240, I_BR = 8 * 32, I_OUT = 32 * 32, I_UP = 32 * 176;
    const float* W; bf16* WT; int K, N, kb, nb; bool zmap = false;
    if (r < I_IN) { W = p.w_in + (size_t)l * D * NIN; K = D; N = NIN; WT = (bf16*)(wl + WL_IN); kb = r / 240; nb = r % 240; zmap = true; }
    else if ((r -= I_IN) < 4 * I_BR) { const int br = r / I_BR; r %= I_BR; W = p.w_br + ((size_t)l * 4 + br) * MIXW * D; K = MIXW; N = D; WT = (bf16*)(wl + WL_BR) + (size_t)br * D * MIXW; kb = r / 32; nb = r % 32; }
    else if ((r -= 4 * I_BR) < I_OUT) { W = p.w_out + (size_t)l * D * D; K = D; N = D; WT = (bf16*)(wl + WL_OUT); kb = r / 32; nb = r % 32; }
    else if ((r -= I_OUT) < I_UP) { W = p.ffn_up + (size_t)l * D * 2 * DFF; K = D; N = 2 * DFF; WT = (bf16*)(wl + WL_UP); kb = r / 176; nb = r % 176; }
    else { r -= I_UP; W = p.ffn_down + (size_t)l * DFF * D; K = DFF; N = D; WT = (bf16*)(wl + WL_DN); kb = r / 32; nb = r % 32; }
    const int n = 64 * nb + lane; const int src = zmap ? zcol_src(n) : n;
    WTile t; t.wp = W + (size_t)(64 * kb) * N + (src >= 0 ? src : 0); t.N = (size_t)N; t.dst = WT + (size_t)n * K + 64 * kb; t.zero = src < 0; return t;
}
DI void wt_load(const WTile& t, int hf, float (&v)[32]) {
#pragma unroll
    for (int i = 0; i < 32; ++i) v[i] = __builtin_nontemporal_load(t.wp + (size_t)(hf * 32 + i) * t.N); }
DI void wt_store(const WTile& t, int hf, const float (&v)[32]) {
#pragma unroll
    for (int j = 0; j < 4; ++j) { u32x4 o; o.x = pk2(v[8 * j], v[8 * j + 1]); o.y = pk2(v[8 * j + 2], v[8 * j + 3]); o.z = pk2(v[8 * j + 4], v[8 * j + 5]); o.w = pk2(v[8 * j + 6], v[8 * j + 7]);
        if (t.zero) o = (u32x4){0u, 0u, 0u, 0u};
        *(u32x4*)(t.dst + hf * 32 + 8 * j) = o; } }
DI void phase_wconv(Ctx& c, int l) {
    const Params& p = *c.p;
    {
        const int gw = c.bid * 8 + c.wave, NGW = c.G * 8;
        constexpr int I_L = 32 * 240 + 4 * 8 * 32 + 32 * 32 + 32 * 176 + 88 * 32;
        unsigned char* wl = c.ws + WS_W;
        if (gw < I_L) { float vA[32], vB[32]; WTile cur = wconv_tile(p, l, wl, gw, c.lane); wt_load(cur, 0, vA);
            for (int it = gw; it < I_L; it += NGW) {
                wt_load(cur, 1, vB); wt_store(cur, 0, vA);
                const int nx = it + NGW; WTile nxt = cur;
                if (nx < I_L) { nxt = wconv_tile(p, l, wl, nx, c.lane); wt_load(nxt, 0, vA); }
                wt_store(cur, 1, vB); cur = nxt; } }
        bf16* lw = (bf16*)(wl + WL_LORA);
        for (int it = c.bid * 512 + c.tid; it < 4 * 6144 + 16384; it += c.G * 512) {
            const float* W; bf16* dst; int K, n, k8;
            if (it < 4 * 6144) { const int m = it / 6144, rr = it % 6144; n = rr & 511; k8 = rr >> 9; K = 96; W = (m < 2 ? p.rw_w2 : p.rw_a2) + (size_t)(l * 2 + (m & 1)) * 96 * 512; dst = lw + (size_t)m * 512 * 96; }
            else { const int rr = it - 4 * 6144; n = rr & 511; k8 = rr >> 9; K = 256; W = p.rw_g2 + (size_t)l * 256 * 512; dst = lw + (size_t)4 * 512 * 96; }
            float v[8];
#pragma unroll
            for (int i = 0; i < 8; ++i) v[i] = W[(size_t)(k8 * 8 + i) * 512 + n];
            st8(dst + (size_t)n * K + k8 * 8, v); }
    }
    __syncthreads();
}
DI void phase_pro1(Ctx& c) {
    const Params& p = *c.p; const float* MODP = (const float*)(c.ws + WS_MODP); float* MOD = (float*)(c.ws + WS_MOD);
    for (int i = c.bid * 512 + c.tid; i < NL * 3 * 12288; i += c.G * 512) { const int l = i / 36864, v = (i / 12288) % 3, n = i % 12288;
        float s = p.b_mod[l * 12288 + n];
#pragma unroll
        for (int ks = 0; ks < 8; ++ks) s += MODP[((size_t)(l * 8 + ks) * 3 + v) * 12288 + n];
        MOD[i] = s; }
}
DI void row_load(const float* r, int lane, f32x4 (&v)[8]) {
#pragma unroll
    for (int j = 0; j < 8; ++j) v[j] = *(const f32x4*)(r + 4 * lane + 256 * j); }
DI float row_rstd(const f32x4 (&v)[8]) { float s = 0.f;
#pragma unroll
    for (int j = 0; j < 8; ++j) s += (v[j][0] * v[j][0] + v[j][1] * v[j][1]) + (v[j][2] * v[j][2] + v[j][3] * v[j][3]);
    return rsqrtf(wave_sum(s) * (1.f / D) + 1e-6f); }
DI void norm_mod_store(const f32x4 (&v)[8], float rstd, const float* g, const float* sh, const float* sc, bf16* o, int lane) {
#pragma unroll
    for (int j = 0; j < 8; ++j) { const int cc = 4 * lane + 256 * j; const f32x4 g4 = *(const f32x4*)(g + cc), s4 = *(const f32x4*)(sh + cc), c4 = *(const f32x4*)(sc + cc);
        const f32x4 r = v[j] * rstd * g4 * (c4 + 1.f) + s4; u32x2 w; w.x = pk2(r[0], r[1]); w.y = pk2(r[2], r[3]); *(u32x2*)(o + cc) = w; } }
DI int mod_vec(int row) { return row < LAT ? (row >> 12) : 2; }
DI void phase_pro2(Ctx& c) {
    const Params& p = *c.p; const float* MOD = (const float*)(c.ws + WS_MOD); bf16* U = (bf16*)(c.ws + WS_U);
    const int gw = c.bid * 8 + c.wave, NGW = c.G * 8;
    for (int row = gw; row < MROWS; row += NGW) { const float* xr = row < LAT ? p.x + (size_t)row * D : p.ctx + (size_t)(row - LAT) * D;
        f32x4 v[8]; row_load(xr, c.lane, v); const float rs = row_rstd(v); const float* mv = MOD + (size_t)(0 * 3 + mod_vec(row)) * 12288;
        norm_mod_store(v, rs, p.norm_g, mv, mv + 2048, U + (size_t)row * D, c.lane); }
}
DI void norm_mod_store_l(const f32x4 (&v)[8], float rstd, const LAS float* g, const LAS float* sh, const LAS float* sc, bf16* o, int lane) {
#pragma unroll
    for (int j = 0; j < 8; ++j) { const int cc = 4 * lane + 256 * j; const f32x4 g4 = *(const LAS f32x4*)(g + cc), s4 = *(const LAS f32x4*)(sh + cc), c4 = *(const LAS f32x4*)(sc + cc);
        const f32x4 r = v[j] * rstd * g4 * (c4 + 1.f) + s4; u32x2 w; w.x = pk2(r[0], r[1]); w.y = pk2(r[2], r[3]); *(u32x2*)(o + cc) = w;
        if (j & 1) asm volatile("" ::: "memory"); } }
template <bool LP>
DI void resid_row(Ctx& c, int l, int which, int row, const f32x4 (&fv)[8], f32x4 (&xv)[8], const LAS float* pl) {
    const Params& p = *c.p; const float* MOD = (const float*)(c.ws + WS_MOD); bf16* U = (bf16*)(c.ws + WS_U); float* X = (float*)(c.ws + WS_X);
    const float rs = row_rstd(fv); const float* mv = MOD + (size_t)(l * 3 + mod_vec(row)) * 12288;
    const float* g = p.norm_g + (size_t)(l * 4 + (which ? 3 : 1)) * D; const float* gt = mv + (which ? 10240 : 4096);
#pragma unroll
    for (int j = 0; j < 8; ++j) { const int cc = 4 * c.lane + 256 * j;
        if (LP) { xv[j] += *(const LAS f32x4*)(pl + 2048 + cc) * (fv[j] * rs * *(const LAS f32x4*)(pl + cc)); if (j & 1) asm volatile("" ::: "memory"); }
        else xv[j] += *(const f32x4*)(gt + cc) * (fv[j] * rs * *(const f32x4*)(g + cc)); }
    if (which == 1 && l == NL - 1) { if (row < LAT) {
#pragma unroll
        for (int j = 0; j < 8; ++j) *(f32x4*)(p.out + (size_t)row * D + 4 * c.lane + 256 * j) = xv[j]; } return; }
#pragma unroll
    for (int j = 0; j < 8; ++j) *(f32x4*)(X + (size_t)row * D + 4 * c.lane + 256 * j) = xv[j];
    const float rs2 = row_rstd(xv);
    if (LP) { norm_mod_store_l(xv, rs2, pl + 2 * 2048, pl + 3 * 2048, pl + 4 * 2048, U + (size_t)row * D, c.lane); return; }
    if (which == 0) norm_mod_store(xv, rs2, p.norm_g + (size_t)(l * 4 + 2) * D, mv + 6144, mv + 8192, U + (size_t)row * D, c.lane);
    else { const float* mv2 = MOD + (size_t)((l + 1) * 3 + mod_vec(row)) * 12288; norm_mod_store(xv, rs2, p.norm_g + (size_t)((l + 1) * 4) * D, mv2, mv2 + 2048, U + (size_t)row * D, c.lane); }
}
DI void frow_load(const bf16* r, int lane, u32x2 (&v)[8]) {
#pragma unroll
    for (int j = 0; j < 8; ++j) v[j] = *(const u32x2*)(r + 4 * lane + 256 * j); }
DI void frow_cvt(const u32x2 (&h)[8], f32x4 (&v)[8]) {
#pragma unroll
    for (int j = 0; j < 8; ++j) v[j] = (f32x4){__uint_as_float(h[j].x << 16), __uint_as_float(h[j].x & 0xffff0000u), __uint_as_float(h[j].y << 16), __uint_as_float(h[j].y & 0xffff0000u)}; }
DI void phase_resid(Ctx& c, int l, int which) {
    const Params& p = *c.p; float* X = (float*)(c.ws + WS_X); const bf16* Fh = (const bf16*)(c.ws + WS_F);
    const int gw = c.bid * 8 + c.wave, NGW = c.G * 8; const bool first = (l == 0 && which == 0);
    if (NGW * 4 == LAT) {
        const int r0 = gw * 4; const float* xb = first ? p.x : X;
        u32x2 hA[8], hB[8], hC[8]; f32x4 xA[8], xB[8], xC[8], fv[8];
        LAS float* pl = (LAS float*)c.lds + 4096; const bool lastp = (which == 1 && l == NL - 1); f32x4 pv[5];
        { const float* MOD = (const float*)(c.ws + WS_MOD); const int bb = c.bid >> 7; const float* mv = MOD + (size_t)(l * 3 + bb) * 12288; const float* mv2 = MOD + (size_t)((l + 1) * 3 + bb) * 12288;
          pv[0] = *(const f32x4*)(p.norm_g + (size_t)(l * 4 + (which ? 3 : 1)) * D + 4 * c.tid);
          pv[1] = *(const f32x4*)(mv + (which ? 10240 : 4096) + 4 * c.tid);
          if (!lastp) { pv[2] = *(const f32x4*)(p.norm_g + (size_t)(which ? (l + 1) * 4 : l * 4 + 2) * D + 4 * c.tid);
                        pv[3] = *(const f32x4*)((which ? mv2 : mv + 6144) + 4 * c.tid);
                        pv[4] = *(const f32x4*)((which ? mv2 + 2048 : mv + 8192) + 4 * c.tid); }
          else { pv[2] = pv[0]; pv[3] = pv[0]; pv[4] = pv[0]; } }
#pragma unroll
        for (int v = 0; v < 5; ++v) *(LAS f32x4*)(pl + v * 2048 + 4 * c.tid) = pv[v];
        asm volatile("" ::: "memory");
        frow_load(Fh + (size_t)r0 * D, c.lane, hA); row_load(xb + (size_t)r0 * D, c.lane, xA);
        frow_load(Fh + (size_t)(r0 + 1) * D, c.lane, hB); row_load(xb + (size_t)(r0 + 1) * D, c.lane, xB);
        frow_load(Fh + (size_t)(r0 + 2) * D, c.lane, hC); row_load(xb + (size_t)(r0 + 2) * D, c.lane, xC);
        asm volatile("s_waitcnt lgkmcnt(0)" ::: "memory"); __builtin_amdgcn_s_barrier(); asm volatile("" ::: "memory");
        frow_cvt(hA, fv); resid_row<true>(c, l, which, r0, fv, xA, pl);
        frow_load(Fh + (size_t)(r0 + 3) * D, c.lane, hA); row_load(xb + (size_t)(r0 + 3) * D, c.lane, xA);
        frow_cvt(hB, fv); resid_row<true>(c, l, which, r0 + 1, fv, xB, pl);
        frow_cvt(hC, fv); resid_row<true>(c, l, which, r0 + 2, fv, xC, pl);
        frow_cvt(hA, fv); resid_row<true>(c, l, which, r0 + 3, fv, xA, pl);
    } else {
        for (int row = gw; row < LAT; row += NGW) { u32x2 h[8]; f32x4 fv[8], xv[8]; frow_load(Fh + (size_t)row * D, c.lane, h); row_load((first ? p.x : X) + (size_t)row * D, c.lane, xv); frow_cvt(h, fv); resid_row<false>(c, l, which, row, fv, xv, nullptr); }
    }
    if (l == NL - 1) return;
    LAS float* rb = (LAS float*)c.lds;
    const int ns = which ? 11 : 16;
    for (int pr2 = c.bid; pr2 < NB * TC / 2; pr2 += c.G) {
        __syncthreads();
        f32x4 xv[8]; if (c.wave < 2) row_load((first ? p.ctx - (size_t)LAT * D : X) + (size_t)(LAT + 2 * pr2 + c.wave) * D, c.lane, xv);
#pragma unroll
        for (int rr = 0; rr < 2; ++rr) { const float* pr = (const float*)(c.ws + WS_PART) + (size_t)(2 * pr2 + rr) * D + 256 * c.wave + 4 * c.lane; f32x4 a = {0.f, 0.f, 0.f, 0.f};
#pragma unroll
            for (int s = 0; s < 16; ++s) if (s < ns) a += *(const f32x4*)(pr + (size_t)s * 512 * D);
            *(LAS f32x4*)(rb + rr * 2048 + 256 * c.wave + 4 * c.lane) = a; }
        __syncthreads();
        if (c.wave < 2) { const int row = LAT + 2 * pr2 + c.wave; f32x4 fv[8];
#pragma unroll
            for (int j = 0; j < 8; ++j) fv[j] = *(const LAS f32x4*)(rb + c.wave * 2048 + 4 * c.lane + 256 * j);
            resid_row<false>(c, l, which, row, fv, xv, nullptr); }
    }
    __syncthreads();
}

DI f32x4 mfma16(bf16x8 a, bf16x8 b, f32x4 c) { return __builtin_amdgcn_mfma_f32_16x16x32_bf16(a, b, c, 0, 0, 0); }
DI bf16x8 ldfrag(const LAS bf16* base, int ld, int r0, int k0, int lane) { return *(const LAS bf16x8*)(base + (r0 + (lane & 15)) * ld + k0 + 8 * (lane >> 4)); }
template <int K> DI f32x4 mm_tile(const LAS bf16* X, int ldx, int xr0, const LAS bf16* Yt, int ldy, int yr0, int lane, f32x4 acc) {
#pragma unroll
    for (int k0 = 0; k0 < K; k0 += 32) acc = mfma16(ldfrag(X, ldx, xr0, k0, lane), ldfrag(Yt, ldy, yr0, k0, lane), acc);
    return acc; }
DI float wave_scan_add(float v, int lane) {
#pragma unroll
    for (int o = 1; o < 64; o <<= 1) { const float t = shup(v, o); if (lane >= o) v += t; }
    return v; }
DI float wave_scan_max(float v, int lane) {
#pragma unroll
    for (int o = 1; o < 64; o <<= 1) { const float t = shup(v, o); if (lane >= o) v = fmaxf(v, t); }
    return v; }
DI float wave_max(float v) { v = fmaxf(v, dppf<0xB1>(v)); v = fmaxf(v, dppf<0x4E>(v)); v = fmaxf(v, dppf<0x141>(v)); v = fmaxf(v, dppf<0x140>(v)); return fmaxf(fmaxf(rdl(v, 0), rdl(v, 16)), fmaxf(rdl(v, 32), rdl(v, 48))); }
constexpr float QSC = 0.08838834764831845f;

DI void mlstm_local(Ctx& c, int l, int u) {
    { int t0_ = pg8::lane_id_hw(); asm volatile("" : "+v"(t0_)); c.lane = t0_; c.tid = c.wave * 64 + t0_; }
    const Params& p = *c.p; const bf16* Z = (const bf16*)(c.ws + WS_Z); const float* G32 = (const float*)(c.ws + WS_G32); float* ML = (float*)(c.ws + WS_ML) + (size_t)u * ML_US;
    const int chain = u / 68, cc = u % 68, g = chain >> 2, h = chain & 3, dir = g >> 1, b = g & 1;
    LAS bf16* kT = (LAS bf16*)c.lds; LAS bf16* vT = kT + 128 * 72; LAS float* sw = (LAS float*)(vT + 128 * 72);
    __syncthreads();
    if (c.wave == 0) { const int row = scan_row(dir, b, cc * 64 + c.lane);
        const float li = G32[(size_t)row * 32 + dir * 8 + h] + p.ml_gate_b[((l * 2 + dir) * 2 + 0) * 4 + h];
        const float lf = logsigmoidf_(G32[(size_t)row * 32 + dir * 8 + 4 + h] + p.ml_gate_b[((l * 2 + dir) * 2 + 1) * 4 + h]);
        const float bt = wave_scan_add(lf, c.lane); const float bl = rdlane63(bt); const float wl = bl - bt + li; const float mloc = wave_max(wl);
        sw[c.lane] = fexp(wl - mloc); if (c.lane == 0) { ML[ML_HDR] = mloc; ML[ML_HDR + 1] = bl; } }
    __syncthreads();
    for (int it = c.tid; it < 64 * 32; it += 512) { const int s = it & 63, r = it >> 6, mat = r >> 4, ch = (r & 15) * 8; const int row = scan_row(dir, b, cc * 64 + s);
        float v[8]; ld8(Z + (size_t)row * NZ + (mat ? MLV : MLK) + h * 128 + ch, v); const float sc = mat ? 1.f : sw[s]; LAS bf16* dst = (mat ? vT : kT) + ch * 72 + s;
#pragma unroll
        for (int i = 0; i < 8; ++i) dst[i * 72] = (bf16)f2bf(v[i] * sc); }
    __syncthreads();
    f32x4 acc[8];
#pragma unroll
    for (int nt = 0; nt < 8; ++nt) acc[nt] = mm_tile<64>(kT, 72, 16 * c.wave, vT, 72, 16 * nt, c.lane, (f32x4){0.f, 0.f, 0.f, 0.f});
    const int q = c.lane >> 4, r = c.lane & 15;
#pragma unroll
    for (int nt = 0; nt < 8; ++nt) *(f32x4*)(ML + (size_t)(16 * nt + r) * 128 + 16 * c.wave + 4 * q) = acc[nt];
    if (c.tid < 128) { float s = 0.f;
#pragma unroll
        for (int j = 0; j < 64; j += 8) { const u32x4 w = *(const LAS u32x4*)(kT + c.tid * 72 + j);
#pragma unroll
            for (int i = 0; i < 4; ++i) s += __uint_as_float(w[i] << 16) + __uint_as_float(w[i] & 0xffff0000u); }
        ML[ML_NL + c.tid] = s; }
}
DI void mlstm_prefix(Ctx& c) {
    const float* ML = (const float*)(c.ws + WS_ML); bf16* CT = (bf16*)(c.ws + WS_MLC); float* MS = (float*)(c.ws + WS_MLM);
    for (int item = c.bid * 512 + c.tid; item < 65536; item += c.G * 512) {
        const int chain = item >> 12, e = (item >> 5) & 127, dq = item & 31; const bool two = (e == 127);
        const size_t so = (size_t)e * 128 + 4 * dq, so2 = (size_t)ML_NL + 4 * dq; const size_t dofs = (size_t)e * 128 + 4 * dq, dofs2 = (size_t)128 * 128 + 4 * dq;
        f32x4 C = {0.f, 0.f, 0.f, 0.f}, C2 = C; float m = 0.f;
#pragma unroll 17
        for (int cc = 0; cc < 68; ++cc) { const size_t u = (size_t)chain * 68 + cc; const float* mu = ML + u * ML_US;
            const f32x4 L = *(const f32x4*)(mu + so); const float mloc = mu[ML_HDR], bl = mu[ML_HDR + 1]; f32x4 L2 = {0.f, 0.f, 0.f, 0.f}; if (two) L2 = *(const f32x4*)(mu + so2);
            u32x2 w; w.x = pk2(C[0], C[1]); w.y = pk2(C[2], C[3]); *(u32x2*)(CT + u * MLC_US + dofs) = w;
            if (two) { u32x2 w2; w2.x = pk2(C2[0], C2[1]); w2.y = pk2(C2[2], C2[3]); *(u32x2*)(CT + u * MLC_US + dofs2) = w2; }
            if (e == 0 && dq == 0) MS[u] = m;
            const float mn = fmaxf(bl + m, mloc); const float dec = fexp(bl + m - mn), wl = fexp(mloc - mn); m = mn;
            C = C * dec + L * wl; C2 = C2 * dec + L2 * wl; }
    }
}
DI void mlstm_out(Ctx& c, int l, int u) {
    const Params& p = *c.p; const bf16* Z = (const bf16*)(c.ws + WS_Z); const float* G32 = (const float*)(c.ws + WS_G32); bf16* Y = (bf16*)(c.ws + WS_Y);
    const bf16* CTg = (const bf16*)(c.ws + WS_MLC); const float* MS = (const float*)(c.ws + WS_MLM);
    const int b = u / (4 * 68), h = (u / 68) & 3, tb = u % 68;
    LAS bf16* sq = (LAS bf16*)c.lds; LAS bf16* sk = sq + 64 * 136; LAS bf16* vT = sk + 64 * 136; LAS bf16* CT = vT + 144 * 72; LAS bf16* sdw = CT + 144 * 136;
    LAS float* hbuf = (LAS float*)(sdw + 64 * 72); LAS float* sAt = hbuf + 64 * 128; LAS float* sBs = sAt + 64; LAS float* siw = sBs + 64; LAS float* semt = siw + 64; LAS float* sden = semt + 64;
    const int q = c.lane >> 4, r = c.lane & 15;
    for (int dir = 0; dir < 2; ++dir) {
        const int cc = dir == 0 ? tb : (tb < 4 ? 3 - tb : 71 - tb); const int chain = (dir * 2 + b) * 4 + h; const size_t un = (size_t)chain * 68 + cc;
        __syncthreads();
        if (c.wave == 0) { const int row = scan_row(dir, b, cc * 64 + c.lane); const float mc = MS[un];
            const float li = G32[(size_t)row * 32 + dir * 8 + h] + p.ml_gate_b[((l * 2 + dir) * 2 + 0) * 4 + h];
            const float lf = logsigmoidf_(G32[(size_t)row * 32 + dir * 8 + 4 + h] + p.ml_gate_b[((l * 2 + dir) * 2 + 1) * 4 + h]);
            const float bt = wave_scan_add(lf, c.lane); const float x = li - bt; const float cm = wave_scan_max(x, c.lane); const float mt = bt + fmaxf(mc, cm);
            sAt[c.lane] = bt - mt; sBs[c.lane] = x; siw[c.lane] = fexp(bt + mc - mt) * QSC; semt[c.lane] = fexp(-mt); }
        for (int it = c.tid; it < 64 * 32; it += 512) { const int s = it >> 5, r2 = it & 31, mat = r2 >> 4, ch = (r2 & 15) * 8; const int row = scan_row(dir, b, cc * 64 + s);
            *(LAS u32x4*)((mat ? sk : sq) + s * 136 + ch) = *(const u32x4*)(Z + (size_t)row * NZ + (mat ? MLK : MLQ) + h * 128 + ch); }
        for (int it = c.tid; it < 64 * 16; it += 512) { const int s = it & 63, ch = (it >> 6) * 8; const int row = scan_row(dir, b, cc * 64 + s);
            const u32x4 w = *(const u32x4*)(Z + (size_t)row * NZ + MLV + h * 128 + ch); LAS bf16* dst = vT + ch * 72 + s;
#pragma unroll
            for (int i = 0; i < 4; ++i) { dst[(2 * i) * 72] = (bf16)(w[i] & 0xffffu); dst[(2 * i + 1) * 72] = (bf16)(w[i] >> 16); } }
        if (c.tid < 64) vT[128 * 72 + c.tid] = (bf16)0x3F80u;
        for (int it = c.tid; it < 129 * 16; it += 512) { const int e = it >> 4, ch = (it & 15) * 8; *(LAS u32x4*)(CT + e * 136 + ch) = *(const u32x4*)(CTg + un * MLC_US + (size_t)e * 128 + ch); }
        __syncthreads();
#pragma unroll
        for (int j = 0; j < 2; ++j) { const int ti = 2 * c.wave + j, mt = ti >> 2, nt = ti & 3;
            const f32x4 a = mm_tile<128>(sk, 136, 16 * nt, sq, 136, 16 * mt, c.lane, (f32x4){0.f, 0.f, 0.f, 0.f});
            const int t = 16 * mt + r; const float At = sAt[t]; float d[4];
#pragma unroll
            for (int i = 0; i < 4; ++i) { const int s = 16 * nt + 4 * q + i; d[i] = (s <= t) ? a[i] * QSC * fexp(At + sBs[s]) : 0.f; }
            u32x2 w; w.x = pk2(d[0], d[1]); w.y = pk2(d[2], d[3]); *(LAS u32x2*)(sdw + t * 72 + 16 * nt + 4 * q) = w; }
        const int mt = c.wave & 3, nt0 = (c.wave >> 2) * 5, ntn = (c.wave >> 2) ? 4 : 5;
        f32x4 acc[5];
#pragma unroll
        for (int j = 0; j < 5; ++j) if (j < ntn) acc[j] = mm_tile<128>(CT, 136, 16 * (nt0 + j), sq, 136, 16 * mt, c.lane, (f32x4){0.f, 0.f, 0.f, 0.f});
        __syncthreads();
        const int t = 16 * mt + r; const float iw = siw[t];
#pragma unroll
        for (int j = 0; j < 5; ++j) if (j < ntn) acc[j] = mm_tile<64>(vT, 72, 16 * (nt0 + j), sdw, 72, 16 * mt, c.lane, acc[j] * iw);
        if (c.wave >= 4 && q == 0) sden[t] = acc[3][0];
        __syncthreads();
        const float dn = fmaxf(fabsf(sden[t]), semt[t]); const float inv = 1.f / dn; const int tok = dir ? 63 - t : t;
#pragma unroll
        for (int j = 0; j < 5; ++j) if (j < ntn && nt0 + j < 8) { LAS f32x4* hp = (LAS f32x4*)(hbuf + tok * 128 + 16 * (nt0 + j) + 4 * q); const f32x4 hv = acc[j] * inv; if (dir == 0) *hp = hv; else *hp += hv; }
    }
    __syncthreads();
    { const int tok = c.tid >> 3, eg = (c.tid & 7) * 16; const int row = (tb < 4 ? LAT + b * TC + tb * 64 : b * T + (tb - 4) * 64) + tok;
        float hv[16]; float ss = 0.f;
#pragma unroll
        for (int j = 0; j < 4; ++j) { const f32x4 x = *(const LAS f32x4*)(hbuf + tok * 128 + eg + 4 * j); hv[4 * j] = x[0]; hv[4 * j + 1] = x[1]; hv[4 * j + 2] = x[2]; hv[4 * j + 3] = x[3]; ss += (x[0] * x[0] + x[1] * x[1]) + (x[2] * x[2] + x[3] * x[3]); }
        ss = grp_sum<8>(ss); const float rs = rsqrtf(ss * (1.f / 128.f) + 1e-6f);
#pragma unroll
        for (int j = 0; j < 2; ++j) { float g[8], o[8], y[8]; ldf8(p.ml_norm_g + l * 512 + h * 128 + eg + 8 * j, g); ld8(Z + (size_t)row * NZ + MLO + h * 128 + eg + 8 * j, o);
#pragma unroll
            for (int i = 0; i < 8; ++i) y[i] = hv[8 * j + i] * rs * g[i] * sigmoidf_(o[i]);
            st8(Y + (size_t)row * D + 512 + h * 128 + eg + 8 * j, y); } }
}


DI bf16x8 frag_f32(const LAS float* base, int ld, int r0, int c0, int lane, int kvalid) {
    const int q = lane >> 4, r = lane & 15; u32x4 o = {0u, 0u, 0u, 0u};
    if (8 * q < kvalid) { const f32x4 a = *(const LAS f32x4*)(base + (r0 + r) * ld + c0 + 8 * q), b = *(const LAS f32x4*)(base + (r0 + r) * ld + c0 + 8 * q + 4);
        o.x = pk2(a[0], a[1]); o.y = pk2(a[2], a[3]); o.z = pk2(b[0], b[1]); o.w = pk2(b[2], b[3]); }
    return __builtin_bit_cast(bf16x8, o); }
DI bf16x8 frag_k16(const LAS bf16* base, int ld, int r0, int lane) {
    const u32x4 z = {0u, 0u, 0u, 0u}; return (lane >> 4) < 2 ? ldfrag(base, ld, r0, 0, lane) : __builtin_bit_cast(bf16x8, z); }
DI void tri_inverse64(const LAS float* Nf, const LAS bf16*  , LAS bf16* Tm, LAS bf16* scr, int lane) {
    const int blk = lane >> 4, j = lane & 15, q = lane >> 4, r = lane & 15; LAS bf16* TT = scr; LAS bf16* M1 = scr + 1280; LAS bf16* TTb2 = M1 + 768;
    unsigned zo = 0u; asm volatile("" : "+v"(zo)); const u32x4 zv = {zo, zo, zo, zo};
#pragma unroll
    for (int i = 0; i < 9; ++i) *(LAS u32x4*)(Tm + (lane * 9 + i) * 8) = zv;
    float x[16]; const LAS float* Nz = Nf + (16 * blk) * 68 + 16 * blk;
#pragma unroll
    for (int t = 0; t < 16; ++t) { float a = (t == j) ? 1.f : 0.f;
#pragma unroll
        for (int s4 = 0; s4 < (t + 3) / 4; ++s4) { const f32x4 n4 = *(const LAS f32x4*)(Nz + t * 68 + 4 * s4);
#pragma unroll
            for (int i = 0; i < 4; ++i) if (4 * s4 + i < t) a = fmaf(-n4[i], x[4 * s4 + i], a); }
        x[t] = a; Tm[(16 * blk + t) * 72 + 16 * blk + j] = (bf16)f2bf(a); }
    {   u32x4 lo, hi; lo.x = pk2(x[0], x[1]); lo.y = pk2(x[2], x[3]); lo.z = pk2(x[4], x[5]); lo.w = pk2(x[6], x[7]); hi.x = pk2(x[8], x[9]); hi.y = pk2(x[10], x[11]); hi.z = pk2(x[12], x[13]); hi.w = pk2(x[14], x[15]);
        if (blk < 2) { *(LAS u32x4*)(TT + (16 * blk + j) * 40 + 16 * blk) = lo; *(LAS u32x4*)(TT + (16 * blk + j) * 40 + 16 * blk + 8) = hi; }
        if (blk == 1) { *(LAS u32x4*)(TT + (16 + j) * 40) = zv; *(LAS u32x4*)(TT + (16 + j) * 40 + 8) = zv; }
        if (blk == 2) { *(LAS u32x4*)(TTb2 + j * 24) = lo; *(LAS u32x4*)(TTb2 + j * 24 + 8) = hi; } }
    asm volatile("s_waitcnt lgkmcnt(0)" ::: "memory");
#pragma unroll
    for (int p = 0; p < 2; ++p) { const f32x4 a = mfma16(frag_f32(Nf, 68, 16 * (2 * p + 1), 16 * (2 * p), lane, 16), frag_k16(p ? TTb2 : TT, p ? 24 : 40, 0, lane), (f32x4){0.f, 0.f, 0.f, 0.f});
        u32x2 w; w.x = pk2(a[0], a[1]); w.y = pk2(a[2], a[3]); *(LAS u32x2*)(M1 + p * 384 + r * 24 + 4 * q) = w; }
    asm volatile("s_waitcnt lgkmcnt(0)" ::: "memory");
#pragma unroll
    for (int p = 0; p < 2; ++p) { const f32x4 a = mfma16(frag_k16(M1 + p * 384, 24, 0, lane), frag_k16(Tm + (16 * (2 * p + 1)) * 72 + 16 * (2 * p + 1), 72, 0, lane), (f32x4){0.f, 0.f, 0.f, 0.f});
        u32x2 w; w.x = pk2(-a[0], -a[1]); w.y = pk2(-a[2], -a[3]); *(LAS u32x2*)(Tm + (16 * (2 * p + 1) + r) * 72 + 16 * (2 * p) + 4 * q) = w;
        if (p == 0) {
#pragma unroll
            for (int i = 0; i < 4; ++i) TT[(4 * q + i) * 40 + 16 + r] = (bf16)f2bf(-a[i]); } }
    asm volatile("s_waitcnt lgkmcnt(0)" ::: "memory");
#pragma unroll
    for (int xt = 0; xt < 2; ++xt)
#pragma unroll
        for (int yt = 0; yt < 2; ++yt) { const f32x4 a = mfma16(frag_f32(Nf, 68, 32 + 16 * xt, 0, lane, 32), ldfrag(TT, 40, 16 * yt, 0, lane), (f32x4){0.f, 0.f, 0.f, 0.f});
            u32x2 w; w.x = pk2(a[0], a[1]); w.y = pk2(a[2], a[3]); *(LAS u32x2*)(M1 + (16 * yt + r) * 40 + 16 * xt + 4 * q) = w; }
    asm volatile("s_waitcnt lgkmcnt(0)" ::: "memory");
#pragma unroll
    for (int xt = 0; xt < 2; ++xt)
#pragma unroll
        for (int yt = 0; yt < 2; ++yt) { const f32x4 a = mfma16(ldfrag(M1, 40, 16 * xt, 0, lane), ldfrag(Tm + 32 * 72 + 32, 72, 16 * yt, 0, lane), (f32x4){0.f, 0.f, 0.f, 0.f});
            u32x2 w; w.x = pk2(-a[0], -a[1]); w.y = pk2(-a[2], -a[3]); *(LAS u32x2*)(Tm + (32 + 16 * yt + r) * 72 + 16 * xt + 4 * q) = w; }
}
DI bf16x8 gfrag(const bf16* base, int ld, int r0, int k0, int lane) { return *(const bf16x8*)(base + (size_t)(r0 + (lane & 15)) * ld + k0 + 8 * (lane >> 4)); }
DI void gdn_local(Ctx& c, int l, int u) {
    { int t0_ = pg8::lane_id_hw(); asm volatile("" : "+v"(t0_)); c.lane = t0_; c.tid = c.wave * 64 + t0_; }
    const Params& p = *c.p; const bf16* Z = (const bf16*)(c.ws + WS_Z); const float* G32 = (const float*)(c.ws + WS_G32);
    const int chain = u / 68, cc = u % 68, g = chain >> 2, h = chain & 3, dir = g >> 1, b = g & 1;
    bf16* gA = (bf16*)(c.ws + WS_GDA) + (size_t)u * 16384; float* gB = (float*)(c.ws + WS_GDB) + (size_t)(u / 68) * 68 * 16384 + (size_t)(u % 68) * 2048;     float* gU = (float*)(c.ws + WS_GDU) + (size_t)u * 8192;
    bf16* gW = (bf16*)(c.ws + WS_GDW) + (size_t)u * 8192; bf16* gAT = (bf16*)(c.ws + WS_GDAT) + (size_t)u * 4096; bf16* gQD = (bf16*)(c.ws + WS_GDQ) + (size_t)u * 8192;
    LAS bf16* sq = (LAS bf16*)c.lds; LAS bf16* sk = sq + 64 * 136; LAS bf16* skb = sk + 64 * 136; LAS bf16* uT = sq; LAS bf16* wT = uT + 128 * 72;
    LAS bf16* kdT = (LAS bf16*)(c.lds + 52224); LAS bf16* vbT = kdT + 128 * 72; LAS bf16* kbgT = vbT + 128 * 72;
    LAS float* Nf = (LAS float*)(c.lds + 107520); LAS bf16* Tm = (LAS bf16*)(c.lds + 124928); LAS float* sm = (LAS float*)(c.lds + 134144);
    LAS bf16* Nb21 = (LAS bf16*)(c.lds + 135424); LAS bf16* tscr = Nb21 + 1280;
    const int q = c.lane >> 4, r = c.lane & 15;
    __syncthreads();
    if (c.wave == 0) { const int row = scan_row(dir, b, cc * 64 + c.lane); const float a = G32[(size_t)row * 32 + 16 + dir * 8 + h], bb = G32[(size_t)row * 32 + 16 + dir * 8 + 4 + h];
        const float lg = -fexp(p.gd_a_log[l * 8 + dir * 4 + h]) * softplusf_(a + p.gd_dt_bias[l * 8 + dir * 4 + h]);
        const float gc = wave_scan_add(lg, c.lane); const float gl = rdlane63(gc);
        sm[c.lane] = gc; sm[64 + c.lane] = sigmoidf_(bb); sm[128 + c.lane] = fexp(gc); sm[192 + c.lane] = fexp(gl - gc); if (c.lane == 0) sm[256] = fexp(gl); }
    __syncthreads();
    if (c.tid < 384) { const float* cw = p.gd_conv + (size_t)l * 5 * 1536; const int sr = c.tid / 48, rr = c.tid % 48, mat = rr >> 4, ch = (rr & 15) * 8;
        const int row_first = scan_row(dir, b, cc * 64); int sbase, slen, tp0; seq_of(row_first, sbase, slen, tp0);
        const int rj0 = row_first + (dir ? -(sr * 8) : sr * 8); const int lo = dir ? rj0 - 7 : rj0;
        u32x4 xin[12]; float wv[5][8];
#pragma unroll
        for (int m = 0; m < 12; ++m) { const int row = lo - 2 + m; const bool ok = row >= sbase && row < sbase + slen;
            xin[m] = ok ? *(const u32x4*)(Z + (size_t)row * NZ + GDQ + mat * 512 + h * 128 + ch) : (u32x4){0u, 0u, 0u, 0u}; }
#pragma unroll
        for (int j = 0; j < 5; ++j) ldf8(cw + j * 1536 + mat * 512 + h * 128 + ch, wv[j]);
#pragma unroll
        for (int m = 0; m < 8; ++m) { const int s = sr * 8 + (dir ? 7 - m : m);
            float acc[8];
#pragma unroll
            for (int i = 0; i < 8; ++i) acc[i] = 0.f;
#pragma unroll
            for (int j = 0; j < 5; ++j) { const u32x4 a = xin[m + j];
#pragma unroll
                for (int i = 0; i < 4; ++i) { acc[2 * i] = fmaf(__uint_as_float(a[i] << 16), wv[j][2 * i], acc[2 * i]); acc[2 * i + 1] = fmaf(__uint_as_float(a[i] & 0xffff0000u), wv[j][2 * i + 1], acc[2 * i + 1]); } }
            float ss = 0.f;
#pragma unroll
            for (int i = 0; i < 8; ++i) { acc[i] = siluf_(acc[i]); ss += acc[i] * acc[i]; }
            ss = grp_sum<16>(ss);
            const float be = sm[64 + s], egc = sm[128 + s], ekd = sm[192 + s];
            if (mat == 0) { const float sc = rsqrtf(ss + 1e-6f) * QSC; float o[8], o2[8];
#pragma unroll
                for (int i = 0; i < 8; ++i) { o[i] = acc[i] * sc; o2[i] = o[i] * egc; }
                *(LAS u32x4*)(sq + s * 136 + ch) = pack8(o); st8(gQD + s * 128 + ch, o2); }
            else if (mat == 1) { const float sc = rsqrtf(ss + 1e-6f); float o[8], ob[8];
#pragma unroll
                for (int i = 0; i < 8; ++i) { o[i] = acc[i] * sc; ob[i] = o[i] * be; }
                *(LAS u32x4*)(sk + s * 136 + ch) = pack8(o); *(LAS u32x4*)(skb + s * 136 + ch) = pack8(ob);
#pragma unroll
                for (int i = 0; i < 8; ++i) { kdT[(ch + i) * 72 + s] = (bf16)f2bf(o[i] * ekd); kbgT[(ch + i) * 72 + s] = (bf16)f2bf(ob[i] * egc); } }
            else {
#pragma unroll
                for (int i = 0; i < 8; ++i) vbT[(ch + i) * 72 + s] = (bf16)f2bf(acc[i] * be); } } }
    __syncthreads();
#pragma unroll
    for (int j = 0; j < 2; ++j) { const int ti = 2 * c.wave + j, mt = ti >> 2, nt = ti & 3;
        { const f32x4 a = mm_tile<128>(skb, 136, 16 * mt, sk, 136, 16 * nt, c.lane, (f32x4){0.f, 0.f, 0.f, 0.f}); const int s = 16 * nt + r; const float gs = sm[s];
#pragma unroll
          for (int i = 0; i < 4; ++i) { const int t = 16 * mt + 4 * q + i; const float nv = (s < t) ? a[i] * fexp(sm[t] - gs) : 0.f; Nf[t * 68 + s] = nv; if (mt >= 2 && nt < 2) Nb21[(t - 32) * 40 + s] = (bf16)f2bf(nv); } }
        { const f32x4 a = mm_tile<128>(sk, 136, 16 * nt, sq, 136, 16 * mt, c.lane, (f32x4){0.f, 0.f, 0.f, 0.f}); const int t = 16 * mt + r; const float gt = sm[t]; float d[4];
#pragma unroll
          for (int i = 0; i < 4; ++i) { const int s = 16 * nt + 4 * q + i; d[i] = (s <= t) ? a[i] * fexp(gt - sm[s]) : 0.f; }
          u32x2 w; w.x = pk2(d[0], d[1]); w.y = pk2(d[2], d[3]); *(u32x2*)(gAT + t * 64 + 16 * nt + 4 * q) = w; } }
    __syncthreads();
    if (c.wave == 0) tri_inverse64(Nf, Nb21, Tm, tscr, c.lane);
    __syncthreads();
    int lz = c.lane; asm volatile("" : "+v"(lz)); c.lane = lz;
    { const int q = lz >> 4, r = lz & 15; const int mt = c.wave & 3;
#pragma unroll
      for (int j = 0; j < 4; ++j) { const int nt = (c.wave >> 2) * 4 + j;
        const f32x4 au = mm_tile<64>(Tm, 72, 16 * mt, vbT, 72, 16 * nt, c.lane, (f32x4){0.f, 0.f, 0.f, 0.f});
        { u32x2 w; w.x = pk2(au[0], au[1]); w.y = pk2(au[2], au[3]); *(LAS u32x2*)(uT + (16 * nt + r) * 72 + 16 * mt + 4 * q) = w; *(f32x4*)(gU + (16 * nt + r) * 64 + 16 * mt + 4 * q) = au; }
        const f32x4 aw = mm_tile<64>(Tm, 72, 16 * mt, kbgT, 72, 16 * nt, c.lane, (f32x4){0.f, 0.f, 0.f, 0.f});
        { u32x2 w; w.x = pk2(aw[0], aw[1]); w.y = pk2(aw[2], aw[3]); *(LAS u32x2*)(wT + (16 * nt + r) * 72 + 16 * mt + 4 * q) = w; }
        const f32x4 aw2 = mm_tile<64>(kbgT, 72, 16 * nt, Tm, 72, 16 * mt, c.lane, (f32x4){0.f, 0.f, 0.f, 0.f});
        { u32x2 w; w.x = pk2(aw2[0], aw2[1]); w.y = pk2(aw2[2], aw2[3]); *(u32x2*)(gW + (16 * mt + r) * 128 + 16 * nt + 4 * q) = w; } } }
    __syncthreads();
    { const int q = lz >> 4, r = lz & 15; const float egl = sm[256]; const int yt = c.wave;
#pragma unroll
      for (int xt = 0; xt < 8; ++xt) {
        const f32x4 a = mm_tile<64>(wT, 72, 16 * xt, kdT, 72, 16 * yt, c.lane, (f32x4){0.f, 0.f, 0.f, 0.f}); const int d = 16 * yt + r; float v[4];
#pragma unroll
        for (int i = 0; i < 4; ++i) v[i] = ((16 * xt + 4 * q + i) == d ? egl : 0.f) - a[i];
        u32x2 w; w.x = pk2(v[0], v[1]); w.y = pk2(v[2], v[3]); *(u32x2*)(gA + ((yt * 4 + (xt >> 1)) * 64 + (2 * (xt & 1) + (q >> 1)) * 16 + r) * 8 + 4 * (q & 1)) = w;
        const f32x4 bq = mm_tile<64>(kdT, 72, 16 * xt, uT, 72, 16 * yt, c.lane, (f32x4){0.f, 0.f, 0.f, 0.f});
        *(f32x4*)(gB + (size_t)yt * 68 * 2048 + (xt * 64 + 16 * q + r) * 4) = bq; } }
}
template <int N, int PD, bool SWZ = false> DI void affine_prefix(Ctx& c, const bf16* gA, const float* gB, bf16* gS, int sl) {
    constexpr int NN = N * N, KS = N / 32, LD = N + 8; const int w = c.wave, q = c.lane >> 4, r = c.lane & 15;
    static_assert((67 - 1) % PD == 0, "67 steps = whole trips of PD + one peeled step");
    LAS bf16* ST = (LAS bf16*)c.lds;
    __syncthreads();
    if (w < N / 16) {
        { unsigned z0 = 0u; asm volatile("" : "+v"(z0)); const u32x2 z = {z0, z0};     *(LAS u32x2*)(ST + r * LD + 16 * w + 4 * q) = z; if (!SWZ) *(u32x2*)(gS + (size_t)(16 * sl + r) * N + 16 * w + 4 * q) = z; }
        bf16x8 a[PD][KS]; f32x4 B[PD];
        bf16* pfs = gS + (size_t)(16 * sl + 2 * w + (c.lane >> 5)) * N + 4 * (c.lane & 31);
        constexpr int KOFF = SWZ ? 512 : 32;
        const bf16* pa = SWZ ? gA + ((size_t)(w * KS) * 64 + c.lane) * 8 : gA + (size_t)(16 * w + r) * N + 8 * q; constexpr bool BSL = SWZ && N == 128; constexpr size_t BSTR = BSL ? 2048 : NN;
        const float* pb = BSL ? gB + (size_t)sl * 68 * 2048 + (size_t)(w * 64 + c.lane) * 4 : SWZ ? gB + ((size_t)(sl * (N / 16) + w) * 64 + c.lane) * 4 : gB + (size_t)(16 * sl + r) * N + 16 * w + 4 * q; bf16* ps = gS + (size_t)(16 * sl + r) * N + 16 * w + 4 * q;
#pragma unroll
        for (int s = 0; s < PD; ++s) {
#pragma unroll
            for (int kk = 0; kk < KS; ++kk) a[s][kk] = *(const bf16x8*)(pa + (size_t)s * NN + KOFF * kk);
            B[s] = *(const f32x4*)(pb + (size_t)s * BSTR); }
        asm volatile("s_waitcnt lgkmcnt(0)" ::: "memory"); __builtin_amdgcn_s_barrier(); asm volatile("" ::: "memory");
        for (int cc0 = 0; cc0 < 66; cc0 += PD) {
#pragma unroll
            for (int s = 0; s < PD; ++s) { const int cc = cc0 + s; const LAS bf16* Sr = ST + (s & 1) * (16 * LD); LAS bf16* Sw = ST + ((s + 1) & 1) * (16 * LD);
                f32x4 acc = B[s];
#pragma unroll
                for (int kk = 0; kk < KS; ++kk) acc = mfma16(a[s][kk], ldfrag(Sr, LD, 0, 32 * kk, c.lane), acc);
                asm volatile("" : "+v"(acc) :: "memory");
                { const size_t o = (size_t)(cc + PD) * NN;
#pragma unroll
                  for (int kk = 0; kk < KS; ++kk) a[s][kk] = *(const bf16x8*)(pa + o + KOFF * kk);
                  B[s] = *(const f32x4*)(pb + (size_t)(cc + PD) * BSTR); }
                u32x2 wv; wv.x = pk2(acc[0], acc[1]); wv.y = pk2(acc[2], acc[3]);
                *(LAS u32x2*)(Sw + r * LD + 16 * w + 4 * q) = wv;
                if (SWZ) { const u32x2 t = *(const LAS u32x2*)(Sr + (2 * w + (c.lane >> 5)) * LD + 4 * (c.lane & 31)); *(u32x2*)(pfs + (size_t)cc * NN) = t; }
                else *(u32x2*)(ps + (size_t)(cc + 1) * NN) = wv;
                asm volatile("s_waitcnt lgkmcnt(0)" ::: "memory"); __builtin_amdgcn_s_barrier(); asm volatile("" ::: "memory"); } }
        {
            f32x4 acc = B[0];
#pragma unroll
            for (int kk = 0; kk < KS; ++kk) acc = mfma16(a[0][kk], ldfrag(ST, LD, 0, 32 * kk, c.lane), acc);
            u32x2 wv; wv.x = pk2(acc[0], acc[1]); wv.y = pk2(acc[2], acc[3]); *(u32x2*)(ps + (size_t)67 * NN) = wv;
            if (SWZ) { const u32x2 t = *(const LAS u32x2*)(ST + (2 * w + (c.lane >> 5)) * LD + 4 * (c.lane & 31)); *(u32x2*)(pfs + (size_t)66 * NN) = t; } }
    } else {
        asm volatile("" ::: "memory"); __builtin_amdgcn_s_barrier();
        for (int cc = 0; cc < 66; ++cc) { asm volatile("" ::: "memory"); __builtin_amdgcn_s_barrier(); }
    }
    __syncthreads();
}
DI void gdn_prefix(Ctx& c, int u2) { const int chain = (u2 & 7) + 8 * (u2 >> 6), sl = (u2 >> 3) & 7;
    affine_prefix<128, 6, true>(c, (const bf16*)(c.ws + WS_GDA) + (size_t)chain * 68 * 16384, (const float*)(c.ws + WS_GDB) + (size_t)chain * 68 * 16384, (bf16*)(c.ws + WS_GDS) + (size_t)chain * 68 * 16384, sl); }
DI void rwkv_prefix(Ctx& c, int u2) { const int chain = (u2 & 7) + 8 * (u2 >> 5), sl = (u2 >> 3) & 3;
    affine_prefix<64, 6>(c, (const bf16*)(c.ws + WS_RAC) + (size_t)chain * 68 * 4096, (const float*)(c.ws + WS_RBC) + (size_t)chain * 68 * 4096, (bf16*)(c.ws + WS_RPT) + (size_t)chain * 68 * 4096, sl); }
DI void gdn_out(Ctx& c, int l, int u) {
    const Params& p = *c.p; const bf16* Z = (const bf16*)(c.ws + WS_Z); bf16* Y = (bf16*)(c.ws + WS_Y);
    const int b = u / (4 * 68), h = (u / 68) & 3, tb = u % 68;
    LAS bf16* ST = (LAS bf16*)c.lds; LAS bf16* vnT = ST + 128 * 136; LAS float* hbuf = (LAS float*)(vnT + 128 * 72);
    const int q = c.lane >> 4, r = c.lane & 15; const int mt = c.wave & 3, ntb = (c.wave >> 2) * 4;
    for (int dir = 0; dir < 2; ++dir) {
        const int cc = dir == 0 ? tb : (tb < 4 ? 3 - tb : 71 - tb); const int chain = (dir * 2 + b) * 4 + h; const size_t un = (size_t)chain * 68 + cc;
        const bf16* gS = (const bf16*)(c.ws + WS_GDS) + un * 16384; const float* gU = (const float*)(c.ws + WS_GDU) + un * 8192; const bf16* gW = (const bf16*)(c.ws + WS_GDW) + un * 8192;
        const bf16* gAT = (const bf16*)(c.ws + WS_GDAT) + un * 4096; const bf16* gQD = (const bf16*)(c.ws + WS_GDQ) + un * 8192;
        __syncthreads();
        for (int it = c.tid; it < 128 * 16; it += 512) { const int e = it >> 4, ch = (it & 15) * 8; *(LAS u32x4*)(ST + e * 136 + ch) = *(const u32x4*)(gS + (size_t)e * 128 + ch); }
        bf16x8 wf[4], qf[4], af[2];
#pragma unroll
        for (int kk = 0; kk < 4; ++kk) { wf[kk] = gfrag(gW, 128, 16 * mt, 32 * kk, c.lane); qf[kk] = gfrag(gQD, 128, 16 * mt, 32 * kk, c.lane); }
#pragma unroll
        for (int kk = 0; kk < 2; ++kk) af[kk] = gfrag(gAT, 64, 16 * mt, 32 * kk, c.lane);
        __syncthreads();
#pragma unroll
        for (int j = 0; j < 4; ++j) { const int nt = ntb + j; f32x4 acc = {0.f, 0.f, 0.f, 0.f};
#pragma unroll
            for (int kk = 0; kk < 4; ++kk) acc = mfma16(wf[kk], ldfrag(ST, 136, 16 * nt, 32 * kk, c.lane), acc);
            const f32x4 uv = *(const f32x4*)(gU + (16 * nt + r) * 64 + 16 * mt + 4 * q); const f32x4 vn = uv - acc;
            u32x2 wv; wv.x = pk2(vn[0], vn[1]); wv.y = pk2(vn[2], vn[3]); *(LAS u32x2*)(vnT + (16 * nt + r) * 72 + 16 * mt + 4 * q) = wv; }
        __syncthreads();
        const int t = 16 * mt + r, tok = dir ? 63 - t : t;
#pragma unroll
        for (int j = 0; j < 4; ++j) { const int nt = ntb + j; f32x4 acc = {0.f, 0.f, 0.f, 0.f};
#pragma unroll
            for (int kk = 0; kk < 4; ++kk) acc = mfma16(ldfrag(ST, 136, 16 * nt, 32 * kk, c.lane), qf[kk], acc);
#pragma unroll
            for (int kk = 0; kk < 2; ++kk) acc = mfma16(ldfrag(vnT, 72, 16 * nt, 32 * kk, c.lane), af[kk], acc);
            LAS f32x4* hp = (LAS f32x4*)(hbuf + tok * 128 + 16 * nt + 4 * q); if (dir == 0) *hp = acc; else *hp += acc; }
    }
    __syncthreads();
    { const int tok = c.tid >> 3, eg = (c.tid & 7) * 16; const int row = (tb < 4 ? LAT + b * TC + tb * 64 : b * T + (tb - 4) * 64) + tok;
        float hv[16]; float ss = 0.f;
#pragma unroll
        for (int j = 0; j < 4; ++j) { const f32x4 x = *(const LAS f32x4*)(hbuf + tok * 128 + eg + 4 * j); hv[4 * j] = x[0]; hv[4 * j + 1] = x[1]; hv[4 * j + 2] = x[2]; hv[4 * j + 3] = x[3]; ss += (x[0] * x[0] + x[1] * x[1]) + (x[2] * x[2] + x[3] * x[3]); }
        ss = grp_sum<8>(ss); const float rs = rsqrtf(ss * (1.f / 128.f) + 1e-6f);
#pragma unroll
        for (int j = 0; j < 2; ++j) { float g[8], o[8], y[8]; ldf8(p.gd_norm_g + l * 512 + h * 128 + eg + 8 * j, g); ld8(Z + (size_t)row * NZ + GDZ + h * 128 + eg + 8 * j, o);
#pragma unroll
            for (int i = 0; i < 8; ++i) y[i] = hv[8 * j + i] * rs * g[i] * siluf_(o[i]);
            st8(Y + (size_t)row * D + 1024 + h * 128 + eg + 8 * j, y); } }
}


DI void rwkv_local(Ctx& c, int l, int u) {
    { int t0_ = pg8::lane_id_hw(); asm volatile("" : "+v"(t0_)); c.lane = t0_; c.tid = c.wave * 64 + t0_; }
    const Params& p = *c.p; const bf16* Z = (const bf16*)(c.ws + WS_Z); const float* mu = p.rw_mu + (size_t)l * 2 * RWMIX; const bf16* lw = (const bf16*)(c.ws + WS_W + WL_LORA);
    const int chain = u / 68, cc = u % 68, g = chain >> 3, h = chain & 7, dir = g >> 1, b = g & 1;
    bf16* gQE = (bf16*)(c.ws + WS_RQE) + (size_t)u * 4096; float* gYL = (float*)(c.ws + WS_RYL) + (size_t)u * 4096; bf16* gAC = (bf16*)(c.ws + WS_RAC) + (size_t)u * 4096; float* gBC = (float*)(c.ws + WS_RBC) + (size_t)u * 4096;
    LAS bf16* IM = (LAS bf16*)c.lds;
#define RIM(k) (IM + (k) * 4608)
    LAS bf16 *At = RIM(0), *Tm = RIM(0), *Bt = RIM(1), *X1T = RIM(1), *Kt = RIM(2), *AhT = RIM(2), *Rt = RIM(3), *AtT = RIM(4), *VT = RIM(5), *BhT = RIM(6), *KhT = RIM(7), *NAK = RIM(8), *SgT = RIM(8), *MBR = RIM(9), *MKR = RIM(10);
#undef RIM
    LAS float* Nf = (LAS float*)(c.lds + 101376); LAS float* seg = (LAS float*)(c.lds + 118784); LAS float* W63 = seg + 512;
    LAS bf16* Nb21 = (LAS bf16*)(c.lds + 121088); LAS bf16* tscr = Nb21 + 1280;
    LAS bf16* in = (LAS bf16*)c.lds; LAS bf16* wTw = in + 64 * 200; LAS bf16* wTa = wTw + 64 * 104; LAS float* Ldec = (LAS float*)(c.lds + 52224); LAS float* Lic = Ldec + 4096;
    const int q = c.lane >> 4, r = c.lane & 15; const int ch = c.tid & 63, tq = c.tid >> 6;
    const int row_first = scan_row(dir, b, cc * 64); int sbase, slen, tp0; seq_of(row_first, sbase, slen, tp0);
    float xr[10], xk[10], xv[10];
    const int rj0 = row_first + (dir ? -(tq * 8) : tq * 8); const int lo = dir ? rj0 - 7 : rj0; const int cz = h * 64 + ch;
#pragma unroll
    for (int m = 0; m < 10; ++m) { const int row = lo - 1 + m; const bool ok = row >= sbase && row < sbase + slen; const bf16* zp = Z + (size_t)row * NZ + RWR + cz;
        xr[m] = ok ? bf2f(zp[0]) : 0.f; xk[m] = ok ? bf2f(zp[512]) : 0.f; xv[m] = ok ? bf2f(zp[1024]) : 0.f; }
    const float mr0 = mu[cz], mr1 = mu[RWMIX + cz], mk0 = mu[512 + cz], mk1 = mu[RWMIX + 512 + cz], mv0 = mu[1024 + cz], mv1 = mu[RWMIX + 1024 + cz];
    const float kks = p.rw_kk[l * 512 + cz], kas = p.rw_ka[l * 512 + cz], rks = p.rw_rk[l * 512 + cz]; float* BON = (float*)(c.ws + WS_BON);
    const int pc0 = h * 64 + 16 * ((c.wave >> 2) * 2) + 4 * q;
    const f32x4 pw0 = *(const f32x4*)(p.rw_w0 + (l * 2 + dir) * 512 + pc0), pw1 = *(const f32x4*)(p.rw_w0 + (l * 2 + dir) * 512 + pc0 + 16);
    const f32x4 pa0 = *(const f32x4*)(p.rw_a0 + (l * 2 + dir) * 512 + pc0), pa1 = *(const f32x4*)(p.rw_a0 + (l * 2 + dir) * 512 + pc0 + 16);
    __syncthreads();
    for (int it = c.tid; it < 64 * 24; it += 512) { const int t = it / 24, k8 = it % 24; const int row = row_first + (dir ? -t : t); const int tp = row - sbase;
        const bf16* zp = Z + (size_t)row * NZ + RWXW + k8 * 8; float x[8], pv[8], nx[8], m0[8], m1[8], f[8];
        ld8(zp, x);
        if (tp > 0) ld8(zp - NZ, pv); else {
#pragma unroll
            for (int i = 0; i < 8; ++i) pv[i] = 0.f; }
        if (tp < slen - 1) ld8(zp + NZ, nx); else {
#pragma unroll
            for (int i = 0; i < 8; ++i) nx[i] = 0.f; }
        ldf8(mu + 1536 + k8 * 8, m0); ldf8(mu + RWMIX + 1536 + k8 * 8, m1);
#pragma unroll
        for (int i = 0; i < 8; ++i) { const float v = x[i] + m0[i] * (pv[i] - x[i]) + m1[i] * (nx[i] - x[i]); f[i] = k8 < 12 ? ftanh(v) : v; }
        *(LAS u32x4*)(in + t * 200 + k8 * 8) = pack8(f); }
    for (int it = c.tid; it < 2 * 64 * 12; it += 512) { const int m = it / 768, rr = it % 768, n = rr / 12, k8 = rr % 12;
        *(LAS u32x4*)((m ? wTa : wTw) + n * 104 + k8 * 8) = *(const u32x4*)(lw + (size_t)((m ? 2 : 0) + dir) * 512 * 96 + (size_t)(h * 64 + n) * 96 + k8 * 8); }
    float r8[8], kf8[8], v8[8];
#pragma unroll
    for (int j = 0; j < 8; ++j) { const int m = (dir ? 7 - j : j) + 1;
        r8[j] = xr[m] + mr0 * (xr[m - 1] - xr[m]) + mr1 * (xr[m + 1] - xr[m]); kf8[j] = xk[m] + mk0 * (xk[m - 1] - xk[m]) + mk1 * (xk[m + 1] - xk[m]); v8[j] = xv[m] + mv0 * (xv[m - 1] - xv[m]) + mv1 * (xv[m + 1] - xv[m]); }
    __syncthreads();
    { const int mt = c.wave & 3;
#pragma unroll
      for (int jj = 0; jj < 2; ++jj) { const int nt = (c.wave >> 2) * 2 + jj; f32x4 aw = {0.f, 0.f, 0.f, 0.f}, aa = aw;
#pragma unroll
        for (int kk = 0; kk < 3; ++kk) { aw = mfma16(ldfrag(wTw, 104, 16 * nt, 32 * kk, c.lane), ldfrag(in, 200, 16 * mt, 32 * kk, c.lane), aw); aa = mfma16(ldfrag(wTa, 104, 16 * nt, 32 * kk, c.lane), ldfrag(in + 96, 200, 16 * mt, 32 * kk, c.lane), aa); }
        const f32x4 w0 = jj ? pw1 : pw0, a0 = jj ? pa1 : pa0; f32x4 dv, iv;
#pragma unroll
        for (int i = 0; i < 4; ++i) { dv[i] = fexp(-fexp(-softplusf_(-(w0[i] + aw[i])) - 0.5f)); iv[i] = sigmoidf_(a0[i] + aa[i]); }
        *(LAS f32x4*)(Ldec + (16 * mt + r) * 64 + 16 * nt + 4 * q) = dv; *(LAS f32x4*)(Lic + (16 * mt + r) * 64 + 16 * nt + 4 * q) = iv; } }
    __syncthreads();
    {   float w8[8], k8[8], a8[8], b8[8];
#pragma unroll
        for (int j = 0; j < 8; ++j) { const float kf = kf8[j]; const float ic = Lic[(tq * 8 + j) * 64 + ch]; w8[j] = Ldec[(tq * 8 + j) * 64 + ch];
            const float kx = kf * kks; const float kkv = kx * rsqrtf(wave_sum(kx * kx) + 1e-6f);
            k8[j] = kf * (1.f + (ic - 1.f) * kas); a8[j] = -kkv; b8[j] = kkv * ic;
            const float bo = wave_sum(r8[j] * k8[j] * rks); if (c.lane == 0) BON[((size_t)dir * MROWS + (row_first + (dir ? -(tq * 8 + j) : (tq * 8 + j)))) * 8 + h] = bo; }
        __syncthreads();
#pragma unroll
        for (int j = 1; j < 8; ++j) w8[j] *= w8[j - 1];
        seg[tq * 64 + ch] = w8[7];
        __syncthreads();
        float pre = 1.f, tot = 1.f;
#pragma unroll
        for (int s = 0; s < 8; ++s) { const float sv = seg[s * 64 + ch]; if (s < tq) pre *= sv; tot *= sv; }
        if (tq == 0) W63[ch] = tot;
        float aT[8], bhT[8], khT[8];
#pragma unroll
        for (int j = 0; j < 8; ++j) { const float winc = pre * w8[j], wexc = j ? pre * w8[j - 1] : pre; const float iw = 1.f / winc; const int t = tq * 8 + j;
            const float at = a8[j] * wexc, bt = b8[j] * iw, kt = k8[j] * iw, rt = r8[j] * winc;
            At[t * 72 + ch] = (bf16)f2bf(at); Bt[t * 72 + ch] = (bf16)f2bf(bt); Kt[t * 72 + ch] = (bf16)f2bf(kt); Rt[t * 72 + ch] = (bf16)f2bf(rt);
            aT[j] = at; bhT[j] = bt * tot; khT[j] = kt * tot; }
        *(LAS u32x4*)(AtT + ch * 72 + tq * 8) = pack8(aT); *(LAS u32x4*)(VT + ch * 72 + tq * 8) = pack8(v8); *(LAS u32x4*)(BhT + ch * 72 + tq * 8) = pack8(bhT); *(LAS u32x4*)(KhT + ch * 72 + tq * 8) = pack8(khT);
    }
    __syncthreads();
#pragma unroll
    for (int jj = 0; jj < 2; ++jj) { const int ti = 2 * c.wave + jj, mt = ti >> 2, nt = ti & 3; const int t = 16 * mt + r, j0 = 16 * nt + 4 * q; const f32x4 z4 = {0.f, 0.f, 0.f, 0.f};
        const f32x4 p1 = mm_tile<64>(Bt, 72, 16 * nt, At, 72, 16 * mt, c.lane, z4), p2 = mm_tile<64>(Kt, 72, 16 * nt, At, 72, 16 * mt, c.lane, z4);
        const f32x4 p3 = mm_tile<64>(Bt, 72, 16 * nt, Rt, 72, 16 * mt, c.lane, z4), p4 = mm_tile<64>(Kt, 72, 16 * nt, Rt, 72, 16 * mt, c.lane, z4);
        f32x4 n1; float d2[4], d3[4], d4[4];
#pragma unroll
        for (int i = 0; i < 4; ++i) { const bool lt = (j0 + i) < t, le = (j0 + i) <= t; n1[i] = lt ? -p1[i] : 0.f; d2[i] = lt ? p2[i] : 0.f; d3[i] = le ? p3[i] : 0.f; d4[i] = le ? p4[i] : 0.f; }
        *(LAS f32x4*)(Nf + t * 68 + j0) = n1;
        if (mt >= 2 && nt < 2) { u32x2 wn; wn.x = pk2(n1[0], n1[1]); wn.y = pk2(n1[2], n1[3]); *(LAS u32x2*)(Nb21 + (t - 32) * 40 + j0) = wn; }
        u32x2 w; w.x = pk2(d2[0], d2[1]); w.y = pk2(d2[2], d2[3]); *(LAS u32x2*)(NAK + t * 72 + j0) = w;
        w.x = pk2(d3[0], d3[1]); w.y = pk2(d3[2], d3[3]); *(LAS u32x2*)(MBR + t * 72 + j0) = w;
        w.x = pk2(d4[0], d4[1]); w.y = pk2(d4[2], d4[3]); *(LAS u32x2*)(MKR + t * 72 + j0) = w; }
    __syncthreads();
    if (c.wave == 0) tri_inverse64(Nf, Nb21, Tm, tscr, c.lane);
    else { for (int ti = c.wave - 1; ti < 16; ti += 7) { const int mt = ti >> 2, nt = ti & 3;
            const f32x4 a = mm_tile<64>(NAK, 72, 16 * mt, VT, 72, 16 * nt, c.lane, (f32x4){0.f, 0.f, 0.f, 0.f});
            u32x2 w; w.x = pk2(a[0], a[1]); w.y = pk2(a[2], a[3]); *(LAS u32x2*)(X1T + (16 * nt + r) * 72 + 16 * mt + 4 * q) = w; } }
    __syncthreads();
    int lz = c.lane; asm volatile("" : "+v"(lz)); c.lane = lz;
    { const int q = lz >> 4, r = lz & 15;
#pragma unroll
    for (int jj = 0; jj < 2; ++jj) { const int ti = 2 * c.wave + jj, mt = ti >> 2, nt = ti & 3; const f32x4 z4 = {0.f, 0.f, 0.f, 0.f};
        const f32x4 a = mm_tile<64>(Tm, 72, 16 * mt, AtT, 72, 16 * nt, c.lane, z4), s = mm_tile<64>(Tm, 72, 16 * mt, X1T, 72, 16 * nt, c.lane, z4);
        u32x2 w; w.x = pk2(a[0], a[1]); w.y = pk2(a[2], a[3]); *(LAS u32x2*)(AhT + (16 * nt + r) * 72 + 16 * mt + 4 * q) = w;
        w.x = pk2(s[0], s[1]); w.y = pk2(s[2], s[3]); *(LAS u32x2*)(SgT + (16 * nt + r) * 72 + 16 * mt + 4 * q) = w; } }
    __syncthreads();
    int lz2 = c.lane; asm volatile("" : "+v"(lz2)); c.lane = lz2;
    { const int q = lz2 >> 4, r = lz2 & 15;
#pragma unroll
    for (int jj = 0; jj < 2; ++jj) { const int ti = 2 * c.wave + jj, xt = ti >> 2, yt = ti & 3; const int x0 = 16 * xt + 4 * q, yr = 16 * yt + r; const f32x4 z4 = {0.f, 0.f, 0.f, 0.f};
        { f32x4 a = mm_tile<64>(AhT, 72, 16 * xt, MBR, 72, 16 * yt, c.lane, z4); const u32x2 rw = *(const LAS u32x2*)(Rt + yr * 72 + x0);
          a[0] += __uint_as_float(rw.x << 16); a[1] += __uint_as_float(rw.x & 0xffff0000u); a[2] += __uint_as_float(rw.y << 16); a[3] += __uint_as_float(rw.y & 0xffff0000u);
          u32x2 w; w.x = pk2(a[0], a[1]); w.y = pk2(a[2], a[3]); *(u32x2*)(gQE + yr * 64 + x0) = w; }
        { f32x4 a = mm_tile<64>(SgT, 72, 16 * xt, MBR, 72, 16 * yt, c.lane, z4); a = mm_tile<64>(VT, 72, 16 * xt, MKR, 72, 16 * yt, c.lane, a); *(f32x4*)(gYL + yr * 64 + x0) = a; }
        { f32x4 a = mm_tile<64>(AhT, 72, 16 * xt, BhT, 72, 16 * yt, c.lane, z4); const float wd = W63[yr];
#pragma unroll
          for (int i = 0; i < 4; ++i) if (x0 + i == yr) a[i] += wd;
          u32x2 w; w.x = pk2(a[0], a[1]); w.y = pk2(a[2], a[3]); *(u32x2*)(gAC + yr * 64 + x0) = w; }
        { f32x4 a = mm_tile<64>(BhT, 72, 16 * xt, SgT, 72, 16 * yt, c.lane, z4); a = mm_tile<64>(KhT, 72, 16 * xt, VT, 72, 16 * yt, c.lane, a); *(f32x4*)(gBC + yr * 64 + x0) = a; } } }
}
DI void rwkv_out(Ctx& c, int l, int u) {
    const Params& p = *c.p; bf16* Y = (bf16*)(c.ws + WS_Y); const bf16* Z = (const bf16*)(c.ws + WS_Z); const float* SA = (const float*)(c.ws + WS_S); const size_t AS = (size_t)MROWS * 512;
    const int b = u / 136, rem = u % 136, tb = rem >> 1, hg = rem & 1; const int hl = c.wave & 3, dir = c.wave >> 2, head = hg * 4 + hl;
    LAS float* hbuf = (LAS float*)c.lds;
    const int q = c.lane >> 4, r = c.lane & 15;
    __syncthreads();
    { const int cc = dir == 0 ? tb : (tb < 4 ? 3 - tb : 71 - tb); const int chain = (dir * 2 + b) * 8 + head; const size_t un = (size_t)chain * 68 + cc;
      const bf16* gQE = (const bf16*)(c.ws + WS_RQE) + un * 4096; const float* gYL = (const float*)(c.ws + WS_RYL) + un * 4096; const bf16* gPT = (const bf16*)(c.ws + WS_RPT) + un * 4096;
      bf16x8 pf[4][2];
#pragma unroll
      for (int it = 0; it < 4; ++it)
#pragma unroll
          for (int kk = 0; kk < 2; ++kk) pf[it][kk] = gfrag(gPT, 64, 16 * it, 32 * kk, c.lane);
#pragma unroll
      for (int mt = 0; mt < 4; ++mt) { const bf16x8 q0 = gfrag(gQE, 64, 16 * mt, 0, c.lane), q1 = gfrag(gQE, 64, 16 * mt, 32, c.lane); const int t = 16 * mt + r, tok = dir ? 63 - t : t;
#pragma unroll
          for (int it = 0; it < 4; ++it) { f32x4 acc = *(const f32x4*)(gYL + t * 64 + 16 * it + 4 * q); acc = mfma16(pf[it][0], q0, acc); acc = mfma16(pf[it][1], q1, acc);
              *(LAS f32x4*)(hbuf + ((dir * 4 + hl) * 64 + tok) * 64 + 16 * it + 4 * q) = acc; } } }
    __syncthreads();
    { const int pr = c.tid >> 1, hf = c.tid & 1, h2 = pr >> 6, tok = pr & 63, hd = hg * 4 + h2; const int row = (tb < 4 ? LAT + b * TC + tb * 64 : b * T + (tb - 4) * 64) + tok;
      float y[32]; float s = 0.f;
#pragma unroll
      for (int j = 0; j < 8; ++j) { const f32x4 a = *(const LAS f32x4*)(hbuf + (h2 * 64 + tok) * 64 + hf * 32 + 4 * j), bq = *(const LAS f32x4*)(hbuf + ((4 + h2) * 64 + tok) * 64 + hf * 32 + 4 * j);
#pragma unroll
          for (int i = 0; i < 4; ++i) { y[4 * j + i] = a[i] + bq[i]; s += y[4 * j + i]; } }
      s += shx<1>(s); const float mean = s * (1.f / 64.f); float qq = 0.f;
#pragma unroll
      for (int i = 0; i < 32; ++i) { y[i] -= mean; qq += y[i] * y[i]; }
      qq += shx<1>(qq); const float rs = rsqrtf(qq * (1.f / 64.f) + 64e-5f);
      const int cb = hd * 64 + hf * 32; int bases, lens, tps; seq_of(row, bases, lens, tps); const float* BON = (const float*)(c.ws + WS_BON);
      const float bonus = BON[(size_t)row * 8 + hd] + BON[((size_t)MROWS + row) * 8 + hd]; const float* mu = p.rw_mu + (size_t)l * 2 * RWMIX;
#pragma unroll
      for (int j = 0; j < 4; ++j) { float g[8], bb[8], ax[8], gg[8], o[8]; ldf8(p.rw_ln_g + l * 512 + cb + 8 * j, g); ldf8(p.rw_ln_b + l * 512 + cb + 8 * j, bb);
          { float x[8], pv[8], nx[8], m0[8], m1[8]; const bf16* zp = Z + (size_t)row * NZ + RWV + cb + 8 * j; ld8(zp, x);
            if (tps > 0) ld8(zp - NZ, pv); else {
#pragma unroll
                for (int i = 0; i < 8; ++i) pv[i] = 0.f; }
            if (tps < lens - 1) ld8(zp + NZ, nx); else {
#pragma unroll
                for (int i = 0; i < 8; ++i) nx[i] = 0.f; }
            ldf8(mu + 1024 + cb + 8 * j, m0); ldf8(mu + RWMIX + 1024 + cb + 8 * j, m1);
#pragma unroll
            for (int i = 0; i < 8; ++i) ax[i] = bonus * (x[i] + m0[i] * (pv[i] - x[i]) + m1[i] * (nx[i] - x[i])); }
          ldf8(SA + SA_RG * AS + (size_t)row * 512 + cb + 8 * j, gg);
#pragma unroll
          for (int i = 0; i < 8; ++i) o[i] = (y[8 * j + i] * rs * g[i] + bb[i] + ax[i]) * gg[i];
          st8(Y + (size_t)row * D + 1536 + cb + 8 * j, o); } }
}

DI float rw_feat(const bf16* Z, const float* mu, int row, int cz) {
    int base, len, t; seq_of(row, base, len, t); const bf16* zp = Z + (size_t)row * NZ + RWR + cz;
    const float x = bf2f(zp[0]); const float pv = t > 0 ? bf2f(zp[-NZ]) : 0.f; const float nx = t < len - 1 ? bf2f(zp[NZ]) : 0.f;
    return x + mu[cz] * (pv - x) + mu[RWMIX + cz] * (nx - x);
}
DI void ld4(const bf16* p, float (&o)[4]) { const u32x2 w = *(const u32x2*)p; o[0] = __uint_as_float(w.x << 16); o[1] = __uint_as_float(w.x & 0xffff0000u); o[2] = __uint_as_float(w.y << 16); o[3] = __uint_as_float(w.y & 0xffff0000u); }
DI void rw_feat4(const bf16* Z, const float* mu, int row, int tpos, int len, int cz, float (&f)[4]) {
    const bf16* zp = Z + (size_t)row * NZ + RWR + cz; float x[4], pv[4] = {0.f, 0.f, 0.f, 0.f}, nx[4] = {0.f, 0.f, 0.f, 0.f}; ld4(zp, x); if (tpos > 0) ld4(zp - NZ, pv); if (tpos < len - 1) ld4(zp + NZ, nx);
    const f32x4 m0 = *(const f32x4*)(mu + cz), m1 = *(const f32x4*)(mu + RWMIX + cz);
#pragma unroll
    for (int i = 0; i < 4; ++i) f[i] = x[i] + m0[i] * (pv[i] - x[i]) + m1[i] * (nx[i] - x[i]);
}
DI void conv_unit(Ctx& c, int l, int u) {
    { int t0_ = pg8::lane_id_hw(); asm volatile("" : "+v"(t0_)); c.lane = t0_; c.tid = c.wave * 64 + t0_; }
    const Params& p = *c.p; const bf16* Z = (const bf16*)(c.ws + WS_Z); bf16* Y = (bf16*)(c.ws + WS_Y);
    LAS bf16* ys = (LAS bf16*)c.lds; LAS bf16* wq = ys + 64 * 520;
    const int r0 = 34 * u - 15;
    __syncthreads();
    for (int it = c.tid; it < 64 * 64; it += 512) { const int cg = it & 63, rr = it >> 6; const int grow = r0 + rr; float y[8];
        if (grow >= 0 && grow < MROWS) { float a[8], g[8]; ld8(Z + (size_t)grow * NZ + ZA + cg * 8, a); ld8(Z + (size_t)grow * NZ + ZAG + cg * 8, g);
#pragma unroll
            for (int i = 0; i < 8; ++i) y[i] = a[i] * sigmoidf_(g[i]); }
        else {
#pragma unroll
            for (int i = 0; i < 8; ++i) y[i] = 0.f; }
        *(LAS u32x4*)(ys + rr * 520 + cg * 8) = pack8(y); }
    for (int it = c.tid; it < 31 * 64; it += 512) { float w8[8]; ldf8(p.conv_dw + (size_t)l * 31 * 512 + it * 8, w8); *(LAS u32x4*)(wq + it * 8) = pack8(w8); }
    __syncthreads();
    const int ch = c.lane * 8;
    for (int tl = c.wave; tl < 34; tl += 8) { const int row = 34 * u + tl; int base, len, t; seq_of(row, base, len, t);
        float acc[8];
#pragma unroll
        for (int i = 0; i < 8; ++i) acc[i] = 0.f;
#pragma unroll
        for (int j = 0; j < 31; ++j) { const int tt = t + j - 15; if (tt < 0 || tt >= len) continue;
            const u32x4 yv = *(const LAS u32x4*)(ys + (tl + j) * 520 + ch), wv = *(const LAS u32x4*)(wq + j * 512 + ch);
#pragma unroll
            for (int i = 0; i < 4; ++i) { acc[2 * i] = fmaf(__uint_as_float(yv[i] << 16), __uint_as_float(wv[i] << 16), acc[2 * i]); acc[2 * i + 1] = fmaf(__uint_as_float(yv[i] & 0xffff0000u), __uint_as_float(wv[i] & 0xffff0000u), acc[2 * i + 1]); } }
        float bv[8]; ldf8(p.conv_b + l * 512 + ch, bv); float s = 0.f;
#pragma unroll
        for (int i = 0; i < 8; ++i) { acc[i] += bv[i]; s += acc[i]; }
        const float mean = wave_sum(s) * (1.f / 512.f); float qv = 0.f;
#pragma unroll
        for (int i = 0; i < 8; ++i) { acc[i] -= mean; qv += acc[i] * acc[i]; }
        const float rstd = rsqrtf(wave_sum(qv) * (1.f / 512.f) + 1e-6f);
        float lg[8], lb[8], o[8]; ldf8(p.conv_ln_g + l * 512 + ch, lg); ldf8(p.conv_ln_b + l * 512 + ch, lb);
#pragma unroll
        for (int i = 0; i < 8; ++i) o[i] = siluf_(acc[i] * rstd * lg[i] + lb[i]);
        st8(Y + (size_t)row * D + ch, o); }
}
DI void phase_prep(Ctx& c, int l) {
    const Params& p = *c.p; const bf16* Z = (const bf16*)(c.ws + WS_Z); bf16* Y = (bf16*)(c.ws + WS_Y); const float* G32 = (const float*)(c.ws + WS_G32);
    float* SA = (float*)(c.ws + WS_S); float* SG = (float*)(c.ws + WS_SG);
    const int gw = c.bid * 8 + c.wave, NGW = c.G * 8; const int ch = c.lane * 8;
    { const float* mu = p.rw_mu + (size_t)l * 2 * RWMIX; bf16* XG = (bf16*)(c.ws + WS_XG);
      for (int it = c.bid * 512 + c.tid; it < MROWS * 32; it += c.G * 512) { const int row = it >> 5, k8 = it & 31; int base, len, tp; seq_of(row, base, len, tp);
        const bf16* zp = Z + (size_t)row * NZ + RWXG + k8 * 8; float x[8], pv[8], nx[8], m0[8], m1[8], f[8]; ld8(zp, x);
        if (tp > 0) ld8(zp - NZ, pv); else {
#pragma unroll
            for (int i = 0; i < 8; ++i) pv[i] = 0.f; }
        if (tp < len - 1) ld8(zp + NZ, nx); else {
#pragma unroll
            for (int i = 0; i < 8; ++i) nx[i] = 0.f; }
        ldf8(mu + 1728 + k8 * 8, m0); ldf8(mu + RWMIX + 1728 + k8 * 8, m1);
#pragma unroll
        for (int i = 0; i < 8; ++i) f[i] = sigmoidf_(x[i] + m0[i] * (pv[i] - x[i]) + m1[i] * (nx[i] - x[i]));
        st8(XG + (size_t)row * 256 + k8 * 8, f); } }
    REPS(6) for (int u = (c.bid + c.G - 128) % c.G; u < RW_NU; u += c.G) rwkv_local(c, l, u);
    __syncthreads();
    REPS(2) for (int u = c.bid; u < ML_NU; u += c.G) mlstm_local(c, l, u);
    REPS(3) for (int u = (c.bid + c.G - 64) % c.G; u < GD_NU; u += c.G) gdn_local(c, l, u);
    __syncthreads();
}


DI void phase_mid(Ctx& c, int l) {
    REPS(4) mlstm_prefix(c);
    REPS(5) { for (int u = c.bid; u < 128; u += c.G) gdn_prefix(c, u);
              for (int u = c.bid - 128; u < 128; u += c.G) if (u >= 0) rwkv_prefix(c, u); }
    if (c.G == 256) { if (c.bid >= 128) for (int u = c.bid - 128; u < MROWS / 34; u += 128) conv_unit(c, l, u); }
    else for (int u = c.bid; u < MROWS / 34; u += c.G) conv_unit(c, l, u);
    __syncthreads();
}
DI void phase_finish(Ctx& c, int l) {
    if (l == NL - 1) {
        for (int v = c.bid; v < NB * 4 * 64; v += c.G) mlstm_out(c, l, (v >> 8) * 272 + ((v >> 6) & 3) * 68 + 4 + (v & 63));
        for (int v = c.bid; v < NB * 4 * 64; v += c.G) gdn_out(c, l, (v >> 8) * 272 + ((v >> 6) & 3) * 68 + 4 + (v & 63));
        for (int v = c.bid; v < NB * 64 * 2; v += c.G) rwkv_out(c, l, (v >> 7) * 136 + (4 + ((v & 127) >> 1)) * 2 + (v & 1));
        __syncthreads(); return; }
    REPS(7) for (int u = c.bid; u < NB * 4 * 68; u += c.G) mlstm_out(c, l, u);
    REPS(8) for (int u = (c.bid + c.G - 32) % c.G; u < NB * 4 * 68; u += c.G) gdn_out(c, l, u);
    REPS(9) for (int u = (c.bid + c.G - 64) % c.G; u < NB * 68 * 2; u += c.G) rwkv_out(c, l, u);
    __syncthreads();
}
DI void phase_ffnconv(Ctx& c, int l) {
    const Params& p = *c.p; const bf16* UP = (const bf16*)(c.ws + WS_Z); bf16* H = (bf16*)(c.ws + WS_S); const float* w = p.ffn_dw + (size_t)l * 9 * DFF;
    constexpr int CPR = DFF / 8;
    for (int it = c.bid * 512 + c.tid; it < NB * 4 * 64 * CPR; it += c.G * 512) {
        const int cg = it % CPR; int r1 = it / CPR; const int gx = r1 & 63; r1 >>= 6; const int seg = r1 & 3, bb = r1 >> 2; const int ch = cg * 8, gy0 = seg * 16;
        u32x4 wv[9];
#pragma unroll
        for (int k = 0; k < 9; ++k) { float t8[8]; ldf8(w + k * DFF + ch, t8); wv[k] = pack8(t8); }
        const bf16* base = UP + (size_t)bb * T * (2 * DFF) + ch; const u32x4 z4 = {0u, 0u, 0u, 0u};
        u32x4 ring[6][3], vr[4];
#define FC_ROW(slot, j) do { const int yy = gy0 - 1 + (j); _Pragma("unroll") for (int dx = 0; dx < 3; ++dx) { const int xx = gx + dx - 1; \
            ring[slot][dx] = (yy >= 0 && yy < 64 && xx >= 0 && xx < 64) ? *(const u32x4*)(base + (size_t)(yy * 64 + xx) * (2 * DFF)) : z4; } } while (0)
#define FC_V(slot, dy_) do { vr[slot] = *(const u32x4*)(UP + ((size_t)bb * T + (gy0 + (dy_)) * 64 + gx) * (2 * DFF) + DFF + ch); } while (0)
        FC_ROW(0, 0); FC_ROW(1, 1); FC_ROW(2, 2); FC_ROW(3, 3); FC_ROW(4, 4); FC_V(0, 0); FC_V(1, 1); FC_V(2, 2);
#pragma unroll
        for (int dy = 0; dy < 16; ++dy) {
            if (dy + 5 < 18) FC_ROW((dy + 5) % 6, dy + 5);
            if (dy + 3 < 16) FC_V((dy + 3) % 4, dy + 3);
            const size_t row = (size_t)bb * T + (gy0 + dy) * 64 + gx; float acc[8];
#pragma unroll
            for (int i = 0; i < 8; ++i) acc[i] = 0.f;
#pragma unroll
            for (int k = 0; k < 3; ++k)
#pragma unroll
                for (int dx = 0; dx < 3; ++dx) { const u32x4 a = ring[(dy + k) % 6][dx];
#pragma unroll
                    for (int j = 0; j < 4; ++j) { const unsigned ww = wv[k * 3 + dx][j]; acc[2 * j] = fmaf(__uint_as_float(a[j] << 16), __uint_as_float(ww << 16), acc[2 * j]); acc[2 * j + 1] = fmaf(__uint_as_float(a[j] & 0xffff0000u), __uint_as_float(ww & 0xffff0000u), acc[2 * j + 1]); } }
            const u32x4 vw = vr[dy % 4]; float o[8];
#pragma unroll
            for (int j = 0; j < 4; ++j) { o[2 * j] = gelu_tanh(acc[2 * j]) * __uint_as_float(vw[j] << 16); o[2 * j + 1] = gelu_tanh(acc[2 * j + 1]) * __uint_as_float(vw[j] & 0xffff0000u); }
            st8(H + row * DFF + ch, o); asm volatile("" ::: "memory"); }
#undef FC_ROW
#undef FC_V
    }
    if (l < NL - 1) for (int it = c.bid * 512 + c.tid; it < NB * TC * CPR; it += c.G * 512) {
        const int row = LAT + it / CPR, ch = (it % CPR) * 8; float acc[8];
#pragma unroll
        for (int i = 0; i < 8; ++i) acc[i] = 0.f;
        const int t = (row - LAT) & (TC - 1);
#pragma unroll
        for (int dx = 0; dx < 3; ++dx) { const int tt = t + dx - 1; if (tt < 0 || tt >= TC) continue;
            float a[8], wv[8]; ld8(UP + (size_t)(row + dx - 1) * (2 * DFF) + ch, a); ldf8(w + (3 + dx) * DFF + ch, wv);
#pragma unroll
            for (int i = 0; i < 8; ++i) acc[i] = fmaf(a[i], wv[i], acc[i]); }
        float v[8], o[8]; ld8(UP + (size_t)row * (2 * DFF) + DFF + ch, v);
#pragma unroll
        for (int i = 0; i < 8; ++i) o[i] = gelu_tanh(acc[i]) * v[i];
        st8(H + (size_t)row * DFF + ch, o);
    }
}

constexpr int PH_PRO = 3, PH_PER_LAYER = 11, NPHASE = PH_PRO + NL * PH_PER_LAYER;
#ifndef MK_PER_PHASE
#define MK_PER_PHASE 0
#endif
#ifndef DUP_MASK
#define DUP_MASK 0u
#endif
#define REP(ty) for (int rep_ = 0; rep_ < ((((DUP_MASK) >> (ty)) & 1u) ? 2 : 1); ++rep_)
#ifndef PROBE_MASK
#define PROBE_MASK 0u
#endif
constexpr int CW_BAR = 4096;

__global__ void __launch_bounds__(512, 2) fwd_kernel(Params p) {
    extern __shared__ __attribute__((aligned(16))) unsigned char lds_raw[];
    Ctx c; c.lds = (LAS unsigned char*)lds_raw; c.tid = threadIdx.x; c.lane = c.tid & 63; c.wave = __builtin_amdgcn_readfirstlane(c.tid >> 6); asm volatile("" : "+s"(c.wave));     c.G = gridDim.x; c.bid = blockIdx.x; c.p = &p; c.ws = p.ws;
    volatile LAS unsigned* MISC = (volatile LAS unsigned*)(c.lds + LDS_MISC);
    if (c.tid < 32) MISC[c.tid] = 0u;
    __syncthreads();
    const int lo = MK_PER_PHASE ? p.ph_lo : 0, hi = MK_PER_PHASE ? p.ph_hi : NPHASE;
    XcdBarrier bar; bar.bar = (unsigned*)(p.ws + WS_CTL) + CW_BAR; bar.x = 0; bar.st = MISC + 8;
    if (hi - lo > 1) bar = xcd_barrier_post((unsigned*)(p.ws + WS_CTL) + CW_BAR, MISC + 8);
#ifndef PH_MASK
#define PH_MASK 0xFFFFFFFFu
#endif
#define IN(k) (lo <= (k) && (k) < hi)
#define EN(b) ((PH_MASK >> (b)) & 1u)
#define RF() do { asm volatile("" : "+s"(c.wave)); int t_ = pg8::lane_id_hw(); c.lane = t_; c.tid = c.wave * 64 + t_; int b_ = blockIdx.x; asm volatile("" : "+s"(b_)); c.bid = b_; unsigned long long w_ = (unsigned long long)p.ws; asm volatile("" : "+s"(w_)); c.ws = (unsigned char*)(GAS unsigned char*)w_; } while (0)
#define SEAM(k) do { if (IN((k) + 1)) xcd_barrier(bar, c.wave); } while (0)
    unsigned long long tp_ = PROBE_MASK ? __builtin_amdgcn_s_memrealtime() : 0ull; unsigned pacc_ = 0u;
#define STAMP(ty) do { if (PROBE_MASK) { const unsigned long long tn_ = __builtin_amdgcn_s_memrealtime(); if ((PROBE_MASK >> (ty)) & 1u) pacc_ += (unsigned)(tn_ - tp_); tp_ = tn_; } } while (0)
    if (EN(0) && IN(0)) { REP(0) { RF(); phase_pro0(c); } SEAM(0); STAMP(0); }
    if (EN(1) && IN(1)) { REP(1) { RF(); phase_pro1(c); } SEAM(1); STAMP(1); }
    if (EN(2) && IN(2)) { REP(2) { RF(); phase_pro2(c); phase_wconv(c, 0); } SEAM(2); STAMP(2); }
#define U ((bf16*)(c.ws + WS_U))
#define Y ((bf16*)(c.ws + WS_Y))
#define MB ((bf16*)(c.ws + WS_MB))
#define G32 ((float*)(c.ws + WS_G32))
#define F ((float*)(c.ws + WS_F))
#define Z ((bf16*)(c.ws + WS_Z))
#define H ((bf16*)(c.ws + WS_S))
    for (int l = 0; l < NL; ++l) {
        const int pb = PH_PRO + l * PH_PER_LAYER;
#define wl (c.ws + WS_W)
        if (EN(3) && IN(pb + 0)) { RF(); pg8::Gemm g{U, (const bf16*)(wl + WL_IN), D, D, D}; pg8::StdOrder S; S.init(MROWS / 256, NZ / 256, c.G, c.bid); pg8::EpiBf16 E{Z, NZ, G32, (ZSM - 192) / 256, (bf16*)(c.ws + WS_GT), ZG / 256};
            REP(3) pg8::gemm_phase(c.lds, g, S, E, c.wave); SEAM(pb + 0); STAMP(3); }
        if (EN(4) && IN(pb + 1)) { REP(4) { RF(); phase_prep(c, l); } SEAM(pb + 1); STAMP(4); }
        if (EN(5) && IN(pb + 2)) { REP(5) { RF(); phase_mid(c, l); }
            { RF(); pg8::Gemm g{(const bf16*)(c.ws + WS_XG), (const bf16*)(wl + WL_LORA) + (size_t)4 * 512 * 96, 256, 256, 256}; pg8::StdOrder S; S.init(MROWS / 256, 2, c.G, c.G - 1 - c.bid);
              pg8::EpiF32 E{(float*)(c.ws + WS_S) + (size_t)SA_RG * MROWS * 512, 512}; REPS(1) pg8::gemm_phase(c.lds, g, S, E, c.wave); }
            SEAM(pb + 2); STAMP(5); }
        if (EN(7) && IN(pb + 3)) { REP(7) { RF(); phase_finish(c, l); } SEAM(pb + 3); STAMP(7); }
        if (EN(8) && IN(pb + 4)) { RF(); pg8::Gemm g{Y, (const bf16*)(wl + WL_BR), D, MIXW, MIXW}; pg8::MergeOrder S; S.init2(c.G, c.bid, l < NL - 1); pg8::EpiMerge E{(const bf16*)(c.ws + WS_GT), MB, D, (bf16*)(c.ws + WS_MBC)};
            REP(8) pg8::gemm_phase(c.lds, g, S, E, c.wave); SEAM(pb + 4); STAMP(8); }
        if (EN(9) && IN(pb + 5)) { RF(); pg8::Gemm g{MB, (const bf16*)(wl + WL_OUT), D, D, D}; pg8::SplitOrder S; S.init2(D / 256, c.G, c.bid, l < NL - 1 ? 16 : 0, 512, (const bf16*)(c.ws + WS_MBC), 2048); pg8::EpiMixSplit E{(bf16*)F, (float*)(c.ws + WS_PART), D};
            REP(9) pg8::gemm_phase(c.lds, g, S, E, c.wave); SEAM(pb + 5); STAMP(9); }
        if (EN(10) && IN(pb + 6)) { REP(10) { RF(); phase_resid(c, l, 0); } SEAM(pb + 6); STAMP(10); }
        if (EN(11) && IN(pb + 7)) { RF(); pg8::Gemm g{U, (const bf16*)(wl + WL_UP), D, D, D}; pg8::StdOrder S; S.init(l < NL - 1 ? MROWS / 256 : LAT / 256, 2 * DFF / 256, c.G, c.bid); pg8::EpiBf16 E{Z, 2 * DFF, nullptr, -1, nullptr, 0};
            REP(11) pg8::gemm_phase(c.lds, g, S, E, c.wave); SEAM(pb + 7); STAMP(11); }
        if (EN(12) && IN(pb + 8)) { REP(12) { RF(); phase_ffnconv(c, l); } SEAM(pb + 8); STAMP(12); }
        if (EN(13) && IN(pb + 9)) { RF(); pg8::Gemm g{H, (const bf16*)(wl + WL_DN), DFF, DFF, DFF}; pg8::SplitOrder S; S.init2(D / 256, c.G, c.bid, l < NL - 1 ? 11 : 0, 512); pg8::EpiMixSplit E{(bf16*)F, (float*)(c.ws + WS_PART), D};
            REP(13) pg8::gemm_phase(c.lds, g, S, E, c.wave); SEAM(pb + 9); STAMP(13); }
        if (EN(14) && IN(pb + 10)) { REP(14) { RF(); phase_resid(c, l, 1); if (l + 1 < NL) phase_wconv(c, l + 1); } SEAM(pb + 10); STAMP(14); }
    }
    if (PROBE_MASK) { asm volatile("s_waitcnt vmcnt(0)" ::: "memory"); __syncthreads(); if (c.bid == 0 && threadIdx.x == 0) p.out[0] += (float)pacc_ * 1e-4f;     }
#undef IN
#undef SEAM
#undef U
#undef Y
#undef MB
#undef G32
#undef F
#undef Z
#undef H
#undef wl
}

extern "C" void kernel_launch(void* const* d_in, const int* in_sizes, int n_in, void* d_out, int out_size, void* d_ws, size_t ws_size, hipStream_t stream) {
    static int grid = 0;
    if (grid == 0) {
        if (n_in != 34 || ws_size < WS_END) { fprintf(stderr, "kernel_launch: unexpected n_in %d / ws %zu (need %zu)\n", n_in, ws_size, (size_t)WS_END); grid = -1; return; }
        int dev = 0, cus = 0;
        if (hipGetDevice(&dev) != hipSuccess || hipDeviceGetAttribute(&cus, hipDeviceAttributeMultiprocessorCount, dev) != hipSuccess) { grid = -1; return; }
        if (hipFuncSetAttribute((const void*)fwd_kernel, hipFuncAttributeMaxDynamicSharedMemorySize, LDS_BYTES) != hipSuccess) { fprintf(stderr, "kernel_launch: hipFuncSetAttribute failed\n"); grid = -1; return; }
        int per_cu = 0;
        if (hipOccupancyMaxActiveBlocksPerMultiprocessor(&per_cu, (const void*)fwd_kernel, 512, LDS_BYTES) != hipSuccess || per_cu < 1) { fprintf(stderr, "kernel_launch: occupancy query says %d\n", per_cu); }
        (void)hipGetLastError();
        grid = cus;
    }
    if (grid < 0) return;
    (void)hipMemsetAsync((char*)d_ws + WS_CTL, 0, 32768, stream);
    Params p{};
    const float** pp = (const float**)&p;
    for (int i = 0; i < 34; ++i) pp[i] = (const float*)d_in[i];
    p.out = (float*)d_out; p.ws = (unsigned char*)d_ws;
#if MK_PER_PHASE
    for (int k = 0; k < NPHASE; ++k) { p.ph_lo = k; p.ph_hi = k + 1; hipLaunchKernelGGL(fwd_kernel, dim3(grid), dim3(512), LDS_BYTES, stream, p); }
#else
    p.ph_lo = 0; p.ph_hi = NPHASE; hipLaunchKernelGGL(fwd_kernel, dim3(grid), dim3(512), LDS_BYTES, stream, p);
#endif
}
```

```cpp
#include <hip/hip_runtime.h>
#include <cstdio>
#include <cstdint>

#ifndef DUP_SUB
#define DUP_SUB 0u
#endif
#define REPS(b) for (int reps_ = 0; reps_ < ((((DUP_SUB) >> (b)) & 1u) ? 2 : 1); ++reps_)
#define GAS __attribute__((address_space(1)))
#define LAS __attribute__((address_space(3)))
#define DI __device__ __forceinline__
typedef unsigned short bf16;
typedef float f32x4 __attribute__((ext_vector_type(4)));
typedef float f32x2 __attribute__((ext_vector_type(2)));
typedef unsigned u32x4 __attribute__((ext_vector_type(4)));
typedef unsigned u32x2 __attribute__((ext_vector_type(2)));
typedef short bf16x8 __attribute__((ext_vector_type(8)));

constexpr int D = 2048, NB = 2, T = 4096, TC = 256, NL = 4;
constexpr int LAT = NB * T;
constexpr int MROWS = LAT + NB * TC;
constexpr int MIXW = 512, DFF = 5632;
constexpr int NIN = 15328, NZ = 15360;
constexpr int ZA = 0, ZAG = 512, MLQ = 1024, MLK = 1536, MLV = 2048, MLO = 2560, GDQ = 3072, GDK = 3584, GDV = 4096, GDZ = 4608;
constexpr int RWR = 5120, RWK = 5632, RWV = 6144, RWXW = 6656, RWXA = 6752, RWXG = 6848, ZSM = 7104, ZG = 7168;
constexpr int RWMIX = 1984;

namespace pg8 {
typedef unsigned short bf16_t;
constexpr int BM = 256, BK = 64, HALF = 128, HTB = HALF * BK * 2, STAGE_BYTES = 8 * HTB, NXCD = 8, WGM = 8;
__host__ __device__ __forceinline__ int lds_byte(int r, int c) { const int st = (r >> 4) * 2 + (c >> 5), rr = r & 15, cc = c & 31, ob = rr * 64 + cc * 2; return st * 1024 + (ob ^ (((ob >> 9) & 1) << 5)); }
__host__ __device__ __forceinline__ void stage_rc(int b, int& R, int& C) { const int st = b / 1024, sb = b % 1024, swz = sb ^ (((sb >> 9) & 1) << 5); R = (st >> 1) * 16 + swz / 64; C = (st & 1) * 32 + (swz % 64) / 2; }
__host__ __device__ __forceinline__ int perm32(int rho) { const int n = rho >> 4, i = rho & 15; return 8 * (i >> 2) + 4 * n + (i & 3); }

struct Unit { int pm, pn, sub; };
struct Gemm { const bf16_t* A; const bf16_t* Bt; int lda, ldb, K; };

struct StdOrder {
    int nM, nN, nwg, G, c;
    DI void init(int nM_, int nN_, int G_, int c_) { nM = nM_; nN = nN_; nwg = nM * nN; G = G_; c = c_; }
    DI bool map(int i, Unit& u) const {
        const long L = (long)i * G + c; if (L >= nwg) return false;
        int wgid = (int)L; { const int q = nwg / NXCD, r = nwg % NXCD, xcd = wgid % NXCD, off = wgid / NXCD; wgid = (xcd < r ? xcd * (q + 1) : r * (q + 1) + (xcd - r) * q) + off; }
        const int nig = WGM * nN, gid = wgid / nig, fm = gid * WGM, gsz = (nM - fm) < WGM ? (nM - fm) : WGM;
        u.pm = fm + ((wgid % nig) % gsz); u.pn = (wgid % nig) / gsz; return true;
    }
    DI bool next(int i, Unit& u) const { u.sub = 0; return map(i, u); }
    DI const char* a_ptr(const Gemm& g, const Unit& u) const { return (const char*)g.A + (size_t)u.pm * BM * g.lda * 2; }
    DI const char* b_ptr(const Gemm& g, const Unit& u) const { return (const char*)g.Bt + (size_t)u.pn * BM * g.ldb * 2; }
    DI int ntiles(const Gemm& g, const Unit&) const { return g.K / BK; }
};
struct MergeOrder : StdOrder {
    int nctx;
    DI void init2(int G_, int c_, bool with_ctx) { init(32, 8, G_, c_); nctx = with_ctx ? 64 : 0; }
    DI bool next(int i4, Unit& u) const {
        if (i4 < 4) { u.sub = i4; return map(0, u); }
        const int j = c + (i4 - 4) * G; if (j >= nctx) return false;
        const int cu = j >> 2; u.sub = 4 + (j & 3); u.pm = 32 + (cu >> 3); u.pn = cu & 7; return true; }
    DI const char* a_ptr(const Gemm& g, const Unit& u) const { return (const char*)g.A + (size_t)u.pm * BM * g.lda * 2 + (size_t)(u.sub & 3) * 512 * 2; }
    DI const char* b_ptr(const Gemm& g, const Unit& u) const { return (const char*)g.Bt + ((size_t)(u.sub & 3) * 2048 + (size_t)u.pn * BM) * g.ldb * 2; }
    DI int ntiles(const Gemm& g, const Unit&) const { return g.K / BK; }
};
struct SplitOrder : StdOrder {
    int SK, KS; const bf16_t* Actx; int kwrap;
    DI void init2(int nN_, int G_, int c_, int SK_, int KS_, const bf16_t* Actx_ = nullptr, int kwrap_ = 0) { init(32, nN_, G_, c_); SK = SK_; KS = KS_; Actx = Actx_; kwrap = kwrap_; }
    DI bool next(int i, Unit& u) const {
        if (i == 0) { u.sub = 0; if (map(0, u)) return true; }
        const int j = c + (i - 1) * G; if (i < 1 || j >= 2 * nN * SK) return false;
        const int cu = j / SK; u.sub = 1 + j % SK; u.pm = 32 + cu / nN; u.pn = cu % nN; return true; }
    DI const char* a_ptr(const Gemm& g, const Unit& u) const {
        if (u.sub && Actx) { const int kk = (u.sub - 1) * KS; return (const char*)Actx + ((size_t)(kk / kwrap) * 512 + (size_t)(u.pm - 32) * BM) * g.lda * 2 + (size_t)(kk % kwrap) * 2; }
        return (const char*)g.A + (size_t)u.pm * BM * g.lda * 2 + (u.sub ? (size_t)(u.sub - 1) * KS * 2 : 0); }
    DI const char* b_ptr(const Gemm& g, const Unit& u) const { const int kk = u.sub ? (u.sub - 1) * KS : 0; return (const char*)g.Bt + (size_t)u.pn * BM * g.ldb * 2 + (size_t)(kwrap ? kk % kwrap : kk) * 2; }
    DI int ntiles(const Gemm& g, const Unit& u) const { return u.sub ? KS / BK : g.K / BK; }
};
DI int lane_id_hw() { int l; asm volatile("v_mbcnt_lo_u32_b32 %0, -1, 0\n\tv_mbcnt_hi_u32_b32 %0, -1, %0" : "=v"(l)); return l; }
DI unsigned cvt_pk_bf16(float lo, float hi) { unsigned r; asm volatile("v_cvt_pk_bf16_f32 %0, %1, %2" : "=v"(r) : "v"(lo), "v"(hi)); return r; }

struct EpiF32 {
    static constexpr bool PERM = false; DI bool keep(const Unit&) const { return false; }
    float* C; int ldc;
    DI void operator()(const f32x4 (&acc)[2][2][4][2], const Unit& u, int wr, int wc, int fr, int fq) const {
        const int row0 = u.pm * BM + wr * 64 + fr, col0 = u.pn * BM + wc * 32 + 4 * fq;
#pragma unroll
        for (int ai = 0; ai < 2; ++ai)
#pragma unroll
            for (int m = 0; m < 4; ++m) { float* rowp = C + (size_t)(row0 + ai * HALF + m * 16) * ldc + col0;
#pragma unroll
                for (int bj = 0; bj < 2; ++bj)
#pragma unroll
                    for (int n = 0; n < 2; ++n) *(f32x4*)(rowp + bj * HALF + n * 16) = acc[ai][bj][m][n]; }
    }
};
struct EpiF32Split {
    static constexpr bool PERM = false; DI bool keep(const Unit&) const { return false; }
    float* C; float* PART; int ldc;
    DI void operator()(const f32x4 (&acc)[2][2][4][2], const Unit& u, int wr, int wc, int fr, int fq) const {
        float* base = u.sub ? PART + ((long)(u.sub - 1) * 512 - 8192) * (long)ldc : C;
        const int row0 = u.pm * BM + wr * 64 + fr, col0 = u.pn * BM + wc * 32 + 4 * fq;
#pragma unroll
        for (int ai = 0; ai < 2; ++ai)
#pragma unroll
            for (int m = 0; m < 4; ++m) { float* rowp = base + (size_t)(row0 + ai * HALF + m * 16) * ldc + col0;
#pragma unroll
                for (int bj = 0; bj < 2; ++bj)
#pragma unroll
                    for (int n = 0; n < 2; ++n) *(f32x4*)(rowp + bj * HALF + n * 16) = acc[ai][bj][m][n]; }
    }
};
struct EpiMixSplit {
    static constexpr bool PERM = true; DI bool keep(const Unit&) const { return false; }
    bf16_t* Fh; float* PART; int ldc;
    DI void operator()(const f32x4 (&acc)[2][2][4][2], const Unit& u, int wr, int wc, int fr, int fq) const {
        const int row0 = u.pm * BM + wr * 64 + fr, col0 = u.pn * BM + wc * 32 + 8 * fq;
        float* pb = PART + ((long)(u.sub - 1) * 512 - 8192) * (long)ldc;
#pragma unroll
        for (int ai = 0; ai < 2; ++ai)
#pragma unroll
            for (int m = 0; m < 4; ++m) { const size_t ro = (size_t)(row0 + ai * HALF + m * 16) * ldc + col0;
#pragma unroll
                for (int bj = 0; bj < 2; ++bj) { const f32x4 v0 = acc[ai][bj][m][0], v1 = acc[ai][bj][m][1];
                    if (u.sub) { *(f32x4*)(pb + ro + bj * HALF) = v0; *(f32x4*)(pb + ro + bj * HALF + 4) = v1; }
                    else { u32x4 w; w.x = cvt_pk_bf16(v0[0], v0[1]); w.y = cvt_pk_bf16(v0[2], v0[3]); w.z = cvt_pk_bf16(v1[0], v1[1]); w.w = cvt_pk_bf16(v1[2], v1[3]); *(u32x4*)(Fh + ro + bj * HALF) = w; } } }
    }
};
struct EpiBf16 {
    static constexpr bool PERM = true; DI bool keep(const Unit&) const { return false; }
    bf16_t* O; int ldc; float* G32; int gtile; bf16_t* GT; int gt0;
    DI void operator()(const f32x4 (&acc)[2][2][4][2], const Unit& u, int wr, int wc, int fr, int fq) const {
        const int row0 = u.pm * BM + wr * 64 + fr; const int col0 = u.pn * BM + wc * 32 + 8 * fq;
#pragma unroll
        for (int ai = 0; ai < 2; ++ai)
#pragma unroll
            for (int m = 0; m < 4; ++m) { const int row = row0 + ai * HALF + m * 16; bf16_t* rowp = O + (size_t)row * ldc + col0;
#pragma unroll
                for (int bj = 0; bj < 2; ++bj) { f32x4 v0 = acc[ai][bj][m][0], v1 = acc[ai][bj][m][1];
                    if (GT != nullptr && u.pn >= gt0) {
#pragma unroll
                        for (int j = 0; j < 4; ++j) { v0[j] = fmaxf(__builtin_amdgcn_rcpf(1.f + __expf(-v0[j])), 1e-13f); v1[j] = fmaxf(__builtin_amdgcn_rcpf(1.f + __expf(-v1[j])), 1e-13f); }
                        u32x4 w; w.x = cvt_pk_bf16(v0[0], v0[1]); w.y = cvt_pk_bf16(v0[2], v0[3]); w.z = cvt_pk_bf16(v1[0], v1[1]); w.w = cvt_pk_bf16(v1[2], v1[3]);
                        *(u32x4*)(GT + ((size_t)(u.pm * 32 + (u.pn - gt0)) << 16) + (wr * 64 + fr + ai * HALF + m * 16) * 256 + wc * 32 + 8 * fq + bj * HALF) = w; continue; }
                    u32x4 w; w.x = cvt_pk_bf16(v0[0], v0[1]); w.y = cvt_pk_bf16(v0[2], v0[3]); w.z = cvt_pk_bf16(v1[0], v1[1]); w.w = cvt_pk_bf16(v1[2], v1[3]);
                    *(u32x4*)(rowp + bj * HALF) = w;
                    if (bj == 1 && G32 != nullptr && u.pn == gtile && wc == 2) { float* gp = G32 + (size_t)row * 32 + 8 * fq; *(f32x4*)gp = v0; *(f32x4*)(gp + 4) = v1; } } }
    }
};
struct EpiMerge {
    static constexpr bool PERM = true;
    const bf16_t* GT; bf16_t* Mb; int ldc; bf16_t* Mbc;
    DI bool keep(const Unit& u) const { return u.sub < 3; }
    DI void operator()(f32x4 (&acc)[2][2][4][2], const Unit& u, int wr, int wc, int fr, int fq) const {
        const int nb = u.sub & 3; const bool lastb = u.sub >= 3; bf16_t* dst = u.sub >= 4 ? Mbc + ((long)nb * 512 - 8192) * (long)ldc : Mb;
        const int row0 = u.pm * BM + wr * 64 + fr; const int col0 = u.pn * BM + wc * 32 + 8 * fq;
#pragma unroll
        for (int a2 = 0; a2 < 4; ++a2) { const int ai = a2 >> 1, mb = (a2 & 1) * 2;
            u32x4 ga[4][2], gb[4][2];
#pragma unroll
            for (int m = mb; m < mb + 2; ++m)
#pragma unroll
                for (int bj = 0; bj < 2; ++bj) { const bf16_t* gp = GT + ((size_t)(u.pm * 32 + nb * 8 + u.pn) << 16) + (wr * 64 + fr + ai * HALF + m * 16) * 256 + wc * 32 + 8 * fq + bj * HALF;
                    ga[m][bj] = *(const u32x4*)gp; gb[m][bj] = lastb ? ga[m][bj] : *(const u32x4*)(gp + ((size_t)8 << 16)); }
#pragma unroll
            for (int m = mb; m < mb + 2; ++m) { const int row = row0 + ai * HALF + m * 16;
#pragma unroll
                for (int bj = 0; bj < 2; ++bj) { const int col = col0 + bj * HALF;
                    float sc[8];
#pragma unroll
                    for (int j = 0; j < 4; ++j) { const float a0 = __uint_as_float(ga[m][bj][j] << 16), a1 = __uint_as_float(ga[m][bj][j] & 0xffff0000u);
                        sc[2 * j] = lastb ? a0 : a0 * __builtin_amdgcn_rcpf(__uint_as_float(gb[m][bj][j] << 16)); sc[2 * j + 1] = lastb ? a1 : a1 * __builtin_amdgcn_rcpf(__uint_as_float(gb[m][bj][j] & 0xffff0000u)); }
                    f32x4& v0 = acc[ai][bj][m][0]; f32x4& v1 = acc[ai][bj][m][1];
#pragma unroll
                    for (int j = 0; j < 4; ++j) { v0[j] *= sc[j]; v1[j] *= sc[4 + j]; }
                    if (lastb) { u32x4 w; w.x = cvt_pk_bf16(v0[0], v0[1]); w.y = cvt_pk_bf16(v0[2], v0[3]); w.z = cvt_pk_bf16(v1[0], v1[1]); w.w = cvt_pk_bf16(v1[2], v1[3]);
                        *(u32x4*)(dst + (size_t)row * ldc + col) = w; } } } }
    }
};

template <class Epi, class Sched>
DI void gemm_phase(LAS unsigned char* lds, const Gemm g, const Sched& S, const Epi& E, int wave_id) {
    int tid_ = wave_id * 64 + lane_id_hw(); asm volatile("" : "+v"(tid_));
    const int tid = tid_, wid = wave_id, lane = tid & 63, wr = wid >> 2, wc = wid & 3, fr = lane & 15, fq = lane >> 4;
    unsigned voffA[2], voffB[2];
#pragma unroll
    for (int i = 0; i < 2; ++i) { int R, C; stage_rc(tid * 16 + i * 8192, R, C); const int Rb = Epi::PERM ? ((R & ~31) + perm32(R & 31)) : R;
        voffA[i] = (unsigned)(R * g.lda + C) * 2u; voffB[i] = (unsigned)(Rb * g.ldb + C) * 2u; }
    const size_t kstep = (size_t)(BK * 2);
    const size_t hstepA = (size_t)HALF * g.lda * 2, hstepB = (size_t)HALF * g.ldb * 2;
    const unsigned ldsw = (unsigned)wid * 1024u;
    const int aoff = lds_byte(wr * 64 + fr, fq * 8), boff = lds_byte(wc * 32 + fr, fq * 8);
#define PG8_SA(b, h) (((b) * 2 + (h)) * HTB)
#define PG8_SB(b, h) ((4 + (b) * 2 + (h)) * HTB)
#define PG8_STAGE(bufoff, gbase, voff) do { _Pragma("unroll") for (int _i = 0; _i < 2; ++_i) \
        __builtin_amdgcn_global_load_lds((const unsigned*)((const char*)(gbase) + (voff)[_i]), (LAS unsigned*)(lds + (bufoff) + ldsw + _i * 8192), 16, 0, 0); } while (0)
#define PG8_LDA(dst, b, h) do { _Pragma("unroll") for (int m = 0; m < 4; ++m) _Pragma("unroll") for (int k = 0; k < 2; ++k) dst[m][k] = *(const LAS bf16x8*)(lds + PG8_SA(b, h) + aoff + m * 2048 + k * 1024); } while (0)
#define PG8_LDB(dst, b, h) do { _Pragma("unroll") for (int n = 0; n < 2; ++n) _Pragma("unroll") for (int k = 0; k < 2; ++k) dst[n][k] = *(const LAS bf16x8*)(lds + PG8_SB(b, h) + boff + n * 2048 + k * 1024); } while (0)
#define PG8_MMA(ai, bj, At, Bt) do { __builtin_amdgcn_s_setprio(1); _Pragma("unroll") for (int m = 0; m < 4; ++m) _Pragma("unroll") for (int n = 0; n < 2; ++n) _Pragma("unroll") for (int k = 0; k < 2; ++k) \
        acc[ai][bj][m][n] = __builtin_amdgcn_mfma_f32_16x16x32_bf16(Bt[n][k], At[m][k], acc[ai][bj][m][n], 0, 0, 0); __builtin_amdgcn_s_setprio(0); } while (0)
#define PG8_WAIT_V(n) asm volatile("s_waitcnt vmcnt(" #n ")" ::: "memory")
#define PG8_WAIT_L(n) asm volatile("s_waitcnt lgkmcnt(" #n ")" ::: "memory")
#define PG8_BAR __builtin_amdgcn_s_barrier()
#define PG8_SCHED __builtin_amdgcn_sched_barrier(0)
    Unit cur, nxt; int ui = 0;
    if (!S.next(0, cur)) return;
    f32x4 acc[2][2][4][2];
#pragma unroll
    for (int a = 0; a < 2; ++a)
#pragma unroll
        for (int b = 0; b < 2; ++b)
#pragma unroll
            for (int m = 0; m < 4; ++m)
#pragma unroll
                for (int n = 0; n < 2; ++n) acc[a][b][m][n] = (f32x4){0.f, 0.f, 0.f, 0.f};
    bf16x8 At[4][2], B0[2][2], B1[2][2];
    const char* cA = S.a_ptr(g, cur); const char* cB = S.b_ptr(g, cur);
    PG8_STAGE(PG8_SB(0, 0), cB, voffB); PG8_STAGE(PG8_SB(0, 1), cB + hstepB, voffB); PG8_STAGE(PG8_SA(0, 0), cA, voffA); PG8_STAGE(PG8_SA(0, 1), cA + hstepA, voffA);
    if (wr == 1) PG8_BAR;
    PG8_WAIT_V(2); PG8_BAR;
    PG8_STAGE(PG8_SB(1, 0), cB + kstep, voffB); PG8_STAGE(PG8_SA(1, 0), cA + kstep, voffA); PG8_STAGE(PG8_SB(1, 1), cB + hstepB + kstep, voffB);
    PG8_WAIT_V(6); PG8_BAR;
    for (;;) {
        const bool has_next = S.next(ui + 1, nxt);
        const char* nA = has_next ? S.a_ptr(g, nxt) : cA; const char* nB = has_next ? S.b_ptr(g, nxt) : cB;
        const int nt = S.ntiles(g, cur);
        for (int t = 0; t < nt; t += 2) {
            const bool last = (t == nt - 2);
            const char* a1 = cA + (size_t)(t + 1) * kstep;
            const char* a2 = last ? nA : cA + (size_t)(t + 2) * kstep; const char* b2 = last ? nB : cB + (size_t)(t + 2) * kstep;
            const char* a3 = a2 + kstep; const char* b3 = b2 + kstep;
            PG8_LDB(B0, 0, 0); PG8_LDB(B1, 0, 1); PG8_SCHED; PG8_LDA(At, 0, 0); PG8_STAGE(PG8_SA(1, 1), a1 + hstepA, voffA);
            PG8_WAIT_V(8); PG8_WAIT_L(0); PG8_BAR; PG8_MMA(0, 0, At, B0); PG8_MMA(0, 1, At, B1); PG8_BAR; PG8_SCHED;
            PG8_LDA(At, 0, 1); PG8_STAGE(PG8_SB(0, 0), b2, voffB); PG8_STAGE(PG8_SB(0, 1), b2 + hstepB, voffB); PG8_STAGE(PG8_SA(0, 0), a2, voffA);
            PG8_WAIT_V(8); PG8_WAIT_L(0); PG8_BAR; PG8_MMA(1, 0, At, B0); PG8_MMA(1, 1, At, B1); PG8_BAR; PG8_SCHED;
            PG8_LDB(B0, 1, 0); PG8_LDB(B1, 1, 1); PG8_SCHED; PG8_LDA(At, 1, 0); PG8_STAGE(PG8_SA(0, 1), a2 + hstepA, voffA);
            PG8_WAIT_V(8); PG8_WAIT_L(0); PG8_BAR; PG8_MMA(0, 0, At, B0); PG8_MMA(0, 1, At, B1); PG8_BAR; PG8_SCHED;
            PG8_LDA(At, 1, 1); PG8_STAGE(PG8_SB(1, 0), b3, voffB); PG8_STAGE(PG8_SB(1, 1), b3 + hstepB, voffB); PG8_STAGE(PG8_SA(1, 0), a3, voffA);
            PG8_WAIT_V(8); PG8_WAIT_L(0); PG8_BAR; PG8_MMA(1, 0, At, B0); PG8_MMA(1, 1, At, B1); PG8_BAR; PG8_SCHED;
        }
        if (wr == 0) PG8_BAR;
        { const int le = lane_id_hw(); E(acc, cur, wr, wc, le & 15, le >> 4); }
        if (!has_next) break;
        if (!E.keep(cur)) {
#pragma unroll
        for (int a = 0; a < 2; ++a)
#pragma unroll
            for (int b = 0; b < 2; ++b)
#pragma unroll
                for (int m = 0; m < 4; ++m)
#pragma unroll
                    for (int n = 0; n < 2; ++n) acc[a][b][m][n] = (f32x4){0.f, 0.f, 0.f, 0.f}; }
        cur = nxt; cA = nA; cB = nB; ++ui;
        if (wr == 1) PG8_BAR;
    }
    PG8_WAIT_V(0);
    PG8_BAR;
#undef PG8_SA
#undef PG8_SB
#undef PG8_STAGE
#undef PG8_LDA
#undef PG8_LDB
#undef PG8_MMA
#undef PG8_WAIT_V
#undef PG8_WAIT_L
#undef PG8_BAR
#undef PG8_SCHED
}
}

constexpr size_t al256(size_t x) { return (x + 255) & ~(size_t)255; }
constexpr size_t WS_CTL = 0, CTL_BYTES = 1u << 20;
constexpr size_t WS_MODP = WS_CTL + CTL_BYTES;
constexpr size_t WS_MOD = WS_MODP + al256((size_t)NL * 8 * 3 * 12288 * 4);
constexpr size_t WS_W = WS_MOD + al256((size_t)NL * 3 * 12288 * 4);
constexpr size_t WL_IN = 0, WL_BR = WL_IN + (size_t)NZ * D * 2, WL_OUT = WL_BR + (size_t)4 * D * MIXW * 2, WL_UP = WL_OUT + (size_t)D * D * 2,
                 WL_DN = WL_UP + (size_t)2 * DFF * D * 2, WL_LORA = WL_DN + (size_t)D * DFF * 2, WL_SIZE = WL_LORA + (size_t)(4 * 512 * 96 + 512 * 256) * 2;
constexpr size_t WS_U = WS_W + WL_SIZE;
constexpr size_t WS_Y = WS_U + (size_t)MROWS * D * 2;
constexpr size_t WS_MB = WS_Y + (size_t)MROWS * D * 2;
constexpr size_t WS_G32 = WS_MB + (size_t)MROWS * D * 2;
constexpr size_t WS_X = WS_G32 + (size_t)MROWS * 32 * 4;
constexpr size_t WS_F = WS_X + (size_t)MROWS * D * 4;
constexpr size_t WS_Z = WS_F + (size_t)MROWS * D * 4;
constexpr size_t WS_S = WS_Z + (size_t)MROWS * NZ * 2;
constexpr size_t SARR = (size_t)MROWS * MIXW * 4;
constexpr int N_SARR = 6;
constexpr size_t WS_SG = WS_S + N_SARR * SARR;
constexpr size_t WS_ML = WS_SG + (size_t)MROWS * 16 * 4;
constexpr int ML_US = 16640, ML_NL = 16384, ML_HDR = 16512, ML_NU = 16 * 68;
constexpr size_t WS_MLC = WS_ML + (size_t)ML_NU * ML_US * 4;
constexpr int MLC_US = 144 * 128;
constexpr size_t WS_MLM = WS_MLC + (size_t)ML_NU * MLC_US * 2;
constexpr size_t WS_GDA = WS_MLM + al256((size_t)ML_NU * 4);
constexpr int GD_NU = 16 * 68;
constexpr size_t WS_GDB = WS_GDA + (size_t)GD_NU * 16384 * 2;
constexpr size_t WS_GDU = WS_GDB + (size_t)GD_NU * 16384 * 4;
constexpr size_t WS_GDW = WS_GDU + (size_t)GD_NU * 8192 * 4;
constexpr size_t WS_GDAT = WS_GDW + (size_t)GD_NU * 8192 * 2;
constexpr size_t WS_GDQ = WS_GDAT + (size_t)GD_NU * 4096 * 2;
constexpr size_t WS_GDS = WS_GDQ + (size_t)GD_NU * 8192 * 2;
constexpr int RW_NU = 32 * 68;
constexpr size_t WS_RQE = WS_GDS + (size_t)GD_NU * 16384 * 2;
constexpr size_t WS_RYL = WS_RQE + (size_t)RW_NU * 4096 * 2;
constexpr size_t WS_RAC = WS_RYL + (size_t)RW_NU * 4096 * 4;
constexpr size_t WS_RBC = WS_RAC + (size_t)RW_NU * 4096 * 2;
constexpr size_t WS_RPT = WS_RBC + (size_t)RW_NU * 4096 * 4;
constexpr size_t WS_PART = WS_RPT + (size_t)RW_NU * 4096 * 2;
constexpr size_t WS_MBC = WS_PART + (size_t)16 * 512 * D * 4;
constexpr size_t WS_BON = WS_MBC + (size_t)4 * 512 * D * 2;
constexpr size_t WS_XG = WS_BON + (size_t)2 * MROWS * 8 * 4;
constexpr size_t WS_GT = WS_XG + (size_t)MROWS * 256 * 2;
constexpr size_t WS_END = WS_GT + (size_t)34 * 32 * 65536 * 2;
static_assert((size_t)MROWS * DFF * 2 <= N_SARR * SARR && (size_t)MROWS * 2 * DFF * 2 <= (size_t)MROWS * NZ * 2, "aliases");
static_assert(WS_END < 1590000000ull, "workspace budget");
enum { SA_RG = 0 };

constexpr int LDS_RING = 131072, LDS_BYTES = 147456, LDS_MISC = LDS_BYTES - 128;

#define XB_TMO      128
#define XB_XCNT(j)  (256  + 64 * (j))
#define XB_XSUB(j)  (1280 + 64 * (j))
#define XB_XGEN(j)  (2304 + 64 * (j))
#define XB_TOP      3328
#define XB_TOPGEN   3392
#define XCD_BAR_WORDS 3456
#define XB_SPIN_CAP (1u << 18)
__device__ __forceinline__ unsigned xb_ld(unsigned* p)              { return __hip_atomic_load(p, __ATOMIC_RELAXED, __HIP_MEMORY_SCOPE_AGENT); }
__device__ __forceinline__ unsigned xb_add(unsigned* p, unsigned v) { return __hip_atomic_fetch_add(p, v, __ATOMIC_RELAXED, __HIP_MEMORY_SCOPE_AGENT); }
__device__ __forceinline__ unsigned xb_xcc_id() { return (unsigned)__builtin_amdgcn_s_getreg((3 << 11) | 20) & 0xFu; }
#define XB_SPIN(cond, bar) do { unsigned _sp = 0; while (cond) { __builtin_amdgcn_s_sleep(1); \
    if ((++_sp & 255u) == 0u) { if (xb_ld(&(bar)[XB_TMO])) break; if (_sp > XB_SPIN_CAP) { atomicAdd(&(bar)[XB_TMO], 1u); break; } } } } while (0)
struct XcdBarrier { unsigned* bar; unsigned x; volatile LAS unsigned* st; };
__device__ __forceinline__ XcdBarrier xcd_barrier_post(unsigned* bar, volatile LAS unsigned* st) {
    XcdBarrier b; b.bar = bar; b.x = xb_xcc_id(); b.st = st;
    if (threadIdx.x == 0) (void)xb_add(&bar[XB_XCNT(b.x)], 1u);
    return b;
}
__device__ __forceinline__ void xcd_barrier_complete(unsigned* bar, unsigned x, unsigned& nloc, unsigned& nx) {
    const unsigned G = gridDim.x * gridDim.y * gridDim.z;
    unsigned sum, cnt, mine, sp = 0u;
    for (;;) {
        sum = 0u; cnt = 0u; mine = 0u;
#pragma unroll
        for (unsigned j = 0; j < 16; ++j) { const unsigned c = xb_ld(&bar[XB_XCNT(j)]); sum += c; cnt += (c > 0u) ? 1u : 0u; mine = (j == x) ? c : mine; }
        if (sum == G) break;
        __builtin_amdgcn_s_sleep(1);
        if ((++sp & 255u) == 0u) { if (xb_ld(&bar[XB_TMO])) break; if (sp > XB_SPIN_CAP) { atomicAdd(&bar[XB_TMO], 1u); break; } }
    }
    nloc = mine > 0u ? mine : 1u; nx = cnt > 0u ? cnt : 1u;
}
__device__ __forceinline__ void xcd_barrier(const XcdBarrier& b, int wave_id) {
    asm volatile("s_waitcnt vmcnt(0)" ::: "memory");
    __syncthreads();
    if (wave_id == 0 && pg8::lane_id_hw() == 0) {
        unsigned* bar = b.bar; const unsigned bx = xb_xcc_id();
        __builtin_amdgcn_s_waitcnt(0);
        unsigned nloc = b.st[0], nx = b.st[1];
        if (nloc == 0u) { xcd_barrier_complete(bar, bx, nloc, nx); b.st[0] = nloc; b.st[1] = nx; }
        const unsigned old = xb_add(&bar[XB_XSUB(bx)], 1u);
        const unsigned gen = old / nloc;
        if (old + 1u == (gen + 1u) * nloc) {
            __builtin_amdgcn_fence(__ATOMIC_RELEASE, "agent");
            asm volatile("s_waitcnt vmcnt(0)" ::: "memory");
            const unsigned og = xb_add(&bar[XB_TOP], 1u);
            const unsigned tg = og / nx;
            if (og + 1u == (tg + 1u) * nx) xb_add(&bar[XB_TOPGEN], 1u);
            else XB_SPIN(xb_ld(&bar[XB_TOPGEN]) == tg, bar);
            __builtin_amdgcn_fence(__ATOMIC_ACQUIRE, "agent");
            xb_add(&bar[XB_XGEN(bx)], 1u);
            asm volatile("s_waitcnt vmcnt(0)" ::: "memory");
        } else {
            XB_SPIN(xb_ld(&bar[XB_XGEN(bx)]) == gen, bar);
            __builtin_amdgcn_fence(__ATOMIC_ACQUIRE, "agent");
            asm volatile("s_waitcnt vmcnt(0)" ::: "memory");
        }
    }
    __syncthreads();
}

struct Params {
    const float *x, *c, *ctx, *c_ctx, *w_mod, *b_mod, *norm_g, *w_in, *conv_dw, *conv_b, *conv_ln_g, *conv_ln_b, *ml_gate_b, *ml_norm_g,
        *gd_conv, *gd_a_log, *gd_dt_bias, *gd_norm_g, *rw_mu, *rw_w0, *rw_w2, *rw_a0, *rw_a2, *rw_g2, *rw_kk, *rw_ka, *rw_rk, *rw_ln_g, *rw_ln_b,
        *w_br, *w_out, *ffn_up, *ffn_dw, *ffn_down;
    float* out; unsigned char* ws; int ph_lo, ph_hi;
};

DI float bf2f(unsigned short u) { return __uint_as_float(((unsigned)u) << 16); }
typedef __bf16 bf16v2_t __attribute__((ext_vector_type(2)));
DI unsigned pk2(float lo, float hi) { bf16v2_t v = {(__bf16)lo, (__bf16)hi}; return __builtin_bit_cast(unsigned, v); }
DI unsigned f2bf(float f) { return pk2(f, 0.f) & 0xffffu; }
DI void ld8(const bf16* p, float (&o)[8]) { const u32x4 w = *(const u32x4*)p;
#pragma unroll
    for (int j = 0; j < 4; ++j) { o[2 * j] = __uint_as_float(w[j] << 16); o[2 * j + 1] = __uint_as_float(w[j] & 0xffff0000u); } }
DI u32x4 pack8(const float (&v)[8]) { u32x4 w; w.x = pk2(v[0], v[1]); w.y = pk2(v[2], v[3]); w.z = pk2(v[4], v[5]); w.w = pk2(v[6], v[7]); return w; }
DI void st8(bf16* p, const float (&v)[8]) { u32x4 w; w.x = pk2(v[0], v[1]); w.y = pk2(v[2], v[3]); w.z = pk2(v[4], v[5]); w.w = pk2(v[6], v[7]); *(u32x4*)p = w; }
DI void ldf8(const float* p, float (&o)[8]) { const f32x4 a = *(const f32x4*)p, b = *(const f32x4*)(p + 4);
    o[0] = a[0]; o[1] = a[1]; o[2] = a[2]; o[3] = a[3]; o[4] = b[0]; o[5] = b[1]; o[6] = b[2]; o[7] = b[3]; }
DI void stf8(float* p, const float (&v)[8]) { *(f32x4*)p = (f32x4){v[0], v[1], v[2], v[3]}; *(f32x4*)(p + 4) = (f32x4){v[4], v[5], v[6], v[7]}; }
template <int X> DI float shx(float v) {
    if constexpr (X < 32) return __builtin_bit_cast(float, __builtin_amdgcn_ds_swizzle(__builtin_bit_cast(int, v), (X << 10) | 0x1f));
    else { int l = pg8::lane_id_hw(); asm volatile("" : "+v"(l)); return __builtin_bit_cast(float, __builtin_amdgcn_ds_bpermute((l ^ 32) << 2, __builtin_bit_cast(int, v))); } }
DI float shup(float v, int o) { int l = pg8::lane_id_hw(); asm volatile("" : "+v"(l)); return __builtin_bit_cast(float, __builtin_amdgcn_ds_bpermute(((l - o) & 63) << 2, __builtin_bit_cast(int, v))); }
DI float rdlane63(float v) { return __builtin_bit_cast(float, __builtin_amdgcn_readlane(__builtin_bit_cast(int, v), 63)); }
template <int CTRL> DI float dppf(float v) { return __builtin_bit_cast(float, __builtin_amdgcn_update_dpp(0, __builtin_bit_cast(int, v), CTRL, 0xF, 0xF, true)); }
DI float row16_sum(float v) { v += dppf<0xB1>(v); v += dppf<0x4E>(v); v += dppf<0x141>(v); v += dppf<0x140>(v); return v; }
DI float rdl(float v, int l) { return __builtin_bit_cast(float, __builtin_amdgcn_readlane(__builtin_bit_cast(int, v), l)); }
DI float wave_sum(float v) { v = row16_sum(v); return (rdl(v, 0) + rdl(v, 16)) + (rdl(v, 32) + rdl(v, 48)); }
template <int W> DI float grp_sum(float v) {
    v += dppf<0xB1>(v); if constexpr (W > 2) v += dppf<0x4E>(v); if constexpr (W > 4) v += dppf<0x141>(v); if constexpr (W > 8) v += dppf<0x140>(v); return v; }
DI float fexp(float x) { return __builtin_amdgcn_exp2f(x * 1.4426950408889634f); }
DI float flog(float x) { return __builtin_amdgcn_logf(x) * 0.6931471805599453f; }
DI float ftanh(float x) { return 1.f - 2.f * __builtin_amdgcn_rcpf(1.f + fexp(2.f * x)); }
DI float sigmoidf_(float x) { return __builtin_amdgcn_rcpf(1.f + fexp(-x)); }
DI float siluf_(float x) { return x * __builtin_amdgcn_rcpf(1.f + fexp(-x)); }
DI float softplusf_(float x) { return fmaxf(x, 0.f) + flog(1.f + fexp(-fabsf(x))); }
DI float logsigmoidf_(float x) { return fminf(x, 0.f) - flog(1.f + fexp(-fabsf(x))); }
DI float gelu_tanh(float x) { const float u = 0.7978845608028654f * (x + 0.044715f * x * x * x); return 0.5f * x * (1.f + ftanh(u)); }

DI void seq_of(int row, int& base, int& len, int& t) { if (row < LAT) { base = row & ~(T - 1); len = T; t = row & (T - 1); } else { const int r = row - LAT; base = LAT + (r & ~(TC - 1)); len = TC; t = r & (TC - 1); } }
DI int scan_row(int dir, int b, int j) { if (j < TC) { const int tok = dir ? (TC - 1 - j) : j; return LAT + b * TC + tok; } const int jj = j - TC; const int tok = dir ? (T - 1 - jj) : jj; return b * T + tok; }

struct Ctx {
    LAS unsigned char* lds; int tid, lane, wave, G, bid;
    const Params* p; unsigned char* ws;
};

DI int zcol_src(int j) { if (j < 3072) return j; if (j < 5120) return j + 16; if (j < ZSM) return j + 32; if (j < ZSM + 16) return 3072 + (j - ZSM); if (j < ZSM + 32) return 5136 + (j - ZSM - 16); if (j < ZG) return -1; return 7136 + (j - ZG); }
template <bool ZMAP> DI void transpose_item(const float* W, int K, int N, bf16* WT, LAS float* scr, int kb, int nb, int lane) {
    const int k0 = 64 * kb, n0 = 32 * nb; const int nn = n0 + (lane & 31); const int src = ZMAP ? zcol_src(nn) : nn;
#pragma unroll 8
    for (int i = 0; i < 32; ++i) { const int kk = 2 * i + (lane >> 5); scr[kk * 33 + (lane & 31)] = (src >= 0) ? W[(size_t)(k0 + kk) * N + src] : 0.f; }
    asm volatile("s_waitcnt lgkmcnt(0)" ::: "memory");
    const int c = lane & 7;
#pragma unroll
    for (int j = 0; j < 4; ++j) { const int n = (lane >> 3) + 8 * j; const LAS float* s = scr + (8 * c) * 33 + n;
        u32x4 o; o.x = pk2(s[0 * 33], s[1 * 33]); o.y = pk2(s[2 * 33], s[3 * 33]); o.z = pk2(s[4 * 33], s[5 * 33]); o.w = pk2(s[6 * 33], s[7 * 33]);
        *(u32x4*)(WT + (size_t)(n0 + n) * K + k0 + 8 * c) = o; }
    asm volatile("s_waitcnt lgkmcnt(0)" ::: "memory");
}
DI void phase_pro0(Ctx& c) {
    const Params& p = *c.p;
    {
        LAS float* red = (LAS float*)c.lds;
        float* MODP = (float*)(c.ws + WS_MODP);
        for (int u = c.bid; u < NL * 48 * 8; u += c.G) {
            const int l = u / 384, cb = (u >> 3) % 48, ks = u & 7; const int col = cb * 256 + c.lane * 4;
            f32x4 a0 = {0.f, 0.f, 0.f, 0.f}, a1 = a0, a2 = a0;
            const float* wp = p.w_mod + ((size_t)l * D + ks * 256 + c.wave * 32) * 12288 + col;
            const int kb = ks * 256 + c.wave * 32;
#pragma unroll 8
            for (int i = 0; i < 32; ++i) { const f32x4 w = __builtin_nontemporal_load((const f32x4*)(wp + (size_t)i * 12288));
                const float s0 = siluf_(p.c[kb + i]), s1 = siluf_(p.c[D + kb + i]), s2 = siluf_(p.c_ctx[kb + i]);
                a0 += w * s0; a1 += w * s1; a2 += w * s2; }
            __syncthreads();
            *(LAS f32x4*)(red + (c.wave * 3 + 0) * 256 + c.lane * 4) = a0; *(LAS f32x4*)(red + (c.wave * 3 + 1) * 256 + c.lane * 4) = a1; *(LAS f32x4*)(red + (c.wave * 3 + 2) * 256 + c.lane * 4) = a2;
            __syncthreads();
            for (int o = c.tid; o < 768; o += 512) { float s = 0.f;
#pragma unroll
                for (int w = 0; w < 8; ++w) s += red[w * 768 + o];
                MODP[((size_t)(l * 8 + ks) * 3 + o / 256) * 12288 + cb * 256 + (o & 255)] = s; }
        }
        __syncthreads();
    }
}
struct WTile { const float* wp; size_t N; bf16* dst; bool zero; };
DI WTile wconv_tile(const Params& p, int l, unsigned char* wl, int r, int lane) {
    constexpr int I_IN = 32 * 240, I_BR = 8 * 32, I_OUT = 32 * 32, I_UP = 32 * 176;
    const float* W; bf16* WT; int K, N, kb, nb; bool zmap = false;
    if (r < I_IN) { W = p.w_in + (size_t)l * D * NIN; K = D; N = NIN; WT = (bf16*)(wl + WL_IN); kb = r / 240; nb = r % 240; zmap = true; }
    else if ((r -= I_IN) < 4 * I_BR) { const int br = r / I_BR; r %= I_BR; W = p.w_br + ((size_t)l * 4 + br) * MIXW * D; K = MIXW; N = D; WT = (bf16*)(wl + WL_BR) + (size_t)br * D * MIXW; kb = r / 32; nb = r % 32; }
    else if ((r -= 4 * I_BR) < I_OUT) { W = p.w_out + (size_t)l * D * D; K = D; N = D; WT = (bf16*)(wl + WL_OUT); kb = r / 32; nb = r % 32; }
    else if ((r -= I_OUT) < I_UP) { W = p.ffn_up + (size_t)l * D * 2 * DFF; K = D; N = 2 * DFF; WT = (bf16*)(wl + WL_UP); kb = r / 176; nb = r % 176; }
    else { r -= I_UP; W = p.ffn_down + (size_t)l * DFF * D; K = DFF; N = D; WT = (bf16*)(wl + WL_DN); kb = r / 32; nb = r % 32; }
    const int n = 64 * nb + lane; const int src = zmap ? zcol_src(n) : n;
    WTile t; t.wp = W + (size_t)(64 * kb) * N + (src >= 0 ? src : 0); t.N = (size_t)N; t.dst = WT + (size_t)n * K + 64 * kb; t.zero = src < 0; return t;
}
DI void wt_load(const WTile& t, int hf, float (&v)[32]) {
#pragma unroll
    for (int i = 0; i < 32; ++i) v[i] = __builtin_nontemporal_load(t.wp + (size_t)(hf * 32 + i) * t.N); }
DI void wt_store(const WTile& t, int hf, const float (&v)[32]) {
#pragma unroll
    for (int j = 0; j < 4; ++j) { u32x4 o; o.x = pk2(v[8 * j], v[8 * j + 1]); o.y = pk2(v[8 * j + 2], v[8 * j + 3]); o.z = pk2(v[8 * j + 4], v[8 * j + 5]); o.w = pk2(v[8 * j + 6], v[8 * j + 7]);
        if (t.zero) o = (u32x4){0u, 0u, 0u, 0u};
        *(u32x4*)(t.dst + hf * 32 + 8 * j) = o; } }
DI void phase_wconv(Ctx& c, int l) {
    const Params& p = *c.p;
    {
        const int gw = c.bid * 8 + c.wave, NGW = c.G * 8;
        constexpr int I_L = 32 * 240 + 4 * 8 * 32 + 32 * 32 + 32 * 176 + 88 * 32;
        unsigned char* wl = c.ws + WS_W;
        if (gw < I_L) { float vA[32], vB[32]; WTile cur = wconv_tile(p, l, wl, gw, c.lane); wt_load(cur, 0, vA);
            for (int it = gw; it < I_L; it += NGW) {
                wt_load(cur, 1, vB); wt_store(cur, 0, vA);
                const int nx = it + NGW; WTile nxt = cur;
                if (nx < I_L) { nxt = wconv_tile(p, l, wl, nx, c.lane); wt_load(nxt, 0, vA); }
                wt_store(cur, 1, vB); cur = nxt; } }
        bf16* lw = (bf16*)(wl + WL_LORA);
        for (int it = c.bid * 512 + c.tid; it < 4 * 6144 + 16384; it += c.G * 512) {
            const float* W; bf16* dst; int K, n, k8;
            if (it < 4 * 6144) { const int m = it / 6144, rr = it % 6144; n = rr & 511; k8 = rr >> 9; K = 96; W = (m < 2 ? p.rw_w2 : p.rw_a2) + (size_t)(l * 2 + (m & 1)) * 96 * 512; dst = lw + (size_t)m * 512 * 96; }
            else { const int rr = it - 4 * 6144; n = rr & 511; k8 = rr >> 9; K = 256; W = p.rw_g2 + (size_t)l * 256 * 512; dst = lw + (size_t)4 * 512 * 96; }
            float v[8];
#pragma unroll
            for (int i = 0; i < 8; ++i) v[i] = W[(size_t)(k8 * 8 + i) * 512 + n];
            st8(dst + (size_t)n * K + k8 * 8, v); }
    }
    __syncthreads();
}
DI void phase_pro1(Ctx& c) {
    const Params& p = *c.p; const float* MODP = (const float*)(c.ws + WS_MODP); float* MOD = (float*)(c.ws + WS_MOD);
    for (int i = c.bid * 512 + c.tid; i < NL * 3 * 12288; i += c.G * 512) { const int l = i / 36864, v = (i / 12288) % 3, n = i % 12288;
        float s = p.b_mod[l * 12288 + n];
#pragma unroll
        for (int ks = 0; ks < 8; ++ks) s += MODP[((size_t)(l * 8 + ks) * 3 + v) * 12288 + n];
        MOD[i] = s; }
}
DI void row_load(const float* r, int lane, f32x4 (&v)[8]) {
#pragma unroll
    for (int j = 0; j < 8; ++j) v[j] = *(const f32x4*)(r + 4 * lane + 256 * j); }
DI float row_rstd(const f32x4 (&v)[8]) { float s = 0.f;
#pragma unroll
    for (int j = 0; j < 8; ++j) s += (v[j][0] * v[j][0] + v[j][1] * v[j][1]) + (v[j][2] * v[j][2] + v[j][3] * v[j][3]);
    return rsqrtf(wave_sum(s) * (1.f / D) + 1e-6f); }
DI void norm_mod_store(const f32x4 (&v)[8], float rstd, const float* g, const float* sh, const float* sc, bf16* o, int lane) {
#pragma unroll
    for (int j = 0; j < 8; ++j) { const int cc = 4 * lane + 256 * j; const f32x4 g4 = *(const f32x4*)(g + cc), s4 = *(const f32x4*)(sh + cc), c4 = *(const f32x4*)(sc + cc);
        const f32x4 r = v[j] * rstd * g4 * (c4 + 1.f) + s4; u32x2 w; w.x = pk2(r[0], r[1]); w.y = pk2(r[2], r[3]); *(u32x2*)(o + cc) = w; } }
DI int mod_vec(int row) { return row < LAT ? (row >> 12) : 2; }
DI void phase_pro2(Ctx& c) {
    const Params& p = *c.p; const float* MOD = (const float*)(c.ws + WS_MOD); bf16* U = (bf16*)(c.ws + WS_U);
    const int gw = c.bid * 8 + c.wave, NGW = c.G * 8;
    for (int row = gw; row < MROWS; row += NGW) { const float* xr = row < LAT ? p.x + (size_t)row * D : p.ctx + (size_t)(row - LAT) * D;
        f32x4 v[8]; row_load(xr, c.lane, v); const float rs = row_rstd(v); const float* mv = MOD + (size_t)(0 * 3 + mod_vec(row)) * 12288;
        norm_mod_store(v, rs, p.norm_g, mv, mv + 2048, U + (size_t)row * D, c.lane); }
}
DI void norm_mod_store_l(const f32x4 (&v)[8], float rstd, const LAS float* g, const LAS float* sh, const LAS float* sc, bf16* o, int lane) {
#pragma unroll
    for (int j = 0; j < 8; ++j) { const int cc = 4 * lane + 256 * j; const f32x4 g4 = *(const LAS f32x4*)(g + cc), s4 = *(const LAS f32x4*)(sh + cc), c4 = *(const LAS f32x4*)(sc + cc);
        const f32x4 r = v[j] * rstd * g4 * (c4 + 1.f) + s4; u32x2 w; w.x = pk2(r[0], r[1]); w.y = pk2(r[2], r[3]); *(u32x2*)(o + cc) = w;
        if (j & 1) asm volatile("" ::: "memory"); } }
template <bool LP>
DI void resid_row(Ctx& c, int l, int which, int row, const f32x4 (&fv)[8], f32x4 (&xv)[8], const LAS float* pl) {
    const Params& p = *c.p; const float* MOD = (const float*)(c.ws + WS_MOD); bf16* U = (bf16*)(c.ws + WS_U); float* X = (float*)(c.ws + WS_X);
    const float rs = row_rstd(fv); const float* mv = MOD + (size_t)(l * 3 + mod_vec(row)) * 12288;
    const float* g = p.norm_g + (size_t)(l * 4 + (which ? 3 : 1)) * D; const float* gt = mv + (which ? 10240 : 4096);
#pragma unroll
    for (int j = 0; j < 8; ++j) { const int cc = 4 * c.lane + 256 * j;
        if (LP) { xv[j] += *(const LAS f32x4*)(pl + 2048 + cc) * (fv[j] * rs * *(const LAS f32x4*)(pl + cc)); if (j & 1) asm volatile("" ::: "memory"); }
        else xv[j] += *(const f32x4*)(gt + cc) * (fv[j] * rs * *(const f32x4*)(g + cc)); }
    if (which == 1 && l == NL - 1) { if (row < LAT) {
#pragma unroll
        for (int j = 0; j < 8; ++j) *(f32x4*)(p.out + (size_t)row * D + 4 * c.lane + 256 * j) = xv[j]; } return; }
#pragma unroll
    for (int j = 0; j < 8; ++j) *(f32x4*)(X + (size_t)row * D + 4 * c.lane + 256 * j) = xv[j];
    const float rs2 = row_rstd(xv);
    if (LP) { norm_mod_store_l(xv, rs2, pl + 2 * 2048, pl + 3 * 2048, pl + 4 * 2048, U + (size_t)row * D, c.lane); return; }
    if (which == 0) norm_mod_store(xv, rs2, p.norm_g + (size_t)(l * 4 + 2) * D, mv + 6144, mv + 8192, U + (size_t)row * D, c.lane);
    else { const float* mv2 = MOD + (size_t)((l + 1) * 3 + mod_vec(row)) * 12288; norm_mod_store(xv, rs2, p.norm_g + (size_t)((l + 1) * 4) * D, mv2, mv2 + 2048, U + (size_t)row * D, c.lane); }
}
DI void frow_load(const bf16* r, int lane, u32x2 (&v)[8]) {
#pragma unroll
    for (int j = 0; j < 8; ++j) v[j] = *(const u32x2*)(r + 4 * lane + 256 * j); }
DI void frow_cvt(const u32x2 (&h)[8], f32x4 (&v)[8]) {
#pragma unroll
    for (int j = 0; j < 8; ++j) v[j] = (f32x4){__uint_as_float(h[j].x << 16), __uint_as_float(h[j].x & 0xffff0000u), __uint_as_float(h[j].y << 16), __uint_as_float(h[j].y & 0xffff0000u)}; }
DI void phase_resid(Ctx& c, int l, int which) {
    const Params& p = *c.p; float* X = (float*)(c.ws + WS_X); const bf16* Fh = (const bf16*)(c.ws + WS_F);
    const int gw = c.bid * 8 + c.wave, NGW = c.G * 8; const bool first = (l == 0 && which == 0);
    if (NGW * 4 == LAT) {
        const int r0 = gw * 4; const float* xb = first ? p.x : X;
        u32x2 hA[8], hB[8], hC[8]; f32x4 xA[8], xB[8], xC[8], fv[8];
        LAS float* pl = (LAS float*)c.lds + 4096; const bool lastp = (which == 1 && l == NL - 1); f32x4 pv[5];
        { const float* MOD = (const float*)(c.ws + WS_MOD); const int bb = c.bid >> 7; const float* mv = MOD + (size_t)(l * 3 + bb) * 12288; const float* mv2 = MOD + (size_t)((l + 1) * 3 + bb) * 12288;
          pv[0] = *(const f32x4*)(p.norm_g + (size_t)(l * 4 + (which ? 3 : 1)) * D + 4 * c.tid);
          pv[1] = *(const f32x4*)(mv + (which ? 10240 : 4096) + 4 * c.tid);
          if (!lastp) { pv[2] = *(const f32x4*)(p.norm_g + (size_t)(which ? (l + 1) * 4 : l * 4 + 2) * D + 4 * c.tid);
                        pv[3] = *(const f32x4*)((which ? mv2 : mv + 6144) + 4 * c.tid);
                        pv[4] = *(const f32x4*)((which ? mv2 + 2048 : mv + 8192) + 4 * c.tid); }
          else { pv[2] = pv[0]; pv[3] = pv[0]; pv[4] = pv[0]; } }
#pragma unroll
        for (int v = 0; v < 5; ++v) *(LAS f32x4*)(pl + v * 2048 + 4 * c.tid) = pv[v];
        asm volatile("" ::: "memory");
        frow_load(Fh + (size_t)r0 * D, c.lane, hA); row_load(xb + (size_t)r0 * D, c.lane, xA);
        frow_load(Fh + (size_t)(r0 + 1) * D, c.lane, hB); row_load(xb + (size_t)(r0 + 1) * D, c.lane, xB);
        frow_load(Fh + (size_t)(r0 + 2) * D, c.lane, hC); row_load(xb + (size_t)(r0 + 2) * D, c.lane, xC);
        asm volatile("s_waitcnt lgkmcnt(0)" ::: "memory"); __builtin_amdgcn_s_barrier(); asm volatile("" ::: "memory");
        frow_cvt(hA, fv); resid_row<true>(c, l, which, r0, fv, xA, pl);
        frow_load(Fh + (size_t)(r0 + 3) * D, c.lane, hA); row_load(xb + (size_t)(r0 + 3) * D, c.lane, xA);
        frow_cvt(hB, fv); resid_row<true>(c, l, which, r0 + 1, fv, xB, pl);
        frow_cvt(hC, fv); resid_row<true>(c, l, which, r0 + 2, fv, xC, pl);
        frow_cvt(hA, fv); resid_row<true>(c, l, which, r0 + 3, fv, xA, pl);
    } else {
        for (int row = gw; row < LAT; row += NGW) { u32x2 h[8]; f32x4 fv[8], xv[8]; frow_load(Fh + (size_t)row * D, c.lane, h); row_load((first ? p.x : X) + (size_t)row * D, c.lane, xv); frow_cvt(h, fv); resid_row<false>(c, l, which, row, fv, xv, nullptr); }
    }
    if (l == NL - 1) return;
    LAS float* rb = (LAS float*)c.lds;
    const int ns = which ? 11 : 16;
    for (int pr2 = c.bid; pr2 < NB * TC / 2; pr2 += c.G) {
        __syncthreads();
        f32x4 xv[8]; if (c.wave < 2) row_load((first ? p.ctx - (size_t)LAT * D : X) + (size_t)(LAT + 2 * pr2 + c.wave) * D, c.lane, xv);
#pragma unroll
        for (int rr = 0; rr < 2; ++rr) { const float* pr = (const float*)(c.ws + WS_PART) + (size_t)(2 * pr2 + rr) * D + 256 * c.wave + 4 * c.lane; f32x4 a = {0.f, 0.f, 0.f, 0.f};
#pragma unroll
            for (int s = 0; s < 16; ++s) if (s < ns) a += *(const f32x4*)(pr + (size_t)s * 512 * D);
            *(LAS f32x4*)(rb + rr * 2048 + 256 * c.wave + 4 * c.lane) = a; }
        __syncthreads();
        if (c.wave < 2) { const int row = LAT + 2 * pr2 + c.wave; f32x4 fv[8];
#pragma unroll
            for (int j = 0; j < 8; ++j) fv[j] = *(const LAS f32x4*)(rb + c.wave * 2048 + 4 * c.lane + 256 * j);
            resid_row<false>(c, l, which, row, fv, xv, nullptr); }
    }
    __syncthreads();
}

DI f32x4 mfma16(bf16x8 a, bf16x8 b, f32x4 c) { return __builtin_amdgcn_mfma_f32_16x16x32_bf16(a, b, c, 0, 0, 0); }
DI bf16x8 ldfrag(const LAS bf16* base, int ld, int r0, int k0, int lane) { return *(const LAS bf16x8*)(base + (r0 + (lane & 15)) * ld + k0 + 8 * (lane >> 4)); }
template <int K> DI f32x4 mm_tile(const LAS bf16* X, int ldx, int xr0, const LAS bf16* Yt, int ldy, int yr0, int lane, f32x4 acc) {
#pragma unroll
    for (int k0 = 0; k0 < K; k0 += 32) acc = mfma16(ldfrag(X, ldx, xr0, k0, lane), ldfrag(Yt, ldy, yr0, k0, lane), acc);
    return acc; }
DI float wave_scan_add(float v, int lane) {
#pragma unroll
    for (int o = 1; o < 64; o <<= 1) { const float t = shup(v, o); if (lane >= o) v += t; }
    return v; }
DI float wave_scan_max(float v, int lane) {
#pragma unroll
    for (int o = 1; o < 64; o <<= 1) { const float t = shup(v, o); if (lane >= o) v = fmaxf(v, t); }
    return v; }
DI float wave_max(float v) { v = fmaxf(v, dppf<0xB1>(v)); v = fmaxf(v, dppf<0x4E>(v)); v = fmaxf(v, dppf<0x141>(v)); v = fmaxf(v, dppf<0x140>(v)); return fmaxf(fmaxf(rdl(v, 0), rdl(v, 16)), fmaxf(rdl(v, 32), rdl(v, 48))); }
constexpr float QSC = 0.08838834764831845f;

DI void mlstm_local(Ctx& c, int l, int u) {
    { int t0_ = pg8::lane_id_hw(); asm volatile("" : "+v"(t0_)); c.lane = t0_; c.tid = c.wave * 64 + t0_; }
    const Params& p = *c.p; const bf16* Z = (const bf16*)(c.ws + WS_Z); const float* G32 = (const float*)(c.ws + WS_G32); float* ML = (float*)(c.ws + WS_ML) + (size_t)u * ML_US;
    const int chain = u / 68, cc = u % 68, g = chain >> 2, h = chain & 3, dir = g >> 1, b = g & 1;
    LAS bf16* kT = (LAS bf16*)c.lds; LAS bf16* vT = kT + 128 * 72; LAS float* sw = (LAS float*)(vT + 128 * 72);
    __syncthreads();
    if (c.wave == 0) { const int row = scan_row(dir, b, cc * 64 + c.lane);
        const float li = G32[(size_t)row * 32 + dir * 8 + h] + p.ml_gate_b[((l * 2 + dir) * 2 + 0) * 4 + h];
        const float lf = logsigmoidf_(G32[(size_t)row * 32 + dir * 8 + 4 + h] + p.ml_gate_b[((l * 2 + dir) * 2 + 1) * 4 + h]);
        const float bt = wave_scan_add(lf, c.lane); const float bl = rdlane63(bt); const float wl = bl - bt + li; const float mloc = wave_max(wl);
        sw[c.lane] = fexp(wl - mloc); if (c.lane == 0) { ML[ML_HDR] = mloc; ML[ML_HDR + 1] = bl; } }
    __syncthreads();
    for (int it = c.tid; it < 64 * 32; it += 512) { const int s = it & 63, r = it >> 6, mat = r >> 4, ch = (r & 15) * 8; const int row = scan_row(dir, b, cc * 64 + s);
        float v[8]; ld8(Z + (size_t)row * NZ + (mat ? MLV : MLK) + h * 128 + ch, v); const float sc = mat ? 1.f : sw[s]; LAS bf16* dst = (mat ? vT : kT) + ch * 72 + s;
#pragma unroll
        for (int i = 0; i < 8; ++i) dst[i * 72] = (bf16)f2bf(v[i] * sc); }
    __syncthreads();
    f32x4 acc[8];
#pragma unroll
    for (int nt = 0; nt < 8; ++nt) acc[nt] = mm_tile<64>(kT, 72, 16 * c.wave, vT, 72, 16 * nt, c.lane, (f32x4){0.f, 0.f, 0.f, 0.f});
    const int q = c.lane >> 4, r = c.lane & 15;
#pragma unroll
    for (int nt = 0; nt < 8; ++nt) *(f32x4*)(ML + (size_t)(16 * nt + r) * 128 + 16 * c.wave + 4 * q) = acc[nt];
    if (c.tid < 128) { float s = 0.f;
#pragma unroll
        for (int j = 0; j < 64; j += 8) { const u32x4 w = *(const LAS u32x4*)(kT + c.tid * 72 + j);
#pragma unroll
            for (int i = 0; i < 4; ++i) s += __uint_as_float(w[i] << 16) + __uint_as_float(w[i] & 0xffff0000u); }
        ML[ML_NL + c.tid] = s; }
}
DI void mlstm_prefix(Ctx& c) {
    const float* ML = (const float*)(c.ws + WS_ML); bf16* CT = (bf16*)(c.ws + WS_MLC); float* MS = (float*)(c.ws + WS_MLM);
    for (int item = c.bid * 512 + c.tid; item < 65536; item += c.G * 512) {
        const int chain = item >> 12, e = (item >> 5) & 127, dq = item & 31; const bool two = (e == 127);
        const size_t so = (size_t)e * 128 + 4 * dq, so2 = (size_t)ML_NL + 4 * dq; const size_t dofs = (size_t)e * 128 + 4 * dq, dofs2 = (size_t)128 * 128 + 4 * dq;
        f32x4 C = {0.f, 0.f, 0.f, 0.f}, C2 = C; float m = 0.f;
#pragma unroll 17
        for (int cc = 0; cc < 68; ++cc) { const size_t u = (size_t)chain * 68 + cc; const float* mu = ML + u * ML_US;
            const f32x4 L = *(const f32x4*)(mu + so); const float mloc = mu[ML_HDR], bl = mu[ML_HDR + 1]; f32x4 L2 = {0.f, 0.f, 0.f, 0.f}; if (two) L2 = *(const f32x4*)(mu + so2);
            u32x2 w; w.x = pk2(C[0], C[1]); w.y = pk2(C[2], C[3]); *(u32x2*)(CT + u * MLC_US + dofs) = w;
            if (two) { u32x2 w2; w2.x = pk2(C2[0], C2[1]); w2.y = pk2(C2[2], C2[3]); *(u32x2*)(CT + u * MLC_US + dofs2) = w2; }
            if (e == 0 && dq == 0) MS[u] = m;
            const float mn = fmaxf(bl + m, mloc); const float dec = fexp(bl + m - mn), wl = fexp(mloc - mn); m = mn;
            C = C * dec + L * wl; C2 = C2 * dec + L2 * wl; }
    }
}
DI void mlstm_out(Ctx& c, int l, int u) {
    const Params& p = *c.p; const bf16* Z = (const bf16*)(c.ws + WS_Z); const float* G32 = (const float*)(c.ws + WS_G32); bf16* Y = (bf16*)(c.ws + WS_Y);
    const bf16* CTg = (const bf16*)(c.ws + WS_MLC); const float* MS = (const float*)(c.ws + WS_MLM);
    const int b = u / (4 * 68), h = (u / 68) & 3, tb = u % 68;
    LAS bf16* sq = (LAS bf16*)c.lds; LAS bf16* sk = sq + 64 * 136; LAS bf16* vT = sk + 64 * 136; LAS bf16* CT = vT + 144 * 72; LAS bf16* sdw = CT + 144 * 136;
    LAS float* hbuf = (LAS float*)(sdw + 64 * 72); LAS float* sAt = hbuf + 64 * 128; LAS float* sBs = sAt + 64; LAS float* siw = sBs + 64; LAS float* semt = siw + 64; LAS float* sden = semt + 64;
    const int q = c.lane >> 4, r = c.lane & 15;
    for (int dir = 0; dir < 2; ++dir) {
        const int cc = dir == 0 ? tb : (tb < 4 ? 3 - tb : 71 - tb); const int chain = (dir * 2 + b) * 4 + h; const size_t un = (size_t)chain * 68 + cc;
        __syncthreads();
        if (c.wave == 0) { const int row = scan_row(dir, b, cc * 64 + c.lane); const float mc = MS[un];
            const float li = G32[(size_t)row * 32 + dir * 8 + h] + p.ml_gate_b[((l * 2 + dir) * 2 + 0) * 4 + h];
            const float lf = logsigmoidf_(G32[(size_t)row * 32 + dir * 8 + 4 + h] + p.ml_gate_b[((l * 2 + dir) * 2 + 1) * 4 + h]);
            const float bt = wave_scan_add(lf, c.lane); const float x = li - bt; const float cm = wave_scan_max(x, c.lane); const float mt = bt + fmaxf(mc, cm);
            sAt[c.lane] = bt - mt; sBs[c.lane] = x; siw[c.lane] = fexp(bt + mc - mt) * QSC; semt[c.lane] = fexp(-mt); }
        for (int it = c.tid; it < 64 * 32; it += 512) { const int s = it >> 5, r2 = it & 31, mat = r2 >> 4, ch = (r2 & 15) * 8; const int row = scan_row(dir, b, cc * 64 + s);
            *(LAS u32x4*)((mat ? sk : sq) + s * 136 + ch) = *(const u32x4*)(Z + (size_t)row * NZ + (mat ? MLK : MLQ) + h * 128 + ch); }
        for (int it = c.tid; it < 64 * 16; it += 512) { const int s = it & 63, ch = (it >> 6) * 8; const int row = scan_row(dir, b, cc * 64 + s);
            const u32x4 w = *(const u32x4*)(Z + (size_t)row * NZ + MLV + h * 128 + ch); LAS bf16* dst = vT + ch * 72 + s;
#pragma unroll
            for (int i = 0; i < 4; ++i) { dst[(2 * i) * 72] = (bf16)(w[i] & 0xffffu); dst[(2 * i + 1) * 72] = (bf16)(w[i] >> 16); } }
        if (c.tid < 64) vT[128 * 72 + c.tid] = (bf16)0x3F80u;
        for (int it = c.tid; it < 129 * 16; it += 512) { const int e = it >> 4, ch = (it & 15) * 8; *(LAS u32x4*)(CT + e * 136 + ch) = *(const u32x4*)(CTg + un * MLC_US + (size_t)e * 128 + ch); }
        __syncthreads();
#pragma unroll
        for (int j = 0; j < 2; ++j) { const int ti = 2 * c.wave + j, mt = ti >> 2, nt = ti & 3;
            const f32x4 a = mm_tile<128>(sk, 136, 16 * nt, sq, 136, 16 * mt, c.lane, (f32x4){0.f, 0.f, 0.f, 0.f});
            const int t = 16 * mt + r; const float At = sAt[t]; float d[4];
#pragma unroll
            for (int i = 0; i < 4; ++i) { const int s = 16 * nt + 4 * q + i; d[i] = (s <= t) ? a[i] * QSC * fexp(At + sBs[s]) : 0.f; }
            u32x2 w; w.x = pk2(d[0], d[1]); w.y = pk2(d[2], d[3]); *(LAS u32x2*)(sdw + t * 72 + 16 * nt + 4 * q) = w; }
        const int mt = c.wave & 3, nt0 = (c.wave >> 2) * 5, ntn = (c.wave >> 2) ? 4 : 5;
        f32x4 acc[5];
#pragma unroll
        for (int j = 0; j < 5; ++j) if (j < ntn) acc[j] = mm_tile<128>(CT, 136, 16 * (nt0 + j), sq, 136, 16 * mt, c.lane, (f32x4){0.f, 0.f, 0.f, 0.f});
        __syncthreads();
        const int t = 16 * mt + r; const float iw = siw[t];
#pragma unroll
        for (int j = 0; j < 5; ++j) if (j < ntn) acc[j] = mm_tile<64>(vT, 72, 16 * (nt0 + j), sdw, 72, 16 * mt, c.lane, acc[j] * iw);
        if (c.wave >= 4 && q == 0) sden[t] = acc[3][0];
        __syncthreads();
        const float dn = fmaxf(fabsf(sden[t]), semt[t]); const float inv = 1.f / dn; const int tok = dir ? 63 - t : t;
#pragma unroll
        for (int j = 0; j < 5; ++j) if (j < ntn && nt0 + j < 8) { LAS f32x4* hp = (LAS f32x4*)(hbuf + tok * 128 + 16 * (nt0 + j) + 4 * q); const f32x4 hv = acc[j] * inv; if (dir == 0) *hp = hv; else *hp += hv; }
    }
    __syncthreads();
    { const int tok = c.tid >> 3, eg = (c.tid & 7) * 16; const int row = (tb < 4 ? LAT + b * TC + tb * 64 : b * T + (tb - 4) * 64) + tok;
        float hv[16]; float ss = 0.f;
#pragma unroll
        for (int j = 0; j < 4; ++j) { const f32x4 x = *(const LAS f32x4*)(hbuf + tok * 128 + eg + 4 * j); hv[4 * j] = x[0]; hv[4 * j + 1] = x[1]; hv[4 * j + 2] = x[2]; hv[4 * j + 3] = x[3]; ss += (x[0] * x[0] + x[1] * x[1]) + (x[2] * x[2] + x[3] * x[3]); }
        ss = grp_sum<8>(ss); const float rs = rsqrtf(ss * (1.f / 128.f) + 1e-6f);
#pragma unroll
        for (int j = 0; j < 2; ++j) { float g[8], o[8], y[8]; ldf8(p.ml_norm_g + l * 512 + h * 128 + eg + 8 * j, g); ld8(Z + (size_t)row * NZ + MLO + h * 128 + eg + 8 * j, o);
#pragma unroll
            for (int i = 0; i < 8; ++i) y[i] = hv[8 * j + i] * rs * g[i] * sigmoidf_(o[i]);
            st8(Y + (size_t)row * D + 512 + h * 128 + eg + 8 * j, y); } }
}


DI bf16x8 frag_f32(const LAS float* base, int ld, int r0, int c0, int lane, int kvalid) {
    const int q = lane >> 4, r = lane & 15; u32x4 o = {0u, 0u, 0u, 0u};
    if (8 * q < kvalid) { const f32x4 a = *(const LAS f32x4*)(base + (r0 + r) * ld + c0 + 8 * q), b = *(const LAS f32x4*)(base + (r0 + r) * ld + c0 + 8 * q + 4);
        o.x = pk2(a[0], a[1]); o.y = pk2(a[2], a[3]); o.z = pk2(b[0], b[1]); o.w = pk2(b[2], b[3]); }
    return __builtin_bit_cast(bf16x8, o); }
DI bf16x8 frag_k16(const LAS bf16* base, int ld, int r0, int lane) {
    const u32x4 z = {0u, 0u, 0u, 0u}; return (lane >> 4) < 2 ? ldfrag(base, ld, r0, 0, lane) : __builtin_bit_cast(bf16x8, z); }
DI void tri_inverse64(const LAS float* Nf, const LAS bf16*  , LAS bf16* Tm, LAS bf16* scr, int lane) {
    const int blk = lane >> 4, j = lane & 15, q = lane >> 4, r = lane & 15; LAS bf16* TT = scr; LAS bf16* M1 = scr + 1280; LAS bf16* TTb2 = M1 + 768;
    unsigned zo = 0u; asm volatile("" : "+v"(zo)); const u32x4 zv = {zo, zo, zo, zo};
#pragma unroll
    for (int i = 0; i < 9; ++i) *(LAS u32x4*)(Tm + (lane * 9 + i) * 8) = zv;
    float x[16]; const LAS float* Nz = Nf + (16 * blk) * 68 + 16 * blk;
#pragma unroll
    for (int t = 0; t < 16; ++t) { float a = (t == j) ? 1.f : 0.f;
#pragma unroll
        for (int s4 = 0; s4 < (t + 3) / 4; ++s4) { const f32x4 n4 = *(const LAS f32x4*)(Nz + t * 68 + 4 * s4);
#pragma unroll
            for (int i = 0; i < 4; ++i) if (4 * s4 + i < t) a = fmaf(-n4[i], x[4 * s4 + i], a); }
        x[t] = a; Tm[(16 * blk + t) * 72 + 16 * blk + j] = (bf16)f2bf(a); }
    {   u32x4 lo, hi; lo.x = pk2(x[0], x[1]); lo.y = pk2(x[2], x[3]); lo.z = pk2(x[4], x[5]); lo.w = pk2(x[6], x[7]); hi.x = pk2(x[8], x[9]); hi.y = pk2(x[10], x[11]); hi.z = pk2(x[12], x[13]); hi.w = pk2(x[14], x[15]);
        if (blk < 2) { *(LAS u32x4*)(TT + (16 * blk + j) * 40 + 16 * blk) = lo; *(LAS u32x4*)(TT + (16 * blk + j) * 40 + 16 * blk + 8) = hi; }
        if (blk == 1) { *(LAS u32x4*)(TT + (16 + j) * 40) = zv; *(LAS u32x4*)(TT + (16 + j) * 40 + 8) = zv; }
        if (blk == 2) { *(LAS u32x4*)(TTb2 + j * 24) = lo; *(LAS u32x4*)(TTb2 + j * 24 + 8) = hi; } }
    asm volatile("s_waitcnt lgkmcnt(0)" ::: "memory");
#pragma unroll
    for (int p = 0; p < 2; ++p) { const f32x4 a = mfma16(frag_f32(Nf, 68, 16 * (2 * p + 1), 16 * (2 * p), lane, 16), frag_k16(p ? TTb2 : TT, p ? 24 : 40, 0, lane), (f32x4){0.f, 0.f, 0.f, 0.f});
        u32x2 w; w.x = pk2(a[0], a[1]); w.y = pk2(a[2], a[3]); *(LAS u32x2*)(M1 + p * 384 + r * 24 + 4 * q) = w; }
    asm volatile("s_waitcnt lgkmcnt(0)" ::: "memory");
#pragma unroll
    for (int p = 0; p < 2; ++p) { const f32x4 a = mfma16(frag_k16(M1 + p * 384, 24, 0, lane), frag_k16(Tm + (16 * (2 * p + 1)) * 72 + 16 * (2 * p + 1), 72, 0, lane), (f32x4){0.f, 0.f, 0.f, 0.f});
        u32x2 w; w.x = pk2(-a[0], -a[1]); w.y = pk2(-a[2], -a[3]); *(LAS u32x2*)(Tm + (16 * (2 * p + 1) + r) * 72 + 16 * (2 * p) + 4 * q) = w;
        if (p == 0) {
#pragma unroll
            for (int i = 0; i < 4; ++i) TT[(4 * q + i) * 40 + 16 + r] = (bf16)f2bf(-a[i]); } }
    asm volatile("s_waitcnt lgkmcnt(0)" ::: "memory");
#pragma unroll
    for (int xt = 0; xt < 2; ++xt)
#pragma unroll
        for (int yt = 0; yt < 2; ++yt) { const f32x4 a = mfma16(frag_f32(Nf, 68, 32 + 16 * xt, 0, lane, 32), ldfrag(TT, 40, 16 * yt, 0, lane), (f32x4){0.f, 0.f, 0.f, 0.f});
            u32x2 w; w.x = pk2(a[0], a[1]); w.y = pk2(a[2], a[3]); *(LAS u32x2*)(M1 + (16 * yt + r) * 40 + 16 * xt + 4 * q) = w; }
    asm volatile("s_waitcnt lgkmcnt(0)" ::: "memory");
#pragma unroll
    for (int xt = 0; xt < 2; ++xt)
#pragma unroll
        for (int yt = 0; yt < 2; ++yt) { const f32x4 a = mfma16(ldfrag(M1, 40, 16 * xt, 0, lane), ldfrag(Tm + 32 * 72 + 32, 72, 16 * yt, 0, lane), (f32x4){0.f, 0.f, 0.f, 0.f});
            u32x2 w; w.x = pk2(-a[0], -a[1]); w.y = pk2(-a[2], -a[3]); *(LAS u32x2*)(Tm + (32 + 16 * yt + r) * 72 + 16 * xt + 4 * q) = w; }
}
DI bf16x8 gfrag(const bf16* base, int ld, int r0, int k0, int lane) { return *(const bf16x8*)(base + (size_t)(r0 + (lane & 15)) * ld + k0 + 8 * (lane >> 4)); }
DI void gdn_local(Ctx& c, int l, int u) {
    { int t0_ = pg8::lane_id_hw(); asm volatile("" : "+v"(t0_)); c.lane = t0_; c.tid = c.wave * 64 + t0_; }
    const Params& p = *c.p; const bf16* Z = (const bf16*)(c.ws + WS_Z); const float* G32 = (const float*)(c.ws + WS_G32);
    const int chain = u / 68, cc = u % 68, g = chain >> 2, h = chain & 3, dir = g >> 1, b = g & 1;
    bf16* gA = (bf16*)(c.ws + WS_GDA) + (size_t)u * 16384; float* gB = (float*)(c.ws + WS_GDB) + (size_t)u * 16384; float* gU = (float*)(c.ws + WS_GDU) + (size_t)u * 8192;
    bf16* gW = (bf16*)(c.ws + WS_GDW) + (size_t)u * 8192; bf16* gAT = (bf16*)(c.ws + WS_GDAT) + (size_t)u * 4096; bf16* gQD = (bf16*)(c.ws + WS_GDQ) + (size_t)u * 8192;
    LAS bf16* sq = (LAS bf16*)c.lds; LAS bf16* sk = sq + 64 * 136; LAS bf16* skb = sk + 64 * 136; LAS bf16* uT = sq; LAS bf16* wT = uT + 128 * 72;
    LAS bf16* kdT = (LAS bf16*)(c.lds + 52224); LAS bf16* vbT = kdT + 128 * 72; LAS bf16* kbgT = vbT + 128 * 72;
    LAS float* Nf = (LAS float*)(c.lds + 107520); LAS bf16* Tm = (LAS bf16*)(c.lds + 124928); LAS float* sm = (LAS float*)(c.lds + 134144);
    LAS bf16* Nb21 = (LAS bf16*)(c.lds + 135424); LAS bf16* tscr = Nb21 + 1280;
    const int q = c.lane >> 4, r = c.lane & 15;
    __syncthreads();
    if (c.wave == 0) { const int row = scan_row(dir, b, cc * 64 + c.lane); const float a = G32[(size_t)row * 32 + 16 + dir * 8 + h], bb = G32[(size_t)row * 32 + 16 + dir * 8 + 4 + h];
        const float lg = -fexp(p.gd_a_log[l * 8 + dir * 4 + h]) * softplusf_(a + p.gd_dt_bias[l * 8 + dir * 4 + h]);
        const float gc = wave_scan_add(lg, c.lane); const float gl = rdlane63(gc);
        sm[c.lane] = gc; sm[64 + c.lane] = sigmoidf_(bb); sm[128 + c.lane] = fexp(gc); sm[192 + c.lane] = fexp(gl - gc); if (c.lane == 0) sm[256] = fexp(gl); }
    __syncthreads();
    if (c.tid < 384) { const float* cw = p.gd_conv + (size_t)l * 5 * 1536; const int sr = c.tid / 48, rr = c.tid % 48, mat = rr >> 4, ch = (rr & 15) * 8;
        const int row_first = scan_row(dir, b, cc * 64); int sbase, slen, tp0; seq_of(row_first, sbase, slen, tp0);
        const int rj0 = row_first + (dir ? -(sr * 8) : sr * 8); const int lo = dir ? rj0 - 7 : rj0;
        u32x4 xin[12]; float wv[5][8];
#pragma unroll
        for (int m = 0; m < 12; ++m) { const int row = lo - 2 + m; const bool ok = row >= sbase && row < sbase + slen;
            xin[m] = ok ? *(const u32x4*)(Z + (size_t)row * NZ + GDQ + mat * 512 + h * 128 + ch) : (u32x4){0u, 0u, 0u, 0u}; }
#pragma unroll
        for (int j = 0; j < 5; ++j) ldf8(cw + j * 1536 + mat * 512 + h * 128 + ch, wv[j]);
#pragma unroll
        for (int m = 0; m < 8; ++m) { const int s = sr * 8 + (dir ? 7 - m : m);
            float acc[8];
#pragma unroll
            for (int i = 0; i < 8; ++i) acc[i] = 0.f;
#pragma unroll
            for (int j = 0; j < 5; ++j) { const u32x4 a = xin[m + j];
#pragma unroll
                for (int i = 0; i < 4; ++i) { acc[2 * i] = fmaf(__uint_as_float(a[i] << 16), wv[j][2 * i], acc[2 * i]); acc[2 * i + 1] = fmaf(__uint_as_float(a[i] & 0xffff0000u), wv[j][2 * i + 1], acc[2 * i + 1]); } }
            float ss = 0.f;
#pragma unroll
            for (int i = 0; i < 8; ++i) { acc[i] = siluf_(acc[i]); ss += acc[i] * acc[i]; }
            ss = grp_sum<16>(ss);
            const float be = sm[64 + s], egc = sm[128 + s], ekd = sm[192 + s];
            if (mat == 0) { const float sc = rsqrtf(ss + 1e-6f) * QSC; float o[8], o2[8];
#pragma unroll
                for (int i = 0; i < 8; ++i) { o[i] = acc[i] * sc; o2[i] = o[i] * egc; }
                *(LAS u32x4*)(sq + s * 136 + ch) = pack8(o); st8(gQD + s * 128 + ch, o2); }
            else if (mat == 1) { const float sc = rsqrtf(ss + 1e-6f); float o[8], ob[8];
#pragma unroll
                for (int i = 0; i < 8; ++i) { o[i] = acc[i] * sc; ob[i] = o[i] * be; }
                *(LAS u32x4*)(sk + s * 136 + ch) = pack8(o); *(LAS u32x4*)(skb + s * 136 + ch) = pack8(ob);
#pragma unroll
                for (int i = 0; i < 8; ++i) { kdT[(ch + i) * 72 + s] = (bf16)f2bf(o[i] * ekd); kbgT[(ch + i) * 72 + s] = (bf16)f2bf(ob[i] * egc); } }
            else {
#pragma unroll
                for (int i = 0; i < 8; ++i) vbT[(ch + i) * 72 + s] = (bf16)f2bf(acc[i] * be); } } }
    __syncthreads();
#pragma unroll
    for (int j = 0; j < 2; ++j) { const int ti = 2 * c.wave + j, mt = ti >> 2, nt = ti & 3;
        { const f32x4 a = mm_tile<128>(skb, 136, 16 * mt, sk, 136, 16 * nt, c.lane, (f32x4){0.f, 0.f, 0.f, 0.f}); const int s = 16 * nt + r; const float gs = sm[s];
#pragma unroll
          for (int i = 0; i < 4; ++i) { const int t = 16 * mt + 4 * q + i; const float nv = (s < t) ? a[i] * fexp(sm[t] - gs) : 0.f; Nf[t * 68 + s] = nv; if (mt >= 2 && nt < 2) Nb21[(t - 32) * 40 + s] = (bf16)f2bf(nv); } }
        { const f32x4 a = mm_tile<128>(sk, 136, 16 * nt, sq, 136, 16 * mt, c.lane, (f32x4){0.f, 0.f, 0.f, 0.f}); const int t = 16 * mt + r; const float gt = sm[t]; float d[4];
#pragma unroll
          for (int i = 0; i < 4; ++i) { const int s = 16 * nt + 4 * q + i; d[i] = (s <= t) ? a[i] * fexp(gt - sm[s]) : 0.f; }
          u32x2 w; w.x = pk2(d[0], d[1]); w.y = pk2(d[2], d[3]); *(u32x2*)(gAT + t * 64 + 16 * nt + 4 * q) = w; } }
    __syncthreads();
    if (c.wave == 0) tri_inverse64(Nf, Nb21, Tm, tscr, c.lane);
    __syncthreads();
    int lz = c.lane; asm volatile("" : "+v"(lz)); c.lane = lz;
    { const int q = lz >> 4, r = lz & 15; const int mt = c.wave & 3;
#pragma unroll
      for (int j = 0; j < 4; ++j) { const int nt = (c.wave >> 2) * 4 + j;
        const f32x4 au = mm_tile<64>(Tm, 72, 16 * mt, vbT, 72, 16 * nt, c.lane, (f32x4){0.f, 0.f, 0.f, 0.f});
        { u32x2 w; w.x = pk2(au[0], au[1]); w.y = pk2(au[2], au[3]); *(LAS u32x2*)(uT + (16 * nt + r) * 72 + 16 * mt + 4 * q) = w; *(f32x4*)(gU + (16 * nt + r) * 64 + 16 * mt + 4 * q) = au; }
        const f32x4 aw = mm_tile<64>(Tm, 72, 16 * mt, kbgT, 72, 16 * nt, c.lane, (f32x4){0.f, 0.f, 0.f, 0.f});
        { u32x2 w; w.x = pk2(aw[0], aw[1]); w.y = pk2(aw[2], aw[3]); *(LAS u32x2*)(wT + (16 * nt + r) * 72 + 16 * mt + 4 * q) = w; }
        const f32x4 aw2 = mm_tile<64>(kbgT, 72, 16 * nt, Tm, 72, 16 * mt, c.lane, (f32x4){0.f, 0.f, 0.f, 0.f});
        { u32x2 w; w.x = pk2(aw2[0], aw2[1]); w.y = pk2(aw2[2], aw2[3]); *(u32x2*)(gW + (16 * mt + r) * 128 + 16 * nt + 4 * q) = w; } } }
    __syncthreads();
    { const int q = lz >> 4, r = lz & 15; const float egl = sm[256]; const int yt = c.wave;
#pragma unroll
      for (int xt = 0; xt < 8; ++xt) {
        const f32x4 a = mm_tile<64>(wT, 72, 16 * xt, kdT, 72, 16 * yt, c.lane, (f32x4){0.f, 0.f, 0.f, 0.f}); const int d = 16 * yt + r; float v[4];
#pragma unroll
        for (int i = 0; i < 4; ++i) v[i] = ((16 * xt + 4 * q + i) == d ? egl : 0.f) - a[i];
        u32x2 w; w.x = pk2(v[0], v[1]); w.y = pk2(v[2], v[3]); *(u32x2*)(gA + ((yt * 4 + (xt >> 1)) * 64 + (2 * (xt & 1) + (q >> 1)) * 16 + r) * 8 + 4 * (q & 1)) = w;
        const f32x4 bq = mm_tile<64>(kdT, 72, 16 * xt, uT, 72, 16 * yt, c.lane, (f32x4){0.f, 0.f, 0.f, 0.f});
        { u32x2 wb; wb.x = pk2(bq[0], bq[1]); wb.y = pk2(bq[2], bq[3]); *(u32x2*)((bf16*)gB + ((yt * 8 + xt) * 64 + 16 * q + r) * 4) = wb; } } }
}
template <int N, int PD, bool SWZ = false> DI void affine_prefix(Ctx& c, const bf16* gA, const float* gB, bf16* gS, int sl) {
    constexpr int NN = N * N, KS = N / 32, LD = N + 8; const int w = c.wave, q = c.lane >> 4, r = c.lane & 15;
    static_assert((67 - 1) % PD == 0, "67 steps = whole trips of PD + one peeled step");
    LAS bf16* ST = (LAS bf16*)c.lds;
    __syncthreads();
    if (w < N / 16) {
        { unsigned z0 = 0u; asm volatile("" : "+v"(z0)); const u32x2 z = {z0, z0};     *(LAS u32x2*)(ST + r * LD + 16 * w + 4 * q) = z; if (!SWZ) *(u32x2*)(gS + (size_t)(16 * sl + r) * N + 16 * w + 4 * q) = z; }
        bf16x8 a[PD][KS]; f32x4 B[PD]; u32x2 Bh[PD]; constexpr bool BH = SWZ;
        bf16* pfs = gS + (size_t)(16 * sl + 2 * w + (c.lane >> 5)) * N + 4 * (c.lane & 31);
        const bf16* pbh = (const bf16*)gB + ((size_t)(sl * (N / 16) + w) * 64 + c.lane) * 4;
        constexpr int KOFF = SWZ ? 512 : 32;
        const bf16* pa = SWZ ? gA + ((size_t)(w * KS) * 64 + c.lane) * 8 : gA + (size_t)(16 * w + r) * N + 8 * q; const float* pb = SWZ ? gB + ((size_t)(sl * (N / 16) + w) * 64 + c.lane) * 4 : gB + (size_t)(16 * sl + r) * N + 16 * w + 4 * q; bf16* ps = gS + (size_t)(16 * sl + r) * N + 16 * w + 4 * q;
#pragma unroll
        for (int s = 0; s < PD; ++s) {
#pragma unroll
            for (int kk = 0; kk < KS; ++kk) a[s][kk] = *(const bf16x8*)(pa + (size_t)s * NN + KOFF * kk);
            if (BH) Bh[s] = *(const u32x2*)(pbh + (size_t)s * 2 * NN); else B[s] = *(const f32x4*)(pb + (size_t)s * NN); }
        asm volatile("s_waitcnt lgkmcnt(0)" ::: "memory"); __builtin_amdgcn_s_barrier(); asm volatile("" ::: "memory");
        for (int cc0 = 0; cc0 < 66; cc0 += PD) {
#pragma unroll
            for (int s = 0; s < PD; ++s) { const int cc = cc0 + s; const LAS bf16* Sr = ST + (s & 1) * (16 * LD); LAS bf16* Sw = ST + ((s + 1) & 1) * (16 * LD);
                f32x4 acc = BH ? (f32x4){__uint_as_float(Bh[s].x << 16), __uint_as_float(Bh[s].x & 0xffff0000u), __uint_as_float(Bh[s].y << 16), __uint_as_float(Bh[s].y & 0xffff0000u)} : B[s];
#pragma unroll
                for (int kk = 0; kk < KS; ++kk) acc = mfma16(a[s][kk], ldfrag(Sr, LD, 0, 32 * kk, c.lane), acc);
                asm volatile("" : "+v"(acc) :: "memory");
                { const size_t o = (size_t)(cc + PD) * NN;
#pragma unroll
                  for (int kk = 0; kk < KS; ++kk) a[s][kk] = *(const bf16x8*)(pa + o + KOFF * kk);
                  if (BH) Bh[s] = *(const u32x2*)(pbh + 2 * o); else B[s] = *(const f32x4*)(pb + o); }
                u32x2 wv; wv.x = pk2(acc[0], acc[1]); wv.y = pk2(acc[2], acc[3]);
                *(LAS u32x2*)(Sw + r * LD + 16 * w + 4 * q) = wv;
                if (SWZ) { const u32x2 t = *(const LAS u32x2*)(Sr + (2 * w + (c.lane >> 5)) * LD + 4 * (c.lane & 31)); *(u32x2*)(pfs + (size_t)cc * NN) = t; }
                else *(u32x2*)(ps + (size_t)(cc + 1) * NN) = wv;
                asm volatile("s_waitcnt lgkmcnt(0)" ::: "memory"); __builtin_amdgcn_s_barrier(); asm volatile("" ::: "memory"); } }
        {
            f32x4 acc = BH ? (f32x4){__uint_as_float(Bh[0].x << 16), __uint_as_float(Bh[0].x & 0xffff0000u), __uint_as_float(Bh[0].y << 16), __uint_as_float(Bh[0].y & 0xffff0000u)} : B[0];
#pragma unroll
            for (int kk = 0; kk < KS; ++kk) acc = mfma16(a[0][kk], ldfrag(ST, LD, 0, 32 * kk, c.lane), acc);
            u32x2 wv; wv.x = pk2(acc[0], acc[1]); wv.y = pk2(acc[2], acc[3]); *(u32x2*)(ps + (size_t)67 * NN) = wv;
            if (SWZ) { const u32x2 t = *(const LAS u32x2*)(ST + (2 * w + (c.lane >> 5)) * LD + 4 * (c.lane & 31)); *(u32x2*)(pfs + (size_t)66 * NN) = t; } }
    } else {
        asm volatile("" ::: "memory"); __builtin_amdgcn_s_barrier();
        for (int cc = 0; cc < 66; ++cc) { asm volatile("" ::: "memory"); __builtin_amdgcn_s_barrier(); }
    }
    __syncthreads();
}
DI void gdn_prefix(Ctx& c, int u2) { const int chain = (u2 & 7) + 8 * (u2 >> 6), sl = (u2 >> 3) & 7;
    affine_prefix<128, 6, true>(c, (const bf16*)(c.ws + WS_GDA) + (size_t)chain * 68 * 16384, (const float*)(c.ws + WS_GDB) + (size_t)chain * 68 * 16384, (bf16*)(c.ws + WS_GDS) + (size_t)chain * 68 * 16384, sl); }
DI void rwkv_prefix(Ctx& c, int u2) { const int chain = (u2 & 7) + 8 * (u2 >> 5), sl = (u2 >> 3) & 3;
    affine_prefix<64, 6>(c, (const bf16*)(c.ws + WS_RAC) + (size_t)chain * 68 * 4096, (const float*)(c.ws + WS_RBC) + (size_t)chain * 68 * 4096, (bf16*)(c.ws + WS_RPT) + (size_t)chain * 68 * 4096, sl); }
DI void gdn_out(Ctx& c, int l, int u) {
    const Params& p = *c.p; const bf16* Z = (const bf16*)(c.ws + WS_Z); bf16* Y = (bf16*)(c.ws + WS_Y);
    const int b = u / (4 * 68), h = (u / 68) & 3, tb = u % 68;
    LAS bf16* ST = (LAS bf16*)c.lds; LAS bf16* vnT = ST + 128 * 136; LAS float* hbuf = (LAS float*)(vnT + 128 * 72);
    const int q = c.lane >> 4, r = c.lane & 15; const int mt = c.wave & 3, ntb = (c.wave >> 2) * 4;
    for (int dir = 0; dir < 2; ++dir) {
        const int cc = dir == 0 ? tb : (tb < 4 ? 3 - tb : 71 - tb); const int chain = (dir * 2 + b) * 4 + h; const size_t un = (size_t)chain * 68 + cc;
        const bf16* gS = (const bf16*)(c.ws + WS_GDS) + un * 16384; const float* gU = (const float*)(c.ws + WS_GDU) + un * 8192; const bf16* gW = (const bf16*)(c.ws + WS_GDW) + un * 8192;
        const bf16* gAT = (const bf16*)(c.ws + WS_GDAT) + un * 4096; const bf16* gQD = (const bf16*)(c.ws + WS_GDQ) + un * 8192;
        __syncthreads();
        for (int it = c.tid; it < 128 * 16; it += 512) { const int e = it >> 4, ch = (it & 15) * 8; *(LAS u32x4*)(ST + e * 136 + ch) = *(const u32x4*)(gS + (size_t)e * 128 + ch); }
        bf16x8 wf[4], qf[4], af[2];
#pragma unroll
        for (int kk = 0; kk < 4; ++kk) { wf[kk] = gfrag(gW, 128, 16 * mt, 32 * kk, c.lane); qf[kk] = gfrag(gQD, 128, 16 * mt, 32 * kk, c.lane); }
#pragma unroll
        for (int kk = 0; kk < 2; ++kk) af[kk] = gfrag(gAT, 64, 16 * mt, 32 * kk, c.lane);
        __syncthreads();
#pragma unroll
        for (int j = 0; j < 4; ++j) { const int nt = ntb + j; f32x4 acc = {0.f, 0.f, 0.f, 0.f};
#pragma unroll
            for (int kk = 0; kk < 4; ++kk) acc = mfma16(wf[kk], ldfrag(ST, 136, 16 * nt, 32 * kk, c.lane), acc);
            const f32x4 uv = *(const f32x4*)(gU + (16 * nt + r) * 64 + 16 * mt + 4 * q); const f32x4 vn = uv - acc;
            u32x2 wv; wv.x = pk2(vn[0], vn[1]); wv.y = pk2(vn[2], vn[3]); *(LAS u32x2*)(vnT + (16 * nt + r) * 72 + 16 * mt + 4 * q) = wv; }
        __syncthreads();
        const int t = 16 * mt + r, tok = dir ? 63 - t : t;
#pragma unroll
        for (int j = 0; j < 4; ++j) { const int nt = ntb + j; f32x4 acc = {0.f, 0.f, 0.f, 0.f};
#pragma unroll
            for (int kk = 0; kk < 4; ++kk) acc = mfma16(ldfrag(ST, 136, 16 * nt, 32 * kk, c.lane), qf[kk], acc);
#pragma unroll
            for (int kk = 0; kk < 2; ++kk) acc = mfma16(ldfrag(vnT, 72, 16 * nt, 32 * kk, c.lane), af[kk], acc);
            LAS f32x4* hp = (LAS f32x4*)(hbuf + tok * 128 + 16 * nt + 4 * q); if (dir == 0) *hp = acc; else *hp += acc; }
    }
    __syncthreads();
    { const int tok = c.tid >> 3, eg = (c.tid & 7) * 16; const int row = (tb < 4 ? LAT + b * TC + tb * 64 : b * T + (tb - 4) * 64) + tok;
        float hv[16]; float ss = 0.f;
#pragma unroll
        for (int j = 0; j < 4; ++j) { const f32x4 x = *(const LAS f32x4*)(hbuf + tok * 128 + eg + 4 * j); hv[4 * j] = x[0]; hv[4 * j + 1] = x[1]; hv[4 * j + 2] = x[2]; hv[4 * j + 3] = x[3]; ss += (x[0] * x[0] + x[1] * x[1]) + (x[2] * x[2] + x[3] * x[3]); }
        ss = grp_sum<8>(ss); const float rs = rsqrtf(ss * (1.f / 128.f) + 1e-6f);
#pragma unroll
        for (int j = 0; j < 2; ++j) { float g[8], o[8], y[8]; ldf8(p.gd_norm_g + l * 512 + h * 128 + eg + 8 * j, g); ld8(Z + (size_t)row * NZ + GDZ + h * 128 + eg + 8 * j, o);
#pragma unroll
            for (int i = 0; i < 8; ++i) y[i] = hv[8 * j + i] * rs * g[i] * siluf_(o[i]);
            st8(Y + (size_t)row * D + 1024 + h * 128 + eg + 8 * j, y); } }
}


DI void rwkv_local(Ctx& c, int l, int u) {
    { int t0_ = pg8::lane_id_hw(); asm volatile("" : "+v"(t0_)); c.lane = t0_; c.tid = c.wave * 64 + t0_; }
    const Params& p = *c.p; const bf16* Z = (const bf16*)(c.ws + WS_Z); const float* mu = p.rw_mu + (size_t)l * 2 * RWMIX; const bf16* lw = (const bf16*)(c.ws + WS_W + WL_LORA);
    const int chain = u / 68, cc = u % 68, g = chain >> 3, h = chain & 7, dir = g >> 1, b = g & 1;
    bf16* gQE = (bf16*)(c.ws + WS_RQE) + (size_t)u * 4096; float* gYL = (float*)(c.ws + WS_RYL) + (size_t)u * 4096; bf16* gAC = (bf16*)(c.ws + WS_RAC) + (size_t)u * 4096; float* gBC = (float*)(c.ws + WS_RBC) + (size_t)u * 4096;
    LAS bf16* IM = (LAS bf16*)c.lds;
#define RIM(k) (IM + (k) * 4608)
    LAS bf16 *At = RIM(0), *Tm = RIM(0), *Bt = RIM(1), *X1T = RIM(1), *Kt = RIM(2), *AhT = RIM(2), *Rt = RIM(3), *AtT = RIM(4), *VT = RIM(5), *BhT = RIM(6), *KhT = RIM(7), *NAK = RIM(8), *SgT = RIM(8), *MBR = RIM(9), *MKR = RIM(10);
#undef RIM
    LAS float* Nf = (LAS float*)(c.lds + 101376); LAS float* seg = (LAS float*)(c.lds + 118784); LAS float* W63 = seg + 512;
    LAS bf16* Nb21 = (LAS bf16*)(c.lds + 121088); LAS bf16* tscr = Nb21 + 1280;
    LAS bf16* in = (LAS bf16*)c.lds; LAS bf16* wTw = in + 64 * 200; LAS bf16* wTa = wTw + 64 * 104; LAS float* Ldec = (LAS float*)(c.lds + 52224); LAS float* Lic = Ldec + 4096;
    const int q = c.lane >> 4, r = c.lane & 15; const int ch = c.tid & 63, tq = c.tid >> 6;
    const int row_first = scan_row(dir, b, cc * 64); int sbase, slen, tp0; seq_of(row_first, sbase, slen, tp0);
    float xr[10], xk[10], xv[10];
    const int rj0 = row_first + (dir ? -(tq * 8) : tq * 8); const int lo = dir ? rj0 - 7 : rj0; const int cz = h * 64 + ch;
#pragma unroll
    for (int m = 0; m < 10; ++m) { const int row = lo - 1 + m; const bool ok = row >= sbase && row < sbase + slen; const bf16* zp = Z + (size_t)row * NZ + RWR + cz;
        xr[m] = ok ? bf2f(zp[0]) : 0.f; xk[m] = ok ? bf2f(zp[512]) : 0.f; xv[m] = ok ? bf2f(zp[1024]) : 0.f; }
    const float mr0 = mu[cz], mr1 = mu[RWMIX + cz], mk0 = mu[512 + cz], mk1 = mu[RWMIX + 512 + cz], mv0 = mu[1024 + cz], mv1 = mu[RWMIX + 1024 + cz];
    const float kks = p.rw_kk[l * 512 + cz], kas = p.rw_ka[l * 512 + cz], rks = p.rw_rk[l * 512 + cz]; float* BON = (float*)(c.ws + WS_BON);
    const int pc0 = h * 64 + 16 * ((c.wave >> 2) * 2) + 4 * q;
    const f32x4 pw0 = *(const f32x4*)(p.rw_w0 + (l * 2 + dir) * 512 + pc0), pw1 = *(const f32x4*)(p.rw_w0 + (l * 2 + dir) * 512 + pc0 + 16);
    const f32x4 pa0 = *(const f32x4*)(p.rw_a0 + (l * 2 + dir) * 512 + pc0), pa1 = *(const f32x4*)(p.rw_a0 + (l * 2 + dir) * 512 + pc0 + 16);
    __syncthreads();
    for (int it = c.tid; it < 64 * 24; it += 512) { const int t = it / 24, k8 = it % 24; const int row = row_first + (dir ? -t : t); const int tp = row - sbase;
        const bf16* zp = Z + (size_t)row * NZ + RWXW + k8 * 8; float x[8], pv[8], nx[8], m0[8], m1[8], f[8];
        ld8(zp, x);
        if (tp > 0) ld8(zp - NZ, pv); else {
#pragma unroll
            for (int i = 0; i < 8; ++i) pv[i] = 0.f; }
        if (tp < slen - 1) ld8(zp + NZ, nx); else {
#pragma unroll
            for (int i = 0; i < 8; ++i) nx[i] = 0.f; }
        ldf8(mu + 1536 + k8 * 8, m0); ldf8(mu + RWMIX + 1536 + k8 * 8, m1);
#pragma unroll
        for (int i = 0; i < 8; ++i) { const float v = x[i] + m0[i] * (pv[i] - x[i]) + m1[i] * (nx[i] - x[i]); f[i] = k8 < 12 ? ftanh(v) : v; }
        *(LAS u32x4*)(in + t * 200 + k8 * 8) = pack8(f); }
    for (int it = c.tid; it < 2 * 64 * 12; it += 512) { const int m = it / 768, rr = it % 768, n = rr / 12, k8 = rr % 12;
        *(LAS u32x4*)((m ? wTa : wTw) + n * 104 + k8 * 8) = *(const u32x4*)(lw + (size_t)((m ? 2 : 0) + dir) * 512 * 96 + (size_t)(h * 64 + n) * 96 + k8 * 8); }
    float r8[8], kf8[8], v8[8];
#pragma unroll
    for (int j = 0; j < 8; ++j) { const int m = (dir ? 7 - j : j) + 1;
        r8[j] = xr[m] + mr0 * (xr[m - 1] - xr[m]) + mr1 * (xr[m + 1] - xr[m]); kf8[j] = xk[m] + mk0 * (xk[m - 1] - xk[m]) + mk1 * (xk[m + 1] - xk[m]); v8[j] = xv[m] + mv0 * (xv[m - 1] - xv[m]) + mv1 * (xv[m + 1] - xv[m]); }
    __syncthreads();
    { const int mt = c.wave & 3;
#pragma unroll
      for (int jj = 0; jj < 2; ++jj) { const int nt = (c.wave >> 2) * 2 + jj; f32x4 aw = {0.f, 0.f, 0.f, 0.f}, aa = aw;
#pragma unroll
        for (int kk = 0; kk < 3; ++kk) { aw = mfma16(ldfrag(wTw, 104, 16 * nt, 32 * kk, c.lane), ldfrag(in, 200, 16 * mt, 32 * kk, c.lane), aw); aa = mfma16(ldfrag(wTa, 104, 16 * nt, 32 * kk, c.lane), ldfrag(in + 96, 200, 16 * mt, 32 * kk, c.lane), aa); }
        const f32x4 w0 = jj ? pw1 : pw0, a0 = jj ? pa1 : pa0; f32x4 dv, iv;
#pragma unroll
        for (int i = 0; i < 4; ++i) { dv[i] = fexp(-fexp(-softplusf_(-(w0[i] + aw[i])) - 0.5f)); iv[i] = sigmoidf_(a0[i] + aa[i]); }
        *(LAS f32x4*)(Ldec + (16 * mt + r) * 64 + 16 * nt + 4 * q) = dv; *(LAS f32x4*)(Lic + (16 * mt + r) * 64 + 16 * nt + 4 * q) = iv; } }
    __syncthreads();
    {   float w8[8], k8[8], a8[8], b8[8];
#pragma unroll
        for (int j = 0; j < 8; ++j) { const float kf = kf8[j]; const float ic = Lic[(tq * 8 + j) * 64 + ch]; w8[j] = Ldec[(tq * 8 + j) * 64 + ch];
            const float kx = kf * kks; const float kkv = kx * rsqrtf(wave_sum(kx * kx) + 1e-6f);
            k8[j] = kf * (1.f + (ic - 1.f) * kas); a8[j] = -kkv; b8[j] = kkv * ic;
            const float bo = wave_sum(r8[j] * k8[j] * rks); if (c.lane == 0) BON[((size_t)dir * MROWS + (row_first + (dir ? -(tq * 8 + j) : (tq * 8 + j)))) * 8 + h] = bo; }
        __syncthreads();
#pragma unroll
        for (int j = 1; j < 8; ++j) w8[j] *= w8[j - 1];
        seg[tq * 64 + ch] = w8[7];
        __syncthreads();
        float pre = 1.f, tot = 1.f;
#pragma unroll
        for (int s = 0; s < 8; ++s) { const float sv = seg[s * 64 + ch]; if (s < tq) pre *= sv; tot *= sv; }
        if (tq == 0) W63[ch] = tot;
        float aT[8], bhT[8], khT[8];
#pragma unroll
        for (int j = 0; j < 8; ++j) { const float winc = pre * w8[j], wexc = j ? pre * w8[j - 1] : pre; const float iw = 1.f / winc; const int t = tq * 8 + j;
            const float at = a8[j] * wexc, bt = b8[j] * iw, kt = k8[j] * iw, rt = r8[j] * winc;
            At[t * 72 + ch] = (bf16)f2bf(at); Bt[t * 72 + ch] = (bf16)f2bf(bt); Kt[t * 72 + ch] = (bf16)f2bf(kt); Rt[t * 72 + ch] = (bf16)f2bf(rt);
            aT[j] = at; bhT[j] = bt * tot; khT[j] = kt * tot; }
        *(LAS u32x4*)(AtT + ch * 72 + tq * 8) = pack8(aT); *(LAS u32x4*)(VT + ch * 72 + tq * 8) = pack8(v8); *(LAS u32x4*)(BhT + ch * 72 + tq * 8) = pack8(bhT); *(LAS u32x4*)(KhT + ch * 72 + tq * 8) = pack8(khT);
    }
    __syncthreads();
#pragma unroll
    for (int jj = 0; jj < 2; ++jj) { const int ti = 2 * c.wave + jj, mt = ti >> 2, nt = ti & 3; const int t = 16 * mt + r, j0 = 16 * nt + 4 * q; const f32x4 z4 = {0.f, 0.f, 0.f, 0.f};
        const f32x4 p1 = mm_tile<64>(Bt, 72, 16 * nt, At, 72, 16 * mt, c.lane, z4), p2 = mm_tile<64>(Kt, 72, 16 * nt, At, 72, 16 * mt, c.lane, z4);
        const f32x4 p3 = mm_tile<64>(Bt, 72, 16 * nt, Rt, 72, 16 * mt, c.lane, z4), p4 = mm_tile<64>(Kt, 72, 16 * nt, Rt, 72, 16 * mt, c.lane, z4);
        f32x4 n1; float d2[4], d3[4], d4[4];
#pragma unroll
        for (int i = 0; i < 4; ++i) { const bool lt = (j0 + i) < t, le = (j0 + i) <= t; n1[i] = lt ? -p1[i] : 0.f; d2[i] = lt ? p2[i] : 0.f; d3[i] = le ? p3[i] : 0.f; d4[i] = le ? p4[i] : 0.f; }
        *(LAS f32x4*)(Nf + t * 68 + j0) = n1;
        if (mt >= 2 && nt < 2) { u32x2 wn; wn.x = pk2(n1[0], n1[1]); wn.y = pk2(n1[2], n1[3]); *(LAS u32x2*)(Nb21 + (t - 32) * 40 + j0) = wn; }
        u32x2 w; w.x = pk2(d2[0], d2[1]); w.y = pk2(d2[2], d2[3]); *(LAS u32x2*)(NAK + t * 72 + j0) = w;
        w.x = pk2(d3[0], d3[1]); w.y = pk2(d3[2], d3[3]); *(LAS u32x2*)(MBR + t * 72 + j0) = w;
        w.x = pk2(d4[0], d4[1]); w.y = pk2(d4[2], d4[3]); *(LAS u32x2*)(MKR + t * 72 + j0) = w; }
    __syncthreads();
    if (c.wave == 0) tri_inverse64(Nf, Nb21, Tm, tscr, c.lane);
    else { for (int ti = c.wave - 1; ti < 16; ti += 7) { const int mt = ti >> 2, nt = ti & 3;
            const f32x4 a = mm_tile<64>(NAK, 72, 16 * mt, VT, 72, 16 * nt, c.lane, (f32x4){0.f, 0.f, 0.f, 0.f});
            u32x2 w; w.x = pk2(a[0], a[1]); w.y = pk2(a[2], a[3]); *(LAS u32x2*)(X1T + (16 * nt + r) * 72 + 16 * mt + 4 * q) = w; } }
    __syncthreads();
    int lz = c.lane; asm volatile("" : "+v"(lz)); c.lane = lz;
    { const int q = lz >> 4, r = lz & 15;
#pragma unroll
    for (int jj = 0; jj < 2; ++jj) { const int ti = 2 * c.wave + jj, mt = ti >> 2, nt = ti & 3; const f32x4 z4 = {0.f, 0.f, 0.f, 0.f};
        const f32x4 a = mm_tile<64>(Tm, 72, 16 * mt, AtT, 72, 16 * nt, c.lane, z4), s = mm_tile<64>(Tm, 72, 16 * mt, X1T, 72, 16 * nt, c.lane, z4);
        u32x2 w; w.x = pk2(a[0], a[1]); w.y = pk2(a[2], a[3]); *(LAS u32x2*)(AhT + (16 * nt + r) * 72 + 16 * mt + 4 * q) = w;
        w.x = pk2(s[0], s[1]); w.y = pk2(s[2], s[3]); *(LAS u32x2*)(SgT + (16 * nt + r) * 72 + 16 * mt + 4 * q) = w; } }
    __syncthreads();
    int lz2 = c.lane; asm volatile("" : "+v"(lz2)); c.lane = lz2;
    { const int q = lz2 >> 4, r = lz2 & 15;
#pragma unroll
    for (int jj = 0; jj < 2; ++jj) { const int ti = 2 * c.wave + jj, xt = ti >> 2, yt = ti & 3; const int x0 = 16 * xt + 4 * q, yr = 16 * yt + r; const f32x4 z4 = {0.f, 0.f, 0.f, 0.f};
        { f32x4 a = mm_tile<64>(AhT, 72, 16 * xt, MBR, 72, 16 * yt, c.lane, z4); const u32x2 rw = *(const LAS u32x2*)(Rt + yr * 72 + x0);
          a[0] += __uint_as_float(rw.x << 16); a[1] += __uint_as_float(rw.x & 0xffff0000u); a[2] += __uint_as_float(rw.y << 16); a[3] += __uint_as_float(rw.y & 0xffff0000u);
          u32x2 w; w.x = pk2(a[0], a[1]); w.y = pk2(a[2], a[3]); *(u32x2*)(gQE + yr * 64 + x0) = w; }
        { f32x4 a = mm_tile<64>(SgT, 72, 16 * xt, MBR, 72, 16 * yt, c.lane, z4); a = mm_tile<64>(VT, 72, 16 * xt, MKR, 72, 16 * yt, c.lane, a); *(f32x4*)(gYL + yr * 64 + x0) = a; }
        { f32x4 a = mm_tile<64>(AhT, 72, 16 * xt, BhT, 72, 16 * yt, c.lane, z4); const float wd = W63[yr];
#pragma unroll
          for (int i = 0; i < 4; ++i) if (x0 + i == yr) a[i] += wd;
          u32x2 w; w.x = pk2(a[0], a[1]); w.y = pk2(a[2], a[3]); *(u32x2*)(gAC + yr * 64 + x0) = w; }
        { f32x4 a = mm_tile<64>(BhT, 72, 16 * xt, SgT, 72, 16 * yt, c.lane, z4); a = mm_tile<64>(KhT, 72, 16 * xt, VT, 72, 16 * yt, c.lane, a); *(f32x4*)(gBC + yr * 64 + x0) = a; } } }
}
DI void rwkv_out(Ctx& c, int l, int u) {
    const Params& p = *c.p; bf16* Y = (bf16*)(c.ws + WS_Y); const bf16* Z = (const bf16*)(c.ws + WS_Z); const float* SA = (const float*)(c.ws + WS_S); const size_t AS = (size_t)MROWS * 512;
    const int b = u / 136, rem = u % 136, tb = rem >> 1, hg = rem & 1; const int hl = c.wave & 3, dir = c.wave >> 2, head = hg * 4 + hl;
    LAS float* hbuf = (LAS float*)c.lds;
    const int q = c.lane >> 4, r = c.lane & 15;
    __syncthreads();
    { const int cc = dir == 0 ? tb : (tb < 4 ? 3 - tb : 71 - tb); const int chain = (dir * 2 + b) * 8 + head; const size_t un = (size_t)chain * 68 + cc;
      const bf16* gQE = (const bf16*)(c.ws + WS_RQE) + un * 4096; const float* gYL = (const float*)(c.ws + WS_RYL) + un * 4096; const bf16* gPT = (const bf16*)(c.ws + WS_RPT) + un * 4096;
      bf16x8 pf[4][2];
#pragma unroll
      for (int it = 0; it < 4; ++it)
#pragma unroll
          for (int kk = 0; kk < 2; ++kk) pf[it][kk] = gfrag(gPT, 64, 16 * it, 32 * kk, c.lane);
#pragma unroll
      for (int mt = 0; mt < 4; ++mt) { const bf16x8 q0 = gfrag(gQE, 64, 16 * mt, 0, c.lane), q1 = gfrag(gQE, 64, 16 * mt, 32, c.lane); const int t = 16 * mt + r, tok = dir ? 63 - t : t;
#pragma unroll
          for (int it = 0; it < 4; ++it) { f32x4 acc = *(const f32x4*)(gYL + t * 64 + 16 * it + 4 * q); acc = mfma16(pf[it][0], q0, acc); acc = mfma16(pf[it][1], q1, acc);
              *(LAS f32x4*)(hbuf + ((dir * 4 + hl) * 64 + tok) * 64 + 16 * it + 4 * q) = acc; } } }
    __syncthreads();
    { const int pr = c.tid >> 1, hf = c.tid & 1, h2 = pr >> 6, tok = pr & 63, hd = hg * 4 + h2; const int row = (tb < 4 ? LAT + b * TC + tb * 64 : b * T + (tb - 4) * 64) + tok;
      float y[32]; float s = 0.f;
#pragma unroll
      for (int j = 0; j < 8; ++j) { const f32x4 a = *(const LAS f32x4*)(hbuf + (h2 * 64 + tok) * 64 + hf * 32 + 4 * j), bq = *(const LAS f32x4*)(hbuf + ((4 + h2) * 64 + tok) * 64 + hf * 32 + 4 * j);
#pragma unroll
          for (int i = 0; i < 4; ++i) { y[4 * j + i] = a[i] + bq[i]; s += y[4 * j + i]; } }
      s += shx<1>(s); const float mean = s * (1.f / 64.f); float qq = 0.f;
#pragma unroll
      for (int i = 0; i < 32; ++i) { y[i] -= mean; qq += y[i] * y[i]; }
      qq += shx<1>(qq); const float rs = rsqrtf(qq * (1.f / 64.f) + 64e-5f);
      const int cb = hd * 64 + hf * 32; int bases, lens, tps; seq_of(row, bases, lens, tps); const float* BON = (const float*)(c.ws + WS_BON);
      const float bonus = BON[(size_t)row * 8 + hd] + BON[((size_t)MROWS + row) * 8 + hd]; const float* mu = p.rw_mu + (size_t)l * 2 * RWMIX;
#pragma unroll
      for (int j = 0; j < 4; ++j) { float g[8], bb[8], ax[8], gg[8], o[8]; ldf8(p.rw_ln_g + l * 512 + cb + 8 * j, g); ldf8(p.rw_ln_b + l * 512 + cb + 8 * j, bb);
          { float x[8], pv[8], nx[8], m0[8], m1[8]; const bf16* zp = Z + (size_t)row * NZ + RWV + cb + 8 * j; ld8(zp, x);
            if (tps > 0) ld8(zp - NZ, pv); else {
#pragma unroll
                for (int i = 0; i < 8; ++i) pv[i] = 0.f; }
            if (tps < lens - 1) ld8(zp + NZ, nx); else {
#pragma unroll
                for (int i = 0; i < 8; ++i) nx[i] = 0.f; }
            ldf8(mu + 1024 + cb + 8 * j, m0); ldf8(mu + RWMIX + 1024 + cb + 8 * j, m1);
#pragma unroll
            for (int i = 0; i < 8; ++i) ax[i] = bonus * (x[i] + m0[i] * (pv[i] - x[i]) + m1[i] * (nx[i] - x[i])); }
          ldf8(SA + SA_RG * AS + (size_t)row * 512 + cb + 8 * j, gg);
#pragma unroll
          for (int i = 0; i < 8; ++i) o[i] = (y[8 * j + i] * rs * g[i] + bb[i] + ax[i]) * gg[i];
          st8(Y + (size_t)row * D + 1536 + cb + 8 * j, o); } }
}

DI float rw_feat(const bf16* Z, const float* mu, int row, int cz) {
    int base, len, t; seq_of(row, base, len, t); const bf16* zp = Z + (size_t)row * NZ + RWR + cz;
    const float x = bf2f(zp[0]); const float pv = t > 0 ? bf2f(zp[-NZ]) : 0.f; const float nx = t < len - 1 ? bf2f(zp[NZ]) : 0.f;
    return x + mu[cz] * (pv - x) + mu[RWMIX + cz] * (nx - x);
}
DI void ld4(const bf16* p, float (&o)[4]) { const u32x2 w = *(const u32x2*)p; o[0] = __uint_as_float(w.x << 16); o[1] = __uint_as_float(w.x & 0xffff0000u); o[2] = __uint_as_float(w.y << 16); o[3] = __uint_as_float(w.y & 0xffff0000u); }
DI void rw_feat4(const bf16* Z, const float* mu, int row, int tpos, int len, int cz, float (&f)[4]) {
    const bf16* zp = Z + (size_t)row * NZ + RWR + cz; float x[4], pv[4] = {0.f, 0.f, 0.f, 0.f}, nx[4] = {0.f, 0.f, 0.f, 0.f}; ld4(zp, x); if (tpos > 0) ld4(zp - NZ, pv); if (tpos < len - 1) ld4(zp + NZ, nx);
    const f32x4 m0 = *(const f32x4*)(mu + cz), m1 = *(const f32x4*)(mu + RWMIX + cz);
#pragma unroll
    for (int i = 0; i < 4; ++i) f[i] = x[i] + m0[i] * (pv[i] - x[i]) + m1[i] * (nx[i] - x[i]);
}
DI void conv_unit(Ctx& c, int l, int u) {
    { int t0_ = pg8::lane_id_hw(); asm volatile("" : "+v"(t0_)); c.lane = t0_; c.tid = c.wave * 64 + t0_; }
    const Params& p = *c.p; const bf16* Z = (const bf16*)(c.ws + WS_Z); bf16* Y = (bf16*)(c.ws + WS_Y);
    LAS bf16* ys = (LAS bf16*)c.lds; LAS bf16* wq = ys + 64 * 520;
    const int r0 = 34 * u - 15;
    __syncthreads();
    for (int it = c.tid; it < 64 * 64; it += 512) { const int cg = it & 63, rr = it >> 6; const int grow = r0 + rr; float y[8];
        if (grow >= 0 && grow < MROWS) { float a[8], g[8]; ld8(Z + (size_t)grow * NZ + ZA + cg * 8, a); ld8(Z + (size_t)grow * NZ + ZAG + cg * 8, g);
#pragma unroll
            for (int i = 0; i < 8; ++i) y[i] = a[i] * sigmoidf_(g[i]); }
        else {
#pragma unroll
            for (int i = 0; i < 8; ++i) y[i] = 0.f; }
        *(LAS u32x4*)(ys + rr * 520 + cg * 8) = pack8(y); }
    for (int it = c.tid; it < 31 * 64; it += 512) { float w8[8]; ldf8(p.conv_dw + (size_t)l * 31 * 512 + it * 8, w8); *(LAS u32x4*)(wq + it * 8) = pack8(w8); }
    __syncthreads();
    const int ch = c.lane * 8;
    for (int tl = c.wave; tl < 34; tl += 8) { const int row = 34 * u + tl; int base, len, t; seq_of(row, base, len, t);
        float acc[8];
#pragma unroll
        for (int i = 0; i < 8; ++i) acc[i] = 0.f;
#pragma unroll
        for (int j = 0; j < 31; ++j) { const int tt = t + j - 15; if (tt < 0 || tt >= len) continue;
            const u32x4 yv = *(const LAS u32x4*)(ys + (tl + j) * 520 + ch), wv = *(const LAS u32x4*)(wq + j * 512 + ch);
#pragma unroll
            for (int i = 0; i < 4; ++i) { acc[2 * i] = fmaf(__uint_as_float(yv[i] << 16), __uint_as_float(wv[i] << 16), acc[2 * i]); acc[2 * i + 1] = fmaf(__uint_as_float(yv[i] & 0xffff0000u), __uint_as_float(wv[i] & 0xffff0000u), acc[2 * i + 1]); } }
        float bv[8]; ldf8(p.conv_b + l * 512 + ch, bv); float s = 0.f;
#pragma unroll
        for (int i = 0; i < 8; ++i) { acc[i] += bv[i]; s += acc[i]; }
        const float mean = wave_sum(s) * (1.f / 512.f); float qv = 0.f;
#pragma unroll
        for (int i = 0; i < 8; ++i) { acc[i] -= mean; qv += acc[i] * acc[i]; }
        const float rstd = rsqrtf(wave_sum(qv) * (1.f / 512.f) + 1e-6f);
        float lg[8], lb[8], o[8]; ldf8(p.conv_ln_g + l * 512 + ch, lg); ldf8(p.conv_ln_b + l * 512 + ch, lb);
#pragma unroll
        for (int i = 0; i < 8; ++i) o[i] = siluf_(acc[i] * rstd * lg[i] + lb[i]);
        st8(Y + (size_t)row * D + ch, o); }
}
DI void phase_prep(Ctx& c, int l) {
    const Params& p = *c.p; const bf16* Z = (const bf16*)(c.ws + WS_Z); bf16* Y = (bf16*)(c.ws + WS_Y); const float* G32 = (const float*)(c.ws + WS_G32);
    float* SA = (float*)(c.ws + WS_S); float* SG = (float*)(c.ws + WS_SG);
    const int gw = c.bid * 8 + c.wave, NGW = c.G * 8; const int ch = c.lane * 8;
    { const float* mu = p.rw_mu + (size_t)l * 2 * RWMIX; bf16* XG = (bf16*)(c.ws + WS_XG);
      for (int it = c.bid * 512 + c.tid; it < MROWS * 32; it += c.G * 512) { const int row = it >> 5, k8 = it & 31; int base, len, tp; seq_of(row, base, len, tp);
        const bf16* zp = Z + (size_t)row * NZ + RWXG + k8 * 8; float x[8], pv[8], nx[8], m0[8], m1[8], f[8]; ld8(zp, x);
        if (tp > 0) ld8(zp - NZ, pv); else {
#pragma unroll
            for (int i = 0; i < 8; ++i) pv[i] = 0.f; }
        if (tp < len - 1) ld8(zp + NZ, nx); else {
#pragma unroll
            for (int i = 0; i < 8; ++i) nx[i] = 0.f; }
        ldf8(mu + 1728 + k8 * 8, m0); ldf8(mu + RWMIX + 1728 + k8 * 8, m1);
#pragma unroll
        for (int i = 0; i < 8; ++i) f[i] = sigmoidf_(x[i] + m0[i] * (pv[i] - x[i]) + m1[i] * (nx[i] - x[i]));
        st8(XG + (size_t)row * 256 + k8 * 8, f); } }
    REPS(6) for (int u = (c.bid + c.G - 128) % c.G; u < RW_NU; u += c.G) rwkv_local(c, l, u);
    __syncthreads();
    REPS(2) for (int u = c.bid; u < ML_NU; u += c.G) mlstm_local(c, l, u);
    REPS(3) for (int u = (c.bid + c.G - 64) % c.G; u < GD_NU; u += c.G) gdn_local(c, l, u);
    __syncthreads();
}


DI void phase_mid(Ctx& c, int l) {
    REPS(4) mlstm_prefix(c);
    REPS(5) { for (int u = c.bid; u < 128; u += c.G) gdn_prefix(c, u);
              for (int u = c.bid - 128; u < 128; u += c.G) if (u >= 0) rwkv_prefix(c, u); }
    if (c.G == 256) { if (c.bid >= 128) for (int u = c.bid - 128; u < MROWS / 34; u += 128) conv_unit(c, l, u); }
    else for (int u = c.bid; u < MROWS / 34; u += c.G) conv_unit(c, l, u);
    __syncthreads();
}
DI void phase_finish(Ctx& c, int l) {
    if (l == NL - 1) {
        for (int v = c.bid; v < NB * 4 * 64; v += c.G) mlstm_out(c, l, (v >> 8) * 272 + ((v >> 6) & 3) * 68 + 4 + (v & 63));
        for (int v = c.bid; v < NB * 4 * 64; v += c.G) gdn_out(c, l, (v >> 8) * 272 + ((v >> 6) & 3) * 68 + 4 + (v & 63));
        for (int v = c.bid; v < NB * 64 * 2; v += c.G) rwkv_out(c, l, (v >> 7) * 136 + (4 + ((v & 127) >> 1)) * 2 + (v & 1));
        __syncthreads(); return; }
    REPS(7) for (int u = c.bid; u < NB * 4 * 68; u += c.G) mlstm_out(c, l, u);
    REPS(8) for (int u = (c.bid + c.G - 32) % c.G; u < NB * 4 * 68; u += c.G) gdn_out(c, l, u);
    REPS(9) for (int u = (c.bid + c.G - 64) % c.G; u < NB * 68 * 2; u += c.G) rwkv_out(c, l, u);
    __syncthreads();
}
DI void phase_ffnconv(Ctx& c, int l) {
    const Params& p = *c.p; const bf16* UP = (const bf16*)(c.ws + WS_Z); bf16* H = (bf16*)(c.ws + WS_S); const float* w = p.ffn_dw + (size_t)l * 9 * DFF;
    constexpr int CPR = DFF / 8;
    for (int it = c.bid * 512 + c.tid; it < NB * 4 * 64 * CPR; it += c.G * 512) {
        const int cg = it % CPR; int r1 = it / CPR; const int gx = r1 & 63; r1 >>= 6; const int seg = r1 & 3, bb = r1 >> 2; const int ch = cg * 8, gy0 = seg * 16;
        u32x4 wv[9];
#pragma unroll
        for (int k = 0; k < 9; ++k) { float t8[8]; ldf8(w + k * DFF + ch, t8); wv[k] = pack8(t8); }
        const bf16* base = UP + (size_t)bb * T * (2 * DFF) + ch; const u32x4 z4 = {0u, 0u, 0u, 0u};
        u32x4 ring[6][3], vr[4];
#define FC_ROW(slot, j) do { const int yy = gy0 - 1 + (j); _Pragma("unroll") for (int dx = 0; dx < 3; ++dx) { const int xx = gx + dx - 1; \
            ring[slot][dx] = (yy >= 0 && yy < 64 && xx >= 0 && xx < 64) ? *(const u32x4*)(base + (size_t)(yy * 64 + xx) * (2 * DFF)) : z4; } } while (0)
#define FC_V(slot, dy_) do { vr[slot] = *(const u32x4*)(UP + ((size_t)bb * T + (gy0 + (dy_)) * 64 + gx) * (2 * DFF) + DFF + ch); } while (0)
        FC_ROW(0, 0); FC_ROW(1, 1); FC_ROW(2, 2); FC_ROW(3, 3); FC_ROW(4, 4); FC_V(0, 0); FC_V(1, 1); FC_V(2, 2);
#pragma unroll
        for (int dy = 0; dy < 16; ++dy) {
            if (dy + 5 < 18) FC_ROW((dy + 5) % 6, dy + 5);
            if (dy + 3 < 16) FC_V((dy + 3) % 4, dy + 3);
            const size_t row = (size_t)bb * T + (gy0 + dy) * 64 + gx; float acc[8];
#pragma unroll
            for (int i = 0; i < 8; ++i) acc[i] = 0.f;
#pragma unroll
            for (int k = 0; k < 3; ++k)
#pragma unroll
                for (int dx = 0; dx < 3; ++dx) { const u32x4 a = ring[(dy + k) % 6][dx];
#pragma unroll
                    for (int j = 0; j < 4; ++j) { const unsigned ww = wv[k * 3 + dx][j]; acc[2 * j] = fmaf(__uint_as_float(a[j] << 16), __uint_as_float(ww << 16), acc[2 * j]); acc[2 * j + 1] = fmaf(__uint_as_float(a[j] & 0xffff0000u), __uint_as_float(ww & 0xffff0000u), acc[2 * j + 1]); } }
            const u32x4 vw = vr[dy % 4]; float o[8];
#pragma unroll
            for (int j = 0; j < 4; ++j) { o[2 * j] = gelu_tanh(acc[2 * j]) * __uint_as_float(vw[j] << 16); o[2 * j + 1] = gelu_tanh(acc[2 * j + 1]) * __uint_as_float(vw[j] & 0xffff0000u); }
            st8(H + row * DFF + ch, o); asm volatile("" ::: "memory"); }
#undef FC_ROW
#undef FC_V
    }
    if (l < NL - 1) for (int it = c.bid * 512 + c.tid; it < NB * TC * CPR; it += c.G * 512) {
        const int row = LAT + it / CPR, ch = (it % CPR) * 8; float acc[8];
#pragma unroll
        for (int i = 0; i < 8; ++i) acc[i] = 0.f;
        const int t = (row - LAT) & (TC - 1);
#pragma unroll
        for (int dx = 0; dx < 3; ++dx) { const int tt = t + dx - 1; if (tt < 0 || tt >= TC) continue;
            float a[8], wv[8]; ld8(UP + (size_t)(row + dx - 1) * (2 * DFF) + ch, a); ldf8(w + (3 + dx) * DFF + ch, wv);
#pragma unroll
            for (int i = 0; i < 8; ++i) acc[i] = fmaf(a[i], wv[i], acc[i]); }
        float v[8], o[8]; ld8(UP + (size_t)row * (2 * DFF) + DFF + ch, v);
#pragma unroll
        for (int i = 0; i < 8; ++i) o[i] = gelu_tanh(acc[i]) * v[i];
        st8(H + (size_t)row * DFF + ch, o);
    }
}

constexpr int PH_PRO = 3, PH_PER_LAYER = 11, NPHASE = PH_PRO + NL * PH_PER_LAYER;
#ifndef MK_PER_PHASE
#define MK_PER_PHASE 0
#endif
#ifndef DUP_MASK
#define DUP_MASK 0u
#endif
#define REP(ty) for (int rep_ = 0; rep_ < ((((DUP_MASK) >> (ty)) & 1u) ? 2 : 1); ++rep_)
#ifndef PROBE_MASK
#define PROBE_MASK 0u
#endif
constexpr int CW_BAR = 4096;

__global__ void __launch_bounds__(512, 2) fwd_kernel(Params p) {
    extern __shared__ __attribute__((aligned(16))) unsigned char lds_raw[];
    Ctx c; c.lds = (LAS unsigned char*)lds_raw; c.tid = threadIdx.x; c.lane = c.tid & 63; c.wave = __builtin_amdgcn_readfirstlane(c.tid >> 6); asm volatile("" : "+s"(c.wave));     c.G = gridDim.x; c.bid = blockIdx.x; c.p = &p; c.ws = p.ws;
    volatile LAS unsigned* MISC = (volatile LAS unsigned*)(c.lds + LDS_MISC);
    if (c.tid < 32) MISC[c.tid] = 0u;
    __syncthreads();
    const int lo = MK_PER_PHASE ? p.ph_lo : 0, hi = MK_PER_PHASE ? p.ph_hi : NPHASE;
    XcdBarrier bar; bar.bar = (unsigned*)(p.ws + WS_CTL) + CW_BAR; bar.x = 0; bar.st = MISC + 8;
    if (hi - lo > 1) bar = xcd_barrier_post((unsigned*)(p.ws + WS_CTL) + CW_BAR, MISC + 8);
#ifndef PH_MASK
#define PH_MASK 0xFFFFFFFFu
#endif
#define IN(k) (lo <= (k) && (k) < hi)
#define EN(b) ((PH_MASK >> (b)) & 1u)
#define RF() do { asm volatile("" : "+s"(c.wave)); int t_ = pg8::lane_id_hw(); c.lane = t_; c.tid = c.wave * 64 + t_; int b_ = blockIdx.x; asm volatile("" : "+s"(b_)); c.bid = b_; unsigned long long w_ = (unsigned long long)p.ws; asm volatile("" : "+s"(w_)); c.ws = (unsigned char*)(GAS unsigned char*)w_; } while (0)
#define SEAM(k) do { if (IN((k) + 1)) xcd_barrier(bar, c.wave); } while (0)
    unsigned long long tp_ = PROBE_MASK ? __builtin_amdgcn_s_memrealtime() : 0ull; unsigned pacc_ = 0u;
#define STAMP(ty) do { if (PROBE_MASK) { const unsigned long long tn_ = __builtin_amdgcn_s_memrealtime(); if ((PROBE_MASK >> (ty)) & 1u) pacc_ += (unsigned)(tn_ - tp_); tp_ = tn_; } } while (0)
    if (EN(0) && IN(0)) { REP(0) { RF(); phase_pro0(c); } SEAM(0); STAMP(0); }
    if (EN(1) && IN(1)) { REP(1) { RF(); phase_pro1(c); } SEAM(1); STAMP(1); }
    if (EN(2) && IN(2)) { REP(2) { RF(); phase_pro2(c); phase_wconv(c, 0); } SEAM(2); STAMP(2); }
#define U ((bf16*)(c.ws + WS_U))
#define Y ((bf16*)(c.ws + WS_Y))
#define MB ((bf16*)(c.ws + WS_MB))
#define G32 ((float*)(c.ws + WS_G32))
#define F ((float*)(c.ws + WS_F))
#define Z ((bf16*)(c.ws + WS_Z))
#define H ((bf16*)(c.ws + WS_S))
    for (int l = 0; l < NL; ++l) {
        const int pb = PH_PRO + l * PH_PER_LAYER;
#define wl (c.ws + WS_W)
        if (EN(3) && IN(pb + 0)) { RF(); pg8::Gemm g{U, (const bf16*)(wl + WL_IN), D, D, D}; pg8::StdOrder S; S.init(MROWS / 256, NZ / 256, c.G, c.bid); pg8::EpiBf16 E{Z, NZ, G32, (ZSM - 192) / 256, (bf16*)(c.ws + WS_GT), ZG / 256};
            REP(3) pg8::gemm_phase(c.lds, g, S, E, c.wave); SEAM(pb + 0); STAMP(3); }
        if (EN(4) && IN(pb + 1)) { REP(4) { RF(); phase_prep(c, l); } SEAM(pb + 1); STAMP(4); }
        if (EN(5) && IN(pb + 2)) { REP(5) { RF(); phase_mid(c, l); }
            { RF(); pg8::Gemm g{(const bf16*)(c.ws + WS_XG), (const bf16*)(wl + WL_LORA) + (size_t)4 * 512 * 96, 256, 256, 256}; pg8::StdOrder S; S.init(MROWS / 256, 2, c.G, c.G - 1 - c.bid);
              pg8::EpiF32 E{(float*)(c.ws + WS_S) + (size_t)SA_RG * MROWS * 512, 512}; REPS(1) pg8::gemm_phase(c.lds, g, S, E, c.wave); }
            SEAM(pb + 2); STAMP(5); }
        if (EN(7) && IN(pb + 3)) { REP(7) { RF(); phase_finish(c, l); } SEAM(pb + 3); STAMP(7); }
        if (EN(8) && IN(pb + 4)) { RF(); pg8::Gemm g{Y, (const bf16*)(wl + WL_BR), D, MIXW, MIXW}; pg8::MergeOrder S; S.init2(c.G, c.bid, l < NL - 1); pg8::EpiMerge E{(const bf16*)(c.ws + WS_GT), MB, D, (bf16*)(c.ws + WS_MBC)};
            REP(8) pg8::gemm_phase(c.lds, g, S, E, c.wave); SEAM(pb + 4); STAMP(8); }
        if (EN(9) && IN(pb + 5)) { RF(); pg8::Gemm g{MB, (const bf16*)(wl + WL_OUT), D, D, D}; pg8::SplitOrder S; S.init2(D / 256, c.G, c.bid, l < NL - 1 ? 16 : 0, 512, (const bf16*)(c.ws + WS_MBC), 2048); pg8::EpiMixSplit E{(bf16*)F, (float*)(c.ws + WS_PART), D};
            REP(9) pg8::gemm_phase(c.lds, g, S, E, c.wave); SEAM(pb + 5); STAMP(9); }
        if (EN(10) && IN(pb + 6)) { REP(10) { RF(); phase_resid(c, l, 0); } SEAM(pb + 6); STAMP(10); }
        if (EN(11) && IN(pb + 7)) { RF(); pg8::Gemm g{U, (const bf16*)(wl + WL_UP), D, D, D}; pg8::StdOrder S; S.init(l < NL - 1 ? MROWS / 256 : LAT / 256, 2 * DFF / 256, c.G, c.bid); pg8::EpiBf16 E{Z, 2 * DFF, nullptr, -1, nullptr, 0};
            REP(11) pg8::gemm_phase(c.lds, g, S, E, c.wave); SEAM(pb + 7); STAMP(11); }
        if (EN(12) && IN(pb + 8)) { REP(12) { RF(); phase_ffnconv(c, l); } SEAM(pb + 8); STAMP(12); }
        if (EN(13) && IN(pb + 9)) { RF(); pg8::Gemm g{H, (const bf16*)(wl + WL_DN), DFF, DFF, DFF}; pg8::SplitOrder S; S.init2(D / 256, c.G, c.bid, l < NL - 1 ? 11 : 0, 512); pg8::EpiMixSplit E{(bf16*)F, (float*)(c.ws + WS_PART), D};
            REP(13) pg8::gemm_phase(c.lds, g, S, E, c.wave); SEAM(pb + 9); STAMP(13); }
        if (EN(14) && IN(pb + 10)) { REP(14) { RF(); phase_resid(c, l, 1); if (l + 1 < NL) phase_wconv(c, l + 1); } SEAM(pb + 10); STAMP(14); }
    }
    if (PROBE_MASK) { asm volatile("s_waitcnt vmcnt(0)" ::: "memory"); __syncthreads(); if (c.bid == 0 && threadIdx.x == 0) p.out[0] += (float)pacc_ * 1e-4f;     }
#undef IN
#undef SEAM
#undef U
#undef Y
#undef MB
#undef G32
#undef F
#undef Z
#undef H
#undef wl
}

extern "C" void kernel_launch(void* const* d_in, const int* in_sizes, int n_in, void* d_out, int out_size, void* d_ws, size_t ws_size, hipStream_t stream) {
    static int grid = 0;
    if (grid == 0) {
        if (n_in != 34 || ws_size < WS_END) { fprintf(stderr, "kernel_launch: unexpected n_in %d / ws %zu (need %zu)\n", n_in, ws_size, (size_t)WS_END); grid = -1; return; }
        int dev = 0, cus = 0;
        if (hipGetDevice(&dev) != hipSuccess || hipDeviceGetAttribute(&cus, hipDeviceAttributeMultiprocessorCount, dev) != hipSuccess) { grid = -1; return; }
        if (hipFuncSetAttribute((const void*)fwd_kernel, hipFuncAttributeMaxDynamicSharedMemorySize, LDS_BYTES) != hipSuccess) { fprintf(stderr, "kernel_launch: hipFuncSetAttribute failed\n"); grid = -1; return; }
        int per_cu = 0;
        if (hipOccupancyMaxActiveBlocksPerMultiprocessor(&per_cu, (const void*)fwd_kernel, 512, LDS_BYTES) != hipSuccess || per_cu < 1) { fprintf(stderr, "kernel_launch: occupancy query says %d\n", per_cu); }
        (void)hipGetLastError();
        grid = cus;
    }
    if (grid < 0) return;
    (void)hipMemsetAsync((char*)d_ws + WS_CTL, 0, 32768, stream);
    Params p{};
    const float** pp = (const float**)&p;
    for (int i = 0; i < 34; ++i) pp[i] = (const float*)d_in[i];
    p.out = (float*)d_out; p.ws = (unsigned char*)d_ws;
#if MK_PER_PHASE
    for (int k = 0; k < NPHASE; ++k) { p.ph_lo = k; p.ph_hi = k + 1; hipLaunchKernelGGL(fwd_kernel, dim3(grid), dim3(512), LDS_BYTES, stream, p); }
#else
    p.ph_lo = 0; p.ph_hi = NPHASE; hipLaunchKernelGGL(fwd_kernel, dim3(grid), dim3(512), LDS_BYTES, stream, p);
#endif
}
```
